# Optimizing an MI355X kernel written in HIP

```python
import math
import jax, jax.numpy as jnp
from jax import lax
import numpy as np

D_MODEL = 1024
BATCH = 32
SEQ = 256
DEPTH = 4
DEC_BATCH = 4
DEC_SEQ = 1024
PAST_LEN = 512

GRID_W = 64
N_HEADS_A = 4
QK_NOPE = 128
QK_ROPE = 64
V_HEAD = 128
Q_LORA = 384
KV_LORA = 256
WIDTH_A = N_HEADS_A * V_HEAD
ROPE_THETA = 10000.0
WIDTH_B = 256
N_HEADS_B = 4
HEAD_B = WIDTH_B // N_HEADS_B
CHUNK = 128
WIDTH_C = 256
CONV_W = 3
D_FF = 4 * D_MODEL
MIX_WIDTH = WIDTH_A + WIDTH_B + WIDTH_C
IN_SPLITS = (Q_LORA, KV_LORA, QK_ROPE, WIDTH_B, WIDTH_B, WIDTH_C, WIDTH_C, WIDTH_C)
IN_COLS = Q_LORA + KV_LORA + QK_ROPE + 2 * WIDTH_B + 3 * WIDTH_C
N_MOD = 6
EPS = 1e-6

kernel_name = "hybrid_diffusion_prefix_trunk_step"


def rmsnorm(x, g):
    xf = x.astype(jnp.float32)
    y = xf * lax.rsqrt(jnp.mean(xf * xf, axis=-1, keepdims=True) + EPS)
    return (y * g.astype(jnp.float32)).astype(x.dtype)


def axial_rope_tables(n_tokens):
    rows = n_tokens // GRID_W
    row = jnp.repeat(jnp.arange(rows, dtype=jnp.float32), GRID_W)
    col = jnp.tile(jnp.arange(GRID_W, dtype=jnp.float32), rows)
    nf = QK_ROPE // 4
    inv = ROPE_THETA ** (-jnp.arange(nf, dtype=jnp.float32) / nf)
    ang = jnp.stack([row[:, None] * inv, col[:, None] * inv], axis=1)
    return jnp.cos(ang), jnp.sin(ang)


def apply_axial_rope(x, cos, sin):
    xs = x.astype(jnp.float32).reshape(x.shape[:-1] + (2, 2, QK_ROPE // 4))
    x1, x2 = xs[..., 0, :], xs[..., 1, :]
    out = jnp.stack([x1 * cos - x2 * sin, x1 * sin + x2 * cos], axis=-2)
    return out.reshape(x.shape).astype(x.dtype)


def split_projection(z):
    idx, acc = [], 0
    for s in IN_SPLITS[:-1]:
        acc += s
        idx.append(acc)
    return jnp.split(z, idx, axis=-1)


def modulation(cond, w_ada, b_ada):
    m = jax.nn.silu(cond) @ w_ada + b_ada
    return jnp.split(m[:, None, :], N_MOD, axis=-1)


def mla_queries(q_c, g_q, w_uq):
    q = jnp.einsum('bnr,rhd->bhnd', rmsnorm(q_c, g_q), w_uq)
    return q[..., :QK_NOPE], q[..., QK_NOPE:]


def mla_keys_values(ckv, w_ukv):
    kv = jnp.einsum('blr,rhd->bhld', ckv, w_ukv)
    return kv[..., :QK_NOPE], kv[..., QK_NOPE:]


def mla_attend(q_nope, q_rope, k_nope, k_rope, v):
    b, _, n, _ = q_nope.shape
    scale = 1.0 / math.sqrt(QK_NOPE + QK_ROPE)
    s = (jnp.einsum('bhnd,bhld->bhnl', q_nope, k_nope)
         + jnp.einsum('bhnd,bld->bhnl', q_rope, k_rope)) * scale
    p = jax.nn.softmax(s.astype(jnp.float32), axis=-1).astype(v.dtype)
    o = jnp.einsum('bhnl,bhld->bnhd', p, v)
    return o.reshape(b, n, WIDTH_A)


def chunk_gmlp(u, v, g_v, w_s, b_s):
    b, n, _ = v.shape
    vn = rmsnorm(v, g_v).reshape(b, n // CHUNK, CHUNK, N_HEADS_B, HEAD_B)
    mixed = jnp.einsum('hpq,bcqhd->bcphd', w_s, vn) + b_s.T[None, None, :, :, None]
    return u * mixed.reshape(b, n, WIDTH_B)


def short_conv(bg, cg, hh, w_conv):
    n = hh.shape[1]
    z = cg * hh
    pad = CONV_W // 2
    zp = jnp.pad(z, ((0, 0), (pad, pad), (0, 0)))
    y = zp[:, 0:n] * w_conv[0]
    for k in range(1, CONV_W):
        y = y + zp[:, k:k + n] * w_conv[k]
    return bg * y


def trunk_layer(x, cond, ctx_ckv, ctx_krope, rope,
                w_ada, b_ada, g_pre_mix, w_in, g_q, w_uq, g_kv, w_ukv,
                g_v, w_s, b_s, w_conv, w_out, g_post_mix,
                g_pre_ffn, w_ff1, w_ff2, g_post_ffn):
    sh1, sc1, ga1, sh2, sc2, ga2 = modulation(cond, w_ada, b_ada)
    h = rmsnorm(x, g_pre_mix) * (1.0 + sc1) + sh1
    q_c, ckv_raw, kr, u, v, bg, cg, hh = split_projection(h @ w_in)
    u = jax.nn.gelu(u)
    v = jax.nn.gelu(v)
    ckv = rmsnorm(ckv_raw, g_kv)
    q_nope, q_rope = mla_queries(q_c, g_q, w_uq)
    k_nope, v_a = mla_keys_values(ckv, w_ukv)
    if ctx_ckv is None:
        o_a = mla_attend(q_nope, q_rope, k_nope, kr, v_a)
    else:
        cos, sin = rope
        q_rope = apply_axial_rope(q_rope, cos, sin)
        kr_lat = apply_axial_rope(kr, cos, sin)
        kc_nope, vc = mla_keys_values(ctx_ckv, w_ukv)
        o_a = mla_attend(q_nope, q_rope,
                         jnp.concatenate([kc_nope, k_nope], axis=2),
                         jnp.concatenate([ctx_krope, kr_lat], axis=1),
                         jnp.concatenate([vc, v_a], axis=2))
    o_b = chunk_gmlp(u, v, g_v, w_s, b_s)
    o_c = short_conv(bg, cg, hh, w_conv)
    mix = jnp.concatenate([o_a, o_b, o_c], axis=-1) @ w_out
    x = x + ga1 * rmsnorm(mix, g_post_mix)
    h2 = rmsnorm(x, g_pre_ffn) * (1.0 + sc2) + sh2
    f = jnp.square(jax.nn.relu(h2 @ w_ff1)) @ w_ff2
    x = x + ga2 * rmsnorm(f, g_post_ffn)
    return x, ckv, kr


def setup_inputs(seed: int = 0) -> dict:
    key = jax.random.key(seed)
    ks = jax.random.split(key, 24)
    f32 = jnp.float32

    def nrm(k, shape, scale):
        return jax.random.normal(k, shape, f32) * scale

    def gain(k, shape):
        return 1.0 + 0.02 * jax.random.normal(k, shape, f32)

    return {
        "x_prompt": nrm(ks[0], (BATCH, SEQ, D_MODEL), 1.0),
        "x_sample": nrm(ks[1], (DEC_BATCH, DEC_SEQ, D_MODEL), 1.0),
        "cache_ckv": nrm(ks[2], (DEC_BATCH, DEPTH, PAST_LEN, KV_LORA), 1.0),
        "cache_krope": nrm(ks[3], (DEC_BATCH, DEPTH, PAST_LEN, QK_ROPE), 1.0),
        "c": nrm(ks[4], (DEC_BATCH, D_MODEL), 1.0),
        "c_ctx": nrm(ks[5], (D_MODEL,), 1.0),
        "w_ada": nrm(ks[6], (DEPTH, D_MODEL, N_MOD * D_MODEL), 0.5 * D_MODEL ** -0.5),
        "b_ada": nrm(ks[7], (DEPTH, N_MOD * D_MODEL), 0.02),
        "g_pre_mix": gain(ks[8], (DEPTH, D_MODEL)),
        "w_in": nrm(ks[9], (DEPTH, D_MODEL, IN_COLS), D_MODEL ** -0.5),
        "g_q": gain(ks[10], (DEPTH, Q_LORA)),
        "w_uq": nrm(ks[11], (DEPTH, Q_LORA, N_HEADS_A, QK_NOPE + QK_ROPE), Q_LORA ** -0.5),
        "g_kv": gain(ks[12], (DEPTH, KV_LORA)),
        "w_ukv": nrm(ks[13], (DEPTH, KV_LORA, N_HEADS_A, QK_NOPE + V_HEAD), KV_LORA ** -0.5),
        "g_v": gain(ks[14], (DEPTH, WIDTH_B)),
        "w_s": nrm(ks[15], (DEPTH, N_HEADS_B, CHUNK, CHUNK), CHUNK ** -0.5),
        "b_s": 1.0 + nrm(ks[16], (DEPTH, N_HEADS_B, CHUNK), 0.02),
        "w_conv": nrm(ks[17], (DEPTH, CONV_W, WIDTH_C), CONV_W ** -0.5),
        "w_out": nrm(ks[18], (DEPTH, MIX_WIDTH, D_MODEL), MIX_WIDTH ** -0.5),
        "g_post_mix": gain(ks[19], (DEPTH, D_MODEL)),
        "g_pre_ffn": gain(ks[20], (DEPTH, D_MODEL)),
        "w_ff1": nrm(ks[21], (DEPTH, D_MODEL, D_FF), D_MODEL ** -0.5),
        "w_ff2": nrm(ks[22], (DEPTH, D_FF, D_MODEL), D_FF ** -0.5),
        "g_post_ffn": gain(ks[23], (DEPTH, D_MODEL)),
    }


def reference(x_prompt, x_sample, cache_ckv, cache_krope, c, c_ctx,
              w_ada, b_ada, g_pre_mix, w_in, g_q, w_uq, g_kv, w_ukv,
              g_v, w_s, b_s, w_conv, w_out, g_post_mix,
              g_pre_ffn, w_ff1, w_ff2, g_post_ffn):
    rope = axial_rope_tables(x_sample.shape[1])
    cond_ctx = c_ctx[None, :]
    xp, xs = x_prompt, x_sample
    ckv_list, kr_list = [], []
    for l in range(DEPTH):
        layer_w = (w_ada[l], b_ada[l], g_pre_mix[l], w_in[l], g_q[l], w_uq[l], g_kv[l], w_ukv[l],
                   g_v[l], w_s[l], b_s[l], w_conv[l], w_out[l], g_post_mix[l],
                   g_pre_ffn[l], w_ff1[l], w_ff2[l], g_post_ffn[l])
        xp, ckv_l, kr_l = trunk_layer(xp, cond_ctx, None, None, None, *layer_w)
        ckv_list.append(ckv_l)
        kr_list.append(kr_l)
        xs, _, _ = trunk_layer(xs, c, cache_ckv[:, l], cache_krope[:, l], rope, *layer_w)
    new_ckv = jnp.stack(ckv_list, axis=1)
    new_krope = jnp.stack(kr_list, axis=1)
    return (xp, xs, new_ckv, new_krope)
```

```cpp
#include <hip/hip_runtime.h>
#include <hip/hip_cooperative_groups.h>
#include <cstdio>
namespace cg = cooperative_groups;

#ifndef MK_PER_PHASE
#define MK_PER_PHASE 0
#endif

#define LAS __attribute__((address_space(3)))
typedef unsigned short bf16;
typedef short bf16x8 __attribute__((ext_vector_type(8)));
typedef float f32x2 __attribute__((ext_vector_type(2)));
typedef float f32x4 __attribute__((ext_vector_type(4)));
typedef float f32x16 __attribute__((ext_vector_type(16)));
typedef unsigned u32x2 __attribute__((ext_vector_type(2)));
typedef unsigned u32x4 __attribute__((ext_vector_type(4)));

constexpr int DM = 1024, NTOK_P = 8192, NTOK_S = 4096, NTOK = 12288, NROWKV = 14336;
constexpr int DEPTH = 4, INC = 1984, DFF = 4096;
constexpr int ZQ = 0, ZCKV = 384, ZKR = 640, ZU = 704, ZV = 960, ZBG = 1216, ZCG = 1472, ZHH = 1728;
constexpr float EPS = 1e-6f;
constexpr float QSCALE = 0.07216878364870322f * 1.4426950408889634f;

constexpr size_t MiB = 1u << 20;
constexpr size_t WS_MOD = 0, WS_ROPE = 1 * MiB, WS_WIN = 2 * MiB, WS_WUQ = 18 * MiB, WS_WUKV = 21 * MiB, WS_WOUT = 23 * MiB,
                 WS_WFF1 = 31 * MiB, WS_WFF2 = 63 * MiB, WS_H = 95 * MiB, WS_MIX = 119 * MiB, WS_CONCAT = 167 * MiB, WS_QN = 191 * MiB,
                 WS_CKVN = 200 * MiB, WS_KRB = 207 * MiB, WS_UG = 209 * MiB, WS_VN = 215 * MiB, WS_Q = 221 * MiB, WS_KNOPE = 239 * MiB,
                 WS_VTP = 253 * MiB, WS_VTS = 261 * MiB, WS_Z = 267 * MiB, WS_ACT = 267 * MiB, WS_END = 363 * MiB;
constexpr int LDS_BYTES = 147456;

__device__ __forceinline__ unsigned cvt_pk_bf16(float lo, float hi) { unsigned r; asm volatile("v_cvt_pk_bf16_f32 %0, %1, %2" : "=v"(r) : "v"(lo), "v"(hi)); return r; }
__device__ __forceinline__ int fresh_lane() { int l; asm volatile("v_mbcnt_lo_u32_b32 %0, -1, 0\n\tv_mbcnt_hi_u32_b32 %0, -1, %0" : "=v"(l)); return l; }
__device__ __forceinline__ float shx(float v, int mask, int lane) { return __int_as_float(__builtin_amdgcn_ds_bpermute((lane ^ mask) << 2, __float_as_int(v))); }
__device__ __forceinline__ float wave_sum(float v, int lane) {
#pragma unroll
    for (int o = 1; o < 64; o <<= 1) v += shx(v, o, lane);
    return v;
}
__device__ __forceinline__ float gelu_tanh(float x) { const float y = 0.7978845608028654f * (x + 0.044715f * x * x * x); return x / (1.0f + __expf(-2.0f * y)); }
__device__ __forceinline__ f32x4 gelu4(f32x4 v) { return (f32x4){gelu_tanh(v.x), gelu_tanh(v.y), gelu_tanh(v.z), gelu_tanh(v.w)}; }
__device__ __forceinline__ float sumsq4(f32x4 v) { return (v.x * v.x + v.y * v.y) + (v.z * v.z + v.w * v.w); }
__device__ __forceinline__ u32x2 pk4(f32x4 v) { u32x2 w; w.x = cvt_pk_bf16(v.x, v.y); w.y = cvt_pk_bf16(v.z, v.w); return w; }

namespace pg8 {
#define PG8_LAS __attribute__((address_space(3)))
typedef unsigned short bf16_t;
constexpr int BM = 256, BK = 64, HALF = 128, HTB = HALF * BK * 2, STAGE_BYTES = 8 * HTB, NXCD = 8, WGM = 8;
__host__ __device__ __forceinline__ int lds_byte(int r, int c) { const int st = (r >> 4) * 2 + (c >> 5), rr = r & 15, cc = c & 31, ob = rr * 64 + cc * 2; return st * 1024 + (ob ^ (((ob >> 9) & 1) << 5)); }
__host__ __device__ __forceinline__ void stage_rc(int b, int& R, int& C) { const int st = b / 1024, sb = b % 1024, swz = sb ^ (((sb >> 9) & 1) << 5); R = (st >> 1) * 16 + swz / 64; C = (st & 1) * 32 + (swz % 64) / 2; }
__host__ __device__ __forceinline__ int perm32(int rho) { const int n = rho >> 4, i = rho & 15; return 8 * (i >> 2) + 4 * n + (i & 3); }
struct Unit { int pm, pn; };
struct Gemm { const bf16_t* A; const bf16_t* Bt; int M, N, K; };
struct StaticOrder {
    int nM, nN, nwg, G, c;
    __host__ __device__ void init(int M, int N, int G_, int c_) { nM = M / BM; nN = N / BM; nwg = nM * nN; G = G_; c = c_; }
    __host__ __device__ bool next(int i, Unit& u) const {
        const long L = (long)i * G + c; if (L >= nwg) return false;
        int wgid = (int)L; { const int q = nwg / NXCD, r = nwg % NXCD, xcd = wgid % NXCD, off = wgid / NXCD; wgid = (xcd < r ? xcd * (q + 1) : r * (q + 1) + (xcd - r) * q) + off; }
        const int nig = WGM * nN, gid = wgid / nig, fm = gid * WGM, gsz = (nM - fm) < WGM ? (nM - fm) : WGM;
        u.pm = fm + ((wgid % nig) % gsz); u.pn = (wgid % nig) / gsz; return true;
    }
    __device__ __forceinline__ void a_ready(const Unit&) const {}
    __device__ __forceinline__ void done(const Unit&) const {}
};

template <class Epi, class Sched>
__device__ __forceinline__ void gemm_phase(PG8_LAS unsigned char* lds, const Gemm g, const Sched& S, const Epi& E, const int tid) {
    const int wid = __builtin_amdgcn_readfirstlane(tid >> 6), lane = tid & 63, wr = wid >> 2, wc = wid & 3, fr = lane & 15, fq = lane >> 4;
    const int K = g.K, nt = K / BK;
    unsigned voffA[2], voffB[2];
#pragma unroll
    for (int i = 0; i < 2; ++i) { int R, C; stage_rc(tid * 16 + i * 8192, R, C); const int Rb = Epi::PERM ? ((R & ~31) + perm32(R & 31)) : R;
        voffA[i] = (unsigned)(R * K + C) * 2u; voffB[i] = (unsigned)(Rb * K + C) * 2u; }
    const size_t kstep = (size_t)(BK * 2);
    const size_t hstep = (size_t)HALF * K * 2;
    const size_t tstep = 2 * hstep;
    const unsigned ldsw = (unsigned)wid * 1024u;
    const int aoff = lds_byte(wr * 64 + fr, fq * 8), boff = lds_byte(wc * 32 + fr, fq * 8);
#define PG8_SA(b, h) (((b) * 2 + (h)) * HTB)
#define PG8_SB(b, h) ((4 + (b) * 2 + (h)) * HTB)
#define PG8_STAGE(bufoff, gbase, voff) do { _Pragma("unroll") for (int _i = 0; _i < 2; ++_i) \
        __builtin_amdgcn_global_load_lds((const unsigned*)((const char*)(gbase) + (voff)[_i]), (PG8_LAS unsigned*)(lds + (bufoff) + ldsw + _i * 8192), 16, 0, 0); } while (0)
#define PG8_LDA(dst, b, h) do { _Pragma("unroll") for (int m = 0; m < 4; ++m) _Pragma("unroll") for (int k = 0; k < 2; ++k) dst[m][k] = *(const PG8_LAS bf16x8*)(lds + PG8_SA(b, h) + aoff + m * 2048 + k * 1024); } while (0)
#define PG8_LDB(dst, b, h) do { _Pragma("unroll") for (int n = 0; n < 2; ++n) _Pragma("unroll") for (int k = 0; k < 2; ++k) dst[n][k] = *(const PG8_LAS bf16x8*)(lds + PG8_SB(b, h) + boff + n * 2048 + k * 1024); } while (0)
#define PG8_MMA(ai, bj, At, Bt) do { __builtin_amdgcn_s_setprio(1); _Pragma("unroll") for (int m = 0; m < 4; ++m) _Pragma("unroll") for (int n = 0; n < 2; ++n) _Pragma("unroll") for (int k = 0; k < 2; ++k) \
        acc[ai][bj][m][n] = __builtin_amdgcn_mfma_f32_16x16x32_bf16(Bt[n][k], At[m][k], acc[ai][bj][m][n], 0, 0, 0); __builtin_amdgcn_s_setprio(0); } while (0)
#define PG8_WAIT_V(n) asm volatile("s_waitcnt vmcnt(" #n ")" ::: "memory")
#define PG8_WAIT_L(n) asm volatile("s_waitcnt lgkmcnt(" #n ")" ::: "memory")
#define PG8_BAR __builtin_amdgcn_s_barrier()
#define PG8_SCHED __builtin_amdgcn_sched_barrier(0)
    Unit cur, nxt; int ui = 0;
    if (!S.next(0, cur)) return;
    f32x4 acc[2][2][4][2];
#pragma unroll
    for (int a = 0; a < 2; ++a)
#pragma unroll
        for (int b = 0; b < 2; ++b)
#pragma unroll
            for (int m = 0; m < 4; ++m)
#pragma unroll
                for (int n = 0; n < 2; ++n) acc[a][b][m][n] = (f32x4){0.f, 0.f, 0.f, 0.f};
    bf16x8 At[4][2], B0[2][2], B1[2][2];
    const char* cA = (const char*)g.A + (size_t)cur.pm * tstep; const char* cB = (const char*)g.Bt + (size_t)cur.pn * tstep;
    S.a_ready(cur);
    PG8_STAGE(PG8_SB(0, 0), cB, voffB); PG8_STAGE(PG8_SA(0, 0), cA, voffA); PG8_STAGE(PG8_SB(0, 1), cB + hstep, voffB); PG8_STAGE(PG8_SA(0, 1), cA + hstep, voffA);
    if (wr == 1) PG8_BAR;
    PG8_WAIT_V(4); PG8_BAR;
    PG8_STAGE(PG8_SB(1, 0), cB + kstep, voffB); PG8_STAGE(PG8_SA(1, 0), cA + kstep, voffA); PG8_STAGE(PG8_SB(1, 1), cB + hstep + kstep, voffB);
    PG8_WAIT_V(6); PG8_BAR;
    for (;;) {
        const bool has_next = S.next(ui + 1, nxt);
        const char* nA = has_next ? (const char*)g.A + (size_t)nxt.pm * tstep : cA; const char* nB = has_next ? (const char*)g.Bt + (size_t)nxt.pn * tstep : cB;
        for (int t = 0; t < nt; t += 2) {
            const bool last = (t == nt - 2);
            const char* a1 = cA + (size_t)(t + 1) * kstep;
            const char* a2 = last ? nA : cA + (size_t)(t + 2) * kstep; const char* b2 = last ? nB : cB + (size_t)(t + 2) * kstep;
            const char* a3 = a2 + kstep; const char* b3 = b2 + kstep;
            if (last && has_next) S.a_ready(nxt);
            PG8_LDB(B0, 0, 0); PG8_SCHED; PG8_LDA(At, 0, 0); PG8_STAGE(PG8_SA(1, 1), a1 + hstep, voffA);
            PG8_WAIT_L(8); PG8_BAR; PG8_WAIT_L(0); PG8_MMA(0, 0, At, B0); PG8_BAR; PG8_SCHED;
            PG8_LDB(B1, 0, 1); PG8_STAGE(PG8_SB(0, 0), b2, voffB);
            PG8_BAR; PG8_WAIT_L(0); PG8_MMA(0, 1, At, B1); PG8_BAR;
            PG8_LDA(At, 0, 1); PG8_STAGE(PG8_SA(0, 0), a2, voffA);
            PG8_BAR; PG8_WAIT_L(0); PG8_MMA(1, 0, At, B0); PG8_BAR; PG8_SCHED;
            PG8_STAGE(PG8_SB(0, 1), b2 + hstep, voffB);
            PG8_WAIT_V(6); PG8_BAR; PG8_MMA(1, 1, At, B1); PG8_BAR;
            PG8_LDB(B0, 1, 0); PG8_SCHED; PG8_LDA(At, 1, 0); PG8_STAGE(PG8_SA(0, 1), a2 + hstep, voffA);
            PG8_WAIT_L(8); PG8_BAR; PG8_WAIT_L(0); PG8_MMA(0, 0, At, B0); PG8_BAR; PG8_SCHED;
            PG8_LDB(B1, 1, 1); PG8_STAGE(PG8_SB(1, 0), b3, voffB);
            PG8_BAR; PG8_WAIT_L(0); PG8_MMA(0, 1, At, B1); PG8_BAR;
            PG8_LDA(At, 1, 1); PG8_STAGE(PG8_SA(1, 0), a3, voffA);
            PG8_BAR; PG8_WAIT_L(0); PG8_MMA(1, 0, At, B0); PG8_BAR; PG8_SCHED;
            PG8_STAGE(PG8_SB(1, 1), b3 + hstep, voffB);
            PG8_WAIT_V(6); PG8_BAR; PG8_MMA(1, 1, At, B1); PG8_BAR;
        }
        E(acc, cur, wr, wc, fr, fq); S.done(cur);
        if (!has_next) break;
#pragma unroll
        for (int a = 0; a < 2; ++a)
#pragma unroll
            for (int b = 0; b < 2; ++b)
#pragma unroll
                for (int m = 0; m < 4; ++m)
#pragma unroll
                    for (int n = 0; n < 2; ++n) acc[a][b][m][n] = (f32x4){0.f, 0.f, 0.f, 0.f};
        cur = nxt; cA = nA; cB = nB; ++ui;
    }
    PG8_WAIT_V(0);
    if (wr == 0) PG8_BAR;
    PG8_BAR;
#undef PG8_SA
#undef PG8_SB
#undef PG8_STAGE
#undef PG8_LDA
#undef PG8_LDB
#undef PG8_MMA
#undef PG8_WAIT_V
#undef PG8_WAIT_L
#undef PG8_BAR
#undef PG8_SCHED
}
}

struct EpiF32 {
    static constexpr bool PERM = false;
    float* C; int ldc; int ncols;
    __device__ __forceinline__ void operator()(const f32x4 (&acc)[2][2][4][2], const pg8::Unit& u, int wr, int wc, int fr, int fq) const {
        const int row0 = u.pm * 256 + wr * 64 + fr, col0 = u.pn * 256 + wc * 32 + 4 * fq;
#pragma unroll
        for (int ai = 0; ai < 2; ++ai)
#pragma unroll
            for (int m = 0; m < 4; ++m) { float* rowp = C + (size_t)(row0 + ai * 128 + m * 16) * ldc + col0;
#pragma unroll
                for (int bj = 0; bj < 2; ++bj)
#pragma unroll
                    for (int n = 0; n < 2; ++n) if (col0 + bj * 128 + n * 16 < ncols) *(f32x4*)(rowp + bj * 128 + n * 16) = acc[ai][bj][m][n]; }
    }
};
struct EpiAct {
    static constexpr bool PERM = true;
    bf16* O; int ldc;
    __device__ __forceinline__ void operator()(const f32x4 (&acc)[2][2][4][2], const pg8::Unit& u, int wr, int wc, int fr, int fq) const {
        const int row0 = u.pm * 256 + wr * 64 + fr, col0 = u.pn * 256 + wc * 32 + 8 * fq;
#pragma unroll
        for (int ai = 0; ai < 2; ++ai)
#pragma unroll
            for (int m = 0; m < 4; ++m) { bf16* rowp = O + (size_t)(row0 + ai * 128 + m * 16) * ldc + col0;
#pragma unroll
                for (int bj = 0; bj < 2; ++bj) { f32x4 v0 = acc[ai][bj][m][0], v1 = acc[ai][bj][m][1];
#pragma unroll
                    for (int j = 0; j < 4; ++j) { const float a = fmaxf(v0[j], 0.f), b = fmaxf(v1[j], 0.f); v0[j] = a * a; v1[j] = b * b; }
                    u32x4 w; w.x = cvt_pk_bf16(v0[0], v0[1]); w.y = cvt_pk_bf16(v0[2], v0[3]); w.z = cvt_pk_bf16(v1[0], v1[1]); w.w = cvt_pk_bf16(v1[2], v1[3]);
                    *(u32x4*)(rowp + bj * 128) = w; } }
    }
};
struct EpiQ {
    static constexpr bool PERM = false;
    bf16* Q; const float* ropec; const float* ropes;
    __device__ __forceinline__ void operator()(const f32x4 (&acc)[2][2][4][2], const pg8::Unit& u, int wr, int wc, int fr, int fq) const {
        const int row0 = u.pm * 256 + wr * 64 + fr; const bool sample = u.pm >= 32;
#pragma unroll
        for (int bj = 0; bj < 2; ++bj) {
            const int g0 = u.pn * 256 + bj * 128 + wc * 32, within0 = g0 % 192; const bool isrope = within0 >= 128; const int a = (within0 - 128) >> 5;
#pragma unroll
            for (int ai = 0; ai < 2; ++ai)
#pragma unroll
                for (int m = 0; m < 4; ++m) { const int row = row0 + ai * 128 + m * 16;
                    f32x4 x1 = acc[ai][bj][m][0], x2 = acc[ai][bj][m][1];
                    if (sample && isrope) { const int ntok = (row - NTOK_P) & 1023;
                        const f32x4 cs = *(const f32x4*)(ropec + ntok * 32 + a * 16 + 4 * fq), sn = *(const f32x4*)(ropes + ntok * 32 + a * 16 + 4 * fq);
                        const f32x4 o1 = x1 * cs - x2 * sn, o2 = x1 * sn + x2 * cs; x1 = o1; x2 = o2; }
                    x1 = x1 * QSCALE; x2 = x2 * QSCALE;
                    bf16* p = Q + (size_t)row * 768 + g0 + 4 * fq;
                    *(u32x2*)p = pk4(x1); *(u32x2*)(p + 16) = pk4(x2); asm volatile("" ::: "memory"); }
        }
    }
};
struct EpiKV {
    static constexpr bool PERM = false;
    bf16* KN; bf16* VTP; bf16* VTS;
    __device__ __forceinline__ void operator()(const f32x4 (&acc)[2][2][4][2], const pg8::Unit& u, int wr, int wc, int fr, int fq) const {
        const int h = u.pn, pm = u.pm;
        bf16* vt; int keys, keybase;
        if (pm < 32) { vt = VTP + (size_t)((pm * 4 + h) * 128) * 256; keys = 256; keybase = 0; }
        else if (pm < 48) { const int b = (pm - 32) >> 2; vt = VTS + (size_t)((b * 4 + h) * 128) * 1536; keys = 1536; keybase = 512 + ((pm - 32) & 3) * 256; }
        else { const int b = (pm - 48) >> 1; vt = VTS + (size_t)((b * 4 + h) * 128) * 1536; keys = 1536; keybase = ((pm - 48) & 1) * 256; }
#pragma unroll
        for (int ai = 0; ai < 2; ++ai)
#pragma unroll
            for (int m = 0; m < 4; ++m) { const int rloc = wr * 64 + fr + ai * 128 + m * 16;
                bf16* kp = KN + (size_t)(pm * 256 + rloc) * 512 + h * 128 + wc * 32 + 4 * fq;
#pragma unroll
                for (int n = 0; n < 2; ++n) *(u32x2*)(kp + 16 * n) = pk4(acc[ai][0][m][n]);
#pragma unroll
                for (int n = 0; n < 2; ++n) { const f32x4 v = acc[ai][1][m][n]; const u32x2 w = pk4(v);
                    bf16* vp = vt + (size_t)(wc * 32 + 16 * n + 4 * fq) * keys + keybase + rloc;
                    vp[0] = (bf16)(w.x & 0xffffu); vp[keys] = (bf16)(w.x >> 16); vp[2 * keys] = (bf16)(w.y & 0xffffu); vp[3 * keys] = (bf16)(w.y >> 16); }
                asm volatile("" ::: "memory");
            }
    }
};

struct Args {
    const float *x_prompt, *x_sample, *cache_ckv, *cache_krope, *c, *c_ctx, *w_ada, *b_ada, *g_pre_mix, *w_in, *g_q, *w_uq, *g_kv, *w_ukv,
                *g_v, *w_s, *b_s, *w_conv, *w_out, *g_post_mix, *g_pre_ffn, *w_ff1, *w_ff2, *g_post_ffn;
    float* out; unsigned char* ws; int ph_lo, ph_hi;
};

__device__ __forceinline__ void p0_transpose_item(const float* W, int K, int N, bf16* WT, LAS float* scr, int item, int lane) {
    const int nblk = N / 32, kb = item / nblk, nb = item % nblk, k0 = 64 * kb, n0 = 32 * nb;
#pragma unroll 8
    for (int i = 0; i < 32; ++i) { const int kk = 2 * i + (lane >> 5); scr[kk * 33 + (lane & 31)] = W[(size_t)(k0 + kk) * N + n0 + (lane & 31)]; }
    asm volatile("s_waitcnt lgkmcnt(0)" ::: "memory");
    const int c = lane & 7;
#pragma unroll
    for (int j = 0; j < 4; ++j) { const int n = (lane >> 3) + 8 * j; const LAS float* s = scr + (8 * c) * 33 + n;
        u32x4 o; o.x = cvt_pk_bf16(s[0 * 33], s[1 * 33]); o.y = cvt_pk_bf16(s[2 * 33], s[3 * 33]); o.z = cvt_pk_bf16(s[4 * 33], s[5 * 33]); o.w = cvt_pk_bf16(s[6 * 33], s[7 * 33]);
        *(u32x4*)(WT + (size_t)(n0 + n) * K + k0 + 8 * c) = o; }
    asm volatile("s_waitcnt lgkmcnt(0)" ::: "memory");
}

__device__ __forceinline__ void phase_prologue(const Args& A, LAS unsigned char* lds, int wave) {
    const int lane = fresh_lane(), tid = wave * 64 + lane;
    unsigned char* ws = A.ws;
    const int bid = blockIdx.x, G = gridDim.x;
    { const int gt = bid * 512 + tid;
      if (gt < 32768) { const int n = gt >> 5, a = (gt >> 4) & 1, f = gt & 15; const int pos = a == 0 ? (n >> 6) : (n & 63);
          double inv = 1.0; for (int i = 0; i < f; ++i) inv *= 0.5623413251903491;
          double rev = (double)pos * inv * 0.15915494309189535; rev -= floor(rev);
          const float rf = (float)rev;
          ((float*)(ws + WS_ROPE))[gt] = __builtin_amdgcn_cosf(rf); ((float*)(ws + WS_ROPE))[32768 + gt] = __builtin_amdgcn_sinf(rf); } }
    for (int it = bid; it < 192; it += G) {
        const int l = it / 48, cgp = it % 48;
        LAS float* sl = (LAS float*)lds;
        for (int i = tid; i < 5120; i += 512) { const int ci = i >> 10, k = i & 1023; const float v = ci == 0 ? A.c_ctx[k] : A.c[(ci - 1) * 1024 + k]; sl[i] = v / (1.0f + __expf(-v)); }
        __syncthreads();
        float a0[5], a1[5];
#pragma unroll
        for (int ci = 0; ci < 5; ++ci) { a0[ci] = 0.f; a1[ci] = 0.f; }
        const float* wp = A.w_ada + ((size_t)l * 1024 + wave * 128) * 6144 + cgp * 128 + 2 * lane;
#pragma unroll 8
        for (int kk = 0; kk < 128; ++kk) { const f32x2 wv = *(const f32x2*)(wp + (size_t)kk * 6144); const int k = wave * 128 + kk;
#pragma unroll
            for (int ci = 0; ci < 5; ++ci) { const float s = sl[ci * 1024 + k]; a0[ci] += s * wv.x; a1[ci] += s * wv.y; } }
        LAS float* part = (LAS float*)(lds + 32768);
#pragma unroll
        for (int ci = 0; ci < 5; ++ci) { part[(wave * 5 + ci) * 128 + 2 * lane] = a0[ci]; part[(wave * 5 + ci) * 128 + 2 * lane + 1] = a1[ci]; }
        __syncthreads();
        for (int i = tid; i < 640; i += 512) { const int ci = i >> 7, col = i & 127; float s = 0.f;
#pragma unroll
            for (int w = 0; w < 8; ++w) s += part[(w * 5 + ci) * 128 + col];
            const int gcol = cgp * 128 + col; ((float*)(ws + WS_MOD))[(l * 5 + ci) * 6144 + gcol] = s + A.b_ada[l * 6144 + gcol]; }
        __syncthreads();
    }
    LAS float* scr = (LAS float*)(lds + wave * 16384);
    const int gw = bid * 8 + wave, NGW = G * 8;
    constexpr int I_IN = 16 * 62, I_UQ = 6 * 24, I_UKV = 4 * 32, I_OUT = 16 * 32, I_F1 = 16 * 128, I_F2 = 64 * 32, I_L = I_IN + I_UQ + I_UKV + I_OUT + I_F1 + I_F2;
    for (int it = gw; it < 4 * I_L; it += NGW) {
        const int l = it / I_L; int r = it % I_L;
        if (r < I_IN) { p0_transpose_item(A.w_in + (size_t)l * 1024 * INC, 1024, INC, (bf16*)(ws + WS_WIN) + (size_t)l * 2048 * 1024, scr, r, lane); continue; } r -= I_IN;
        if (r < I_UQ) { p0_transpose_item(A.w_uq + (size_t)l * 384 * 768, 384, 768, (bf16*)(ws + WS_WUQ) + (size_t)l * 768 * 384, scr, r, lane); continue; } r -= I_UQ;
        if (r < I_UKV) { p0_transpose_item(A.w_ukv + (size_t)l * 256 * 1024, 256, 1024, (bf16*)(ws + WS_WUKV) + (size_t)l * 1024 * 256, scr, r, lane); continue; } r -= I_UKV;
        if (r < I_OUT) { p0_transpose_item(A.w_out + (size_t)l * 1024 * 1024, 1024, 1024, (bf16*)(ws + WS_WOUT) + (size_t)l * 1024 * 1024, scr, r, lane); continue; } r -= I_OUT;
        if (r < I_F1) { p0_transpose_item(A.w_ff1 + (size_t)l * 1024 * 4096, 1024, 4096, (bf16*)(ws + WS_WFF1) + (size_t)l * 4096 * 1024, scr, r, lane); continue; } r -= I_F1;
        p0_transpose_item(A.w_ff2 + (size_t)l * 4096 * 1024, 4096, 1024, (bf16*)(ws + WS_WFF2) + (size_t)l * 1024 * 4096, scr, r, lane);
    }
}

__device__ __forceinline__ int cond_of_row(int r) { return r < NTOK_P ? 0 : 1 + ((r - NTOK_P) >> 10); }

__device__ __forceinline__ void norm_mod_store(const f32x4 (&v)[4], const float* g, const float* sc, const float* sh, bf16* hrow, int lane) {
    float ss = 0.f;
#pragma unroll
    for (int j = 0; j < 4; ++j) ss += sumsq4(v[j]);
    const float rstd = 1.0f / sqrtf(wave_sum(ss, lane) * (1.0f / 1024.0f) + EPS);
#pragma unroll
    for (int j = 0; j < 4; ++j) { const int idx = 4 * lane + 256 * j;
        const f32x4 gg = *(const f32x4*)(g + idx), s1 = *(const f32x4*)(sc + idx), s0 = *(const f32x4*)(sh + idx);
        const f32x4 o = v[j] * rstd * gg * (1.0f + s1) + s0;
        *(u32x2*)(hrow + idx) = pk4(o); }
}

__device__ __forceinline__ void phase_pre(const Args& A, int lane, int wave) {
    const int gw = blockIdx.x * 8 + wave, NGW = gridDim.x * 8;
    const float* mod = (const float*)(A.ws + WS_MOD); bf16* H = (bf16*)(A.ws + WS_H);
    for (int r = gw; r < NTOK; r += NGW) {
        const float* xr = r < NTOK_P ? A.x_prompt + (size_t)r * 1024 : A.x_sample + (size_t)(r - NTOK_P) * 1024;
        f32x4 v[4];
#pragma unroll
        for (int j = 0; j < 4; ++j) v[j] = *(const f32x4*)(xr + 4 * lane + 256 * j);
        const float* mb = mod + (size_t)(0 * 5 + cond_of_row(r)) * 6144;
        norm_mod_store(v, A.g_pre_mix, mb + 1024, mb, H + (size_t)r * 1024, lane);
    }
}

__device__ __forceinline__ void phase_post(const Args& A, int l, int which, int lane, int wave) {
    const int gw = blockIdx.x * 8 + wave, NGW = gridDim.x * 8;
    const float* mod = (const float*)(A.ws + WS_MOD); bf16* H = (bf16*)(A.ws + WS_H); const float* MIX = (const float*)(A.ws + WS_MIX);
    const float* gp = (which == 0 ? A.g_post_mix : A.g_post_ffn) + l * 1024;
    for (int r = gw; r < NTOK; r += NGW) {
        const float* xr = (l == 0 && which == 0) ? (r < NTOK_P ? A.x_prompt + (size_t)r * 1024 : A.x_sample + (size_t)(r - NTOK_P) * 1024) : A.out + (size_t)r * 1024;
        const float* tr = MIX + (size_t)r * 1024;
        const int ci = cond_of_row(r);
        const float* mb = mod + (size_t)(l * 5 + ci) * 6144;
        const float* ga = mb + (which == 0 ? 2048 : 5120);
        f32x4 v[4], t[4]; float ss = 0.f;
#pragma unroll
        for (int j = 0; j < 4; ++j) { v[j] = *(const f32x4*)(xr + 4 * lane + 256 * j); t[j] = *(const f32x4*)(tr + 4 * lane + 256 * j); ss += sumsq4(t[j]); }
        const float rstd = 1.0f / sqrtf(wave_sum(ss, lane) * (1.0f / 1024.0f) + EPS);
#pragma unroll
        for (int j = 0; j < 4; ++j) { const int idx = 4 * lane + 256 * j;
            const f32x4 gg = *(const f32x4*)(gp + idx), gv = *(const f32x4*)(ga + idx);
            v[j] = v[j] + gv * (t[j] * rstd * gg);
            *(f32x4*)(A.out + (size_t)r * 1024 + idx) = v[j]; }
        if (which == 0) norm_mod_store(v, A.g_pre_ffn + l * 1024, mb + 4096, mb + 3072, H + (size_t)r * 1024, lane);
        else if (l < DEPTH - 1) { const float* mb2 = mod + (size_t)((l + 1) * 5 + ci) * 6144; norm_mod_store(v, A.g_pre_mix + (l + 1) * 1024, mb2 + 1024, mb2, H + (size_t)r * 1024, lane); }
    }
}

__device__ __forceinline__ void phase_split(const Args& A, int l, int lane, int wave) {
    const int gw = blockIdx.x * 8 + wave, NGW = gridDim.x * 8;
    unsigned char* ws = A.ws;
    const float* Z = (const float*)(ws + WS_Z);
    bf16* QN = (bf16*)(ws + WS_QN); bf16* CKVN = (bf16*)(ws + WS_CKVN); bf16* KRB = (bf16*)(ws + WS_KRB); bf16* UG = (bf16*)(ws + WS_UG); bf16* VN = (bf16*)(ws + WS_VN);
    bf16* CC = (bf16*)(ws + WS_CONCAT);
    const float* ropec = (const float*)(ws + WS_ROPE); const float* ropes = ropec + 32768;
    float* out_ckv = A.out + (size_t)NTOK * 1024; float* out_kr = out_ckv + (size_t)32 * 4 * 256 * 256;
    for (int r = gw; r < NROWKV; r += NGW) {
        if (r >= NTOK) {
            const int idx = r - NTOK, b = idx >> 9, j = idx & 511;
            const f32x4 cv = *(const f32x4*)(A.cache_ckv + ((size_t)(b * 4 + l) * 512 + j) * 256 + 4 * lane);
            *(u32x2*)(CKVN + (size_t)r * 256 + 4 * lane) = pk4(cv);
            const float kv = A.cache_krope[((size_t)(b * 4 + l) * 512 + j) * 64 + lane];
            KRB[(size_t)r * 64 + lane] = (bf16)(cvt_pk_bf16(kv, 0.f) & 0xffffu);
            continue;
        }
        const float* z = Z + (size_t)r * INC;
        const bool prompt = r < NTOK_P;
        const int n = prompt ? (r & 255) : ((r - NTOK_P) & 1023), len = prompt ? 256 : 1024;
        { f32x2 q[3]; float ss = 0.f;
#pragma unroll
          for (int j = 0; j < 3; ++j) { q[j] = *(const f32x2*)(z + ZQ + 2 * lane + 128 * j); ss += q[j].x * q[j].x + q[j].y * q[j].y; }
          const float rstd = 1.0f / sqrtf(wave_sum(ss, lane) * (1.0f / 384.0f) + EPS);
#pragma unroll
          for (int j = 0; j < 3; ++j) { const int idx = 2 * lane + 128 * j; const f32x2 g = *(const f32x2*)(A.g_q + l * 384 + idx);
              *(unsigned*)(QN + (size_t)r * 384 + idx) = cvt_pk_bf16(q[j].x * rstd * g.x, q[j].y * rstd * g.y); } }
        { f32x4 cv = *(const f32x4*)(z + ZCKV + 4 * lane);
          const float rstd = 1.0f / sqrtf(wave_sum(sumsq4(cv), lane) * (1.0f / 256.0f) + EPS);
          cv = cv * rstd * *(const f32x4*)(A.g_kv + l * 256 + 4 * lane);
          if (prompt) *(f32x4*)(out_ckv + ((size_t)((r >> 8) * 4 + l) * 256 + n) * 256 + 4 * lane) = cv;
          *(u32x2*)(CKVN + (size_t)r * 256 + 4 * lane) = pk4(cv); }
        { float kr = z[ZKR + lane];
          if (prompt) out_kr[((size_t)((r >> 8) * 4 + l) * 256 + n) * 64 + lane] = kr;
          else { const float partner = shx(kr, 16, lane); const int a = lane >> 5, p = (lane >> 4) & 1, f = lane & 15;
              const float cs = ropec[n * 32 + a * 16 + f], sn = ropes[n * 32 + a * 16 + f];
              kr = p == 0 ? kr * cs - partner * sn : partner * sn + kr * cs; }
          KRB[(size_t)r * 64 + lane] = (bf16)(cvt_pk_bf16(kr, 0.f) & 0xffffu); }
        { const f32x4 u = gelu4(*(const f32x4*)(z + ZU + 4 * lane)); *(u32x2*)(UG + (size_t)r * 256 + 4 * lane) = pk4(u); }
        { f32x4 v = gelu4(*(const f32x4*)(z + ZV + 4 * lane));
          const float rstd = 1.0f / sqrtf(wave_sum(sumsq4(v), lane) * (1.0f / 256.0f) + EPS);
          v = v * rstd * *(const f32x4*)(A.g_v + l * 256 + 4 * lane);
          *(u32x2*)(VN + (size_t)r * 256 + 4 * lane) = pk4(v); }
        { const f32x4 bg = *(const f32x4*)(z + ZBG + 4 * lane);
          const f32x4 zc = *(const f32x4*)(z + ZCG + 4 * lane) * *(const f32x4*)(z + ZHH + 4 * lane);
          const float* wc = A.w_conv + (size_t)l * 3 * 256 + 4 * lane;
          f32x4 y = zc * *(const f32x4*)(wc + 256);
          if (n > 0) { const float* zm = z - INC; y = y + *(const f32x4*)(zm + ZCG + 4 * lane) * *(const f32x4*)(zm + ZHH + 4 * lane) * *(const f32x4*)(wc); }
          if (n < len - 1) { const float* zp = z + INC; y = y + *(const f32x4*)(zp + ZCG + 4 * lane) * *(const f32x4*)(zp + ZHH + 4 * lane) * *(const f32x4*)(wc + 512); }
          *(u32x2*)(CC + (size_t)r * 1024 + 768 + 4 * lane) = pk4(bg * y); }
    }
}

#define MFMA32(a, b, c) __builtin_amdgcn_mfma_f32_32x32x16_bf16((a), (b), (c), 0, 0, 0)
__device__ __forceinline__ void attn_wave(f32x16 (&o)[4], float& m, float& l, const bf16x8 (&qf)[12], const bf16* KN, const bf16* KRB, const bf16* vtl  ,
                                          int keys, int h, int key_lo, int key_hi, int split, int rowA, int rowB, int lane) {
    const int rho = lane & 31, hh = lane >> 5;
    const int pi = 16 * ((rho >> 2) & 1) + (rho & 3) + 4 * (rho >> 3);
    for (int k = key_lo; k < key_hi; k += 32) {
        const int row = (k < split ? rowA + k : rowB + (k - split)) + pi;
        const bf16* kn = KN + (size_t)row * 512 + h * 128 + 8 * hh;
        const bf16* kr = KRB + (size_t)row * 64 + 8 * hh;
        f32x16 sc;
#pragma unroll
        for (int i = 0; i < 16; ++i) sc[i] = 0.f;
        {
            bf16x8 k0[4], k1[4];
#pragma unroll
            for (int j = 0; j < 4; ++j) k0[j] = *(const bf16x8*)(kn + 16 * j);
#pragma unroll
            for (int j = 0; j < 4; ++j) k1[j] = *(const bf16x8*)(kn + 64 + 16 * j);
            __builtin_amdgcn_sched_barrier(0);
#pragma unroll
            for (int j = 0; j < 4; ++j) sc = MFMA32(k0[j], qf[j], sc);
#pragma unroll
            for (int j = 0; j < 4; ++j) k0[j] = *(const bf16x8*)(kr + 16 * j);
            __builtin_amdgcn_sched_barrier(0);
#pragma unroll
            for (int j = 0; j < 4; ++j) sc = MFMA32(k1[j], qf[4 + j], sc);
#pragma unroll
            for (int j = 0; j < 4; ++j) sc = MFMA32(k0[j], qf[8 + j], sc);
        }
        __builtin_amdgcn_sched_barrier(0);
        bf16x8 va[8];
        const bf16* vp = vtl + k;
#pragma unroll
        for (int t = 0; t < 4; ++t)
#pragma unroll
            for (int s = 0; s < 2; ++s) va[t * 2 + s] = *(const bf16x8*)(vp + (size_t)(32 * t) * keys + 8 * s);
        float mx = sc[0];
#pragma unroll
        for (int i = 1; i < 16; ++i) mx = fmaxf(mx, sc[i]);
        mx = fmaxf(mx, shx(mx, 32, lane));
        const float mn = fmaxf(m, mx), alpha = __builtin_amdgcn_exp2f(m - mn);
        float ps = 0.f;
#pragma unroll
        for (int i = 0; i < 16; ++i) { sc[i] = __builtin_amdgcn_exp2f(sc[i] - mn); ps += sc[i]; }
        l = l * alpha + ps; m = mn;
#pragma unroll
        for (int t = 0; t < 4; ++t) o[t] = o[t] * alpha;
        bf16x8 pb[2];
#pragma unroll
        for (int s = 0; s < 2; ++s) { u32x4 w; w.x = cvt_pk_bf16(sc[8 * s + 0], sc[8 * s + 1]); w.y = cvt_pk_bf16(sc[8 * s + 2], sc[8 * s + 3]); w.z = cvt_pk_bf16(sc[8 * s + 4], sc[8 * s + 5]); w.w = cvt_pk_bf16(sc[8 * s + 6], sc[8 * s + 7]);
            pb[s] = __builtin_bit_cast(bf16x8, w); }
#pragma unroll
        for (int t = 0; t < 4; ++t)
#pragma unroll
            for (int s = 0; s < 2; ++s) o[t] = MFMA32(va[t * 2 + s], pb[s], o[t]);
    }
}
__device__ __forceinline__ void attn_store_tile(const f32x16& ot, float inv, bf16* crow  , int t, int hh) {
#pragma unroll
    for (int g = 0; g < 4; ++g) { u32x2 w; w.x = cvt_pk_bf16(ot[4 * g] * inv, ot[4 * g + 1] * inv); w.y = cvt_pk_bf16(ot[4 * g + 2] * inv, ot[4 * g + 3] * inv);
        *(u32x2*)(crow + 32 * t + 8 * g + 4 * hh) = w; }
}

__device__ __forceinline__ void phase_mixer(const Args& A, int l, LAS unsigned char* lds, int lane_in, int wave) {
    unsigned char* ws = A.ws;
    const bf16* Q = (const bf16*)(ws + WS_Q); const bf16* KN = (const bf16*)(ws + WS_KNOPE); const bf16* KRB = (const bf16*)(ws + WS_KRB);
    const bf16* VTP = (const bf16*)(ws + WS_VTP); const bf16* VTS = (const bf16*)(ws + WS_VTS);
    const bf16* UG = (const bf16*)(ws + WS_UG); const bf16* VN = (const bf16*)(ws + WS_VN);
    bf16* CC = (bf16*)(ws + WS_CONCAT);
    for (int it = blockIdx.x; it < 480; it += gridDim.x) {
        int lane = lane_in; asm volatile("" : "+v"(lane));
        const int rho = lane & 31, hh = lane >> 5, tid = wave * 64 + lane;
        if (it < 384) {
            const bool heavy = it < 256;
            int h, q0, keys, key_lo, key_hi, split, rowA, rowB; const bf16* vt;
            if (heavy) { const int b = it >> 6, qt = it & 15, qg = wave & 1, seg = wave >> 1; h = (it >> 4) & 3;
                q0 = NTOK_P + b * 1024 + qt * 64 + qg * 32; keys = 1536; key_lo = seg * 384; key_hi = key_lo + 384; split = 512; rowA = NTOK + b * 512; rowB = NTOK_P + b * 1024;
                vt = VTS + (size_t)((b * 4 + h) * 128) * 1536; }
            else { const int i2 = it - 256, b = i2 >> 2; h = i2 & 3; q0 = b * 256 + wave * 32; keys = 256; key_lo = 0; key_hi = 256; split = 0; rowA = 0; rowB = b * 256;
                vt = VTP + (size_t)((b * 4 + h) * 128) * 256; }
            bf16x8 qf[12];
            { const bf16* qp = Q + (size_t)(q0 + rho) * 768 + h * 192 + 8 * hh;
#pragma unroll
              for (int ks = 0; ks < 12; ++ks) qf[ks] = *(const bf16x8*)(qp + 16 * ks); }
            f32x16 o[4];
#pragma unroll
            for (int t = 0; t < 4; ++t)
#pragma unroll
                for (int i = 0; i < 16; ++i) o[t][i] = 0.f;
            float m = -1e30f, lsum = 0.f;
            attn_wave(o, m, lsum, qf, KN, KRB, vt + (size_t)rho * keys + 16 * hh, keys, h, key_lo, key_hi, split, rowA, rowB, lane);
            lsum += shx(lsum, 32, lane);
            if (!heavy) {
                const float inv = 1.0f / lsum; bf16* crow = CC + (size_t)(q0 + rho) * 1024 + h * 128;
#pragma unroll
                for (int t = 0; t < 4; ++t) attn_store_tile(o[t], inv, crow, t, hh);
            } else {
                LAS float* wb = (LAS float*)(lds + wave * 16640);
#pragma unroll
                for (int t = 0; t < 4; ++t)
#pragma unroll
                    for (int i = 0; i < 16; ++i) wb[(t * 16 + i) * 64 + lane] = o[t][i];
                if (hh == 0) { wb[4096 + rho] = m; wb[4128 + rho] = lsum; }
                __syncthreads();
                const int qg = wave & 1, seg = wave >> 1;
                float ms[4], wg[4]; float mg = -1e30f;
#pragma unroll
                for (int s = 0; s < 4; ++s) { ms[s] = ((LAS float*)(lds + (qg + 2 * s) * 16640))[4096 + rho]; mg = fmaxf(mg, ms[s]); }
                float lt = 0.f;
#pragma unroll
                for (int s = 0; s < 4; ++s) { wg[s] = __builtin_amdgcn_exp2f(ms[s] - mg); lt += wg[s] * ((LAS float*)(lds + (qg + 2 * s) * 16640))[4128 + rho]; }
                f32x16 acc;
#pragma unroll
                for (int i = 0; i < 16; ++i) { float a = 0.f;
#pragma unroll
                    for (int s = 0; s < 4; ++s) a += wg[s] * ((LAS float*)(lds + (qg + 2 * s) * 16640))[(seg * 16 + i) * 64 + lane];
                    acc[i] = a; }
                const int qrow = (q0 + rho);
                attn_store_tile(acc, 1.0f / lt, CC + (size_t)qrow * 1024 + h * 128, seg, hh);
                __syncthreads();
            }
        } else {
            const int c = it - 384;
            LAS bf16* vnT = (LAS bf16*)lds;
#pragma unroll
            for (int pass = 0; pass < 8; ++pass) { const int id = tid + 512 * pass, qq = id >> 5, c8 = (id & 31) * 8;
                const bf16x8 v = *(const bf16x8*)(VN + (size_t)(c * 128 + qq) * 256 + c8);
#pragma unroll
                for (int j = 0; j < 8; ++j) vnT[(c8 + j) * 136 + qq] = (bf16)v[j]; }
            __syncthreads();
            const int hd = wave & 3, ph = wave >> 2;
#pragma unroll
            for (int pp = 0; pp < 2; ++pp) { const int pt = 2 * ph + pp;
                f32x16 acc[2];
#pragma unroll
                for (int d = 0; d < 2; ++d)
#pragma unroll
                    for (int i = 0; i < 16; ++i) acc[d][i] = 0.f;
                const float* wrow = A.w_s + ((size_t)(l * 4 + hd) * 128 + 32 * pt + rho) * 128 + 8 * hh;
#pragma unroll
                for (int ks = 0; ks < 8; ++ks) { const f32x4 w0 = *(const f32x4*)(wrow + 16 * ks), w1 = *(const f32x4*)(wrow + 16 * ks + 4);
                    u32x4 w; w.x = cvt_pk_bf16(w0.x, w0.y); w.y = cvt_pk_bf16(w0.z, w0.w); w.z = cvt_pk_bf16(w1.x, w1.y); w.w = cvt_pk_bf16(w1.z, w1.w);
                    const bf16x8 af = __builtin_bit_cast(bf16x8, w);
#pragma unroll
                    for (int d = 0; d < 2; ++d) { const bf16x8 bfr = *(const LAS bf16x8*)(vnT + (hd * 64 + 32 * d + rho) * 136 + 16 * ks + 8 * hh); acc[d] = MFMA32(af, bfr, acc[d]); } }
#pragma unroll
                for (int d = 0; d < 2; ++d) { const int col = hd * 64 + 32 * d + rho;
#pragma unroll
                    for (int i = 0; i < 16; ++i) { const int p = 32 * pt + (i & 3) + 8 * (i >> 2) + 4 * hh; const size_t row = (size_t)c * 128 + p;
                        const float mixed = acc[d][i] + A.b_s[(l * 4 + hd) * 128 + p];
                        const float ugv = __uint_as_float((unsigned)UG[row * 256 + col] << 16);
                        CC[row * 1024 + 512 + col] = (bf16)(cvt_pk_bf16(ugv * mixed, 0.f) & 0xffffu); } }
            }
            __syncthreads();
        }
    }
}

__global__ void __launch_bounds__(512, 2) fwd_megakernel(Args A) {
    extern __shared__ __attribute__((aligned(16))) unsigned char smem[];
    LAS unsigned char* lds = (LAS unsigned char*)smem;
    const int wave0 = __builtin_amdgcn_readfirstlane((int)threadIdx.x >> 6);
    for (int ph = A.ph_lo; ph < A.ph_hi; ++ph) {
        const int wave = wave0;
#define LANE fresh_lane()
#define TID (wave * 64 + fresh_lane())
        unsigned char* ws = A.ws; asm volatile("" : "+s"(ws));
        if (ph == 0) phase_prologue(A, lds, wave);
        else if (ph == 1) phase_pre(A, LANE, wave);
        else {
            const int l = (ph - 2) / 9, k = (ph - 2) % 9;
            const int G = gridDim.x, bid = blockIdx.x;
            if (k == 0) {
                pg8::Gemm g{(const bf16*)(ws + WS_H), (const bf16*)(ws + WS_WIN) + (size_t)l * 2048 * 1024, NTOK, 2048, 1024}; pg8::StaticOrder S; S.init(NTOK, 2048, G, bid);
                EpiF32 E{(float*)(ws + WS_Z), INC, INC}; pg8::gemm_phase<EpiF32, pg8::StaticOrder>(lds, g, S, E, TID);
            } else if (k == 1) phase_split(A, l, LANE, wave);
            else if (k == 2) {
                { pg8::Gemm g{(const bf16*)(ws + WS_QN), (const bf16*)(ws + WS_WUQ) + (size_t)l * 768 * 384, NTOK, 768, 384}; pg8::StaticOrder S; S.init(NTOK, 768, G, bid);
                  EpiQ E{(bf16*)(ws + WS_Q), (const float*)(ws + WS_ROPE), (const float*)(ws + WS_ROPE) + 32768}; pg8::gemm_phase<EpiQ, pg8::StaticOrder>(lds, g, S, E, TID); }
                                { pg8::Gemm g{(const bf16*)(ws + WS_CKVN), (const bf16*)(ws + WS_WUKV) + (size_t)l * 1024 * 256, NROWKV, 1024, 256}; pg8::StaticOrder S; S.init(NROWKV, 1024, G, (bid + G - 144 % G) % G);
                  EpiKV E{(bf16*)(ws + WS_KNOPE), (bf16*)(ws + WS_VTP), (bf16*)(ws + WS_VTS)}; pg8::gemm_phase<EpiKV, pg8::StaticOrder>(lds, g, S, E, TID); }
            } else if (k == 3) phase_mixer(A, l, lds, LANE, wave);
            else if (k == 4 || k == 7) {
                const bool o = (k == 4);
                pg8::Gemm g{(const bf16*)(ws + (o ? WS_CONCAT : WS_ACT)), o ? (const bf16*)(ws + WS_WOUT) + (size_t)l * 1024 * 1024 : (const bf16*)(ws + WS_WFF2) + (size_t)l * 1024 * 4096, NTOK, 1024, o ? 1024 : 4096};
                pg8::StaticOrder S; S.init(NTOK, 1024, G, bid);
                EpiF32 E{(float*)(ws + WS_MIX), 1024, 1024}; pg8::gemm_phase<EpiF32, pg8::StaticOrder>(lds, g, S, E, TID);
            } else if (k == 5) phase_post(A, l, 0, LANE, wave);
            else if (k == 6) {
                pg8::Gemm g{(const bf16*)(ws + WS_H), (const bf16*)(ws + WS_WFF1) + (size_t)l * 4096 * 1024, NTOK, 4096, 1024}; pg8::StaticOrder S; S.init(NTOK, 4096, G, bid);
                EpiAct E{(bf16*)(ws + WS_ACT), 4096}; pg8::gemm_phase<EpiAct, pg8::StaticOrder>(lds, g, S, E, TID);
            } else phase_post(A, l, 1, LANE, wave);
        }
        if (ph + 1 < A.ph_hi) { cg::this_grid().sync(); }
    }
}

constexpr int N_PHASES = 2 + 9 * DEPTH;

extern "C" void kernel_launch(void* const* d_in, const int* in_sizes, int n_in, void* d_out, int out_size, void* d_ws, size_t ws_size, hipStream_t stream) {
    static int grid = 0;
    if (grid == 0) {
        if (n_in != 24 || ws_size < WS_END || in_sizes[9] != DEPTH * 1024 * INC) { fprintf(stderr, "kernel_launch: unexpected problem (n_in %d, ws %zu, w_in %d)\n", n_in, ws_size, n_in > 9 ? in_sizes[9] : -1); grid = -1; return; }
        int dev = 0, cus = 0, per_cu = 0;
        hipGetDevice(&dev); hipDeviceGetAttribute(&cus, hipDeviceAttributeMultiprocessorCount, dev);
        if (hipFuncSetAttribute((const void*)fwd_megakernel, hipFuncAttributeMaxDynamicSharedMemorySize, LDS_BYTES) != hipSuccess) { fprintf(stderr, "kernel_launch: hipFuncSetAttribute failed\n"); grid = -1; return; }
        if (hipOccupancyMaxActiveBlocksPerMultiprocessor(&per_cu, (const void*)fwd_megakernel, 512, LDS_BYTES) != hipSuccess || per_cu < 1) { fprintf(stderr, "kernel_launch: occupancy query says %d\n", per_cu); per_cu = 1; }
        (void)hipGetLastError();
        grid = cus * 1;
        fprintf(stderr, "kernel_launch: grid %d (cus %d, per_cu %d)\n", grid, cus, per_cu);
    }
    if (grid < 0) return;
    Args a{};
    const float** ap = (const float**)&a;
    for (int i = 0; i < 24; ++i) ap[i] = (const float*)d_in[i];
    a.out = (float*)d_out; a.ws = (unsigned char*)d_ws;
#if MK_PER_PHASE
    for (int ph = 0; ph < N_PHASES; ++ph) { a.ph_lo = ph; a.ph_hi = ph + 1; hipLaunchKernelGGL(fwd_megakernel, dim3(grid), dim3(512), LDS_BYTES, stream, a); }
#else
    a.ph_lo = 0; a.ph_hi = N_PHASES;
    void* args[] = {&a};
    hipError_t e = hipLaunchCooperativeKernel((const void*)fwd_megakernel, dim3(grid), dim3(512), args, LDS_BYTES, stream);
    if (e != hipSuccess) fprintf(stderr, "kernel_launch: cooperative launch failed: %s (grid %d)\n", hipGetErrorString(e), grid);
#endif
}
```

```cpp
#include <hip/hip_runtime.h>
#include <hip/hip_cooperative_groups.h>
#include <cstdio>
namespace cg = cooperative_groups;

#ifndef MK_PER_PHASE
#define MK_PER_PHASE 0
#endif

#ifndef PROBE_DUP
#define PROBE_DUP -1
#endif
#define LAS __attribute__((address_space(3)))
typedef unsigned short bf16;
typedef short bf16x8 __attribute__((ext_vector_type(8)));
typedef float f32x2 __attribute__((ext_vector_type(2)));
typedef float f32x4 __attribute__((ext_vector_type(4)));
typedef float f32x16 __attribute__((ext_vector_type(16)));
typedef unsigned u32x2 __attribute__((ext_vector_type(2)));
typedef unsigned u32x4 __attribute__((ext_vector_type(4)));

constexpr int DM = 1024, NTOK_P = 8192, NTOK_S = 4096, NTOK = 12288, NROWKV = 14336;
constexpr int DEPTH = 4, INC = 1984, DFF = 4096;
constexpr int ZQ = 0, ZCKV = 384, ZKR = 640, ZU = 704, ZV = 960, ZBG = 1216, ZCG = 1472, ZHH = 1728;
constexpr float EPS = 1e-6f;
constexpr float QSCALE = 0.07216878364870322f * 1.4426950408889634f;

constexpr size_t MiB = 1u << 20;
constexpr size_t WS_MOD = 0, WS_BAR = 512 * 1024, WS_ROPE = 1 * MiB, WS_WIN = 2 * MiB, WS_WUQ = 18 * MiB, WS_WUKV = 21 * MiB, WS_WOUT = 23 * MiB,
                 WS_WFF1 = 31 * MiB, WS_WFF2 = 63 * MiB, WS_H = 95 * MiB, WS_MIX = 119 * MiB, WS_CONCAT = 167 * MiB, WS_QN = 191 * MiB,
                 WS_CKVN = 200 * MiB, WS_KRB = 207 * MiB, WS_UG = 209 * MiB, WS_VN = 215 * MiB, WS_Q = 221 * MiB, WS_KNOPE = 239 * MiB,
                 WS_VTP = 253 * MiB, WS_VTS = 261 * MiB, WS_Z = 267 * MiB, WS_ACT = 267 * MiB, WS_END = 363 * MiB;
constexpr int LDS_BYTES = 147456, LDS_BARST = LDS_BYTES - 64;

__device__ __forceinline__ unsigned cvt_pk_bf16(float lo, float hi) { unsigned r; asm volatile("v_cvt_pk_bf16_f32 %0, %1, %2" : "=v"(r) : "v"(lo), "v"(hi)); return r; }
__device__ __forceinline__ int fresh_lane() { int l; asm volatile("v_mbcnt_lo_u32_b32 %0, -1, 0\n\tv_mbcnt_hi_u32_b32 %0, -1, %0" : "=v"(l)); return l; }
__device__ __forceinline__ float shx(float v, int mask, int lane) { return __int_as_float(__builtin_amdgcn_ds_bpermute((lane ^ mask) << 2, __float_as_int(v))); }
__device__ __forceinline__ float wave_sum(float v, int lane) {
#pragma unroll
    for (int o = 1; o < 64; o <<= 1) v += shx(v, o, lane);
    return v;
}
__device__ __forceinline__ float gelu_tanh(float x) { const float y = 0.7978845608028654f * (x + 0.044715f * x * x * x); return x / (1.0f + __expf(-2.0f * y)); }
__device__ __forceinline__ f32x4 gelu4(f32x4 v) { return (f32x4){gelu_tanh(v.x), gelu_tanh(v.y), gelu_tanh(v.z), gelu_tanh(v.w)}; }
__device__ __forceinline__ float sumsq4(f32x4 v) { return (v.x * v.x + v.y * v.y) + (v.z * v.z + v.w * v.w); }
__device__ __forceinline__ u32x2 pk4(f32x4 v) { u32x2 w; w.x = cvt_pk_bf16(v.x, v.y); w.y = cvt_pk_bf16(v.z, v.w); return w; }


#define XB_TMO      128
#define XB_XCNT(j)  (256  + 64 * (j))
#define XB_XSUB(j)  (1280 + 64 * (j))
#define XB_XGEN(j)  (2304 + 64 * (j))
#define XB_TOP      3328
#define XB_TOPGEN   3392
#define XCD_BAR_WORDS 3456
#define XB_SPIN_CAP (1u << 18)
__device__ __forceinline__ unsigned xb_ld(unsigned* p)              { return __hip_atomic_load(p, __ATOMIC_RELAXED, __HIP_MEMORY_SCOPE_AGENT); }
__device__ __forceinline__ unsigned xb_add(unsigned* p, unsigned v) { return __hip_atomic_fetch_add(p, v, __ATOMIC_RELAXED, __HIP_MEMORY_SCOPE_AGENT); }
__device__ __forceinline__ unsigned xb_xcc_id() { return (unsigned)__builtin_amdgcn_s_getreg((3 << 11) | 20) & 0xFu; }
#define XB_SPIN(cond, bar) do { unsigned _sp = 0; while (cond) { __builtin_amdgcn_s_sleep(1); \
    if ((++_sp & 255u) == 0u) { if (xb_ld(&(bar)[XB_TMO])) break; if (_sp > XB_SPIN_CAP) { atomicAdd(&(bar)[XB_TMO], 1u); break; } } } } while (0)
__device__ __forceinline__ void xcd_barrier_complete(unsigned* bar, unsigned x, unsigned& nloc, unsigned& nx) {
    const unsigned G = gridDim.x * gridDim.y * gridDim.z;
    unsigned sum, cnt, mine, sp = 0u;
    for (;;) {
        sum = 0u; cnt = 0u; mine = 0u;
#pragma unroll
        for (unsigned j = 0; j < 16; ++j) { const unsigned c = xb_ld(&bar[XB_XCNT(j)]); sum += c; cnt += (c > 0u) ? 1u : 0u; mine = (j == x) ? c : mine; }
        if (sum == G) break;
        __builtin_amdgcn_s_sleep(1);
        if ((++sp & 255u) == 0u) { if (xb_ld(&bar[XB_TMO])) break; if (sp > XB_SPIN_CAP) { atomicAdd(&bar[XB_TMO], 1u); break; } }
    }
    nloc = mine > 0u ? mine : 1u; nx = cnt > 0u ? cnt : 1u;
}
__device__ __forceinline__ void xcd_barrier(unsigned* bar, unsigned x, volatile LAS unsigned* st, bool leader) {
    asm volatile("s_waitcnt vmcnt(0)" ::: "memory");
    __syncthreads();
    if (leader) {
        __builtin_amdgcn_s_waitcnt(0);
        unsigned nloc = st[0], nx = st[1];
        if (nloc == 0u) { xcd_barrier_complete(bar, x, nloc, nx); st[0] = nloc; st[1] = nx; }
        const unsigned old = xb_add(&bar[XB_XSUB(x)], 1u);
        const unsigned gen = old / nloc;
        if (old + 1u == (gen + 1u) * nloc) {
            __builtin_amdgcn_fence(__ATOMIC_RELEASE, "agent");
            asm volatile("s_waitcnt vmcnt(0)" ::: "memory");
            const unsigned og = xb_add(&bar[XB_TOP], 1u);
            const unsigned tg = og / nx;
            if (og + 1u == (tg + 1u) * nx) xb_add(&bar[XB_TOPGEN], 1u);
            else XB_SPIN(xb_ld(&bar[XB_TOPGEN]) == tg, bar);
            __builtin_amdgcn_fence(__ATOMIC_ACQUIRE, "agent");
            xb_add(&bar[XB_XGEN(x)], 1u);
            asm volatile("s_waitcnt vmcnt(0)" ::: "memory");
        } else {
            XB_SPIN(xb_ld(&bar[XB_XGEN(x)]) == gen, bar);
            __builtin_amdgcn_fence(__ATOMIC_ACQUIRE, "agent");
            asm volatile("s_waitcnt vmcnt(0)" ::: "memory");
        }
    }
    __syncthreads();
}

namespace pg8 {
#define PG8_LAS __attribute__((address_space(3)))
typedef unsigned short bf16_t;
constexpr int BM = 256, BK = 64, HALF = 128, HTB = HALF * BK * 2, STAGE_BYTES = 8 * HTB, NXCD = 8, WGM = 8;
__host__ __device__ __forceinline__ int lds_byte(int r, int c) { const int st = (r >> 4) * 2 + (c >> 5), rr = r & 15, cc = c & 31, ob = rr * 64 + cc * 2; return st * 1024 + (ob ^ (((ob >> 9) & 1) << 5)); }
__host__ __device__ __forceinline__ void stage_rc(int b, int& R, int& C) { const int st = b / 1024, sb = b % 1024, swz = sb ^ (((sb >> 9) & 1) << 5); R = (st >> 1) * 16 + swz / 64; C = (st & 1) * 32 + (swz % 64) / 2; }
__host__ __device__ __forceinline__ int perm32(int rho) { const int n = rho >> 4, i = rho & 15; return 8 * (i >> 2) + 4 * n + (i & 3); }
struct Unit { int pm, pn; };
struct Gemm { const bf16_t* A; const bf16_t* Bt; int M, N, K; };
struct StaticOrder {
    int nM, nN, nwg, G, c;
    __host__ __device__ void init(int M, int N, int G_, int c_) { nM = M / BM; nN = N / BM; nwg = nM * nN; G = G_; c = c_; }
    __host__ __device__ bool next(int i, Unit& u) const {
        const long L = (long)i * G + c; if (L >= nwg) return false;
        int wgid = (int)L; { const int q = nwg / NXCD, r = nwg % NXCD, xcd = wgid % NXCD, off = wgid / NXCD; wgid = (xcd < r ? xcd * (q + 1) : r * (q + 1) + (xcd - r) * q) + off; }
        const int nig = WGM * nN, gid = wgid / nig, fm = gid * WGM, gsz = (nM - fm) < WGM ? (nM - fm) : WGM;
        u.pm = fm + ((wgid % nig) % gsz); u.pn = (wgid % nig) / gsz; return true;
    }
    __device__ __forceinline__ void a_ready(const Unit&) const {}
    __device__ __forceinline__ void done(const Unit&) const {}
};

template <class Epi, class Sched>
__device__ __forceinline__ void gemm_phase(PG8_LAS unsigned char* lds, const Gemm g, const Sched& S, const Epi& E, const int tid) {
    const int wid = __builtin_amdgcn_readfirstlane(tid >> 6), lane = tid & 63, wr = wid >> 2, wc = wid & 3, fr = lane & 15, fq = lane >> 4;
    const int K = g.K, nt = K / BK;
    unsigned voffA[2], voffB[2];
#pragma unroll
    for (int i = 0; i < 2; ++i) { int R, C; stage_rc(tid * 16 + i * 8192, R, C); const int Rb = Epi::PERM ? ((R & ~31) + perm32(R & 31)) : R;
        voffA[i] = (unsigned)(R * K + C) * 2u; voffB[i] = (unsigned)(Rb * K + C) * 2u; }
    const size_t kstep = (size_t)(BK * 2);
    const size_t hstep = (size_t)HALF * K * 2;
    const size_t tstep = 2 * hstep;
    const unsigned ldsw = (unsigned)wid * 1024u;
    const int aoff = lds_byte(wr * 64 + fr, fq * 8), boff = lds_byte(wc * 32 + fr, fq * 8);
#define PG8_SA(b, h) (((b) * 2 + (h)) * HTB)
#define PG8_SB(b, h) ((4 + (b) * 2 + (h)) * HTB)
#define PG8_STAGE(bufoff, gbase, voff) do { _Pragma("unroll") for (int _i = 0; _i < 2; ++_i) \
        __builtin_amdgcn_global_load_lds((const unsigned*)((const char*)(gbase) + (voff)[_i]), (PG8_LAS unsigned*)(lds + (bufoff) + ldsw + _i * 8192), 16, 0, 0); } while (0)
#define PG8_LDA(dst, b, h) do { _Pragma("unroll") for (int m = 0; m < 4; ++m) _Pragma("unroll") for (int k = 0; k < 2; ++k) dst[m][k] = *(const PG8_LAS bf16x8*)(lds + PG8_SA(b, h) + aoff + m * 2048 + k * 1024); } while (0)
#define PG8_LDB(dst, b, h) do { _Pragma("unroll") for (int n = 0; n < 2; ++n) _Pragma("unroll") for (int k = 0; k < 2; ++k) dst[n][k] = *(const PG8_LAS bf16x8*)(lds + PG8_SB(b, h) + boff + n * 2048 + k * 1024); } while (0)
#define PG8_MMA(ai, bj, At, Bt) do { __builtin_amdgcn_s_setprio(1); _Pragma("unroll") for (int m = 0; m < 4; ++m) _Pragma("unroll") for (int n = 0; n < 2; ++n) _Pragma("unroll") for (int k = 0; k < 2; ++k) \
        acc[ai][bj][m][n] = __builtin_amdgcn_mfma_f32_16x16x32_bf16(Bt[n][k], At[m][k], acc[ai][bj][m][n], 0, 0, 0); __builtin_amdgcn_s_setprio(0); } while (0)
#define PG8_WAIT_V(n) asm volatile("s_waitcnt vmcnt(" #n ")" ::: "memory")
#define PG8_WAIT_L(n) asm volatile("s_waitcnt lgkmcnt(" #n ")" ::: "memory")
#define PG8_BAR __builtin_amdgcn_s_barrier()
#define PG8_SCHED __builtin_amdgcn_sched_barrier(0)
    Unit cur, nxt; int ui = 0;
    if (!S.next(0, cur)) return;
    f32x4 acc[2][2][4][2];
#pragma unroll
    for (int a = 0; a < 2; ++a)
#pragma unroll
        for (int b = 0; b < 2; ++b)
#pragma unroll
            for (int m = 0; m < 4; ++m)
#pragma unroll
                for (int n = 0; n < 2; ++n) acc[a][b][m][n] = (f32x4){0.f, 0.f, 0.f, 0.f};
    bf16x8 At[4][2], B0[2][2], B1[2][2];
    const char* cA = (const char*)g.A + (size_t)cur.pm * tstep; const char* cB = (const char*)g.Bt + (size_t)cur.pn * tstep;
    S.a_ready(cur);
    PG8_STAGE(PG8_SB(0, 0), cB, voffB); PG8_STAGE(PG8_SA(0, 0), cA, voffA); PG8_STAGE(PG8_SB(0, 1), cB + hstep, voffB); PG8_STAGE(PG8_SA(0, 1), cA + hstep, voffA);
    if (wr == 1) PG8_BAR;
    PG8_WAIT_V(4); PG8_BAR;
    PG8_STAGE(PG8_SB(1, 0), cB + kstep, voffB); PG8_STAGE(PG8_SA(1, 0), cA + kstep, voffA); PG8_STAGE(PG8_SB(1, 1), cB + hstep + kstep, voffB);
    PG8_WAIT_V(6); PG8_BAR;
    for (;;) {
        const bool has_next = S.next(ui + 1, nxt);
        const char* nA = has_next ? (const char*)g.A + (size_t)nxt.pm * tstep : cA; const char* nB = has_next ? (const char*)g.Bt + (size_t)nxt.pn * tstep : cB;
        for (int t = 0; t < nt; t += 2) {
            const bool last = (t == nt - 2);
            const char* a1 = cA + (size_t)(t + 1) * kstep;
            const char* a2 = last ? nA : cA + (size_t)(t + 2) * kstep; const char* b2 = last ? nB : cB + (size_t)(t + 2) * kstep;
            const char* a3 = a2 + kstep; const char* b3 = b2 + kstep;
            if (last && has_next) S.a_ready(nxt);
            PG8_LDB(B0, 0, 0); PG8_SCHED; PG8_LDA(At, 0, 0); PG8_STAGE(PG8_SA(1, 1), a1 + hstep, voffA);
            PG8_WAIT_L(8); PG8_BAR; PG8_WAIT_L(0); PG8_MMA(0, 0, At, B0); PG8_BAR; PG8_SCHED;
            PG8_LDB(B1, 0, 1); PG8_STAGE(PG8_SB(0, 0), b2, voffB);
            PG8_BAR; PG8_WAIT_L(0); PG8_MMA(0, 1, At, B1); PG8_BAR;
            PG8_LDA(At, 0, 1); PG8_STAGE(PG8_SA(0, 0), a2, voffA);
            PG8_BAR; PG8_WAIT_L(0); PG8_MMA(1, 0, At, B0); PG8_BAR; PG8_SCHED;
            PG8_STAGE(PG8_SB(0, 1), b2 + hstep, voffB);
            PG8_WAIT_V(6); PG8_BAR; PG8_MMA(1, 1, At, B1); PG8_BAR;
            PG8_LDB(B0, 1, 0); PG8_SCHED; PG8_LDA(At, 1, 0); PG8_STAGE(PG8_SA(0, 1), a2 + hstep, voffA);
            PG8_WAIT_L(8); PG8_BAR; PG8_WAIT_L(0); PG8_MMA(0, 0, At, B0); PG8_BAR; PG8_SCHED;
            PG8_LDB(B1, 1, 1); PG8_STAGE(PG8_SB(1, 0), b3, voffB);
            PG8_BAR; PG8_WAIT_L(0); PG8_MMA(0, 1, At, B1); PG8_BAR;
            PG8_LDA(At, 1, 1); PG8_STAGE(PG8_SA(1, 0), a3, voffA);
            PG8_BAR; PG8_WAIT_L(0); PG8_MMA(1, 0, At, B0); PG8_BAR; PG8_SCHED;
            PG8_STAGE(PG8_SB(1, 1), b3 + hstep, voffB);
            PG8_WAIT_V(6); PG8_BAR; PG8_MMA(1, 1, At, B1); PG8_BAR;
        }
        E(acc, cur, wr, wc, fr, fq); S.done(cur);
        if (!has_next) break;
#pragma unroll
        for (int a = 0; a < 2; ++a)
#pragma unroll
            for (int b = 0; b < 2; ++b)
#pragma unroll
                for (int m = 0; m < 4; ++m)
#pragma unroll
                    for (int n = 0; n < 2; ++n) acc[a][b][m][n] = (f32x4){0.f, 0.f, 0.f, 0.f};
        cur = nxt; cA = nA; cB = nB; ++ui;
    }
    PG8_WAIT_V(0);
    if (wr == 0) PG8_BAR;
    PG8_BAR;
#undef PG8_SA
#undef PG8_SB
#undef PG8_STAGE
#undef PG8_LDA
#undef PG8_LDB
#undef PG8_MMA
#undef PG8_WAIT_V
#undef PG8_WAIT_L
#undef PG8_BAR
#undef PG8_SCHED
}
}

struct EpiF32 {
    static constexpr bool PERM = false;
    float* C; int ldc; int ncols;
    __device__ __forceinline__ void operator()(const f32x4 (&acc)[2][2][4][2], const pg8::Unit& u, int wr, int wc, int fr, int fq) const {
        const int row0 = u.pm * 256 + wr * 64 + fr, col0 = u.pn * 256 + wc * 32 + 4 * fq;
#pragma unroll
        for (int ai = 0; ai < 2; ++ai)
#pragma unroll
            for (int m = 0; m < 4; ++m) { float* rowp = C + (size_t)(row0 + ai * 128 + m * 16) * ldc + col0;
#pragma unroll
                for (int bj = 0; bj < 2; ++bj)
#pragma unroll
                    for (int n = 0; n < 2; ++n) if (col0 + bj * 128 + n * 16 < ncols) *(f32x4*)(rowp + bj * 128 + n * 16) = acc[ai][bj][m][n]; }
    }
};
struct EpiAct {
    static constexpr bool PERM = true;
    bf16* O; int ldc;
    __device__ __forceinline__ void operator()(const f32x4 (&acc)[2][2][4][2], const pg8::Unit& u, int wr, int wc, int fr, int fq) const {
        const int row0 = u.pm * 256 + wr * 64 + fr, col0 = u.pn * 256 + wc * 32 + 8 * fq;
#pragma unroll
        for (int ai = 0; ai < 2; ++ai)
#pragma unroll
            for (int m = 0; m < 4; ++m) { bf16* rowp = O + (size_t)(row0 + ai * 128 + m * 16) * ldc + col0;
#pragma unroll
                for (int bj = 0; bj < 2; ++bj) { f32x4 v0 = acc[ai][bj][m][0], v1 = acc[ai][bj][m][1];
#pragma unroll
                    for (int j = 0; j < 4; ++j) { const float a = fmaxf(v0[j], 0.f), b = fmaxf(v1[j], 0.f); v0[j] = a * a; v1[j] = b * b; }
                    u32x4 w; w.x = cvt_pk_bf16(v0[0], v0[1]); w.y = cvt_pk_bf16(v0[2], v0[3]); w.z = cvt_pk_bf16(v1[0], v1[1]); w.w = cvt_pk_bf16(v1[2], v1[3]);
                    *(u32x4*)(rowp + bj * 128) = w; } }
    }
};
struct EpiQ {
    static constexpr bool PERM = false;
    bf16* Q; const float* ropec; const float* ropes;
    __device__ __forceinline__ void operator()(const f32x4 (&acc)[2][2][4][2], const pg8::Unit& u, int wr, int wc, int fr, int fq) const {
        const int row0 = u.pm * 256 + wr * 64 + fr; const bool sample = u.pm >= 32;
#pragma unroll
        for (int bj = 0; bj < 2; ++bj) {
            const int g0 = u.pn * 256 + bj * 128 + wc * 32, within0 = g0 % 192; const bool isrope = within0 >= 128; const int a = (within0 - 128) >> 5;
#pragma unroll
            for (int ai = 0; ai < 2; ++ai)
#pragma unroll
                for (int m = 0; m < 4; ++m) { const int row = row0 + ai * 128 + m * 16;
                    f32x4 x1 = acc[ai][bj][m][0], x2 = acc[ai][bj][m][1];
                    if (sample && isrope) { const int ntok = (row - NTOK_P) & 1023;
                        const f32x4 cs = *(const f32x4*)(ropec + ntok * 32 + a * 16 + 4 * fq), sn = *(const f32x4*)(ropes + ntok * 32 + a * 16 + 4 * fq);
                        const f32x4 o1 = x1 * cs - x2 * sn, o2 = x1 * sn + x2 * cs; x1 = o1; x2 = o2; }
                    x1 = x1 * QSCALE; x2 = x2 * QSCALE;
                    bf16* p = Q + (size_t)row * 768 + g0 + 4 * fq;
                    *(u32x2*)p = pk4(x1); *(u32x2*)(p + 16) = pk4(x2); asm volatile("" ::: "memory"); }
        }
    }
};
struct EpiKV {
    static constexpr bool PERM = false;
    bf16* KN; bf16* VTP; bf16* VTS;
    __device__ __forceinline__ void operator()(const f32x4 (&acc)[2][2][4][2], const pg8::Unit& u, int wr, int wc, int fr, int fq) const {
        const int h = u.pn, pm = u.pm;
        bf16* vt; int keys, keybase;
        if (pm < 32) { vt = VTP + (size_t)((pm * 4 + h) * 128) * 256; keys = 256; keybase = 0; }
        else if (pm < 48) { const int b = (pm - 32) >> 2; vt = VTS + (size_t)((b * 4 + h) * 128) * 1536; keys = 1536; keybase = 512 + ((pm - 32) & 3) * 256; }
        else { const int b = (pm - 48) >> 1; vt = VTS + (size_t)((b * 4 + h) * 128) * 1536; keys = 1536; keybase = ((pm - 48) & 1) * 256; }
#pragma unroll
        for (int ai = 0; ai < 2; ++ai)
#pragma unroll
            for (int m = 0; m < 4; ++m) { const int rloc = wr * 64 + fr + ai * 128 + m * 16;
                bf16* kp = KN + (size_t)(pm * 256 + rloc) * 512 + h * 128 + wc * 32 + 4 * fq;
#pragma unroll
                for (int n = 0; n < 2; ++n) *(u32x2*)(kp + 16 * n) = pk4(acc[ai][0][m][n]);
#pragma unroll
                for (int n = 0; n < 2; ++n) { const f32x4 v = acc[ai][1][m][n]; const u32x2 w = pk4(v);
                    bf16* vp = vt + (size_t)(wc * 32 + 16 * n + 4 * fq) * keys + keybase + rloc;
                    vp[0] = (bf16)(w.x & 0xffffu); vp[keys] = (bf16)(w.x >> 16); vp[2 * keys] = (bf16)(w.y & 0xffffu); vp[3 * keys] = (bf16)(w.y >> 16); }
                asm volatile("" ::: "memory");
            }
    }
};

struct Args {
    const float *x_prompt, *x_sample, *cache_ckv, *cache_krope, *c, *c_ctx, *w_ada, *b_ada, *g_pre_mix, *w_in, *g_q, *w_uq, *g_kv, *w_ukv,
                *g_v, *w_s, *b_s, *w_conv, *w_out, *g_post_mix, *g_pre_ffn, *w_ff1, *w_ff2, *g_post_ffn;
    float* out; unsigned char* ws; int ph_lo, ph_hi;
};

__device__ __forceinline__ void p0_transpose_item(const float* W, int K, int N, bf16* WT, LAS float* scr, int item, int lane) {
    const int nblk = N / 32, kb = item / nblk, nb = item % nblk, k0 = 64 * kb, n0 = 32 * nb;
#pragma unroll 8
    for (int i = 0; i < 32; ++i) { const int kk = 2 * i + (lane >> 5); scr[kk * 33 + (lane & 31)] = W[(size_t)(k0 + kk) * N + n0 + (lane & 31)]; }
    asm volatile("s_waitcnt lgkmcnt(0)" ::: "memory");
    const int c = lane & 7;
#pragma unroll
    for (int j = 0; j < 4; ++j) { const int n = (lane >> 3) + 8 * j; const LAS float* s = scr + (8 * c) * 33 + n;
        u32x4 o; o.x = cvt_pk_bf16(s[0 * 33], s[1 * 33]); o.y = cvt_pk_bf16(s[2 * 33], s[3 * 33]); o.z = cvt_pk_bf16(s[4 * 33], s[5 * 33]); o.w = cvt_pk_bf16(s[6 * 33], s[7 * 33]);
        *(u32x4*)(WT + (size_t)(n0 + n) * K + k0 + 8 * c) = o; }
    asm volatile("s_waitcnt lgkmcnt(0)" ::: "memory");
}

__device__ __forceinline__ void phase_prologue(const Args& A, LAS unsigned char* lds, int wave) {
    const int lane = fresh_lane(), tid = wave * 64 + lane;
    unsigned char* ws = A.ws;
    const int bid = blockIdx.x, G = gridDim.x;
    { const int gt = bid * 512 + tid;
      if (gt < 32768) { const int n = gt >> 5, a = (gt >> 4) & 1, f = gt & 15; const int pos = a == 0 ? (n >> 6) : (n & 63);
          double inv = 1.0; for (int i = 0; i < f; ++i) inv *= 0.5623413251903491;
          double rev = (double)pos * inv * 0.15915494309189535; rev -= floor(rev);
          const float rf = (float)rev;
          ((float*)(ws + WS_ROPE))[gt] = __builtin_amdgcn_cosf(rf); ((float*)(ws + WS_ROPE))[32768 + gt] = __builtin_amdgcn_sinf(rf); } }
    for (int it = bid; it < 192; it += G) {
        const int l = it / 48, cgp = it % 48;
        LAS float* sl = (LAS float*)lds;
        for (int i = tid; i < 5120; i += 512) { const int ci = i >> 10, k = i & 1023; const float v = ci == 0 ? A.c_ctx[k] : A.c[(ci - 1) * 1024 + k]; sl[i] = v / (1.0f + __expf(-v)); }
        __syncthreads();
        float a0[5], a1[5];
#pragma unroll
        for (int ci = 0; ci < 5; ++ci) { a0[ci] = 0.f; a1[ci] = 0.f; }
        const float* wp = A.w_ada + ((size_t)l * 1024 + wave * 128) * 6144 + cgp * 128 + 2 * lane;
#pragma unroll 8
        for (int kk = 0; kk < 128; ++kk) { const f32x2 wv = *(const f32x2*)(wp + (size_t)kk * 6144); const int k = wave * 128 + kk;
#pragma unroll
            for (int ci = 0; ci < 5; ++ci) { const float s = sl[ci * 1024 + k]; a0[ci] += s * wv.x; a1[ci] += s * wv.y; } }
        LAS float* part = (LAS float*)(lds + 32768);
#pragma unroll
        for (int ci = 0; ci < 5; ++ci) { part[(wave * 5 + ci) * 128 + 2 * lane] = a0[ci]; part[(wave * 5 + ci) * 128 + 2 * lane + 1] = a1[ci]; }
        __syncthreads();
        for (int i = tid; i < 640; i += 512) { const int ci = i >> 7, col = i & 127; float s = 0.f;
#pragma unroll
            for (int w = 0; w < 8; ++w) s += part[(w * 5 + ci) * 128 + col];
            const int gcol = cgp * 128 + col; ((float*)(ws + WS_MOD))[(l * 5 + ci) * 6144 + gcol] = s + A.b_ada[l * 6144 + gcol]; }
        __syncthreads();
    }
    LAS float* scr = (LAS float*)(lds + wave * 16384);
    const int gw = bid * 8 + wave, NGW = G * 8;
    constexpr int I_IN = 16 * 62, I_UQ = 6 * 24, I_UKV = 4 * 32, I_OUT = 16 * 32, I_F1 = 16 * 128, I_F2 = 64 * 32, I_L = I_IN + I_UQ + I_UKV + I_OUT + I_F1 + I_F2;
    for (int it = gw; it < 4 * I_L; it += NGW) {
        const int l = it / I_L; int r = it % I_L;
        if (r < I_IN) { p0_transpose_item(A.w_in + (size_t)l * 1024 * INC, 1024, INC, (bf16*)(ws + WS_WIN) + (size_t)l * 2048 * 1024, scr, r, lane); continue; } r -= I_IN;
        if (r < I_UQ) { p0_transpose_item(A.w_uq + (size_t)l * 384 * 768, 384, 768, (bf16*)(ws + WS_WUQ) + (size_t)l * 768 * 384, scr, r, lane); continue; } r -= I_UQ;
        if (r < I_UKV) { p0_transpose_item(A.w_ukv + (size_t)l * 256 * 1024, 256, 1024, (bf16*)(ws + WS_WUKV) + (size_t)l * 1024 * 256, scr, r, lane); continue; } r -= I_UKV;
        if (r < I_OUT) { p0_transpose_item(A.w_out + (size_t)l * 1024 * 1024, 1024, 1024, (bf16*)(ws + WS_WOUT) + (size_t)l * 1024 * 1024, scr, r, lane); continue; } r -= I_OUT;
        if (r < I_F1) { p0_transpose_item(A.w_ff1 + (size_t)l * 1024 * 4096, 1024, 4096, (bf16*)(ws + WS_WFF1) + (size_t)l * 4096 * 1024, scr, r, lane); continue; } r -= I_F1;
        p0_transpose_item(A.w_ff2 + (size_t)l * 4096 * 1024, 4096, 1024, (bf16*)(ws + WS_WFF2) + (size_t)l * 1024 * 4096, scr, r, lane);
    }
}

__device__ __forceinline__ int cond_of_row(int r) { return r < NTOK_P ? 0 : 1 + ((r - NTOK_P) >> 10); }

__device__ __forceinline__ void norm_mod_store(const f32x4 (&v)[4], const float* g, const float* sc, const float* sh, bf16* hrow, int lane) {
    float ss = 0.f;
#pragma unroll
    for (int j = 0; j < 4; ++j) ss += sumsq4(v[j]);
    const float rstd = 1.0f / sqrtf(wave_sum(ss, lane) * (1.0f / 1024.0f) + EPS);
#pragma unroll
    for (int j = 0; j < 4; ++j) { const int idx = 4 * lane + 256 * j;
        const f32x4 gg = *(const f32x4*)(g + idx), s1 = *(const f32x4*)(sc + idx), s0 = *(const f32x4*)(sh + idx);
        const f32x4 o = v[j] * rstd * gg * (1.0f + s1) + s0;
        *(u32x2*)(hrow + idx) = pk4(o); }
}

__device__ __forceinline__ void phase_pre(const Args& A, int lane, int wave) {
    const int gw = blockIdx.x * 8 + wave, NGW = gridDim.x * 8;
    const float* mod = (const float*)(A.ws + WS_MOD); bf16* H = (bf16*)(A.ws + WS_H);
    for (int r = gw; r < NTOK; r += NGW) {
        const float* xr = r < NTOK_P ? A.x_prompt + (size_t)r * 1024 : A.x_sample + (size_t)(r - NTOK_P) * 1024;
        f32x4 v[4];
#pragma unroll
        for (int j = 0; j < 4; ++j) v[j] = *(const f32x4*)(xr + 4 * lane + 256 * j);
        const float* mb = mod + (size_t)(0 * 5 + cond_of_row(r)) * 6144;
        norm_mod_store(v, A.g_pre_mix, mb + 1024, mb, H + (size_t)r * 1024, lane);
    }
}

__device__ __forceinline__ void phase_post(const Args& A, int l, int which, int lane, int wave) {
    const int gw = blockIdx.x * 8 + wave, NGW = gridDim.x * 8;
    const float* mod = (const float*)(A.ws + WS_MOD); bf16* H = (bf16*)(A.ws + WS_H); const float* MIX = (const float*)(A.ws + WS_MIX);
    const float* gp = (which == 0 ? A.g_post_mix : A.g_post_ffn) + l * 1024;
    for (int r = gw; r < NTOK; r += NGW) {
        const float* xr = (l == 0 && which == 0) ? (r < NTOK_P ? A.x_prompt + (size_t)r * 1024 : A.x_sample + (size_t)(r - NTOK_P) * 1024) : A.out + (size_t)r * 1024;
        const float* tr = MIX + (size_t)r * 1024;
        const int ci = cond_of_row(r);
        const float* mb = mod + (size_t)(l * 5 + ci) * 6144;
        const float* ga = mb + (which == 0 ? 2048 : 5120);
        f32x4 v[4], t[4]; float ss = 0.f;
#pragma unroll
        for (int j = 0; j < 4; ++j) { v[j] = *(const f32x4*)(xr + 4 * lane + 256 * j); t[j] = *(const f32x4*)(tr + 4 * lane + 256 * j); ss += sumsq4(t[j]); }
        const float rstd = 1.0f / sqrtf(wave_sum(ss, lane) * (1.0f / 1024.0f) + EPS);
#pragma unroll
        for (int j = 0; j < 4; ++j) { const int idx = 4 * lane + 256 * j;
            const f32x4 gg = *(const f32x4*)(gp + idx), gv = *(const f32x4*)(ga + idx);
            v[j] = v[j] + gv * (t[j] * rstd * gg);
            *(f32x4*)(A.out + (size_t)r * 1024 + idx) = v[j]; }
        if (which == 0) norm_mod_store(v, A.g_pre_ffn + l * 1024, mb + 4096, mb + 3072, H + (size_t)r * 1024, lane);
        else if (l < DEPTH - 1) { const float* mb2 = mod + (size_t)((l + 1) * 5 + ci) * 6144; norm_mod_store(v, A.g_pre_mix + (l + 1) * 1024, mb2 + 1024, mb2, H + (size_t)r * 1024, lane); }
    }
}

__device__ __forceinline__ void phase_split(const Args& A, int l, int lane, int wave) {
    const int gw = blockIdx.x * 8 + wave, NGW = gridDim.x * 8;
    unsigned char* ws = A.ws;
    const float* Z = (const float*)(ws + WS_Z);
    bf16* QN = (bf16*)(ws + WS_QN); bf16* CKVN = (bf16*)(ws + WS_CKVN); bf16* KRB = (bf16*)(ws + WS_KRB); bf16* UG = (bf16*)(ws + WS_UG); bf16* VN = (bf16*)(ws + WS_VN);
    bf16* CC = (bf16*)(ws + WS_CONCAT);
    const float* ropec = (const float*)(ws + WS_ROPE); const float* ropes = ropec + 32768;
    float* out_ckv = A.out + (size_t)NTOK * 1024; float* out_kr = out_ckv + (size_t)32 * 4 * 256 * 256;
    for (int r = gw; r < NROWKV; r += NGW) {
        if (r >= NTOK) {
            const int idx = r - NTOK, b = idx >> 9, j = idx & 511;
            const f32x4 cv = *(const f32x4*)(A.cache_ckv + ((size_t)(b * 4 + l) * 512 + j) * 256 + 4 * lane);
            *(u32x2*)(CKVN + (size_t)r * 256 + 4 * lane) = pk4(cv);
            const float kv = A.cache_krope[((size_t)(b * 4 + l) * 512 + j) * 64 + lane];
            KRB[(size_t)r * 64 + lane] = (bf16)(cvt_pk_bf16(kv, 0.f) & 0xffffu);
            continue;
        }
        const float* z = Z + (size_t)r * INC;
        const bool prompt = r < NTOK_P;
        const int n = prompt ? (r & 255) : ((r - NTOK_P) & 1023), len = prompt ? 256 : 1024;
        { f32x2 q[3]; float ss = 0.f;
#pragma unroll
          for (int j = 0; j < 3; ++j) { q[j] = *(const f32x2*)(z + ZQ + 2 * lane + 128 * j); ss += q[j].x * q[j].x + q[j].y * q[j].y; }
          const float rstd = 1.0f / sqrtf(wave_sum(ss, lane) * (1.0f / 384.0f) + EPS);
#pragma unroll
          for (int j = 0; j < 3; ++j) { const int idx = 2 * lane + 128 * j; const f32x2 g = *(const f32x2*)(A.g_q + l * 384 + idx);
              *(unsigned*)(QN + (size_t)r * 384 + idx) = cvt_pk_bf16(q[j].x * rstd * g.x, q[j].y * rstd * g.y); } }
        { f32x4 cv = *(const f32x4*)(z + ZCKV + 4 * lane);
          const float rstd = 1.0f / sqrtf(wave_sum(sumsq4(cv), lane) * (1.0f / 256.0f) + EPS);
          cv = cv * rstd * *(const f32x4*)(A.g_kv + l * 256 + 4 * lane);
          if (prompt) *(f32x4*)(out_ckv + ((size_t)((r >> 8) * 4 + l) * 256 + n) * 256 + 4 * lane) = cv;
          *(u32x2*)(CKVN + (size_t)r * 256 + 4 * lane) = pk4(cv); }
        { float kr = z[ZKR + lane];
          if (prompt) out_kr[((size_t)((r >> 8) * 4 + l) * 256 + n) * 64 + lane] = kr;
          else { const float partner = shx(kr, 16, lane); const int a = lane >> 5, p = (lane >> 4) & 1, f = lane & 15;
              const float cs = ropec[n * 32 + a * 16 + f], sn = ropes[n * 32 + a * 16 + f];
              kr = p == 0 ? kr * cs - partner * sn : partner * sn + kr * cs; }
          KRB[(size_t)r * 64 + lane] = (bf16)(cvt_pk_bf16(kr, 0.f) & 0xffffu); }
        { const f32x4 u = gelu4(*(const f32x4*)(z + ZU + 4 * lane)); *(u32x2*)(UG + (size_t)r * 256 + 4 * lane) = pk4(u); }
        { f32x4 v = gelu4(*(const f32x4*)(z + ZV + 4 * lane));
          const float rstd = 1.0f / sqrtf(wave_sum(sumsq4(v), lane) * (1.0f / 256.0f) + EPS);
          v = v * rstd * *(const f32x4*)(A.g_v + l * 256 + 4 * lane);
          *(u32x2*)(VN + (size_t)r * 256 + 4 * lane) = pk4(v); }
        { const f32x4 bg = *(const f32x4*)(z + ZBG + 4 * lane);
          const f32x4 zc = *(const f32x4*)(z + ZCG + 4 * lane) * *(const f32x4*)(z + ZHH + 4 * lane);
          const float* wc = A.w_conv + (size_t)l * 3 * 256 + 4 * lane;
          f32x4 y = zc * *(const f32x4*)(wc + 256);
          if (n > 0) { const float* zm = z - INC; y = y + *(const f32x4*)(zm + ZCG + 4 * lane) * *(const f32x4*)(zm + ZHH + 4 * lane) * *(const f32x4*)(wc); }
          if (n < len - 1) { const float* zp = z + INC; y = y + *(const f32x4*)(zp + ZCG + 4 * lane) * *(const f32x4*)(zp + ZHH + 4 * lane) * *(const f32x4*)(wc + 512); }
          *(u32x2*)(CC + (size_t)r * 1024 + 768 + 4 * lane) = pk4(bg * y); }
    }
}

#define MFMA32(a, b, c) __builtin_amdgcn_mfma_f32_32x32x16_bf16((a), (b), (c), 0, 0, 0)
__device__ __forceinline__ void attn_wave(f32x16 (&o)[4], float& m, float& l, const bf16x8 (&qf)[12], const bf16* KN, const bf16* KRB, const bf16* vtl  ,
                                          int keys, int h, int key_lo, int key_hi, int split, int rowA, int rowB, int lane) {
    const int rho = lane & 31, hh = lane >> 5;
    const int pi = 16 * ((rho >> 2) & 1) + (rho & 3) + 4 * (rho >> 3);
    for (int k = key_lo; k < key_hi; k += 32) {
        const int row = (k < split ? rowA + k : rowB + (k - split)) + pi;
        const bf16* kn = KN + (size_t)row * 512 + h * 128 + 8 * hh;
        const bf16* kr = KRB + (size_t)row * 64 + 8 * hh;
        f32x16 sc;
#pragma unroll
        for (int i = 0; i < 16; ++i) sc[i] = 0.f;
        {
            bf16x8 k0[4], k1[4];
#pragma unroll
            for (int j = 0; j < 4; ++j) k0[j] = *(const bf16x8*)(kn + 16 * j);
#pragma unroll
            for (int j = 0; j < 4; ++j) k1[j] = *(const bf16x8*)(kn + 64 + 16 * j);
            __builtin_amdgcn_sched_barrier(0);
#pragma unroll
            for (int j = 0; j < 4; ++j) sc = MFMA32(k0[j], qf[j], sc);
#pragma unroll
            for (int j = 0; j < 4; ++j) k0[j] = *(const bf16x8*)(kr + 16 * j);
            __builtin_amdgcn_sched_barrier(0);
#pragma unroll
            for (int j = 0; j < 4; ++j) sc = MFMA32(k1[j], qf[4 + j], sc);
#pragma unroll
            for (int j = 0; j < 4; ++j) sc = MFMA32(k0[j], qf[8 + j], sc);
        }
        __builtin_amdgcn_sched_barrier(0);
        bf16x8 va[8];
        const bf16* vp = vtl + k;
#pragma unroll
        for (int t = 0; t < 4; ++t)
#pragma unroll
            for (int s = 0; s < 2; ++s) va[t * 2 + s] = *(const bf16x8*)(vp + (size_t)(32 * t) * keys + 8 * s);
        float mx = sc[0];
#pragma unroll
        for (int i = 1; i < 16; ++i) mx = fmaxf(mx, sc[i]);
        mx = fmaxf(mx, shx(mx, 32, lane));
        const float mn = fmaxf(m, mx), alpha = __builtin_amdgcn_exp2f(m - mn);
        float ps = 0.f;
#pragma unroll
        for (int i = 0; i < 16; ++i) { sc[i] = __builtin_amdgcn_exp2f(sc[i] - mn); ps += sc[i]; }
        l = l * alpha + ps; m = mn;
#pragma unroll
        for (int t = 0; t < 4; ++t) o[t] = o[t] * alpha;
        bf16x8 pb[2];
#pragma unroll
        for (int s = 0; s < 2; ++s) { u32x4 w; w.x = cvt_pk_bf16(sc[8 * s + 0], sc[8 * s + 1]); w.y = cvt_pk_bf16(sc[8 * s + 2], sc[8 * s + 3]); w.z = cvt_pk_bf16(sc[8 * s + 4], sc[8 * s + 5]); w.w = cvt_pk_bf16(sc[8 * s + 6], sc[8 * s + 7]);
            pb[s] = __builtin_bit_cast(bf16x8, w); }
#pragma unroll
        for (int t = 0; t < 4; ++t)
#pragma unroll
            for (int s = 0; s < 2; ++s) o[t] = MFMA32(va[t * 2 + s], pb[s], o[t]);
    }
}
__device__ __forceinline__ void attn_store_tile(const f32x16& ot, float inv, bf16* crow  , int t, int hh) {
#pragma unroll
    for (int g = 0; g < 4; ++g) { u32x2 w; w.x = cvt_pk_bf16(ot[4 * g] * inv, ot[4 * g + 1] * inv); w.y = cvt_pk_bf16(ot[4 * g + 2] * inv, ot[4 * g + 3] * inv);
        *(u32x2*)(crow + 32 * t + 8 * g + 4 * hh) = w; }
}

__device__ __forceinline__ void phase_mixer(const Args& A, int l, LAS unsigned char* lds, int lane_in, int wave) {
    unsigned char* ws = A.ws;
    const bf16* Q = (const bf16*)(ws + WS_Q); const bf16* KN = (const bf16*)(ws + WS_KNOPE); const bf16* KRB = (const bf16*)(ws + WS_KRB);
    const bf16* VTP = (const bf16*)(ws + WS_VTP); const bf16* VTS = (const bf16*)(ws + WS_VTS);
    const bf16* UG = (const bf16*)(ws + WS_UG); const bf16* VN = (const bf16*)(ws + WS_VN);
    bf16* CC = (bf16*)(ws + WS_CONCAT);
    for (int it = blockIdx.x; it < 480; it += gridDim.x) {
        int lane = lane_in; asm volatile("" : "+v"(lane));
        const int rho = lane & 31, hh = lane >> 5, tid = wave * 64 + lane;
        if (it < 384) {
            const bool heavy = it < 256;
            int h, q0, keys, key_lo, key_hi, split, rowA, rowB; const bf16* vt;
            if (heavy) { const int b = it >> 6, qt = it & 15, qg = wave & 1, seg = wave >> 1; h = (it >> 4) & 3;
                q0 = NTOK_P + b * 1024 + qt * 64 + qg * 32; keys = 1536; key_lo = seg * 384; key_hi = key_lo + 384; split = 512; rowA = NTOK + b * 512; rowB = NTOK_P + b * 1024;
                vt = VTS + (size_t)((b * 4 + h) * 128) * 1536; }
            else { const int i2 = it - 256, b = i2 >> 2; h = i2 & 3; q0 = b * 256 + wave * 32; keys = 256; key_lo = 0; key_hi = 256; split = 0; rowA = 0; rowB = b * 256;
                vt = VTP + (size_t)((b * 4 + h) * 128) * 256; }
            bf16x8 qf[12];
            { const bf16* qp = Q + (size_t)(q0 + rho) * 768 + h * 192 + 8 * hh;
#pragma unroll
              for (int ks = 0; ks < 12; ++ks) qf[ks] = *(const bf16x8*)(qp + 16 * ks); }
            f32x16 o[4];
#pragma unroll
            for (int t = 0; t < 4; ++t)
#pragma unroll
                for (int i = 0; i < 16; ++i) o[t][i] = 0.f;
            float m = -1e30f, lsum = 0.f;
            attn_wave(o, m, lsum, qf, KN, KRB, vt + (size_t)rho * keys + 16 * hh, keys, h, key_lo, key_hi, split, rowA, rowB, lane);
            lsum += shx(lsum, 32, lane);
            if (!heavy) {
                const float inv = 1.0f / lsum; bf16* crow = CC + (size_t)(q0 + rho) * 1024 + h * 128;
#pragma unroll
                for (int t = 0; t < 4; ++t) attn_store_tile(o[t], inv, crow, t, hh);
            } else {
                LAS float* wb = (LAS float*)(lds + wave * 16640);
#pragma unroll
                for (int t = 0; t < 4; ++t)
#pragma unroll
                    for (int i = 0; i < 16; ++i) wb[(t * 16 + i) * 64 + lane] = o[t][i];
                if (hh == 0) { wb[4096 + rho] = m; wb[4128 + rho] = lsum; }
                __syncthreads();
                const int qg = wave & 1, seg = wave >> 1;
                float ms[4], wg[4]; float mg = -1e30f;
#pragma unroll
                for (int s = 0; s < 4; ++s) { ms[s] = ((LAS float*)(lds + (qg + 2 * s) * 16640))[4096 + rho]; mg = fmaxf(mg, ms[s]); }
                float lt = 0.f;
#pragma unroll
                for (int s = 0; s < 4; ++s) { wg[s] = __builtin_amdgcn_exp2f(ms[s] - mg); lt += wg[s] * ((LAS float*)(lds + (qg + 2 * s) * 16640))[4128 + rho]; }
                f32x16 acc;
#pragma unroll
                for (int i = 0; i < 16; ++i) { float a = 0.f;
#pragma unroll
                    for (int s = 0; s < 4; ++s) a += wg[s] * ((LAS float*)(lds + (qg + 2 * s) * 16640))[(seg * 16 + i) * 64 + lane];
                    acc[i] = a; }
                const int qrow = (q0 + rho);
                attn_store_tile(acc, 1.0f / lt, CC + (size_t)qrow * 1024 + h * 128, seg, hh);
                __syncthreads();
            }
        } else {
            const int c = it - 384;
            LAS bf16* vnT = (LAS bf16*)lds;
#pragma unroll
            for (int pass = 0; pass < 8; ++pass) { const int id = tid + 512 * pass, qq = id >> 5, c8 = (id & 31) * 8;
                const bf16x8 v = *(const bf16x8*)(VN + (size_t)(c * 128 + qq) * 256 + c8);
#pragma unroll
                for (int j = 0; j < 8; ++j) vnT[(c8 + j) * 136 + qq] = (bf16)v[j]; }
            __syncthreads();
            const int hd = wave & 3, ph = wave >> 2;
#pragma unroll
            for (int pp = 0; pp < 2; ++pp) { const int pt = 2 * ph + pp;
                f32x16 acc[2];
#pragma unroll
                for (int d = 0; d < 2; ++d)
#pragma unroll
                    for (int i = 0; i < 16; ++i) acc[d][i] = 0.f;
                const float* wrow = A.w_s + ((size_t)(l * 4 + hd) * 128 + 32 * pt + rho) * 128 + 8 * hh;
#pragma unroll
                for (int ks = 0; ks < 8; ++ks) { const f32x4 w0 = *(const f32x4*)(wrow + 16 * ks), w1 = *(const f32x4*)(wrow + 16 * ks + 4);
                    u32x4 w; w.x = cvt_pk_bf16(w0.x, w0.y); w.y = cvt_pk_bf16(w0.z, w0.w); w.z = cvt_pk_bf16(w1.x, w1.y); w.w = cvt_pk_bf16(w1.z, w1.w);
                    const bf16x8 af = __builtin_bit_cast(bf16x8, w);
#pragma unroll
                    for (int d = 0; d < 2; ++d) { const bf16x8 bfr = *(const LAS bf16x8*)(vnT + (hd * 64 + 32 * d + rho) * 136 + 16 * ks + 8 * hh); acc[d] = MFMA32(af, bfr, acc[d]); } }
#pragma unroll
                for (int d = 0; d < 2; ++d) { const int col = hd * 64 + 32 * d + rho;
#pragma unroll
                    for (int i = 0; i < 16; ++i) { const int p = 32 * pt + (i & 3) + 8 * (i >> 2) + 4 * hh; const size_t row = (size_t)c * 128 + p;
                        const float mixed = acc[d][i] + A.b_s[(l * 4 + hd) * 128 + p];
                        const float ugv = __uint_as_float((unsigned)UG[row * 256 + col] << 16);
                        CC[row * 1024 + 512 + col] = (bf16)(cvt_pk_bf16(ugv * mixed, 0.f) & 0xffffu); } }
            }
            __syncthreads();
        }
    }
}

__global__ void __launch_bounds__(512, 2) fwd_megakernel(Args A) {
    extern __shared__ __attribute__((aligned(16))) unsigned char smem[];
    LAS unsigned char* lds = (LAS unsigned char*)smem;
    const int wave0 = __builtin_amdgcn_readfirstlane((int)threadIdx.x >> 6);
    unsigned* const bar = (unsigned*)(A.ws + WS_BAR);
    volatile LAS unsigned* const barst = (volatile LAS unsigned*)(lds + LDS_BARST);
    const unsigned xcc = xb_xcc_id();
    if (wave0 == 0) { const int l0 = fresh_lane(); if (l0 < 2) barst[l0] = 0u; if (l0 == 0 && A.ph_hi - A.ph_lo > 1) (void)xb_add(&bar[XB_XCNT(xcc)], 1u); }
    __syncthreads();
    if (A.ph_lo < 0) cg::this_grid().sync();
    bool dup_done = false; (void)dup_done;
    for (int ph = A.ph_lo; ph < A.ph_hi; ++ph) {
        const int wave = wave0;
#define LANE fresh_lane()
#define TID (wave * 64 + fresh_lane())
        unsigned char* ws = A.ws; asm volatile("" : "+s"(ws));
        if (ph == 0) phase_prologue(A, lds, wave);
        else if (ph == 1) phase_pre(A, LANE, wave);
        else {
            const int l = (ph - 2) / 9, k = (ph - 2) % 9;
            const int G = gridDim.x, bid = blockIdx.x;
            if (k == 0) {
                pg8::Gemm g{(const bf16*)(ws + WS_H), (const bf16*)(ws + WS_WIN) + (size_t)l * 2048 * 1024, NTOK, 2048, 1024}; pg8::StaticOrder S; S.init(NTOK, 2048, G, bid);
                EpiF32 E{(float*)(ws + WS_Z), INC, INC}; pg8::gemm_phase<EpiF32, pg8::StaticOrder>(lds, g, S, E, TID);
            } else if (k == 1) phase_split(A, l, LANE, wave);
            else if (k == 2) {
                { pg8::Gemm g{(const bf16*)(ws + WS_QN), (const bf16*)(ws + WS_WUQ) + (size_t)l * 768 * 384, NTOK, 768, 384}; pg8::StaticOrder S; S.init(NTOK, 768, G, bid);
                  EpiQ E{(bf16*)(ws + WS_Q), (const float*)(ws + WS_ROPE), (const float*)(ws + WS_ROPE) + 32768}; pg8::gemm_phase<EpiQ, pg8::StaticOrder>(lds, g, S, E, TID); }
                                { pg8::Gemm g{(const bf16*)(ws + WS_CKVN), (const bf16*)(ws + WS_WUKV) + (size_t)l * 1024 * 256, NROWKV, 1024, 256}; pg8::StaticOrder S; S.init(NROWKV, 1024, G, (bid + G - 144 % G) % G);
                  EpiKV E{(bf16*)(ws + WS_KNOPE), (bf16*)(ws + WS_VTP), (bf16*)(ws + WS_VTS)}; pg8::gemm_phase<EpiKV, pg8::StaticOrder>(lds, g, S, E, TID); }
            } else if (k == 3) phase_mixer(A, l, lds, LANE, wave);
            else if (k == 4 || k == 7) {
                const bool o = (k == 4);
                pg8::Gemm g{(const bf16*)(ws + (o ? WS_CONCAT : WS_ACT)), o ? (const bf16*)(ws + WS_WOUT) + (size_t)l * 1024 * 1024 : (const bf16*)(ws + WS_WFF2) + (size_t)l * 1024 * 4096, NTOK, 1024, o ? 1024 : 4096};
                pg8::StaticOrder S; S.init(NTOK, 1024, G, bid);
                EpiF32 E{(float*)(ws + WS_MIX), 1024, 1024}; pg8::gemm_phase<EpiF32, pg8::StaticOrder>(lds, g, S, E, TID);
            } else if (k == 5) phase_post(A, l, 0, LANE, wave);
            else if (k == 6) {
                pg8::Gemm g{(const bf16*)(ws + WS_H), (const bf16*)(ws + WS_WFF1) + (size_t)l * 4096 * 1024, NTOK, 4096, 1024}; pg8::StaticOrder S; S.init(NTOK, 4096, G, bid);
                EpiAct E{(bf16*)(ws + WS_ACT), 4096}; pg8::gemm_phase<EpiAct, pg8::StaticOrder>(lds, g, S, E, TID);
            } else phase_post(A, l, 1, LANE, wave);
        }
        if (ph + 1 < A.ph_hi) xcd_barrier(bar, xcc, barst, wave == 0 && fresh_lane() == 0);
#if PROBE_DUP >= 0
        {
            bool again = false;
            if (PROBE_DUP == 100) { if (ph + 1 < A.ph_hi) xcd_barrier(bar, xcc, barst, wave == 0 && fresh_lane() == 0); }
            else if (!dup_done) {
                const int kk = ph >= 2 ? (ph - 2) % 9 : -1;
                if (PROBE_DUP == 50) again = (ph == 0);
                else if (PROBE_DUP == 60) again = (kk == 0 || kk == 2 || kk == 4 || kk == 6 || kk == 7);
                else again = (kk == PROBE_DUP);
            }
            if (again) { dup_done = true; --ph; } else dup_done = false;
        }
#endif
    }
}

constexpr int N_PHASES = 2 + 9 * DEPTH;

extern "C" void kernel_launch(void* const* d_in, const int* in_sizes, int n_in, void* d_out, int out_size, void* d_ws, size_t ws_size, hipStream_t stream) {
    static int grid = 0;
    if (grid == 0) {
        if (n_in != 24 || ws_size < WS_END || in_sizes[9] != DEPTH * 1024 * INC) { fprintf(stderr, "kernel_launch: unexpected problem (n_in %d, ws %zu, w_in %d)\n", n_in, ws_size, n_in > 9 ? in_sizes[9] : -1); grid = -1; return; }
        int dev = 0, cus = 0, per_cu = 0;
        hipGetDevice(&dev); hipDeviceGetAttribute(&cus, hipDeviceAttributeMultiprocessorCount, dev);
        if (hipFuncSetAttribute((const void*)fwd_megakernel, hipFuncAttributeMaxDynamicSharedMemorySize, LDS_BYTES) != hipSuccess) { fprintf(stderr, "kernel_launch: hipFuncSetAttribute failed\n"); grid = -1; return; }
        if (hipOccupancyMaxActiveBlocksPerMultiprocessor(&per_cu, (const void*)fwd_megakernel, 512, LDS_BYTES) != hipSuccess || per_cu < 1) { fprintf(stderr, "kernel_launch: occupancy query says %d\n", per_cu); per_cu = 1; }
        (void)hipGetLastError();
        grid = cus * 1;
        fprintf(stderr, "kernel_launch: grid %d (cus %d, per_cu %d)\n", grid, cus, per_cu);
    }
    if (grid < 0) return;
    if (hipMemsetAsync((char*)d_ws + WS_BAR, 0, 16384, stream) != hipSuccess) { fprintf(stderr, "kernel_launch: memset failed\n"); return; }
    Args a{};
    const float** ap = (const float**)&a;
    for (int i = 0; i < 24; ++i) ap[i] = (const float*)d_in[i];
    a.out = (float*)d_out; a.ws = (unsigned char*)d_ws;
#if MK_PER_PHASE
    for (int ph = 0; ph < N_PHASES; ++ph) { a.ph_lo = ph; a.ph_hi = ph + 1; hipLaunchKernelGGL(fwd_megakernel, dim3(grid), dim3(512), LDS_BYTES, stream, a); }
#else
    a.ph_lo = 0; a.ph_hi = N_PHASES;
    void* args[] = {&a};
    hipError_t e = hipLaunchCooperativeKernel((const void*)fwd_megakernel, dim3(grid), dim3(512), args, LDS_BYTES, stream);
    if (e != hipSuccess) fprintf(stderr, "kernel_launch: cooperative launch failed: %s (grid %d)\n", hipGetErrorString(e), grid);
#endif
}
```

```cpp
#include <hip/hip_runtime.h>
#include <hip/hip_cooperative_groups.h>
#include <cstdio>
namespace cg = cooperative_groups;

#ifndef MK_PER_PHASE
#define MK_PER_PHASE 0
#endif

#ifndef PROBE_DUP
#define PROBE_DUP -1
#endif
#define LAS __attribute__((address_space(3)))
typedef unsigned short bf16;
typedef short bf16x8 __attribute__((ext_vector_type(8)));
typedef float f32x2 __attribute__((ext_vector_type(2)));
typedef float f32x4 __attribute__((ext_vector_type(4)));
typedef float f32x16 __attribute__((ext_vector_type(16)));
typedef unsigned u32x2 __attribute__((ext_vector_type(2)));
typedef unsigned u32x4 __attribute__((ext_vector_type(4)));

constexpr int DM = 1024, NTOK_P = 8192, NTOK_S = 4096, NTOK = 12288, NROWKV = 14336;
constexpr int DEPTH = 4, INC = 1984, DFF = 4096;
constexpr int ZQ = 0, ZCKV = 384, ZKR = 640, ZU = 704, ZV = 960, ZBG = 1216, ZCG = 1472, ZHH = 1728;
constexpr float EPS = 1e-6f;
constexpr float QSCALE = 0.07216878364870322f * 1.4426950408889634f;

constexpr size_t MiB = 1u << 20;
constexpr size_t WS_MOD = 0, WS_BAR = 512 * 1024, WS_ROPE = 1 * MiB, WS_WIN = 2 * MiB, WS_WUQ = 18 * MiB, WS_WUKV = 21 * MiB, WS_WOUT = 23 * MiB,
                 WS_WFF1 = 31 * MiB, WS_WFF2 = 63 * MiB, WS_H = 95 * MiB, WS_MIX = 119 * MiB, WS_CONCAT = 167 * MiB, WS_QN = 191 * MiB,
                 WS_CKVN = 200 * MiB, WS_KRB = 207 * MiB, WS_UG = 209 * MiB, WS_VN = 215 * MiB, WS_Q = 221 * MiB, WS_KNOPE = 239 * MiB,
                 WS_VTP = 253 * MiB, WS_VTS = 261 * MiB, WS_Z = 267 * MiB, WS_ACT = 267 * MiB, WS_END = 363 * MiB;
constexpr int LDS_BYTES = 147456, LDS_BARST = LDS_BYTES - 64;

__device__ __forceinline__ unsigned cvt_pk_bf16(float lo, float hi) { unsigned r; asm volatile("v_cvt_pk_bf16_f32 %0, %1, %2" : "=v"(r) : "v"(lo), "v"(hi)); return r; }
__device__ __forceinline__ int fresh_lane() { int l; asm volatile("v_mbcnt_lo_u32_b32 %0, -1, 0\n\tv_mbcnt_hi_u32_b32 %0, -1, %0" : "=v"(l)); return l; }
__device__ __forceinline__ float shx(float v, int mask, int lane) { return __int_as_float(__builtin_amdgcn_ds_bpermute((lane ^ mask) << 2, __float_as_int(v))); }
__device__ __forceinline__ float wave_sum(float v, int lane) {
#pragma unroll
    for (int o = 1; o < 64; o <<= 1) v += shx(v, o, lane);
    return v;
}
__device__ __forceinline__ float gelu_tanh(float x) { const float y = 0.7978845608028654f * (x + 0.044715f * x * x * x); return x / (1.0f + __expf(-2.0f * y)); }
__device__ __forceinline__ f32x4 gelu4(f32x4 v) { return (f32x4){gelu_tanh(v.x), gelu_tanh(v.y), gelu_tanh(v.z), gelu_tanh(v.w)}; }
__device__ __forceinline__ float sumsq4(f32x4 v) { return (v.x * v.x + v.y * v.y) + (v.z * v.z + v.w * v.w); }
__device__ __forceinline__ u32x2 pk4(f32x4 v) { u32x2 w; w.x = cvt_pk_bf16(v.x, v.y); w.y = cvt_pk_bf16(v.z, v.w); return w; }


#define XB_TMO      128
#define XB_XCNT(j)  (256  + 64 * (j))
#define XB_XSUB(j)  (1280 + 64 * (j))
#define XB_XGEN(j)  (2304 + 64 * (j))
#define XB_TOP      3328
#define XB_TOPGEN   3392
#define XCD_BAR_WORDS 3456
#define XB_SPIN_CAP (1u << 18)
__device__ __forceinline__ unsigned xb_ld(unsigned* p)              { return __hip_atomic_load(p, __ATOMIC_RELAXED, __HIP_MEMORY_SCOPE_AGENT); }
__device__ __forceinline__ unsigned xb_add(unsigned* p, unsigned v) { return __hip_atomic_fetch_add(p, v, __ATOMIC_RELAXED, __HIP_MEMORY_SCOPE_AGENT); }
__device__ __forceinline__ unsigned xb_xcc_id() { return (unsigned)__builtin_amdgcn_s_getreg((3 << 11) | 20) & 0xFu; }
#define XB_SPIN(cond, bar) do { unsigned _sp = 0; while (cond) { __builtin_amdgcn_s_sleep(1); \
    if ((++_sp & 255u) == 0u) { if (xb_ld(&(bar)[XB_TMO])) break; if (_sp > XB_SPIN_CAP) { atomicAdd(&(bar)[XB_TMO], 1u); break; } } } } while (0)
__device__ __forceinline__ void xcd_barrier_complete(unsigned* bar, unsigned x, unsigned& nloc, unsigned& nx) {
    const unsigned G = gridDim.x * gridDim.y * gridDim.z;
    unsigned sum, cnt, mine, sp = 0u;
    for (;;) {
        sum = 0u; cnt = 0u; mine = 0u;
#pragma unroll
        for (unsigned j = 0; j < 16; ++j) { const unsigned c = xb_ld(&bar[XB_XCNT(j)]); sum += c; cnt += (c > 0u) ? 1u : 0u; mine = (j == x) ? c : mine; }
        if (sum == G) break;
        __builtin_amdgcn_s_sleep(1);
        if ((++sp & 255u) == 0u) { if (xb_ld(&bar[XB_TMO])) break; if (sp > XB_SPIN_CAP) { atomicAdd(&bar[XB_TMO], 1u); break; } }
    }
    nloc = mine > 0u ? mine : 1u; nx = cnt > 0u ? cnt : 1u;
}
__device__ __forceinline__ void xcd_barrier(unsigned* bar, unsigned x, volatile LAS unsigned* st, bool leader) {
    asm volatile("s_waitcnt vmcnt(0)" ::: "memory");
    __syncthreads();
    if (leader) {
        __builtin_amdgcn_s_waitcnt(0);
        unsigned nloc = st[0], nx = st[1];
        if (nloc == 0u) { xcd_barrier_complete(bar, x, nloc, nx); st[0] = nloc; st[1] = nx; }
        const unsigned old = xb_add(&bar[XB_XSUB(x)], 1u);
        const unsigned gen = old / nloc;
        if (old + 1u == (gen + 1u) * nloc) {
            __builtin_amdgcn_fence(__ATOMIC_RELEASE, "agent");
            asm volatile("s_waitcnt vmcnt(0)" ::: "memory");
            const unsigned og = xb_add(&bar[XB_TOP], 1u);
            const unsigned tg = og / nx;
            if (og + 1u == (tg + 1u) * nx) xb_add(&bar[XB_TOPGEN], 1u);
            else XB_SPIN(xb_ld(&bar[XB_TOPGEN]) == tg, bar);
            __builtin_amdgcn_fence(__ATOMIC_ACQUIRE, "agent");
            xb_add(&bar[XB_XGEN(x)], 1u);
            asm volatile("s_waitcnt vmcnt(0)" ::: "memory");
        } else {
            XB_SPIN(xb_ld(&bar[XB_XGEN(x)]) == gen, bar);
            __builtin_amdgcn_fence(__ATOMIC_ACQUIRE, "agent");
            asm volatile("s_waitcnt vmcnt(0)" ::: "memory");
        }
    }
    __syncthreads();
}

namespace pg8 {
#define PG8_LAS __attribute__((address_space(3)))
typedef unsigned short bf16_t;
constexpr int BM = 256, BK = 64, HALF = 128, HTB = HALF * BK * 2, STAGE_BYTES = 8 * HTB, NXCD = 8, WGM = 8;
__host__ __device__ __forceinline__ int lds_byte(int r, int c) { const int st = (r >> 4) * 2 + (c >> 5), rr = r & 15, cc = c & 31, ob = rr * 64 + cc * 2; return st * 1024 + (ob ^ (((ob >> 9) & 1) << 5)); }
__host__ __device__ __forceinline__ void stage_rc(int b, int& R, int& C) { const int st = b / 1024, sb = b % 1024, swz = sb ^ (((sb >> 9) & 1) << 5); R = (st >> 1) * 16 + swz / 64; C = (st & 1) * 32 + (swz % 64) / 2; }
__host__ __device__ __forceinline__ int perm32(int rho) { const int n = rho >> 4, i = rho & 15; return 8 * (i >> 2) + 4 * n + (i & 3); }
struct Unit { int pm, pn; };
struct Gemm { const bf16_t* A; const bf16_t* Bt; int M, N, K; };
struct StaticOrder {
    int nM, nN, nwg, G, c;
    __host__ __device__ void init(int M, int N, int G_, int c_) { nM = M / BM; nN = N / BM; nwg = nM * nN; G = G_; c = c_; }
    __host__ __device__ bool next(int i, Unit& u) const {
        const long L = (long)i * G + c; if (L >= nwg) return false;
        int wgid = (int)L; { const int q = nwg / NXCD, r = nwg % NXCD, xcd = wgid % NXCD, off = wgid / NXCD; wgid = (xcd < r ? xcd * (q + 1) : r * (q + 1) + (xcd - r) * q) + off; }
        const int nig = WGM * nN, gid = wgid / nig, fm = gid * WGM, gsz = (nM - fm) < WGM ? (nM - fm) : WGM;
        u.pm = fm + ((wgid % nig) % gsz); u.pn = (wgid % nig) / gsz; return true;
    }
    __device__ __forceinline__ void a_ready(const Unit&) const {}
    __device__ __forceinline__ void done(const Unit&) const {}
};

template <class Epi, class Sched>
__device__ __forceinline__ void gemm_phase(PG8_LAS unsigned char* lds, const Gemm g, const Sched& S, const Epi& E, const int tid) {
    const int wid = __builtin_amdgcn_readfirstlane(tid >> 6), lane = tid & 63, wr = wid >> 2, wc = wid & 3, fr = lane & 15, fq = lane >> 4;
    const int K = g.K, nt = K / BK;
    unsigned voffA[2], voffB[2];
#pragma unroll
    for (int i = 0; i < 2; ++i) { int R, C; stage_rc(tid * 16 + i * 8192, R, C); const int Rb = Epi::PERM ? ((R & ~31) + perm32(R & 31)) : R;
        voffA[i] = (unsigned)(R * K + C) * 2u; voffB[i] = (unsigned)(Rb * K + C) * 2u; }
    const size_t kstep = (size_t)(BK * 2);
    const size_t hstep = (size_t)HALF * K * 2;
    const size_t tstep = 2 * hstep;
    const unsigned ldsw = (unsigned)wid * 1024u;
    const int aoff = lds_byte(wr * 64 + fr, fq * 8), boff = lds_byte(wc * 32 + fr, fq * 8);
#define PG8_SA(b, h) (((b) * 2 + (h)) * HTB)
#define PG8_SB(b, h) ((4 + (b) * 2 + (h)) * HTB)
#define PG8_STAGE(bufoff, gbase, voff) do { _Pragma("unroll") for (int _i = 0; _i < 2; ++_i) \
        __builtin_amdgcn_global_load_lds((const unsigned*)((const char*)(gbase) + (voff)[_i]), (PG8_LAS unsigned*)(lds + (bufoff) + ldsw + _i * 8192), 16, 0, 0); } while (0)
#define PG8_LDA(dst, b, h) do { _Pragma("unroll") for (int m = 0; m < 4; ++m) _Pragma("unroll") for (int k = 0; k < 2; ++k) dst[m][k] = *(const PG8_LAS bf16x8*)(lds + PG8_SA(b, h) + aoff + m * 2048 + k * 1024); } while (0)
#define PG8_LDB(dst, b, h) do { _Pragma("unroll") for (int n = 0; n < 2; ++n) _Pragma("unroll") for (int k = 0; k < 2; ++k) dst[n][k] = *(const PG8_LAS bf16x8*)(lds + PG8_SB(b, h) + boff + n * 2048 + k * 1024); } while (0)
#define PG8_MMA(ai, bj, At, Bt) do { __builtin_amdgcn_s_setprio(1); _Pragma("unroll") for (int m = 0; m < 4; ++m) _Pragma("unroll") for (int n = 0; n < 2; ++n) _Pragma("unroll") for (int k = 0; k < 2; ++k) \
        acc[ai][bj][m][n] = __builtin_amdgcn_mfma_f32_16x16x32_bf16(Bt[n][k], At[m][k], acc[ai][bj][m][n], 0, 0, 0); __builtin_amdgcn_s_setprio(0); } while (0)
#define PG8_WAIT_V(n) asm volatile("s_waitcnt vmcnt(" #n ")" ::: "memory")
#define PG8_WAIT_L(n) asm volatile("s_waitcnt lgkmcnt(" #n ")" ::: "memory")
#define PG8_BAR __builtin_amdgcn_s_barrier()
#define PG8_SCHED __builtin_amdgcn_sched_barrier(0)
    Unit cur, nxt; int ui = 0;
    if (!S.next(0, cur)) return;
    f32x4 acc[2][2][4][2];
#pragma unroll
    for (int a = 0; a < 2; ++a)
#pragma unroll
        for (int b = 0; b < 2; ++b)
#pragma unroll
            for (int m = 0; m < 4; ++m)
#pragma unroll
                for (int n = 0; n < 2; ++n) acc[a][b][m][n] = (f32x4){0.f, 0.f, 0.f, 0.f};
    bf16x8 At[4][2], B0[2][2], B1[2][2];
    const char* cA = (const char*)g.A + (size_t)cur.pm * tstep; const char* cB = (const char*)g.Bt + (size_t)cur.pn * tstep;
    S.a_ready(cur);
    PG8_STAGE(PG8_SB(0, 0), cB, voffB); PG8_STAGE(PG8_SA(0, 0), cA, voffA); PG8_STAGE(PG8_SB(0, 1), cB + hstep, voffB); PG8_STAGE(PG8_SA(0, 1), cA + hstep, voffA);
    if (wr == 1) PG8_BAR;
    PG8_WAIT_V(4); PG8_BAR;
    PG8_STAGE(PG8_SB(1, 0), cB + kstep, voffB); PG8_STAGE(PG8_SA(1, 0), cA + kstep, voffA); PG8_STAGE(PG8_SB(1, 1), cB + hstep + kstep, voffB);
    PG8_WAIT_V(6); PG8_BAR;
    for (;;) {
        const bool has_next = S.next(ui + 1, nxt);
        const char* nA = has_next ? (const char*)g.A + (size_t)nxt.pm * tstep : cA; const char* nB = has_next ? (const char*)g.Bt + (size_t)nxt.pn * tstep : cB;
        for (int t = 0; t < nt; t += 2) {
            const bool last = (t == nt - 2);
            const char* a1 = cA + (size_t)(t + 1) * kstep;
            const char* a2 = last ? nA : cA + (size_t)(t + 2) * kstep; const char* b2 = last ? nB : cB + (size_t)(t + 2) * kstep;
            const char* a3 = a2 + kstep; const char* b3 = b2 + kstep;
            if (last && has_next) S.a_ready(nxt);
            PG8_LDB(B0, 0, 0); PG8_SCHED; PG8_LDA(At, 0, 0); PG8_STAGE(PG8_SA(1, 1), a1 + hstep, voffA);
            PG8_WAIT_L(8); PG8_BAR; PG8_WAIT_L(0); PG8_MMA(0, 0, At, B0); PG8_BAR; PG8_SCHED;
            PG8_LDB(B1, 0, 1); PG8_STAGE(PG8_SB(0, 0), b2, voffB);
            PG8_BAR; PG8_WAIT_L(0); PG8_MMA(0, 1, At, B1); PG8_BAR;
            PG8_LDA(At, 0, 1); PG8_STAGE(PG8_SA(0, 0), a2, voffA);
            PG8_BAR; PG8_WAIT_L(0); PG8_MMA(1, 0, At, B0); PG8_BAR; PG8_SCHED;
            PG8_STAGE(PG8_SB(0, 1), b2 + hstep, voffB);
            PG8_WAIT_V(6); PG8_BAR; PG8_MMA(1, 1, At, B1); PG8_BAR;
            PG8_LDB(B0, 1, 0); PG8_SCHED; PG8_LDA(At, 1, 0); PG8_STAGE(PG8_SA(0, 1), a2 + hstep, voffA);
            PG8_WAIT_L(8); PG8_BAR; PG8_WAIT_L(0); PG8_MMA(0, 0, At, B0); PG8_BAR; PG8_SCHED;
            PG8_LDB(B1, 1, 1); PG8_STAGE(PG8_SB(1, 0), b3, voffB);
            PG8_BAR; PG8_WAIT_L(0); PG8_MMA(0, 1, At, B1); PG8_BAR;
            PG8_LDA(At, 1, 1); PG8_STAGE(PG8_SA(1, 0), a3, voffA);
            PG8_BAR; PG8_WAIT_L(0); PG8_MMA(1, 0, At, B0); PG8_BAR; PG8_SCHED;
            PG8_STAGE(PG8_SB(1, 1), b3 + hstep, voffB);
            PG8_WAIT_V(6); PG8_BAR; PG8_MMA(1, 1, At, B1); PG8_BAR;
        }
        E(acc, cur, wr, wc, fr, fq); S.done(cur);
        if (!has_next) break;
#pragma unroll
        for (int a = 0; a < 2; ++a)
#pragma unroll
            for (int b = 0; b < 2; ++b)
#pragma unroll
                for (int m = 0; m < 4; ++m)
#pragma unroll
                    for (int n = 0; n < 2; ++n) acc[a][b][m][n] = (f32x4){0.f, 0.f, 0.f, 0.f};
        cur = nxt; cA = nA; cB = nB; ++ui;
    }
    PG8_WAIT_V(0);
    if (wr == 0) PG8_BAR;
    PG8_BAR;
#undef PG8_SA
#undef PG8_SB
#undef PG8_STAGE
#undef PG8_LDA
#undef PG8_LDB
#undef PG8_MMA
#undef PG8_WAIT_V
#undef PG8_WAIT_L
#undef PG8_BAR
#undef PG8_SCHED
}
}

struct EpiF32 {
    static constexpr bool PERM = false;
    float* C; int ldc; int ncols;
    __device__ __forceinline__ void operator()(const f32x4 (&acc)[2][2][4][2], const pg8::Unit& u, int wr, int wc, int fr, int fq) const {
        const int row0 = u.pm * 256 + wr * 64 + fr, col0 = u.pn * 256 + wc * 32 + 4 * fq;
#pragma unroll
        for (int ai = 0; ai < 2; ++ai)
#pragma unroll
            for (int m = 0; m < 4; ++m) { float* rowp = C + (size_t)(row0 + ai * 128 + m * 16) * ldc + col0;
#pragma unroll
                for (int bj = 0; bj < 2; ++bj)
#pragma unroll
                    for (int n = 0; n < 2; ++n) if (col0 + bj * 128 + n * 16 < ncols) *(f32x4*)(rowp + bj * 128 + n * 16) = acc[ai][bj][m][n]; }
    }
};
struct EpiAct {
    static constexpr bool PERM = true;
    bf16* O; int ldc;
    __device__ __forceinline__ void operator()(const f32x4 (&acc)[2][2][4][2], const pg8::Unit& u, int wr, int wc, int fr, int fq) const {
        const int row0 = u.pm * 256 + wr * 64 + fr, col0 = u.pn * 256 + wc * 32 + 8 * fq;
#pragma unroll
        for (int ai = 0; ai < 2; ++ai)
#pragma unroll
            for (int m = 0; m < 4; ++m) { bf16* rowp = O + (size_t)(row0 + ai * 128 + m * 16) * ldc + col0;
#pragma unroll
                for (int bj = 0; bj < 2; ++bj) { f32x4 v0 = acc[ai][bj][m][0], v1 = acc[ai][bj][m][1];
#pragma unroll
                    for (int j = 0; j < 4; ++j) { const float a = fmaxf(v0[j], 0.f), b = fmaxf(v1[j], 0.f); v0[j] = a * a; v1[j] = b * b; }
                    u32x4 w; w.x = cvt_pk_bf16(v0[0], v0[1]); w.y = cvt_pk_bf16(v0[2], v0[3]); w.z = cvt_pk_bf16(v1[0], v1[1]); w.w = cvt_pk_bf16(v1[2], v1[3]);
                    *(u32x4*)(rowp + bj * 128) = w; } }
    }
};
struct EpiQ {
    static constexpr bool PERM = false;
    bf16* Q; const float* ropec; const float* ropes;
    __device__ __forceinline__ void operator()(const f32x4 (&acc)[2][2][4][2], const pg8::Unit& u, int wr, int wc, int, int) const {
        const int ln = fresh_lane(), fr = ln & 15, fq = ln >> 4;
        const int row0 = u.pm * 256 + wr * 64 + fr; const bool sample = u.pm >= 32;
#pragma unroll
        for (int bj = 0; bj < 2; ++bj) {
            const int g0 = u.pn * 256 + bj * 128 + wc * 32, within0 = g0 % 192; const bool isrope = within0 >= 128; const int a = (within0 - 128) >> 5;
#pragma unroll
            for (int ai = 0; ai < 2; ++ai)
#pragma unroll
                for (int m = 0; m < 4; ++m) { const int row = row0 + ai * 128 + m * 16;
                    f32x4 x1 = acc[ai][bj][m][0], x2 = acc[ai][bj][m][1];
                    if (sample && isrope) { const int ntok = (row - NTOK_P) & 1023;
                        const f32x4 cs = *(const f32x4*)(ropec + ntok * 32 + a * 16 + 4 * fq), sn = *(const f32x4*)(ropes + ntok * 32 + a * 16 + 4 * fq);
                        const f32x4 o1 = x1 * cs - x2 * sn, o2 = x1 * sn + x2 * cs; x1 = o1; x2 = o2; }
                    x1 = x1 * QSCALE; x2 = x2 * QSCALE;
                    bf16* p = Q + (size_t)row * 768 + g0 + 4 * fq;
                    *(u32x2*)p = pk4(x1); *(u32x2*)(p + 16) = pk4(x2); asm volatile("" ::: "memory"); }
        }
    }
};
struct EpiKV {
    static constexpr bool PERM = false;
    bf16* KN; bf16* VTP; bf16* VTS;
    __device__ __forceinline__ void operator()(const f32x4 (&acc)[2][2][4][2], const pg8::Unit& u, int wr, int wc, int, int) const {
        const int ln = fresh_lane(), fr = ln & 15, fq = ln >> 4;
        const int h = u.pn, pm = u.pm;
        bf16* vt; int keys, keybase;
        if (pm < 32) { vt = VTP + (size_t)((pm * 4 + h) * 128) * 256; keys = 256; keybase = 0; }
        else if (pm < 48) { const int b = (pm - 32) >> 2; vt = VTS + (size_t)((b * 4 + h) * 128) * 1536; keys = 1536; keybase = 512 + ((pm - 32) & 3) * 256; }
        else { const int b = (pm - 48) >> 1; vt = VTS + (size_t)((b * 4 + h) * 128) * 1536; keys = 1536; keybase = ((pm - 48) & 1) * 256; }
#pragma unroll
        for (int ai = 0; ai < 2; ++ai)
#pragma unroll
            for (int m = 0; m < 4; ++m) { const int rloc = wr * 64 + fr + ai * 128 + m * 16;
                bf16* kp = KN + (size_t)(pm * 256 + rloc) * 512 + h * 128 + wc * 32 + 4 * fq;
#pragma unroll
                for (int n = 0; n < 2; ++n) *(u32x2*)(kp + 16 * n) = pk4(acc[ai][0][m][n]);
#pragma unroll
                for (int n = 0; n < 2; ++n) { const f32x4 v = acc[ai][1][m][n]; const u32x2 w = pk4(v);
                    bf16* vp = vt + (size_t)(wc * 32 + 16 * n + 4 * fq) * keys + keybase + rloc;
                    vp[0] = (bf16)(w.x & 0xffffu); vp[keys] = (bf16)(w.x >> 16); vp[2 * keys] = (bf16)(w.y & 0xffffu); vp[3 * keys] = (bf16)(w.y >> 16); }
                asm volatile("" ::: "memory");
            }
    }
};

struct Args {
    const float *x_prompt, *x_sample, *cache_ckv, *cache_krope, *c, *c_ctx, *w_ada, *b_ada, *g_pre_mix, *w_in, *g_q, *w_uq, *g_kv, *w_ukv,
                *g_v, *w_s, *b_s, *w_conv, *w_out, *g_post_mix, *g_pre_ffn, *w_ff1, *w_ff2, *g_post_ffn;
    float* out; unsigned char* ws; int ph_lo, ph_hi;
};

__device__ __forceinline__ void p0_transpose_item(const float* W, int K, int N, bf16* WT, LAS float* scr, int item, int lane) {
    const int nblk = N / 32, kb = item / nblk, nb = item % nblk, k0 = 64 * kb, n0 = 32 * nb;
#pragma unroll 8
    for (int i = 0; i < 32; ++i) { const int kk = 2 * i + (lane >> 5); scr[kk * 33 + (lane & 31)] = W[(size_t)(k0 + kk) * N + n0 + (lane & 31)]; }
    asm volatile("s_waitcnt lgkmcnt(0)" ::: "memory");
    const int c = lane & 7;
#pragma unroll
    for (int j = 0; j < 4; ++j) { const int n = (lane >> 3) + 8 * j; const LAS float* s = scr + (8 * c) * 33 + n;
        u32x4 o; o.x = cvt_pk_bf16(s[0 * 33], s[1 * 33]); o.y = cvt_pk_bf16(s[2 * 33], s[3 * 33]); o.z = cvt_pk_bf16(s[4 * 33], s[5 * 33]); o.w = cvt_pk_bf16(s[6 * 33], s[7 * 33]);
        *(u32x4*)(WT + (size_t)(n0 + n) * K + k0 + 8 * c) = o; }
    asm volatile("s_waitcnt lgkmcnt(0)" ::: "memory");
}

__device__ __forceinline__ void phase_prologue(const Args& A, LAS unsigned char* lds, int wave) {
    const int lane = fresh_lane(), tid = wave * 64 + lane;
    unsigned char* ws = A.ws;
    const int bid = blockIdx.x, G = gridDim.x;
    { const int gt = bid * 512 + tid;
      if (gt < 32768) { const int n = gt >> 5, a = (gt >> 4) & 1, f = gt & 15; const int pos = a == 0 ? (n >> 6) : (n & 63);
          double inv = 1.0; for (int i = 0; i < f; ++i) inv *= 0.5623413251903491;
          double rev = (double)pos * inv * 0.15915494309189535; rev -= floor(rev);
          const float rf = (float)rev;
          ((float*)(ws + WS_ROPE))[gt] = __builtin_amdgcn_cosf(rf); ((float*)(ws + WS_ROPE))[32768 + gt] = __builtin_amdgcn_sinf(rf); } }
    for (int it = bid; it < 192; it += G) {
        const int l = it / 48, cgp = it % 48;
        LAS float* sl = (LAS float*)lds;
        for (int i = tid; i < 5120; i += 512) { const int ci = i >> 10, k = i & 1023; const float v = ci == 0 ? A.c_ctx[k] : A.c[(ci - 1) * 1024 + k]; sl[i] = v / (1.0f + __expf(-v)); }
        __syncthreads();
        float a0[5], a1[5];
#pragma unroll
        for (int ci = 0; ci < 5; ++ci) { a0[ci] = 0.f; a1[ci] = 0.f; }
        const float* wp = A.w_ada + ((size_t)l * 1024 + wave * 128) * 6144 + cgp * 128 + 2 * lane;
#pragma unroll 8
        for (int kk = 0; kk < 128; ++kk) { const f32x2 wv = *(const f32x2*)(wp + (size_t)kk * 6144); const int k = wave * 128 + kk;
#pragma unroll
            for (int ci = 0; ci < 5; ++ci) { const float s = sl[ci * 1024 + k]; a0[ci] += s * wv.x; a1[ci] += s * wv.y; } }
        LAS float* part = (LAS float*)(lds + 32768);
#pragma unroll
        for (int ci = 0; ci < 5; ++ci) { part[(wave * 5 + ci) * 128 + 2 * lane] = a0[ci]; part[(wave * 5 + ci) * 128 + 2 * lane + 1] = a1[ci]; }
        __syncthreads();
        for (int i = tid; i < 640; i += 512) { const int ci = i >> 7, col = i & 127; float s = 0.f;
#pragma unroll
            for (int w = 0; w < 8; ++w) s += part[(w * 5 + ci) * 128 + col];
            const int gcol = cgp * 128 + col; ((float*)(ws + WS_MOD))[(l * 5 + ci) * 6144 + gcol] = s + A.b_ada[l * 6144 + gcol]; }
        __syncthreads();
    }
    LAS float* scr = (LAS float*)(lds + wave * 16384);
    const int gw = bid * 8 + wave, NGW = G * 8;
    constexpr int I_IN = 16 * 62, I_UQ = 6 * 24, I_UKV = 4 * 32, I_OUT = 16 * 32, I_F1 = 16 * 128, I_F2 = 64 * 32, I_L = I_IN + I_UQ + I_UKV + I_OUT + I_F1 + I_F2;
    for (int it = gw; it < 4 * I_L; it += NGW) {
        const int l = it / I_L; int r = it % I_L;
        if (r < I_IN) { p0_transpose_item(A.w_in + (size_t)l * 1024 * INC, 1024, INC, (bf16*)(ws + WS_WIN) + (size_t)l * 2048 * 1024, scr, r, lane); continue; } r -= I_IN;
        if (r < I_UQ) { p0_transpose_item(A.w_uq + (size_t)l * 384 * 768, 384, 768, (bf16*)(ws + WS_WUQ) + (size_t)l * 768 * 384, scr, r, lane); continue; } r -= I_UQ;
        if (r < I_UKV) { p0_transpose_item(A.w_ukv + (size_t)l * 256 * 1024, 256, 1024, (bf16*)(ws + WS_WUKV) + (size_t)l * 1024 * 256, scr, r, lane); continue; } r -= I_UKV;
        if (r < I_OUT) { p0_transpose_item(A.w_out + (size_t)l * 1024 * 1024, 1024, 1024, (bf16*)(ws + WS_WOUT) + (size_t)l * 1024 * 1024, scr, r, lane); continue; } r -= I_OUT;
        if (r < I_F1) { p0_transpose_item(A.w_ff1 + (size_t)l * 1024 * 4096, 1024, 4096, (bf16*)(ws + WS_WFF1) + (size_t)l * 4096 * 1024, scr, r, lane); continue; } r -= I_F1;
        p0_transpose_item(A.w_ff2 + (size_t)l * 4096 * 1024, 4096, 1024, (bf16*)(ws + WS_WFF2) + (size_t)l * 1024 * 4096, scr, r, lane);
    }
}

__device__ __forceinline__ int cond_of_row(int r) { return r < NTOK_P ? 0 : 1 + ((r - NTOK_P) >> 10); }

__device__ __forceinline__ void norm_mod_store(const f32x4 (&v)[4], const float* g, const float* sc, const float* sh, bf16* hrow, int lane) {
    float ss = 0.f;
#pragma unroll
    for (int j = 0; j < 4; ++j) ss += sumsq4(v[j]);
    const float rstd = 1.0f / sqrtf(wave_sum(ss, lane) * (1.0f / 1024.0f) + EPS);
#pragma unroll
    for (int j = 0; j < 4; ++j) { const int idx = 4 * lane + 256 * j;
        const f32x4 gg = *(const f32x4*)(g + idx), s1 = *(const f32x4*)(sc + idx), s0 = *(const f32x4*)(sh + idx);
        const f32x4 o = v[j] * rstd * gg * (1.0f + s1) + s0;
        *(u32x2*)(hrow + idx) = pk4(o); }
}

__device__ __forceinline__ void phase_pre(const Args& A, int lane, int wave) {
    const int gw = blockIdx.x * 8 + wave, NGW = gridDim.x * 8;
    const float* mod = (const float*)(A.ws + WS_MOD); bf16* H = (bf16*)(A.ws + WS_H);
    for (int r = gw; r < NTOK; r += NGW) {
        const float* xr = r < NTOK_P ? A.x_prompt + (size_t)r * 1024 : A.x_sample + (size_t)(r - NTOK_P) * 1024;
        f32x4 v[4];
#pragma unroll
        for (int j = 0; j < 4; ++j) v[j] = *(const f32x4*)(xr + 4 * lane + 256 * j);
        const float* mb = mod + (size_t)(0 * 5 + cond_of_row(r)) * 6144;
        norm_mod_store(v, A.g_pre_mix, mb + 1024, mb, H + (size_t)r * 1024, lane);
    }
}

__device__ __forceinline__ void phase_post(const Args& A, int l, int which, int lane, int wave) {
    const int gw = blockIdx.x * 8 + wave, NGW = gridDim.x * 8;
    const float* mod = (const float*)(A.ws + WS_MOD); bf16* H = (bf16*)(A.ws + WS_H); const float* MIX = (const float*)(A.ws + WS_MIX);
    const float* gp = (which == 0 ? A.g_post_mix : A.g_post_ffn) + l * 1024;
    for (int r = gw; r < NTOK; r += NGW) {
        const float* xr = (l == 0 && which == 0) ? (r < NTOK_P ? A.x_prompt + (size_t)r * 1024 : A.x_sample + (size_t)(r - NTOK_P) * 1024) : A.out + (size_t)r * 1024;
        const float* tr = MIX + (size_t)r * 1024;
        const int ci = cond_of_row(r);
        const float* mb = mod + (size_t)(l * 5 + ci) * 6144;
        const float* ga = mb + (which == 0 ? 2048 : 5120);
        f32x4 v[4], t[4]; float ss = 0.f;
#pragma unroll
        for (int j = 0; j < 4; ++j) { v[j] = *(const f32x4*)(xr + 4 * lane + 256 * j); t[j] = *(const f32x4*)(tr + 4 * lane + 256 * j); ss += sumsq4(t[j]); }
        const float rstd = 1.0f / sqrtf(wave_sum(ss, lane) * (1.0f / 1024.0f) + EPS);
#pragma unroll
        for (int j = 0; j < 4; ++j) { const int idx = 4 * lane + 256 * j;
            const f32x4 gg = *(const f32x4*)(gp + idx), gv = *(const f32x4*)(ga + idx);
            v[j] = v[j] + gv * (t[j] * rstd * gg);
            *(f32x4*)(A.out + (size_t)r * 1024 + idx) = v[j]; }
        if (which == 0) norm_mod_store(v, A.g_pre_ffn + l * 1024, mb + 4096, mb + 3072, H + (size_t)r * 1024, lane);
        else if (l < DEPTH - 1) { const float* mb2 = mod + (size_t)((l + 1) * 5 + ci) * 6144; norm_mod_store(v, A.g_pre_mix + (l + 1) * 1024, mb2 + 1024, mb2, H + (size_t)r * 1024, lane); }
    }
}

__device__ __forceinline__ void phase_split(const Args& A, int l, int lane, int wave) {
    const int gw = blockIdx.x * 8 + wave, NGW = gridDim.x * 8;
    unsigned char* ws = A.ws;
    const float* Z = (const float*)(ws + WS_Z);
    bf16* QN = (bf16*)(ws + WS_QN); bf16* CKVN = (bf16*)(ws + WS_CKVN); bf16* KRB = (bf16*)(ws + WS_KRB); bf16* UG = (bf16*)(ws + WS_UG); bf16* VN = (bf16*)(ws + WS_VN);
    bf16* CC = (bf16*)(ws + WS_CONCAT);
    const float* ropec = (const float*)(ws + WS_ROPE); const float* ropes = ropec + 32768;
    float* out_ckv = A.out + (size_t)NTOK * 1024; float* out_kr = out_ckv + (size_t)32 * 4 * 256 * 256;
    for (int r = gw; r < NROWKV; r += NGW) {
        if (r >= NTOK) {
            const int idx = r - NTOK, b = idx >> 9, j = idx & 511;
            const f32x4 cv = *(const f32x4*)(A.cache_ckv + ((size_t)(b * 4 + l) * 512 + j) * 256 + 4 * lane);
            *(u32x2*)(CKVN + (size_t)r * 256 + 4 * lane) = pk4(cv);
            const float kv = A.cache_krope[((size_t)(b * 4 + l) * 512 + j) * 64 + lane];
            KRB[(size_t)r * 64 + lane] = (bf16)(cvt_pk_bf16(kv, 0.f) & 0xffffu);
            continue;
        }
        const float* z = Z + (size_t)r * INC;
        const bool prompt = r < NTOK_P;
        const int n = prompt ? (r & 255) : ((r - NTOK_P) & 1023), len = prompt ? 256 : 1024;
        { f32x2 q[3]; float ss = 0.f;
#pragma unroll
          for (int j = 0; j < 3; ++j) { q[j] = *(const f32x2*)(z + ZQ + 2 * lane + 128 * j); ss += q[j].x * q[j].x + q[j].y * q[j].y; }
          const float rstd = 1.0f / sqrtf(wave_sum(ss, lane) * (1.0f / 384.0f) + EPS);
#pragma unroll
          for (int j = 0; j < 3; ++j) { const int idx = 2 * lane + 128 * j; const f32x2 g = *(const f32x2*)(A.g_q + l * 384 + idx);
              *(unsigned*)(QN + (size_t)r * 384 + idx) = cvt_pk_bf16(q[j].x * rstd * g.x, q[j].y * rstd * g.y); } }
        { f32x4 cv = *(const f32x4*)(z + ZCKV + 4 * lane);
          const float rstd = 1.0f / sqrtf(wave_sum(sumsq4(cv), lane) * (1.0f / 256.0f) + EPS);
          cv = cv * rstd * *(const f32x4*)(A.g_kv + l * 256 + 4 * lane);
          if (prompt) *(f32x4*)(out_ckv + ((size_t)((r >> 8) * 4 + l) * 256 + n) * 256 + 4 * lane) = cv;
          *(u32x2*)(CKVN + (size_t)r * 256 + 4 * lane) = pk4(cv); }
        { float kr = z[ZKR + lane];
          if (prompt) out_kr[((size_t)((r >> 8) * 4 + l) * 256 + n) * 64 + lane] = kr;
          else { const float partner = shx(kr, 16, lane); const int a = lane >> 5, p = (lane >> 4) & 1, f = lane & 15;
              const float cs = ropec[n * 32 + a * 16 + f], sn = ropes[n * 32 + a * 16 + f];
              kr = p == 0 ? kr * cs - partner * sn : partner * sn + kr * cs; }
          KRB[(size_t)r * 64 + lane] = (bf16)(cvt_pk_bf16(kr, 0.f) & 0xffffu); }
        { const f32x4 u = gelu4(*(const f32x4*)(z + ZU + 4 * lane)); *(u32x2*)(UG + (size_t)r * 256 + 4 * lane) = pk4(u); }
        { f32x4 v = gelu4(*(const f32x4*)(z + ZV + 4 * lane));
          const float rstd = 1.0f / sqrtf(wave_sum(sumsq4(v), lane) * (1.0f / 256.0f) + EPS);
          v = v * rstd * *(const f32x4*)(A.g_v + l * 256 + 4 * lane);
          *(u32x2*)(VN + (size_t)r * 256 + 4 * lane) = pk4(v); }
        { const f32x4 bg = *(const f32x4*)(z + ZBG + 4 * lane);
          const f32x4 zc = *(const f32x4*)(z + ZCG + 4 * lane) * *(const f32x4*)(z + ZHH + 4 * lane);
          const float* wc = A.w_conv + (size_t)l * 3 * 256 + 4 * lane;
          f32x4 y = zc * *(const f32x4*)(wc + 256);
          if (n > 0) { const float* zm = z - INC; y = y + *(const f32x4*)(zm + ZCG + 4 * lane) * *(const f32x4*)(zm + ZHH + 4 * lane) * *(const f32x4*)(wc); }
          if (n < len - 1) { const float* zp = z + INC; y = y + *(const f32x4*)(zp + ZCG + 4 * lane) * *(const f32x4*)(zp + ZHH + 4 * lane) * *(const f32x4*)(wc + 512); }
          *(u32x2*)(CC + (size_t)r * 1024 + 768 + 4 * lane) = pk4(bg * y); }
    }
}

#define MFMA32(a, b, c) __builtin_amdgcn_mfma_f32_32x32x16_bf16((a), (b), (c), 0, 0, 0)
constexpr int AT_KROW = 400, AT_VROW = 144, AT_KBYTES = 64 * AT_KROW, AT_STAGE = AT_KBYTES + 128 * AT_VROW;
__device__ __forceinline__ void attn_store_tile(const f32x16& ot, float inv, bf16* crow  , int t, int hh) {
#pragma unroll
    for (int g = 0; g < 4; ++g) { u32x2 w; w.x = cvt_pk_bf16(ot[4 * g] * inv, ot[4 * g + 1] * inv); w.y = cvt_pk_bf16(ot[4 * g + 2] * inv, ot[4 * g + 3] * inv);
        *(u32x2*)(crow + 32 * t + 8 * g + 4 * hh) = w; }
}

__device__ __forceinline__ void phase_mixer(const Args& A, int l, LAS unsigned char* lds, int lane_in, int wave) {
    unsigned char* ws = A.ws;
    const bf16* Q = (const bf16*)(ws + WS_Q); const bf16* KN = (const bf16*)(ws + WS_KNOPE); const bf16* KRB = (const bf16*)(ws + WS_KRB);
    const bf16* VTP = (const bf16*)(ws + WS_VTP); const bf16* VTS = (const bf16*)(ws + WS_VTS);
    const bf16* UG = (const bf16*)(ws + WS_UG); const bf16* VN = (const bf16*)(ws + WS_VN);
    bf16* CC = (bf16*)(ws + WS_CONCAT);
    for (int rnd = 0; rnd < 2; ++rnd) {
        int it;
        if (rnd == 0) it = blockIdx.x; else { if (blockIdx.x < 128 || blockIdx.x >= 160) break; it = 256 + (int)blockIdx.x - 128; }
        if (it >= 288) break;
        int lane = lane_in; asm volatile("" : "+v"(lane));
        const int rho = lane & 31, hh = lane >> 5, tid = wave * 64 + lane;
        if (it < 192) {
            int h, q0, keys, nkeys, split, rowA, rowB; const bf16* vt;
            if (it < 64) { const int b = it >> 4, qt = it & 3; h = (it >> 2) & 3;
                q0 = NTOK_P + b * 1024 + qt * 256 + wave * 32; keys = 1536; nkeys = 1536; split = 512; rowA = NTOK + b * 512; rowB = NTOK_P + b * 1024;
                vt = VTS + (size_t)((b * 4 + h) * 128) * 1536; }
            else { const int i2 = it - 64, b = i2 >> 2; h = i2 & 3; q0 = b * 256 + wave * 32; keys = 256; nkeys = 256; split = 0; rowA = 0; rowB = b * 256;
                vt = VTP + (size_t)((b * 4 + h) * 128) * 256; }
            bf16x8 qf[12];
            { const bf16* qp = Q + (size_t)(q0 + rho) * 768 + h * 192 + 8 * hh;
#pragma unroll
              for (int ks = 0; ks < 12; ++ks) qf[ks] = *(const bf16x8*)(qp + 16 * ks); }
            f32x16 o[4];
#pragma unroll
            for (int t = 0; t < 4; ++t)
#pragma unroll
                for (int i = 0; i < 16; ++i) o[t][i] = 0.f;
            float m = -1e30f, lsum = 0.f;
            int kslot[2], kcol[2], vd[2], vc[2];
#pragma unroll
            for (int j = 0; j < 2; ++j) { const int c = tid + 512 * j, kap = c >> 4; kcol[j] = c & 15;
                kslot[j] = (kap & 32) + (kap & 3) + 4 * ((kap >> 4) & 1) + 8 * ((kap >> 2) & 3);
                vd[j] = c >> 3; vc[j] = c & 7; }
            const int rkap = tid >> 3, rc8 = tid & 7, rslot = (rkap & 32) + (rkap & 3) + 4 * ((rkap >> 4) & 1) + 8 * ((rkap >> 2) & 3);
            u32x4 sk[2], sr, sv[2];
#define AT_GLOAD(k0) do { const int rb_ = (k0) < split ? rowA + (k0) : rowB + ((k0) - split); \
                _Pragma("unroll") for (int j = 0; j < 2; ++j) sk[j] = *(const u32x4*)(KN + (size_t)(rb_ + ((tid + 512 * j) >> 4)) * 512 + h * 128 + kcol[j] * 8); \
                sr = *(const u32x4*)(KRB + (size_t)(rb_ + rkap) * 64 + rc8 * 8); \
                _Pragma("unroll") for (int j = 0; j < 2; ++j) sv[j] = *(const u32x4*)(vt + (size_t)vd[j] * keys + (k0) + vc[j] * 8); } while (0)
#define AT_SWRITE(buf) do { LAS unsigned char* sb_ = lds + (buf) * AT_STAGE; \
                _Pragma("unroll") for (int j = 0; j < 2; ++j) *(LAS u32x4*)(sb_ + kslot[j] * AT_KROW + kcol[j] * 16) = sk[j]; \
                *(LAS u32x4*)(sb_ + rslot * AT_KROW + 256 + rc8 * 16) = sr; \
                _Pragma("unroll") for (int j = 0; j < 2; ++j) *(LAS u32x4*)(sb_ + AT_KBYTES + vd[j] * AT_VROW + vc[j] * 16) = sv[j]; } while (0)
            AT_GLOAD(0); AT_SWRITE(0);
            __syncthreads();
            const int ntile = nkeys >> 6;
            for (int tI = 0; tI < ntile; ++tI) {
                if (tI + 1 < ntile) AT_GLOAD((tI + 1) * 64);
                const LAS unsigned char* sb = lds + (tI & 1) * AT_STAGE;
#pragma unroll
                for (int blk = 0; blk < 2; ++blk) {
                    const LAS unsigned char* kp = sb + (32 * blk + rho) * AT_KROW + hh * 16;
                    f32x16 sc;
#pragma unroll
                    for (int i = 0; i < 16; ++i) sc[i] = 0.f;
#pragma unroll
                    for (int ks = 0; ks < 12; ++ks) sc = MFMA32(*(const LAS bf16x8*)(kp + ks * 32), qf[ks], sc);
                    float mx = sc[0];
#pragma unroll
                    for (int i = 1; i < 16; ++i) mx = fmaxf(mx, sc[i]);
                    mx = fmaxf(mx, shx(mx, 32, lane));
                    const float mn = fmaxf(m, mx), alpha = __builtin_amdgcn_exp2f(m - mn);
                    float ps = 0.f;
#pragma unroll
                    for (int i = 0; i < 16; ++i) { sc[i] = __builtin_amdgcn_exp2f(sc[i] - mn); ps += sc[i]; }
                    lsum = lsum * alpha + ps; m = mn;
#pragma unroll
                    for (int t = 0; t < 4; ++t) o[t] = o[t] * alpha;
                    bf16x8 pb[2];
#pragma unroll
                    for (int s2 = 0; s2 < 2; ++s2) { u32x4 w; w.x = cvt_pk_bf16(sc[8 * s2 + 0], sc[8 * s2 + 1]); w.y = cvt_pk_bf16(sc[8 * s2 + 2], sc[8 * s2 + 3]); w.z = cvt_pk_bf16(sc[8 * s2 + 4], sc[8 * s2 + 5]); w.w = cvt_pk_bf16(sc[8 * s2 + 6], sc[8 * s2 + 7]);
                        pb[s2] = __builtin_bit_cast(bf16x8, w); }
                    const LAS unsigned char* vp = sb + AT_KBYTES + rho * AT_VROW + (32 * blk + 16 * hh) * 2;
#pragma unroll
                    for (int t = 0; t < 4; ++t)
#pragma unroll
                        for (int s2 = 0; s2 < 2; ++s2) o[t] = MFMA32(*(const LAS bf16x8*)(vp + 32 * t * AT_VROW + 16 * s2), pb[s2], o[t]);
                }
                if (tI + 1 < ntile) AT_SWRITE((tI + 1) & 1);
                __syncthreads();
            }
#undef AT_GLOAD
#undef AT_SWRITE
            lsum += shx(lsum, 32, lane);
            const float inv = 1.0f / lsum; bf16* crow = CC + (size_t)(q0 + rho) * 1024 + h * 128;
#pragma unroll
            for (int t = 0; t < 4; ++t) attn_store_tile(o[t], inv, crow, t, hh);
        } else {
            const int c = it - 192;
            LAS bf16* vnT = (LAS bf16*)lds;
#pragma unroll
            for (int pass = 0; pass < 8; ++pass) { const int id = tid + 512 * pass, qq = id >> 5, c8 = (id & 31) * 8;
                const bf16x8 v = *(const bf16x8*)(VN + (size_t)(c * 128 + qq) * 256 + c8);
#pragma unroll
                for (int j = 0; j < 8; ++j) vnT[(c8 + j) * 136 + qq] = (bf16)v[j]; }
            __syncthreads();
            const int hd = wave & 3, ph = wave >> 2;
#pragma unroll
            for (int pp = 0; pp < 2; ++pp) { const int pt = 2 * ph + pp;
                f32x16 acc[2];
#pragma unroll
                for (int d = 0; d < 2; ++d)
#pragma unroll
                    for (int i = 0; i < 16; ++i) acc[d][i] = 0.f;
                const float* wrow = A.w_s + ((size_t)(l * 4 + hd) * 128 + 32 * pt + rho) * 128 + 8 * hh;
                f32x4 wv[16];
#pragma unroll
                for (int ks = 0; ks < 8; ++ks) { wv[2 * ks] = *(const f32x4*)(wrow + 16 * ks); wv[2 * ks + 1] = *(const f32x4*)(wrow + 16 * ks + 4); }
#pragma unroll
                for (int ks = 0; ks < 8; ++ks) { const f32x4 w0 = wv[2 * ks], w1 = wv[2 * ks + 1];
                    u32x4 w; w.x = cvt_pk_bf16(w0.x, w0.y); w.y = cvt_pk_bf16(w0.z, w0.w); w.z = cvt_pk_bf16(w1.x, w1.y); w.w = cvt_pk_bf16(w1.z, w1.w);
                    const bf16x8 af = __builtin_bit_cast(bf16x8, w);
#pragma unroll
                    for (int d = 0; d < 2; ++d) { const bf16x8 bfr = *(const LAS bf16x8*)(vnT + (hd * 64 + 32 * d + rho) * 136 + 16 * ks + 8 * hh); acc[d] = MFMA32(af, bfr, acc[d]); } }
                float bs[16]; bf16 ugv[2][16];
#pragma unroll
                for (int i = 0; i < 16; ++i) { const int p = 32 * pt + (i & 3) + 8 * (i >> 2) + 4 * hh; bs[i] = A.b_s[(l * 4 + hd) * 128 + p];
#pragma unroll
                    for (int d = 0; d < 2; ++d) ugv[d][i] = UG[((size_t)c * 128 + p) * 256 + hd * 64 + 32 * d + rho]; }
#pragma unroll
                for (int d = 0; d < 2; ++d) { const int col = hd * 64 + 32 * d + rho;
#pragma unroll
                    for (int i = 0; i < 16; ++i) { const int p = 32 * pt + (i & 3) + 8 * (i >> 2) + 4 * hh; const size_t row = (size_t)c * 128 + p;
                        const float mixed = acc[d][i] + bs[i];
                        const float ug = __uint_as_float((unsigned)ugv[d][i] << 16);
                        CC[row * 1024 + 512 + col] = (bf16)(cvt_pk_bf16(ug * mixed, 0.f) & 0xffffu); } }
            }
            __syncthreads();
        }
    }
}

__global__ void __launch_bounds__(512, 2) fwd_megakernel(Args A) {
    extern __shared__ __attribute__((aligned(16))) unsigned char smem[];
    LAS unsigned char* lds = (LAS unsigned char*)smem;
    const int wave0 = __builtin_amdgcn_readfirstlane((int)threadIdx.x >> 6);
    unsigned* const bar = (unsigned*)(A.ws + WS_BAR);
    volatile LAS unsigned* const barst = (volatile LAS unsigned*)(lds + LDS_BARST);
    const unsigned xcc = xb_xcc_id();
    if (wave0 == 0) { const int l0 = fresh_lane(); if (l0 < 2) barst[l0] = 0u; if (l0 == 0 && A.ph_hi - A.ph_lo > 1) (void)xb_add(&bar[XB_XCNT(xcc)], 1u); }
    __syncthreads();
    if (A.ph_lo < 0) cg::this_grid().sync();
    bool dup_done = false; (void)dup_done;
    for (int ph = A.ph_lo; ph < A.ph_hi; ++ph) {
        const int wave = wave0;
#define LANE fresh_lane()
#define TID (wave * 64 + fresh_lane())
        unsigned char* ws = A.ws; asm volatile("" : "+s"(ws));
        if (ph == 0) phase_prologue(A, lds, wave);
        else if (ph == 1) phase_pre(A, LANE, wave);
        else {
            const int l = (ph - 2) / 9, k = (ph - 2) % 9;
            const int G = gridDim.x, bid = blockIdx.x;
            if (k == 0) {
                pg8::Gemm g{(const bf16*)(ws + WS_H), (const bf16*)(ws + WS_WIN) + (size_t)l * 2048 * 1024, NTOK, 2048, 1024}; pg8::StaticOrder S; S.init(NTOK, 2048, G, bid);
                EpiF32 E{(float*)(ws + WS_Z), INC, INC}; pg8::gemm_phase<EpiF32, pg8::StaticOrder>(lds, g, S, E, TID);
            } else if (k == 1) phase_split(A, l, LANE, wave);
            else if (k == 2) {
                { pg8::Gemm g{(const bf16*)(ws + WS_QN), (const bf16*)(ws + WS_WUQ) + (size_t)l * 768 * 384, NTOK, 768, 384}; pg8::StaticOrder S; S.init(NTOK, 768, G, bid);
                  EpiQ E{(bf16*)(ws + WS_Q), (const float*)(ws + WS_ROPE), (const float*)(ws + WS_ROPE) + 32768}; pg8::gemm_phase<EpiQ, pg8::StaticOrder>(lds, g, S, E, TID); }
                                { pg8::Gemm g{(const bf16*)(ws + WS_CKVN), (const bf16*)(ws + WS_WUKV) + (size_t)l * 1024 * 256, NROWKV, 1024, 256}; pg8::StaticOrder S; S.init(NROWKV, 1024, G, (bid + G - 144 % G) % G);
                  EpiKV E{(bf16*)(ws + WS_KNOPE), (bf16*)(ws + WS_VTP), (bf16*)(ws + WS_VTS)}; pg8::gemm_phase<EpiKV, pg8::StaticOrder>(lds, g, S, E, TID); }
            } else if (k == 3) phase_mixer(A, l, lds, LANE, wave);
            else if (k == 4 || k == 7) {
                const bool o = (k == 4);
                pg8::Gemm g{(const bf16*)(ws + (o ? WS_CONCAT : WS_ACT)), o ? (const bf16*)(ws + WS_WOUT) + (size_t)l * 1024 * 1024 : (const bf16*)(ws + WS_WFF2) + (size_t)l * 1024 * 4096, NTOK, 1024, o ? 1024 : 4096};
                pg8::StaticOrder S; S.init(NTOK, 1024, G, bid);
                EpiF32 E{(float*)(ws + WS_MIX), 1024, 1024}; pg8::gemm_phase<EpiF32, pg8::StaticOrder>(lds, g, S, E, TID);
            } else if (k == 5) phase_post(A, l, 0, LANE, wave);
            else if (k == 6) {
                pg8::Gemm g{(const bf16*)(ws + WS_H), (const bf16*)(ws + WS_WFF1) + (size_t)l * 4096 * 1024, NTOK, 4096, 1024}; pg8::StaticOrder S; S.init(NTOK, 4096, G, bid);
                EpiAct E{(bf16*)(ws + WS_ACT), 4096}; pg8::gemm_phase<EpiAct, pg8::StaticOrder>(lds, g, S, E, TID);
            } else phase_post(A, l, 1, LANE, wave);
        }
        if (ph + 1 < A.ph_hi) xcd_barrier(bar, xcc, barst, wave == 0 && fresh_lane() == 0);
#if PROBE_DUP >= 0
        {
            bool again = false;
            if (PROBE_DUP == 100) { if (ph + 1 < A.ph_hi) xcd_barrier(bar, xcc, barst, wave == 0 && fresh_lane() == 0); }
            else if (!dup_done) {
                const int kk = ph >= 2 ? (ph - 2) % 9 : -1;
                if (PROBE_DUP == 50) again = (ph == 0);
                else if (PROBE_DUP == 60) again = (kk == 0 || kk == 2 || kk == 4 || kk == 6 || kk == 7);
                else again = (kk == PROBE_DUP);
            }
            if (again) { dup_done = true; --ph; } else dup_done = false;
        }
#endif
    }
}

constexpr int N_PHASES = 2 + 9 * DEPTH;

extern "C" void kernel_launch(void* const* d_in, const int* in_sizes, int n_in, void* d_out, int out_size, void* d_ws, size_t ws_size, hipStream_t stream) {
    static int grid = 0;
    if (grid == 0) {
        if (n_in != 24 || ws_size < WS_END || in_sizes[9] != DEPTH * 1024 * INC) { fprintf(stderr, "kernel_launch: unexpected problem (n_in %d, ws %zu, w_in %d)\n", n_in, ws_size, n_in > 9 ? in_sizes[9] : -1); grid = -1; return; }
        int dev = 0, cus = 0, per_cu = 0;
        hipGetDevice(&dev); hipDeviceGetAttribute(&cus, hipDeviceAttributeMultiprocessorCount, dev);
        if (hipFuncSetAttribute((const void*)fwd_megakernel, hipFuncAttributeMaxDynamicSharedMemorySize, LDS_BYTES) != hipSuccess) { fprintf(stderr, "kernel_launch: hipFuncSetAttribute failed\n"); grid = -1; return; }
        if (hipOccupancyMaxActiveBlocksPerMultiprocessor(&per_cu, (const void*)fwd_megakernel, 512, LDS_BYTES) != hipSuccess || per_cu < 1) { fprintf(stderr, "kernel_launch: occupancy query says %d\n", per_cu); per_cu = 1; }
        (void)hipGetLastError();
        grid = cus * 1;
        fprintf(stderr, "kernel_launch: grid %d (cus %d, per_cu %d)\n", grid, cus, per_cu);
    }
    if (grid < 0) return;
    if (hipMemsetAsync((char*)d_ws + WS_BAR, 0, 16384, stream) != hipSuccess) { fprintf(stderr, "kernel_launch: memset failed\n"); return; }
    Args a{};
    const float** ap = (const float**)&a;
    for (int i = 0; i < 24; ++i) ap[i] = (const float*)d_in[i];
    a.out = (float*)d_out; a.ws = (unsigned char*)d_ws;
#if MK_PER_PHASE
    for (int ph = 0; ph < N_PHASES; ++ph) { a.ph_lo = ph; a.ph_hi = ph + 1; hipLaunchKernelGGL(fwd_megakernel, dim3(grid), dim3(512), LDS_BYTES, stream, a); }
#else
    a.ph_lo = 0; a.ph_hi = N_PHASES;
    void* args[] = {&a};
    hipError_t e = hipLaunchCooperativeKernel((const void*)fwd_megakernel, dim3(grid), dim3(512), args, LDS_BYTES, stream);
    if (e != hipSuccess) fprintf(stderr, "kernel_launch: cooperative launch failed: %s (grid %d)\n", hipGetErrorString(e), grid);
#endif
}
```

```cpp
#include <hip/hip_runtime.h>
#include <hip/hip_cooperative_groups.h>
#include <cstdio>
namespace cg = cooperative_groups;

#ifndef MK_PER_PHASE
#define MK_PER_PHASE 0
#endif

#ifndef PROBE_DUP
#define PROBE_DUP -1
#endif
#define LAS __attribute__((address_space(3)))
typedef unsigned short bf16;
typedef short bf16x8 __attribute__((ext_vector_type(8)));
typedef float f32x2 __attribute__((ext_vector_type(2)));
typedef float f32x4 __attribute__((ext_vector_type(4)));
typedef float f32x16 __attribute__((ext_vector_type(16)));
typedef unsigned u32x2 __attribute__((ext_vector_type(2)));
typedef unsigned u32x4 __attribute__((ext_vector_type(4)));

constexpr int DM = 1024, NTOK_P = 8192, NTOK_S = 4096, NTOK = 12288, NROWKV = 14336;
constexpr int DEPTH = 4, INC = 1984, DFF = 4096;
constexpr int ZQ = 0, ZCKV = 384, ZKR = 640, ZU = 704, ZV = 960, ZBG = 1216, ZCG = 1472, ZHH = 1728;
constexpr float EPS = 1e-6f;
constexpr float QSCALE = 0.07216878364870322f * 1.4426950408889634f;

constexpr size_t MiB = 1u << 20;
constexpr size_t WS_MOD = 0, WS_BAR = 512 * 1024, WS_ROPE = 1 * MiB, WS_WIN = 2 * MiB, WS_WUQ = 18 * MiB, WS_WUKV = 21 * MiB, WS_WOUT = 23 * MiB,
                 WS_WFF1 = 31 * MiB, WS_WFF2 = 63 * MiB, WS_H = 95 * MiB, WS_MIX = 119 * MiB, WS_CONCAT = 167 * MiB, WS_QN = 191 * MiB,
                 WS_CKVN = 200 * MiB, WS_KRB = 207 * MiB, WS_UG = 209 * MiB, WS_VN = 215 * MiB, WS_Q = 221 * MiB, WS_KNOPE = 239 * MiB,
                 WS_VTP = 253 * MiB, WS_VTS = 261 * MiB, WS_Z = 267 * MiB, WS_ACT = 267 * MiB, WS_END = 363 * MiB;
constexpr int LDS_BYTES = 147456, LDS_BARST = LDS_BYTES - 64;

__device__ __forceinline__ unsigned cvt_pk_bf16(float lo, float hi) { unsigned r; asm volatile("v_cvt_pk_bf16_f32 %0, %1, %2" : "=v"(r) : "v"(lo), "v"(hi)); return r; }
__device__ __forceinline__ int fresh_lane() { int l; asm volatile("v_mbcnt_lo_u32_b32 %0, -1, 0\n\tv_mbcnt_hi_u32_b32 %0, -1, %0" : "=v"(l)); return l; }
__device__ __forceinline__ float shx(float v, int mask, int lane) { return __int_as_float(__builtin_amdgcn_ds_bpermute((lane ^ mask) << 2, __float_as_int(v))); }
__device__ __forceinline__ float dpp_add(float v, const int ctrl_is) {
    return v; }
#define DPP_ADD(v, ctrl) ((v) + __int_as_float(__builtin_amdgcn_update_dpp(0, __float_as_int(v), (ctrl), 0xf, 0xf, true)))
__device__ __forceinline__ float wave_sum(float v, int lane) {
    (void)lane;
    v = DPP_ADD(v, 0xB1);
    v = DPP_ADD(v, 0x4E);
    v = DPP_ADD(v, 0x141);
    v = DPP_ADD(v, 0x140);
    const int vi = __float_as_int(v);
    return (__int_as_float(__builtin_amdgcn_readlane(vi, 0)) + __int_as_float(__builtin_amdgcn_readlane(vi, 16))) + (__int_as_float(__builtin_amdgcn_readlane(vi, 32)) + __int_as_float(__builtin_amdgcn_readlane(vi, 48)));
}
__device__ __forceinline__ float gelu_tanh(float x) { const float y = 0.7978845608028654f * (x + 0.044715f * x * x * x); return x / (1.0f + __expf(-2.0f * y)); }
__device__ __forceinline__ f32x4 gelu4(f32x4 v) { return (f32x4){gelu_tanh(v.x), gelu_tanh(v.y), gelu_tanh(v.z), gelu_tanh(v.w)}; }
__device__ __forceinline__ float sumsq4(f32x4 v) { return (v.x * v.x + v.y * v.y) + (v.z * v.z + v.w * v.w); }
__device__ __forceinline__ f32x4 ld4bf(const bf16* p) { const u32x2 w = *(const u32x2*)p; return (f32x4){__uint_as_float(w.x << 16), __uint_as_float(w.x & 0xffff0000u), __uint_as_float(w.y << 16), __uint_as_float(w.y & 0xffff0000u)}; }
__device__ __forceinline__ f32x2 ld2bf(const bf16* p) { const unsigned w = *(const unsigned*)p; return (f32x2){__uint_as_float(w << 16), __uint_as_float(w & 0xffff0000u)}; }
__device__ __forceinline__ float ld1bf(const bf16* p) { return __uint_as_float((unsigned)*p << 16); }
__device__ __forceinline__ u32x2 pk4(f32x4 v) { u32x2 w; w.x = cvt_pk_bf16(v.x, v.y); w.y = cvt_pk_bf16(v.z, v.w); return w; }


#define XB_TMO      128
#define XB_XCNT(j)  (256  + 64 * (j))
#define XB_XSUB(j)  (1280 + 64 * (j))
#define XB_XGEN(j)  (2304 + 64 * (j))
#define XB_TOP      3328
#define XB_TOPGEN   3392
#define XCD_BAR_WORDS 3456
#define XB_SPIN_CAP (1u << 18)
__device__ __forceinline__ unsigned xb_ld(unsigned* p)              { return __hip_atomic_load(p, __ATOMIC_RELAXED, __HIP_MEMORY_SCOPE_AGENT); }
__device__ __forceinline__ unsigned xb_add(unsigned* p, unsigned v) { return __hip_atomic_fetch_add(p, v, __ATOMIC_RELAXED, __HIP_MEMORY_SCOPE_AGENT); }
__device__ __forceinline__ unsigned xb_xcc_id() { return (unsigned)__builtin_amdgcn_s_getreg((3 << 11) | 20) & 0xFu; }
#define XB_SPIN(cond, bar) do { unsigned _sp = 0; while (cond) { __builtin_amdgcn_s_sleep(1); \
    if ((++_sp & 255u) == 0u) { if (xb_ld(&(bar)[XB_TMO])) break; if (_sp > XB_SPIN_CAP) { atomicAdd(&(bar)[XB_TMO], 1u); break; } } } } while (0)
__device__ __forceinline__ void xcd_barrier_complete(unsigned* bar, unsigned x, unsigned& nloc, unsigned& nx) {
    const unsigned G = gridDim.x * gridDim.y * gridDim.z;
    unsigned sum, cnt, mine, sp = 0u;
    for (;;) {
        sum = 0u; cnt = 0u; mine = 0u;
#pragma unroll
        for (unsigned j = 0; j < 16; ++j) { const unsigned c = xb_ld(&bar[XB_XCNT(j)]); sum += c; cnt += (c > 0u) ? 1u : 0u; mine = (j == x) ? c : mine; }
        if (sum == G) break;
        __builtin_amdgcn_s_sleep(1);
        if ((++sp & 255u) == 0u) { if (xb_ld(&bar[XB_TMO])) break; if (sp > XB_SPIN_CAP) { atomicAdd(&bar[XB_TMO], 1u); break; } }
    }
    nloc = mine > 0u ? mine : 1u; nx = cnt > 0u ? cnt : 1u;
}
__device__ __forceinline__ void xcd_barrier(unsigned* bar, unsigned x, volatile LAS unsigned* st, bool leader) {
    asm volatile("s_waitcnt vmcnt(0)" ::: "memory");
    __syncthreads();
    if (leader) {
        __builtin_amdgcn_s_waitcnt(0);
        unsigned nloc = st[0], nx = st[1];
        if (nloc == 0u) { xcd_barrier_complete(bar, x, nloc, nx); st[0] = nloc; st[1] = nx; }
        const unsigned old = xb_add(&bar[XB_XSUB(x)], 1u);
        const unsigned gen = old / nloc;
        if (old + 1u == (gen + 1u) * nloc) {
            __builtin_amdgcn_fence(__ATOMIC_RELEASE, "agent");
            asm volatile("s_waitcnt vmcnt(0)" ::: "memory");
            const unsigned og = xb_add(&bar[XB_TOP], 1u);
            const unsigned tg = og / nx;
            if (og + 1u == (tg + 1u) * nx) xb_add(&bar[XB_TOPGEN], 1u);
            else XB_SPIN(xb_ld(&bar[XB_TOPGEN]) == tg, bar);
            __builtin_amdgcn_fence(__ATOMIC_ACQUIRE, "agent");
            xb_add(&bar[XB_XGEN(x)], 1u);
            asm volatile("s_waitcnt vmcnt(0)" ::: "memory");
        } else {
            XB_SPIN(xb_ld(&bar[XB_XGEN(x)]) == gen, bar);
            __builtin_amdgcn_fence(__ATOMIC_ACQUIRE, "agent");
            asm volatile("s_waitcnt vmcnt(0)" ::: "memory");
        }
    }
    __syncthreads();
}

namespace pg8 {
#define PG8_LAS __attribute__((address_space(3)))
typedef unsigned short bf16_t;
constexpr int BM = 256, BK = 64, HALF = 128, HTB = HALF * BK * 2, STAGE_BYTES = 8 * HTB, NXCD = 8, WGM = 8;
__host__ __device__ __forceinline__ int lds_byte(int r, int c) { const int st = (r >> 4) * 2 + (c >> 5), rr = r & 15, cc = c & 31, ob = rr * 64 + cc * 2; return st * 1024 + (ob ^ (((ob >> 9) & 1) << 5)); }
__host__ __device__ __forceinline__ void stage_rc(int b, int& R, int& C) { const int st = b / 1024, sb = b % 1024, swz = sb ^ (((sb >> 9) & 1) << 5); R = (st >> 1) * 16 + swz / 64; C = (st & 1) * 32 + (swz % 64) / 2; }
__host__ __device__ __forceinline__ int perm32(int rho) { const int n = rho >> 4, i = rho & 15; return 8 * (i >> 2) + 4 * n + (i & 3); }
struct Unit { int pm, pn; };
struct Gemm { const bf16_t* A; const bf16_t* Bt; int M, N, K; };
struct StaticOrder {
    int nM, nN, nwg, G, c;
    __host__ __device__ void init(int M, int N, int G_, int c_) { nM = M / BM; nN = N / BM; nwg = nM * nN; G = G_; c = c_; }
    __host__ __device__ bool next(int i, Unit& u) const {
        const long L = (long)i * G + c; if (L >= nwg) return false;
        int wgid = (int)L; { const int q = nwg / NXCD, r = nwg % NXCD, xcd = wgid % NXCD, off = wgid / NXCD; wgid = (xcd < r ? xcd * (q + 1) : r * (q + 1) + (xcd - r) * q) + off; }
        const int nig = WGM * nN, gid = wgid / nig, fm = gid * WGM, gsz = (nM - fm) < WGM ? (nM - fm) : WGM;
        u.pm = fm + ((wgid % nig) % gsz); u.pn = (wgid % nig) / gsz; return true;
    }
    __device__ __forceinline__ void a_ready(const Unit&) const {}
    __device__ __forceinline__ void done(const Unit&) const {}
};

template <class Epi, class Sched>
__device__ __forceinline__ void gemm_phase(PG8_LAS unsigned char* lds, const Gemm g, const Sched& S, const Epi& E, const int tid) {
    const int wid = __builtin_amdgcn_readfirstlane(tid >> 6), lane = tid & 63, wr = wid >> 2, wc = wid & 3, fr = lane & 15, fq = lane >> 4;
    const int K = g.K, nt = K / BK;
    unsigned voffA[2], voffB[2];
#pragma unroll
    for (int i = 0; i < 2; ++i) { int R, C; stage_rc(tid * 16 + i * 8192, R, C); const int Rb = Epi::PERM ? ((R & ~31) + perm32(R & 31)) : R;
        voffA[i] = (unsigned)(R * K + C) * 2u; voffB[i] = (unsigned)(Rb * K + C) * 2u; }
    const size_t kstep = (size_t)(BK * 2);
    const size_t hstep = (size_t)HALF * K * 2;
    const size_t tstep = 2 * hstep;
    const unsigned ldsw = (unsigned)wid * 1024u;
    const int aoff = lds_byte(wr * 64 + fr, fq * 8), boff = lds_byte(wc * 32 + fr, fq * 8);
#define PG8_SA(b, h) (((b) * 2 + (h)) * HTB)
#define PG8_SB(b, h) ((4 + (b) * 2 + (h)) * HTB)
#define PG8_STAGE(bufoff, gbase, voff) do { _Pragma("unroll") for (int _i = 0; _i < 2; ++_i) \
        __builtin_amdgcn_global_load_lds((const unsigned*)((const char*)(gbase) + (voff)[_i]), (PG8_LAS unsigned*)(lds + (bufoff) + ldsw + _i * 8192), 16, 0, 0); } while (0)
#define PG8_LDA(dst, b, h) do { _Pragma("unroll") for (int m = 0; m < 4; ++m) _Pragma("unroll") for (int k = 0; k < 2; ++k) dst[m][k] = *(const PG8_LAS bf16x8*)(lds + PG8_SA(b, h) + aoff + m * 2048 + k * 1024); } while (0)
#define PG8_LDB(dst, b, h) do { _Pragma("unroll") for (int n = 0; n < 2; ++n) _Pragma("unroll") for (int k = 0; k < 2; ++k) dst[n][k] = *(const PG8_LAS bf16x8*)(lds + PG8_SB(b, h) + boff + n * 2048 + k * 1024); } while (0)
#define PG8_MMA(ai, bj, At, Bt) do { __builtin_amdgcn_s_setprio(1); _Pragma("unroll") for (int m = 0; m < 4; ++m) _Pragma("unroll") for (int n = 0; n < 2; ++n) _Pragma("unroll") for (int k = 0; k < 2; ++k) \
        acc[ai][bj][m][n] = __builtin_amdgcn_mfma_f32_16x16x32_bf16(Bt[n][k], At[m][k], acc[ai][bj][m][n], 0, 0, 0); __builtin_amdgcn_s_setprio(0); } while (0)
#define PG8_WAIT_V(n) asm volatile("s_waitcnt vmcnt(" #n ")" ::: "memory")
#define PG8_WAIT_L(n) asm volatile("s_waitcnt lgkmcnt(" #n ")" ::: "memory")
#define PG8_BAR __builtin_amdgcn_s_barrier()
#define PG8_SCHED __builtin_amdgcn_sched_barrier(0)
    Unit cur, nxt; int ui = 0;
    if (!S.next(0, cur)) return;
    f32x4 acc[2][2][4][2];
#pragma unroll
    for (int a = 0; a < 2; ++a)
#pragma unroll
        for (int b = 0; b < 2; ++b)
#pragma unroll
            for (int m = 0; m < 4; ++m)
#pragma unroll
                for (int n = 0; n < 2; ++n) acc[a][b][m][n] = (f32x4){0.f, 0.f, 0.f, 0.f};
    bf16x8 At[4][2], B0[2][2], B1[2][2];
    const char* cA = (const char*)g.A + (size_t)cur.pm * tstep; const char* cB = (const char*)g.Bt + (size_t)cur.pn * tstep;
    S.a_ready(cur);
    PG8_STAGE(PG8_SB(0, 0), cB, voffB); PG8_STAGE(PG8_SA(0, 0), cA, voffA); PG8_STAGE(PG8_SB(0, 1), cB + hstep, voffB); PG8_STAGE(PG8_SA(0, 1), cA + hstep, voffA);
    if (wr == 1) PG8_BAR;
    PG8_WAIT_V(4); PG8_BAR;
    PG8_STAGE(PG8_SB(1, 0), cB + kstep, voffB); PG8_STAGE(PG8_SA(1, 0), cA + kstep, voffA); PG8_STAGE(PG8_SB(1, 1), cB + hstep + kstep, voffB);
    PG8_WAIT_V(6); PG8_BAR;
    for (;;) {
        const bool has_next = S.next(ui + 1, nxt);
        const char* nA = has_next ? (const char*)g.A + (size_t)nxt.pm * tstep : cA; const char* nB = has_next ? (const char*)g.Bt + (size_t)nxt.pn * tstep : cB;
        for (int t = 0; t < nt; t += 2) {
            const bool last = (t == nt - 2);
            const char* a1 = cA + (size_t)(t + 1) * kstep;
            const char* a2 = last ? nA : cA + (size_t)(t + 2) * kstep; const char* b2 = last ? nB : cB + (size_t)(t + 2) * kstep;
            const char* a3 = a2 + kstep; const char* b3 = b2 + kstep;
            if (last && has_next) S.a_ready(nxt);
            PG8_LDB(B0, 0, 0); PG8_SCHED; PG8_LDA(At, 0, 0); PG8_STAGE(PG8_SA(1, 1), a1 + hstep, voffA);
            PG8_WAIT_L(8); PG8_BAR; PG8_WAIT_L(0); PG8_MMA(0, 0, At, B0); PG8_BAR; PG8_SCHED;
            PG8_LDB(B1, 0, 1); PG8_STAGE(PG8_SB(0, 0), b2, voffB);
            PG8_BAR; PG8_WAIT_L(0); PG8_MMA(0, 1, At, B1); PG8_BAR;
            PG8_LDA(At, 0, 1); PG8_STAGE(PG8_SA(0, 0), a2, voffA);
            PG8_BAR; PG8_WAIT_L(0); PG8_MMA(1, 0, At, B0); PG8_BAR; PG8_SCHED;
            PG8_STAGE(PG8_SB(0, 1), b2 + hstep, voffB);
            PG8_WAIT_V(6); PG8_BAR; PG8_MMA(1, 1, At, B1); PG8_BAR;
            PG8_LDB(B0, 1, 0); PG8_SCHED; PG8_LDA(At, 1, 0); PG8_STAGE(PG8_SA(0, 1), a2 + hstep, voffA);
            PG8_WAIT_L(8); PG8_BAR; PG8_WAIT_L(0); PG8_MMA(0, 0, At, B0); PG8_BAR; PG8_SCHED;
            PG8_LDB(B1, 1, 1); PG8_STAGE(PG8_SB(1, 0), b3, voffB);
            PG8_BAR; PG8_WAIT_L(0); PG8_MMA(0, 1, At, B1); PG8_BAR;
            PG8_LDA(At, 1, 1); PG8_STAGE(PG8_SA(1, 0), a3, voffA);
            PG8_BAR; PG8_WAIT_L(0); PG8_MMA(1, 0, At, B0); PG8_BAR; PG8_SCHED;
            PG8_STAGE(PG8_SB(1, 1), b3 + hstep, voffB);
            PG8_WAIT_V(6); PG8_BAR; PG8_MMA(1, 1, At, B1); PG8_BAR;
        }
        E(acc, cur, wr, wc, fr, fq); S.done(cur);
        if (!has_next) break;
#pragma unroll
        for (int a = 0; a < 2; ++a)
#pragma unroll
            for (int b = 0; b < 2; ++b)
#pragma unroll
                for (int m = 0; m < 4; ++m)
#pragma unroll
                    for (int n = 0; n < 2; ++n) acc[a][b][m][n] = (f32x4){0.f, 0.f, 0.f, 0.f};
        cur = nxt; cA = nA; cB = nB; ++ui;
    }
    PG8_WAIT_V(0);
    if (wr == 0) PG8_BAR;
    PG8_BAR;
#undef PG8_SA
#undef PG8_SB
#undef PG8_STAGE
#undef PG8_LDA
#undef PG8_LDB
#undef PG8_MMA
#undef PG8_WAIT_V
#undef PG8_WAIT_L
#undef PG8_BAR
#undef PG8_SCHED
}
}

struct EpiF32 {
    static constexpr bool PERM = false;
    float* C; int ldc; int ncols;
    __device__ __forceinline__ void operator()(const f32x4 (&acc)[2][2][4][2], const pg8::Unit& u, int wr, int wc, int fr, int fq) const {
        const int row0 = u.pm * 256 + wr * 64 + fr, col0 = u.pn * 256 + wc * 32 + 4 * fq;
#pragma unroll
        for (int ai = 0; ai < 2; ++ai)
#pragma unroll
            for (int m = 0; m < 4; ++m) { float* rowp = C + (size_t)(row0 + ai * 128 + m * 16) * ldc + col0;
#pragma unroll
                for (int bj = 0; bj < 2; ++bj)
#pragma unroll
                    for (int n = 0; n < 2; ++n) if (col0 + bj * 128 + n * 16 < ncols) *(f32x4*)(rowp + bj * 128 + n * 16) = acc[ai][bj][m][n]; }
    }
};
template <int ACT> struct EpiB16 {
    static constexpr bool PERM = true;
    bf16* O; int ldc; int ncols;
    __device__ __forceinline__ void operator()(const f32x4 (&acc)[2][2][4][2], const pg8::Unit& u, int wr, int wc, int fr, int fq) const {
        const int row0 = u.pm * 256 + wr * 64 + fr, col0 = u.pn * 256 + wc * 32 + 8 * fq;
#pragma unroll
        for (int ai = 0; ai < 2; ++ai)
#pragma unroll
            for (int m = 0; m < 4; ++m) { bf16* rowp = O + (size_t)(row0 + ai * 128 + m * 16) * ldc + col0;
#pragma unroll
                for (int bj = 0; bj < 2; ++bj) { f32x4 v0 = acc[ai][bj][m][0], v1 = acc[ai][bj][m][1];
                    if (col0 + bj * 128 >= ncols) continue;
                    if (ACT) {
#pragma unroll
                    for (int j = 0; j < 4; ++j) { const float a = fmaxf(v0[j], 0.f), b = fmaxf(v1[j], 0.f); v0[j] = a * a; v1[j] = b * b; } }
                    u32x4 w; w.x = cvt_pk_bf16(v0[0], v0[1]); w.y = cvt_pk_bf16(v0[2], v0[3]); w.z = cvt_pk_bf16(v1[0], v1[1]); w.w = cvt_pk_bf16(v1[2], v1[3]);
                    *(u32x4*)(rowp + bj * 128) = w; } }
    }
};
struct EpiQ {
    static constexpr bool PERM = false;
    bf16* Q; const float* ropec; const float* ropes;
    __device__ __forceinline__ void operator()(const f32x4 (&acc)[2][2][4][2], const pg8::Unit& u, int wr, int wc, int, int) const {
        const int ln = fresh_lane(), fr = ln & 15, fq = ln >> 4;
        const int row0 = u.pm * 256 + wr * 64 + fr; const bool sample = u.pm >= 32;
#pragma unroll
        for (int bj = 0; bj < 2; ++bj) {
            const int g0 = u.pn * 256 + bj * 128 + wc * 32, within0 = g0 % 192; const bool isrope = within0 >= 128; const int a = (within0 - 128) >> 5;
#pragma unroll
            for (int ai = 0; ai < 2; ++ai)
#pragma unroll
                for (int m = 0; m < 4; ++m) { const int row = row0 + ai * 128 + m * 16;
                    f32x4 x1 = acc[ai][bj][m][0], x2 = acc[ai][bj][m][1];
                    if (sample && isrope) { const int ntok = (row - NTOK_P) & 1023;
                        const f32x4 cs = *(const f32x4*)(ropec + ntok * 32 + a * 16 + 4 * fq), sn = *(const f32x4*)(ropes + ntok * 32 + a * 16 + 4 * fq);
                        const f32x4 o1 = x1 * cs - x2 * sn, o2 = x1 * sn + x2 * cs; x1 = o1; x2 = o2; }
                    x1 = x1 * QSCALE; x2 = x2 * QSCALE;
                    bf16* p = Q + (size_t)row * 768 + g0 + 4 * fq;
                    *(u32x2*)p = pk4(x1); *(u32x2*)(p + 16) = pk4(x2); asm volatile("" ::: "memory"); }
        }
    }
};
struct EpiKV {
    static constexpr bool PERM = false;
    bf16* KN; bf16* VTP; bf16* VTS;
    __device__ __forceinline__ void operator()(const f32x4 (&acc)[2][2][4][2], const pg8::Unit& u, int wr, int wc, int, int) const {
        const int ln = fresh_lane(), fr = ln & 15, fq = ln >> 4;
        const int h = u.pn, pm = u.pm;
        bf16* vt; int keys, keybase;
        if (pm < 32) { vt = VTP + (size_t)((pm * 4 + h) * 128) * 256; keys = 256; keybase = 0; }
        else if (pm < 48) { const int b = (pm - 32) >> 2; vt = VTS + (size_t)((b * 4 + h) * 128) * 1536; keys = 1536; keybase = 512 + ((pm - 32) & 3) * 256; }
        else { const int b = (pm - 48) >> 1; vt = VTS + (size_t)((b * 4 + h) * 128) * 1536; keys = 1536; keybase = ((pm - 48) & 1) * 256; }
#pragma unroll
        for (int ai = 0; ai < 2; ++ai)
#pragma unroll
            for (int m = 0; m < 4; ++m) { const int rloc = wr * 64 + fr + ai * 128 + m * 16;
                bf16* kp = KN + (size_t)(pm * 256 + rloc) * 512 + h * 128 + wc * 32 + 4 * fq;
#pragma unroll
                for (int n = 0; n < 2; ++n) *(u32x2*)(kp + 16 * n) = pk4(acc[ai][0][m][n]);
#pragma unroll
                for (int n = 0; n < 2; ++n) { const f32x4 v = acc[ai][1][m][n]; const u32x2 w = pk4(v);
                    bf16* vp = vt + (size_t)(wc * 32 + 16 * n + 4 * fq) * keys + keybase + rloc;
                    vp[0] = (bf16)(w.x & 0xffffu); vp[keys] = (bf16)(w.x >> 16); vp[2 * keys] = (bf16)(w.y & 0xffffu); vp[3 * keys] = (bf16)(w.y >> 16); }
                asm volatile("" ::: "memory");
            }
    }
};

struct Args {
    const float *x_prompt, *x_sample, *cache_ckv, *cache_krope, *c, *c_ctx, *w_ada, *b_ada, *g_pre_mix, *w_in, *g_q, *w_uq, *g_kv, *w_ukv,
                *g_v, *w_s, *b_s, *w_conv, *w_out, *g_post_mix, *g_pre_ffn, *w_ff1, *w_ff2, *g_post_ffn;
    float* out; unsigned char* ws; int ph_lo, ph_hi;
};

__device__ __forceinline__ void p0_transpose_item(const float* W, int K, int N, bf16* WT, LAS float* scr, int item, int lane) {
    const int nblk = N / 32, kb = item / nblk, nb = item % nblk, k0 = 64 * kb, n0 = 32 * nb;
#pragma unroll 8
    for (int i = 0; i < 32; ++i) { const int kk = 2 * i + (lane >> 5); scr[kk * 33 + (lane & 31)] = W[(size_t)(k0 + kk) * N + n0 + (lane & 31)]; }
    asm volatile("s_waitcnt lgkmcnt(0)" ::: "memory");
    const int c = lane & 7;
#pragma unroll
    for (int j = 0; j < 4; ++j) { const int n = (lane >> 3) + 8 * j; const LAS float* s = scr + (8 * c) * 33 + n;
        u32x4 o; o.x = cvt_pk_bf16(s[0 * 33], s[1 * 33]); o.y = cvt_pk_bf16(s[2 * 33], s[3 * 33]); o.z = cvt_pk_bf16(s[4 * 33], s[5 * 33]); o.w = cvt_pk_bf16(s[6 * 33], s[7 * 33]);
        *(u32x4*)(WT + (size_t)(n0 + n) * K + k0 + 8 * c) = o; }
    asm volatile("s_waitcnt lgkmcnt(0)" ::: "memory");
}

__device__ __forceinline__ void phase_prologue(const Args& A, LAS unsigned char* lds, int wave) {
    const int lane = fresh_lane(), tid = wave * 64 + lane;
    unsigned char* ws = A.ws;
    const int bid = blockIdx.x, G = gridDim.x;
    { const int gt = bid * 512 + tid;
      if (gt < 32768) { const int n = gt >> 5, a = (gt >> 4) & 1, f = gt & 15; const int pos = a == 0 ? (n >> 6) : (n & 63);
          double inv = 1.0; for (int i = 0; i < f; ++i) inv *= 0.5623413251903491;
          double rev = (double)pos * inv * 0.15915494309189535; rev -= floor(rev);
          const float rf = (float)rev;
          ((float*)(ws + WS_ROPE))[gt] = __builtin_amdgcn_cosf(rf); ((float*)(ws + WS_ROPE))[32768 + gt] = __builtin_amdgcn_sinf(rf); } }
    for (int it = bid; it < 192; it += G) {
        const int l = it / 48, cgp = it % 48;
        LAS float* sl = (LAS float*)lds;
        for (int i = tid; i < 5120; i += 512) { const int ci = i >> 10, k = i & 1023; const float v = ci == 0 ? A.c_ctx[k] : A.c[(ci - 1) * 1024 + k]; sl[i] = v / (1.0f + __expf(-v)); }
        __syncthreads();
        float a0[5], a1[5];
#pragma unroll
        for (int ci = 0; ci < 5; ++ci) { a0[ci] = 0.f; a1[ci] = 0.f; }
        const float* wp = A.w_ada + ((size_t)l * 1024 + wave * 128) * 6144 + cgp * 128 + 2 * lane;
#pragma unroll 8
        for (int kk = 0; kk < 128; ++kk) { const f32x2 wv = *(const f32x2*)(wp + (size_t)kk * 6144); const int k = wave * 128 + kk;
#pragma unroll
            for (int ci = 0; ci < 5; ++ci) { const float s = sl[ci * 1024 + k]; a0[ci] += s * wv.x; a1[ci] += s * wv.y; } }
        LAS float* part = (LAS float*)(lds + 32768);
#pragma unroll
        for (int ci = 0; ci < 5; ++ci) { part[(wave * 5 + ci) * 128 + 2 * lane] = a0[ci]; part[(wave * 5 + ci) * 128 + 2 * lane + 1] = a1[ci]; }
        __syncthreads();
        for (int i = tid; i < 640; i += 512) { const int ci = i >> 7, col = i & 127; float s = 0.f;
#pragma unroll
            for (int w = 0; w < 8; ++w) s += part[(w * 5 + ci) * 128 + col];
            const int gcol = cgp * 128 + col; ((float*)(ws + WS_MOD))[(l * 5 + ci) * 6144 + gcol] = s + A.b_ada[l * 6144 + gcol]; }
        __syncthreads();
    }
    LAS float* scr = (LAS float*)(lds + wave * 16384);
    const int gw = bid * 8 + wave, NGW = G * 8;
    constexpr int I_IN = 16 * 62, I_UQ = 6 * 24, I_UKV = 4 * 32, I_OUT = 16 * 32, I_F1 = 16 * 128, I_F2 = 64 * 32, I_L = I_IN + I_UQ + I_UKV + I_OUT + I_F1 + I_F2;
    for (int it = gw; it < 4 * I_L; it += NGW) {
        const int l = it / I_L; int r = it % I_L;
        if (r < I_IN) { p0_transpose_item(A.w_in + (size_t)l * 1024 * INC, 1024, INC, (bf16*)(ws + WS_WIN) + (size_t)l * 2048 * 1024, scr, r, lane); continue; } r -= I_IN;
        if (r < I_UQ) { p0_transpose_item(A.w_uq + (size_t)l * 384 * 768, 384, 768, (bf16*)(ws + WS_WUQ) + (size_t)l * 768 * 384, scr, r, lane); continue; } r -= I_UQ;
        if (r < I_UKV) { p0_transpose_item(A.w_ukv + (size_t)l * 256 * 1024, 256, 1024, (bf16*)(ws + WS_WUKV) + (size_t)l * 1024 * 256, scr, r, lane); continue; } r -= I_UKV;
        if (r < I_OUT) { p0_transpose_item(A.w_out + (size_t)l * 1024 * 1024, 1024, 1024, (bf16*)(ws + WS_WOUT) + (size_t)l * 1024 * 1024, scr, r, lane); continue; } r -= I_OUT;
        if (r < I_F1) { p0_transpose_item(A.w_ff1 + (size_t)l * 1024 * 4096, 1024, 4096, (bf16*)(ws + WS_WFF1) + (size_t)l * 4096 * 1024, scr, r, lane); continue; } r -= I_F1;
        p0_transpose_item(A.w_ff2 + (size_t)l * 4096 * 1024, 4096, 1024, (bf16*)(ws + WS_WFF2) + (size_t)l * 1024 * 4096, scr, r, lane);
    }
}

__device__ __forceinline__ int cond_of_row(int r) { return r < NTOK_P ? 0 : 1 + ((r - NTOK_P) >> 10); }

__device__ __forceinline__ void norm_mod_store(const f32x4 (&v)[4], const float* g, const float* sc, const float* sh, bf16* hrow, int lane) {
    float ss = 0.f;
#pragma unroll
    for (int j = 0; j < 4; ++j) ss += sumsq4(v[j]);
    const float rstd = 1.0f / sqrtf(wave_sum(ss, lane) * (1.0f / 1024.0f) + EPS);
#pragma unroll
    for (int j = 0; j < 4; ++j) { const int idx = 4 * lane + 256 * j;
        const f32x4 gg = *(const f32x4*)(g + idx), s1 = *(const f32x4*)(sc + idx), s0 = *(const f32x4*)(sh + idx);
        const f32x4 o = v[j] * rstd * gg * (1.0f + s1) + s0;
        *(u32x2*)(hrow + idx) = pk4(o); }
}
__device__ __forceinline__ const float* x_in_row(const Args& A, int r) { return r < NTOK_P ? A.x_prompt + (size_t)r * 1024 : A.x_sample + (size_t)(r - NTOK_P) * 1024; }

__device__ __forceinline__ void phase_pre(const Args& A, int lane, int wave) {
    const int gw = blockIdx.x * 8 + wave, NGW = gridDim.x * 8;
    const float* mod = (const float*)(A.ws + WS_MOD); bf16* H = (bf16*)(A.ws + WS_H);
    for (int r0 = gw; r0 < NTOK; r0 += 2 * NGW) {
        f32x4 v[2][4];
#pragma unroll
        for (int u = 0; u < 2; ++u) { const float* xr = x_in_row(A, r0 + u * NGW);
#pragma unroll
            for (int j = 0; j < 4; ++j) v[u][j] = *(const f32x4*)(xr + 4 * lane + 256 * j); }
#pragma unroll
        for (int u = 0; u < 2; ++u) { const int r = r0 + u * NGW; const float* mb = mod + (size_t)(0 * 5 + cond_of_row(r)) * 6144;
            norm_mod_store(v[u], A.g_pre_mix, mb + 1024, mb, H + (size_t)r * 1024, lane); }
    }
}

__device__ __forceinline__ void phase_post(const Args& A, int l, int which, int lane, int wave) {
    const int gw = blockIdx.x * 8 + wave, NGW = gridDim.x * 8;
    const float* mod = (const float*)(A.ws + WS_MOD); bf16* H = (bf16*)(A.ws + WS_H); const bf16* MIX = (const bf16*)(A.ws + WS_MIX);
    const float* gp = (which == 0 ? A.g_post_mix : A.g_post_ffn) + l * 1024;
    const bool first = (l == 0 && which == 0);
    for (int r0 = gw; r0 < NTOK; r0 += 2 * NGW) {
        f32x4 v[2][4], t[2][4];
#pragma unroll
        for (int u = 0; u < 2; ++u) { const int r = r0 + u * NGW;
            const float* xr = first ? x_in_row(A, r) : A.out + (size_t)r * 1024; const bf16* tr = MIX + (size_t)r * 1024;
#pragma unroll
            for (int j = 0; j < 4; ++j) { v[u][j] = *(const f32x4*)(xr + 4 * lane + 256 * j); t[u][j] = ld4bf(tr + 4 * lane + 256 * j); } }
#pragma unroll
        for (int u = 0; u < 2; ++u) { const int r = r0 + u * NGW;
            const float* ga = mod + (size_t)(l * 5 + cond_of_row(r)) * 6144 + (which == 0 ? 2048 : 5120);
            float ss = 0.f;
#pragma unroll
            for (int j = 0; j < 4; ++j) ss += sumsq4(t[u][j]);
            const float rstd = 1.0f / sqrtf(wave_sum(ss, lane) * (1.0f / 1024.0f) + EPS);
#pragma unroll
            for (int j = 0; j < 4; ++j) { const int idx = 4 * lane + 256 * j;
                const f32x4 gg = *(const f32x4*)(gp + idx), gv = *(const f32x4*)(ga + idx);
                v[u][j] = v[u][j] + gv * (t[u][j] * rstd * gg); } }
#pragma unroll
        for (int u = 0; u < 2; ++u) { const int r = r0 + u * NGW;
#pragma unroll
            for (int j = 0; j < 4; ++j) *(f32x4*)(A.out + (size_t)r * 1024 + 4 * lane + 256 * j) = v[u][j]; }
#pragma unroll
        for (int u = 0; u < 2; ++u) { const int r = r0 + u * NGW; const int ci = cond_of_row(r);
            const float* mb = mod + (size_t)(l * 5 + ci) * 6144;
            if (which == 0) norm_mod_store(v[u], A.g_pre_ffn + l * 1024, mb + 4096, mb + 3072, H + (size_t)r * 1024, lane);
            else if (l < DEPTH - 1) { const float* mb2 = mod + (size_t)((l + 1) * 5 + ci) * 6144; norm_mod_store(v[u], A.g_pre_mix + (l + 1) * 1024, mb2 + 1024, mb2, H + (size_t)r * 1024, lane); } }
    }
}

__device__ __forceinline__ void phase_split(const Args& A, int l, int lane, int wave) {
    const int gw = blockIdx.x * 8 + wave, NGW = gridDim.x * 8;
    unsigned char* ws = A.ws;
    const bf16* Z = (const bf16*)(ws + WS_Z);
    bf16* QN = (bf16*)(ws + WS_QN); bf16* CKVN = (bf16*)(ws + WS_CKVN); bf16* KRB = (bf16*)(ws + WS_KRB); bf16* UG = (bf16*)(ws + WS_UG); bf16* VN = (bf16*)(ws + WS_VN);
    bf16* CC = (bf16*)(ws + WS_CONCAT);
    const float* ropec = (const float*)(ws + WS_ROPE); const float* ropes = ropec + 32768;
    float* out_ckv = A.out + (size_t)NTOK * 1024; float* out_kr = out_ckv + (size_t)32 * 4 * 256 * 256;
    for (int idx = gw; idx < 2048; idx += NGW) { const int r = NTOK + idx, b = idx >> 9, j = idx & 511;
        const f32x4 cv = *(const f32x4*)(A.cache_ckv + ((size_t)(b * 4 + l) * 512 + j) * 256 + 4 * lane);
        const float kv = A.cache_krope[((size_t)(b * 4 + l) * 512 + j) * 64 + lane];
        *(u32x2*)(CKVN + (size_t)r * 256 + 4 * lane) = pk4(cv);
        KRB[(size_t)r * 64 + lane] = (bf16)(cvt_pk_bf16(kv, 0.f) & 0xffffu); }
    const f32x4 gkv = *(const f32x4*)(A.g_kv + l * 256 + 4 * lane), gvv = *(const f32x4*)(A.g_v + l * 256 + 4 * lane);
    const float* wcp = A.w_conv + (size_t)l * 3 * 256 + 4 * lane;
    const f32x4 wc0 = *(const f32x4*)(wcp), wc1 = *(const f32x4*)(wcp + 256), wc2 = *(const f32x4*)(wcp + 512);
    f32x2 gq[3];
#pragma unroll
    for (int j = 0; j < 3; ++j) gq[j] = *(const f32x2*)(A.g_q + l * 384 + 2 * lane + 128 * j);
    for (int r0 = gw; r0 < NTOK; r0 += 2 * NGW) {
        f32x2 q[2][3]; f32x4 cv[2], uu[2], vv[2], bg[2], zc[2], zm[2], zp[2]; float kr[2], cs[2], sn[2];
#pragma unroll
        for (int u = 0; u < 2; ++u) { const int r = r0 + u * NGW; const bf16* z = Z + (size_t)r * INC;
            const bool prompt = r < NTOK_P; const int n = prompt ? (r & 255) : ((r - NTOK_P) & 1023), len = prompt ? 256 : 1024;
#pragma unroll
            for (int j = 0; j < 3; ++j) q[u][j] = ld2bf(z + ZQ + 2 * lane + 128 * j);
            cv[u] = ld4bf(z + ZCKV + 4 * lane); kr[u] = ld1bf(z + ZKR + lane);
            uu[u] = ld4bf(z + ZU + 4 * lane); vv[u] = ld4bf(z + ZV + 4 * lane); bg[u] = ld4bf(z + ZBG + 4 * lane);
            zc[u] = ld4bf(z + ZCG + 4 * lane) * ld4bf(z + ZHH + 4 * lane);
            zm[u] = (f32x4){0.f, 0.f, 0.f, 0.f}; zp[u] = zm[u];
            if (n > 0) zm[u] = ld4bf(z - INC + ZCG + 4 * lane) * ld4bf(z - INC + ZHH + 4 * lane);
            if (n < len - 1) zp[u] = ld4bf(z + INC + ZCG + 4 * lane) * ld4bf(z + INC + ZHH + 4 * lane);
            cs[u] = 1.f; sn[u] = 0.f;
            if (!prompt) { const int a = lane >> 5, f = lane & 15; cs[u] = ropec[n * 32 + a * 16 + f]; sn[u] = ropes[n * 32 + a * 16 + f]; } }
#pragma unroll
        for (int u = 0; u < 2; ++u) { const int r = r0 + u * NGW; const bool prompt = r < NTOK_P; const int n = prompt ? (r & 255) : ((r - NTOK_P) & 1023);
            { float ss = 0.f;
#pragma unroll
              for (int j = 0; j < 3; ++j) ss += q[u][j].x * q[u][j].x + q[u][j].y * q[u][j].y;
              const float rstd = 1.0f / sqrtf(wave_sum(ss, lane) * (1.0f / 384.0f) + EPS);
#pragma unroll
              for (int j = 0; j < 3; ++j) *(unsigned*)(QN + (size_t)r * 384 + 2 * lane + 128 * j) = cvt_pk_bf16(q[u][j].x * rstd * gq[j].x, q[u][j].y * rstd * gq[j].y); }
            { const float rstd = 1.0f / sqrtf(wave_sum(sumsq4(cv[u]), lane) * (1.0f / 256.0f) + EPS);
              const f32x4 c2 = cv[u] * rstd * gkv;
              if (prompt) *(f32x4*)(out_ckv + ((size_t)((r >> 8) * 4 + l) * 256 + n) * 256 + 4 * lane) = c2;
              *(u32x2*)(CKVN + (size_t)r * 256 + 4 * lane) = pk4(c2); }
            { float k2 = kr[u];
              if (prompt) out_kr[((size_t)((r >> 8) * 4 + l) * 256 + n) * 64 + lane] = k2;
              else { const float partner = shx(k2, 16, lane); const int p = (lane >> 4) & 1;
                  k2 = p == 0 ? k2 * cs[u] - partner * sn[u] : partner * sn[u] + k2 * cs[u]; }
              KRB[(size_t)r * 64 + lane] = (bf16)(cvt_pk_bf16(k2, 0.f) & 0xffffu); }
            *(u32x2*)(UG + (size_t)r * 256 + 4 * lane) = pk4(gelu4(uu[u]));
            { f32x4 v = gelu4(vv[u]);
              const float rstd = 1.0f / sqrtf(wave_sum(sumsq4(v), lane) * (1.0f / 256.0f) + EPS);
              *(u32x2*)(VN + (size_t)r * 256 + 4 * lane) = pk4(v * rstd * gvv); }
            { const f32x4 y = zm[u] * wc0 + zc[u] * wc1 + zp[u] * wc2;
              *(u32x2*)(CC + (size_t)r * 1024 + 768 + 4 * lane) = pk4(bg[u] * y); }
        }
    }
}

#define MFMA32(a, b, c) __builtin_amdgcn_mfma_f32_32x32x16_bf16((a), (b), (c), 0, 0, 0)
constexpr int AT_KROW = 400, AT_VROW = 144, AT_KBYTES = 64 * AT_KROW, AT_STAGE = AT_KBYTES + 128 * AT_VROW;
__device__ __forceinline__ void attn_store_tile(const f32x16& ot, float inv, bf16* crow  , int t, int hh) {
#pragma unroll
    for (int g = 0; g < 4; ++g) { u32x2 w; w.x = cvt_pk_bf16(ot[4 * g] * inv, ot[4 * g + 1] * inv); w.y = cvt_pk_bf16(ot[4 * g + 2] * inv, ot[4 * g + 3] * inv);
        *(u32x2*)(crow + 32 * t + 8 * g + 4 * hh) = w; }
}

__device__ __forceinline__ void phase_mixer(const Args& A, int l, LAS unsigned char* lds, int lane_in, int wave) {
    unsigned char* ws = A.ws;
    const bf16* Q = (const bf16*)(ws + WS_Q); const bf16* KN = (const bf16*)(ws + WS_KNOPE); const bf16* KRB = (const bf16*)(ws + WS_KRB);
    const bf16* VTP = (const bf16*)(ws + WS_VTP); const bf16* VTS = (const bf16*)(ws + WS_VTS);
    const bf16* UG = (const bf16*)(ws + WS_UG); const bf16* VN = (const bf16*)(ws + WS_VN);
    bf16* CC = (bf16*)(ws + WS_CONCAT);
    for (int rnd = 0; rnd < 2; ++rnd) {
        int it;
        if (rnd == 0) it = blockIdx.x; else { if (blockIdx.x < 128 || blockIdx.x >= 160) break; it = 256 + (int)blockIdx.x - 128; }
        if (it >= 288) break;
        int lane = lane_in; asm volatile("" : "+v"(lane));
        const int rho = lane & 31, hh = lane >> 5, tid = wave * 64 + lane;
        if (it < 192) {
            int h, q0, keys, nkeys, split, rowA, rowB; const bf16* vt;
            if (it < 64) { const int b = it >> 4, qt = it & 3; h = (it >> 2) & 3;
                q0 = NTOK_P + b * 1024 + qt * 256 + wave * 32; keys = 1536; nkeys = 1536; split = 512; rowA = NTOK + b * 512; rowB = NTOK_P + b * 1024;
                vt = VTS + (size_t)((b * 4 + h) * 128) * 1536; }
            else { const int i2 = it - 64, b = i2 >> 2; h = i2 & 3; q0 = b * 256 + wave * 32; keys = 256; nkeys = 256; split = 0; rowA = 0; rowB = b * 256;
                vt = VTP + (size_t)((b * 4 + h) * 128) * 256; }
            bf16x8 qf[12];
            { const bf16* qp = Q + (size_t)(q0 + rho) * 768 + h * 192 + 8 * hh;
#pragma unroll
              for (int ks = 0; ks < 12; ++ks) qf[ks] = *(const bf16x8*)(qp + 16 * ks); }
            f32x16 o[4];
#pragma unroll
            for (int t = 0; t < 4; ++t)
#pragma unroll
                for (int i = 0; i < 16; ++i) o[t][i] = 0.f;
            float m = -1e30f, lsum = 0.f;
            int kslot[2], kcol[2], vd[2], vc[2];
#pragma unroll
            for (int j = 0; j < 2; ++j) { const int c = tid + 512 * j, kap = c >> 4; kcol[j] = c & 15;
                kslot[j] = (kap & 32) + (kap & 3) + 4 * ((kap >> 4) & 1) + 8 * ((kap >> 2) & 3);
                vd[j] = c >> 3; vc[j] = c & 7; }
            const int rkap = tid >> 3, rc8 = tid & 7, rslot = (rkap & 32) + (rkap & 3) + 4 * ((rkap >> 4) & 1) + 8 * ((rkap >> 2) & 3);
            u32x4 sk[2], sr, sv[2];
#define AT_GLOAD(k0) do { const int rb_ = (k0) < split ? rowA + (k0) : rowB + ((k0) - split); \
                _Pragma("unroll") for (int j = 0; j < 2; ++j) sk[j] = *(const u32x4*)(KN + (size_t)(rb_ + ((tid + 512 * j) >> 4)) * 512 + h * 128 + kcol[j] * 8); \
                sr = *(const u32x4*)(KRB + (size_t)(rb_ + rkap) * 64 + rc8 * 8); \
                _Pragma("unroll") for (int j = 0; j < 2; ++j) sv[j] = *(const u32x4*)(vt + (size_t)vd[j] * keys + (k0) + vc[j] * 8); } while (0)
#define AT_SWRITE(buf) do { LAS unsigned char* sb_ = lds + (buf) * AT_STAGE; \
                _Pragma("unroll") for (int j = 0; j < 2; ++j) *(LAS u32x4*)(sb_ + kslot[j] * AT_KROW + kcol[j] * 16) = sk[j]; \
                *(LAS u32x4*)(sb_ + rslot * AT_KROW + 256 + rc8 * 16) = sr; \
                _Pragma("unroll") for (int j = 0; j < 2; ++j) *(LAS u32x4*)(sb_ + AT_KBYTES + vd[j] * AT_VROW + vc[j] * 16) = sv[j]; } while (0)
            AT_GLOAD(0); AT_SWRITE(0);
            __syncthreads();
            const int ntile = nkeys >> 6;
            for (int tI = 0; tI < ntile; ++tI) {
                if (tI + 1 < ntile) AT_GLOAD((tI + 1) * 64);
                const LAS unsigned char* sb = lds + (tI & 1) * AT_STAGE;
#pragma unroll
                for (int blk = 0; blk < 2; ++blk) {
                    const LAS unsigned char* kp = sb + (32 * blk + rho) * AT_KROW + hh * 16;
                    f32x16 sc;
#pragma unroll
                    for (int i = 0; i < 16; ++i) sc[i] = 0.f;
#pragma unroll
                    for (int ks = 0; ks < 12; ++ks) sc = MFMA32(*(const LAS bf16x8*)(kp + ks * 32), qf[ks], sc);
                    float mx = sc[0];
#pragma unroll
                    for (int i = 1; i < 16; ++i) mx = fmaxf(mx, sc[i]);
                    mx = fmaxf(mx, shx(mx, 32, lane));
                    const float mn = fmaxf(m, mx), alpha = __builtin_amdgcn_exp2f(m - mn);
                    float ps = 0.f;
#pragma unroll
                    for (int i = 0; i < 16; ++i) { sc[i] = __builtin_amdgcn_exp2f(sc[i] - mn); ps += sc[i]; }
                    lsum = lsum * alpha + ps; m = mn;
#pragma unroll
                    for (int t = 0; t < 4; ++t) o[t] = o[t] * alpha;
                    bf16x8 pb[2];
#pragma unroll
                    for (int s2 = 0; s2 < 2; ++s2) { u32x4 w; w.x = cvt_pk_bf16(sc[8 * s2 + 0], sc[8 * s2 + 1]); w.y = cvt_pk_bf16(sc[8 * s2 + 2], sc[8 * s2 + 3]); w.z = cvt_pk_bf16(sc[8 * s2 + 4], sc[8 * s2 + 5]); w.w = cvt_pk_bf16(sc[8 * s2 + 6], sc[8 * s2 + 7]);
                        pb[s2] = __builtin_bit_cast(bf16x8, w); }
                    const LAS unsigned char* vp = sb + AT_KBYTES + rho * AT_VROW + (32 * blk + 16 * hh) * 2;
#pragma unroll
                    for (int t = 0; t < 4; ++t)
#pragma unroll
                        for (int s2 = 0; s2 < 2; ++s2) o[t] = MFMA32(*(const LAS bf16x8*)(vp + 32 * t * AT_VROW + 16 * s2), pb[s2], o[t]);
                }
                if (tI + 1 < ntile) AT_SWRITE((tI + 1) & 1);
                __syncthreads();
            }
#undef AT_GLOAD
#undef AT_SWRITE
            lsum += shx(lsum, 32, lane);
            const float inv = 1.0f / lsum; bf16* crow = CC + (size_t)(q0 + rho) * 1024 + h * 128;
#pragma unroll
            for (int t = 0; t < 4; ++t) attn_store_tile(o[t], inv, crow, t, hh);
        } else {
            const int c = it - 192;
            LAS bf16* vnT = (LAS bf16*)lds;
#pragma unroll
            for (int pass = 0; pass < 8; ++pass) { const int id = tid + 512 * pass, qq = id >> 5, c8 = (id & 31) * 8;
                const bf16x8 v = *(const bf16x8*)(VN + (size_t)(c * 128 + qq) * 256 + c8);
#pragma unroll
                for (int j = 0; j < 8; ++j) vnT[(c8 + j) * 136 + qq] = (bf16)v[j]; }
            __syncthreads();
            const int hd = wave & 3, ph = wave >> 2;
#pragma unroll
            for (int pp = 0; pp < 2; ++pp) { const int pt = 2 * ph + pp;
                f32x16 acc[2];
#pragma unroll
                for (int d = 0; d < 2; ++d)
#pragma unroll
                    for (int i = 0; i < 16; ++i) acc[d][i] = 0.f;
                const float* wrow = A.w_s + ((size_t)(l * 4 + hd) * 128 + 32 * pt + rho) * 128 + 8 * hh;
                f32x4 wv[16];
#pragma unroll
                for (int ks = 0; ks < 8; ++ks) { wv[2 * ks] = *(const f32x4*)(wrow + 16 * ks); wv[2 * ks + 1] = *(const f32x4*)(wrow + 16 * ks + 4); }
#pragma unroll
                for (int ks = 0; ks < 8; ++ks) { const f32x4 w0 = wv[2 * ks], w1 = wv[2 * ks + 1];
                    u32x4 w; w.x = cvt_pk_bf16(w0.x, w0.y); w.y = cvt_pk_bf16(w0.z, w0.w); w.z = cvt_pk_bf16(w1.x, w1.y); w.w = cvt_pk_bf16(w1.z, w1.w);
                    const bf16x8 af = __builtin_bit_cast(bf16x8, w);
#pragma unroll
                    for (int d = 0; d < 2; ++d) { const bf16x8 bfr = *(const LAS bf16x8*)(vnT + (hd * 64 + 32 * d + rho) * 136 + 16 * ks + 8 * hh); acc[d] = MFMA32(af, bfr, acc[d]); } }
                float bs[16]; bf16 ugv[2][16];
#pragma unroll
                for (int i = 0; i < 16; ++i) { const int p = 32 * pt + (i & 3) + 8 * (i >> 2) + 4 * hh; bs[i] = A.b_s[(l * 4 + hd) * 128 + p];
#pragma unroll
                    for (int d = 0; d < 2; ++d) ugv[d][i] = UG[((size_t)c * 128 + p) * 256 + hd * 64 + 32 * d + rho]; }
#pragma unroll
                for (int d = 0; d < 2; ++d) { const int col = hd * 64 + 32 * d + rho;
#pragma unroll
                    for (int i = 0; i < 16; ++i) { const int p = 32 * pt + (i & 3) + 8 * (i >> 2) + 4 * hh; const size_t row = (size_t)c * 128 + p;
                        const float mixed = acc[d][i] + bs[i];
                        const float ug = __uint_as_float((unsigned)ugv[d][i] << 16);
                        CC[row * 1024 + 512 + col] = (bf16)(cvt_pk_bf16(ug * mixed, 0.f) & 0xffffu); } }
            }
            __syncthreads();
        }
    }
}

__global__ void __launch_bounds__(512, 2) fwd_megakernel(Args A) {
    extern __shared__ __attribute__((aligned(16))) unsigned char smem[];
    LAS unsigned char* lds = (LAS unsigned char*)smem;
    const int wave0 = __builtin_amdgcn_readfirstlane((int)threadIdx.x >> 6);
    unsigned* const bar = (unsigned*)(A.ws + WS_BAR);
    volatile LAS unsigned* const barst = (volatile LAS unsigned*)(lds + LDS_BARST);
    const unsigned xcc = xb_xcc_id();
    if (wave0 == 0) { const int l0 = fresh_lane(); if (l0 < 2) barst[l0] = 0u; if (l0 == 0 && A.ph_hi - A.ph_lo > 1) (void)xb_add(&bar[XB_XCNT(xcc)], 1u); }
    __syncthreads();
    if (A.ph_lo < 0) cg::this_grid().sync();
    bool dup_done = false; (void)dup_done;
    for (int ph = A.ph_lo; ph < A.ph_hi; ++ph) {
        const int wave = wave0;
#define LANE fresh_lane()
#define TID (wave * 64 + fresh_lane())
        unsigned char* ws = A.ws; asm volatile("" : "+s"(ws));
        if (ph == 0) phase_prologue(A, lds, wave);
        else if (ph == 1) phase_pre(A, LANE, wave);
        else {
            const int l = (ph - 2) / 9, k = (ph - 2) % 9;
            const int G = gridDim.x, bid = blockIdx.x;
            if (k == 0) {
                pg8::Gemm g{(const bf16*)(ws + WS_H), (const bf16*)(ws + WS_WIN) + (size_t)l * 2048 * 1024, NTOK, 2048, 1024}; pg8::StaticOrder S; S.init(NTOK, 2048, G, bid);
                EpiB16<0> E{(bf16*)(ws + WS_Z), INC, INC}; pg8::gemm_phase<EpiB16<0>, pg8::StaticOrder>(lds, g, S, E, TID);
            } else if (k == 1) phase_split(A, l, LANE, wave);
            else if (k == 2) {
                { pg8::Gemm g{(const bf16*)(ws + WS_QN), (const bf16*)(ws + WS_WUQ) + (size_t)l * 768 * 384, NTOK, 768, 384}; pg8::StaticOrder S; S.init(NTOK, 768, G, bid);
                  EpiQ E{(bf16*)(ws + WS_Q), (const float*)(ws + WS_ROPE), (const float*)(ws + WS_ROPE) + 32768}; pg8::gemm_phase<EpiQ, pg8::StaticOrder>(lds, g, S, E, TID); }
                                { pg8::Gemm g{(const bf16*)(ws + WS_CKVN), (const bf16*)(ws + WS_WUKV) + (size_t)l * 1024 * 256, NROWKV, 1024, 256}; pg8::StaticOrder S; S.init(NROWKV, 1024, G, (bid + G - 144 % G) % G);
                  EpiKV E{(bf16*)(ws + WS_KNOPE), (bf16*)(ws + WS_VTP), (bf16*)(ws + WS_VTS)}; pg8::gemm_phase<EpiKV, pg8::StaticOrder>(lds, g, S, E, TID); }
            } else if (k == 3) phase_mixer(A, l, lds, LANE, wave);
            else if (k == 4 || k == 7) {
                const bool o = (k == 4);
                pg8::Gemm g{(const bf16*)(ws + (o ? WS_CONCAT : WS_ACT)), o ? (const bf16*)(ws + WS_WOUT) + (size_t)l * 1024 * 1024 : (const bf16*)(ws + WS_WFF2) + (size_t)l * 1024 * 4096, NTOK, 1024, o ? 1024 : 4096};
                pg8::StaticOrder S; S.init(NTOK, 1024, G, bid);
                EpiB16<0> E{(bf16*)(ws + WS_MIX), 1024, 1024}; pg8::gemm_phase<EpiB16<0>, pg8::StaticOrder>(lds, g, S, E, TID);
            } else if (k == 5) phase_post(A, l, 0, LANE, wave);
            else if (k == 6) {
                pg8::Gemm g{(const bf16*)(ws + WS_H), (const bf16*)(ws + WS_WFF1) + (size_t)l * 4096 * 1024, NTOK, 4096, 1024}; pg8::StaticOrder S; S.init(NTOK, 4096, G, bid);
                EpiB16<1> E{(bf16*)(ws + WS_ACT), 4096, 4096}; pg8::gemm_phase<EpiB16<1>, pg8::StaticOrder>(lds, g, S, E, TID);
            } else phase_post(A, l, 1, LANE, wave);
        }
        if (ph + 1 < A.ph_hi) xcd_barrier(bar, xcc, barst, wave == 0 && fresh_lane() == 0);
#if PROBE_DUP >= 0
        {
            bool again = false;
            if (PROBE_DUP == 100) { if (ph + 1 < A.ph_hi) xcd_barrier(bar, xcc, barst, wave == 0 && fresh_lane() == 0); }
            else if (!dup_done) {
                const int kk = ph >= 2 ? (ph - 2) % 9 : -1;
                if (PROBE_DUP == 50) again = (ph == 0);
                else if (PROBE_DUP == 60) again = (kk == 0 || kk == 2 || kk == 4 || kk == 6 || kk == 7);
                else again = (kk == PROBE_DUP);
            }
            if (again) { dup_done = true; --ph; } else dup_done = false;
        }
#endif
    }
}

constexpr int N_PHASES = 2 + 9 * DEPTH;

extern "C" void kernel_launch(void* const* d_in, const int* in_sizes, int n_in, void* d_out, int out_size, void* d_ws, size_t ws_size, hipStream_t stream) {
    static int grid = 0;
    if (grid == 0) {
        if (n_in != 24 || ws_size < WS_END || in_sizes[9] != DEPTH * 1024 * INC) { fprintf(stderr, "kernel_launch: unexpected problem (n_in %d, ws %zu, w_in %d)\n", n_in, ws_size, n_in > 9 ? in_sizes[9] : -1); grid = -1; return; }
        int dev = 0, cus = 0, per_cu = 0;
        hipGetDevice(&dev); hipDeviceGetAttribute(&cus, hipDeviceAttributeMultiprocessorCount, dev);
        if (hipFuncSetAttribute((const void*)fwd_megakernel, hipFuncAttributeMaxDynamicSharedMemorySize, LDS_BYTES) != hipSuccess) { fprintf(stderr, "kernel_launch: hipFuncSetAttribute failed\n"); grid = -1; return; }
        if (hipOccupancyMaxActiveBlocksPerMultiprocessor(&per_cu, (const void*)fwd_megakernel, 512, LDS_BYTES) != hipSuccess || per_cu < 1) { fprintf(stderr, "kernel_launch: occupancy query says %d\n", per_cu); per_cu = 1; }
        (void)hipGetLastError();
        grid = cus * 1;
        fprintf(stderr, "kernel_launch: grid %d (cus %d, per_cu %d)\n", grid, cus, per_cu);
    }
    if (grid < 0) return;
    if (hipMemsetAsync((char*)d_ws + WS_BAR, 0, 16384, stream) != hipSuccess) { fprintf(stderr, "kernel_launch: memset failed\n"); return; }
    Args a{};
    const float** ap = (const float**)&a;
    for (int i = 0; i < 24; ++i) ap[i] = (const float*)d_in[i];
    a.out = (float*)d_out; a.ws = (unsigned char*)d_ws;
#if MK_PER_PHASE
    for (int ph = 0; ph < N_PHASES; ++ph) { a.ph_lo = ph; a.ph_hi = ph + 1; hipLaunchKernelGGL(fwd_megakernel, dim3(grid), dim3(512), LDS_BYTES, stream, a); }
#else
    a.ph_lo = 0; a.ph_hi = N_PHASES;
    void* args[] = {&a};
    hipError_t e = hipLaunchCooperativeKernel((const void*)fwd_megakernel, dim3(grid), dim3(512), args, LDS_BYTES, stream);
    if (e != hipSuccess) fprintf(stderr, "kernel_launch: cooperative launch failed: %s (grid %d)\n", hipGetErrorString(e), grid);
#endif
}
```

```cpp
#include <hip/hip_runtime.h>
#include <hip/hip_cooperative_groups.h>
#include <cstdio>
namespace cg = cooperative_groups;

#ifndef MK_PER_PHASE
#define MK_PER_PHASE 0
#endif

#ifndef PROBE_DUP
#define PROBE_DUP -1
#endif
#define LAS __attribute__((address_space(3)))
typedef unsigned short bf16;
typedef short bf16x8 __attribute__((ext_vector_type(8)));
typedef float f32x2 __attribute__((ext_vector_type(2)));
typedef float f32x4 __attribute__((ext_vector_type(4)));
typedef float f32x16 __attribute__((ext_vector_type(16)));
typedef unsigned u32x2 __attribute__((ext_vector_type(2)));
typedef unsigned u32x4 __attribute__((ext_vector_type(4)));

constexpr int DM = 1024, NTOK_P = 8192, NTOK_S = 4096, NTOK = 12288, NROWKV = 14336;
constexpr int DEPTH = 4, INC = 1984, DFF = 4096;
constexpr int ZQ = 0, ZCKV = 384, ZKR = 640, ZU = 704, ZV = 960, ZBG = 1216, ZCG = 1472, ZHH = 1728;
constexpr float EPS = 1e-6f;
constexpr float QSCALE = 0.07216878364870322f * 1.4426950408889634f;

constexpr size_t MiB = 1u << 20;
constexpr size_t WS_MOD = 0, WS_BAR = 512 * 1024, WS_ROPE = 1 * MiB, WS_WIN = 2 * MiB, WS_WUQ = 18 * MiB, WS_WUKV = 21 * MiB, WS_WOUT = 23 * MiB,
                 WS_WFF1 = 31 * MiB, WS_WFF2 = 63 * MiB, WS_H = 95 * MiB, WS_MIX = 119 * MiB, WS_CONCAT = 167 * MiB, WS_QN = 191 * MiB,
                 WS_CKVN = 200 * MiB, WS_KRB = 207 * MiB, WS_UG = 209 * MiB, WS_VN = 215 * MiB, WS_Q = 221 * MiB, WS_KNOPE = 239 * MiB,
                 WS_VTP = 253 * MiB, WS_VTS = 261 * MiB, WS_Z = 267 * MiB, WS_ACT = 267 * MiB, WS_END = 363 * MiB;
constexpr int LDS_BYTES = 147456, LDS_BARST = LDS_BYTES - 64;

__device__ __forceinline__ unsigned cvt_pk_bf16(float lo, float hi) { unsigned r; asm volatile("v_cvt_pk_bf16_f32 %0, %1, %2" : "=v"(r) : "v"(lo), "v"(hi)); return r; }
__device__ __forceinline__ int fresh_lane() { int l; asm volatile("v_mbcnt_lo_u32_b32 %0, -1, 0\n\tv_mbcnt_hi_u32_b32 %0, -1, %0" : "=v"(l)); return l; }
__device__ __forceinline__ float shx(float v, int mask, int lane) { return __int_as_float(__builtin_amdgcn_ds_bpermute((lane ^ mask) << 2, __float_as_int(v))); }
__device__ __forceinline__ float dpp_add(float v, const int ctrl_is) {
    return v; }
#define DPP_ADD(v, ctrl) ((v) + __int_as_float(__builtin_amdgcn_update_dpp(0, __float_as_int(v), (ctrl), 0xf, 0xf, true)))
__device__ __forceinline__ float wave_sum(float v, int lane) {
    (void)lane;
    v = DPP_ADD(v, 0xB1);
    v = DPP_ADD(v, 0x4E);
    v = DPP_ADD(v, 0x141);
    v = DPP_ADD(v, 0x140);
    const int vi = __float_as_int(v);
    return (__int_as_float(__builtin_amdgcn_readlane(vi, 0)) + __int_as_float(__builtin_amdgcn_readlane(vi, 16))) + (__int_as_float(__builtin_amdgcn_readlane(vi, 32)) + __int_as_float(__builtin_amdgcn_readlane(vi, 48)));
}
__device__ __forceinline__ float gelu_tanh(float x) { const float y = 0.7978845608028654f * (x + 0.044715f * x * x * x); return x / (1.0f + __expf(-2.0f * y)); }
__device__ __forceinline__ f32x4 gelu4(f32x4 v) { return (f32x4){gelu_tanh(v.x), gelu_tanh(v.y), gelu_tanh(v.z), gelu_tanh(v.w)}; }
__device__ __forceinline__ float sumsq4(f32x4 v) { return (v.x * v.x + v.y * v.y) + (v.z * v.z + v.w * v.w); }
__device__ __forceinline__ f32x4 ld4bf(const bf16* p) { const u32x2 w = *(const u32x2*)p; return (f32x4){__uint_as_float(w.x << 16), __uint_as_float(w.x & 0xffff0000u), __uint_as_float(w.y << 16), __uint_as_float(w.y & 0xffff0000u)}; }
__device__ __forceinline__ f32x2 ld2bf(const bf16* p) { const unsigned w = *(const unsigned*)p; return (f32x2){__uint_as_float(w << 16), __uint_as_float(w & 0xffff0000u)}; }
__device__ __forceinline__ float ld1bf(const bf16* p) { return __uint_as_float((unsigned)*p << 16); }
__device__ __forceinline__ u32x2 pk4(f32x4 v) { u32x2 w; w.x = cvt_pk_bf16(v.x, v.y); w.y = cvt_pk_bf16(v.z, v.w); return w; }


#define XB_TMO      128
#define XB_XCNT(j)  (256  + 64 * (j))
#define XB_XSUB(j)  (1280 + 64 * (j))
#define XB_XGEN(j)  (2304 + 64 * (j))
#define XB_TOP      3328
#define XB_TOPGEN   3392
#define XCD_BAR_WORDS 3456
#define XB_SPIN_CAP (1u << 18)
__device__ __forceinline__ unsigned xb_ld(unsigned* p)              { return __hip_atomic_load(p, __ATOMIC_RELAXED, __HIP_MEMORY_SCOPE_AGENT); }
__device__ __forceinline__ unsigned xb_add(unsigned* p, unsigned v) { return __hip_atomic_fetch_add(p, v, __ATOMIC_RELAXED, __HIP_MEMORY_SCOPE_AGENT); }
__device__ __forceinline__ unsigned xb_xcc_id() { return (unsigned)__builtin_amdgcn_s_getreg((3 << 11) | 20) & 0xFu; }
#define XB_SPIN(cond, bar) do { unsigned _sp = 0; while (cond) { __builtin_amdgcn_s_sleep(1); \
    if ((++_sp & 255u) == 0u) { if (xb_ld(&(bar)[XB_TMO])) break; if (_sp > XB_SPIN_CAP) { atomicAdd(&(bar)[XB_TMO], 1u); break; } } } } while (0)
__device__ __forceinline__ void xcd_barrier_complete(unsigned* bar, unsigned x, unsigned& nloc, unsigned& nx) {
    const unsigned G = gridDim.x * gridDim.y * gridDim.z;
    unsigned sum, cnt, mine, sp = 0u;
    for (;;) {
        sum = 0u; cnt = 0u; mine = 0u;
#pragma unroll
        for (unsigned j = 0; j < 16; ++j) { const unsigned c = xb_ld(&bar[XB_XCNT(j)]); sum += c; cnt += (c > 0u) ? 1u : 0u; mine = (j == x) ? c : mine; }
        if (sum == G) break;
        __builtin_amdgcn_s_sleep(1);
        if ((++sp & 255u) == 0u) { if (xb_ld(&bar[XB_TMO])) break; if (sp > XB_SPIN_CAP) { atomicAdd(&bar[XB_TMO], 1u); break; } }
    }
    nloc = mine > 0u ? mine : 1u; nx = cnt > 0u ? cnt : 1u;
}
__device__ __forceinline__ void xcd_barrier(unsigned* bar, unsigned x, volatile LAS unsigned* st, bool leader) {
    asm volatile("s_waitcnt vmcnt(0)" ::: "memory");
    __syncthreads();
    if (leader) {
        __builtin_amdgcn_s_waitcnt(0);
        unsigned nloc = st[0], nx = st[1];
        if (nloc == 0u) { xcd_barrier_complete(bar, x, nloc, nx); st[0] = nloc; st[1] = nx; }
        const unsigned old = xb_add(&bar[XB_XSUB(x)], 1u);
        const unsigned gen = old / nloc;
        if (old + 1u == (gen + 1u) * nloc) {
            __builtin_amdgcn_fence(__ATOMIC_RELEASE, "agent");
            asm volatile("s_waitcnt vmcnt(0)" ::: "memory");
            const unsigned og = xb_add(&bar[XB_TOP], 1u);
            const unsigned tg = og / nx;
            if (og + 1u == (tg + 1u) * nx) xb_add(&bar[XB_TOPGEN], 1u);
            else XB_SPIN(xb_ld(&bar[XB_TOPGEN]) == tg, bar);
            __builtin_amdgcn_fence(__ATOMIC_ACQUIRE, "agent");
            xb_add(&bar[XB_XGEN(x)], 1u);
            asm volatile("s_waitcnt vmcnt(0)" ::: "memory");
        } else {
            XB_SPIN(xb_ld(&bar[XB_XGEN(x)]) == gen, bar);
            __builtin_amdgcn_fence(__ATOMIC_ACQUIRE, "agent");
            asm volatile("s_waitcnt vmcnt(0)" ::: "memory");
        }
    }
    __syncthreads();
}

namespace pg8 {
#define PG8_LAS __attribute__((address_space(3)))
typedef unsigned short bf16_t;
constexpr int BM = 256, BK = 64, HALF = 128, HTB = HALF * BK * 2, STAGE_BYTES = 8 * HTB, NXCD = 8, WGM = 8;
__host__ __device__ __forceinline__ int lds_byte(int r, int c) { const int st = (r >> 4) * 2 + (c >> 5), rr = r & 15, cc = c & 31, ob = rr * 64 + cc * 2; return st * 1024 + (ob ^ (((ob >> 9) & 1) << 5)); }
__host__ __device__ __forceinline__ void stage_rc(int b, int& R, int& C) { const int st = b / 1024, sb = b % 1024, swz = sb ^ (((sb >> 9) & 1) << 5); R = (st >> 1) * 16 + swz / 64; C = (st & 1) * 32 + (swz % 64) / 2; }
__host__ __device__ __forceinline__ int perm32(int rho) { const int n = rho >> 4, i = rho & 15; return 8 * (i >> 2) + 4 * n + (i & 3); }
struct Unit { int pm, pn; };
struct Gemm { const bf16_t* A; const bf16_t* Bt; int M, N, K; };
struct StaticOrder {
    int nM, nN, nwg, G, c;
    __host__ __device__ void init(int M, int N, int G_, int c_) { nM = M / BM; nN = N / BM; nwg = nM * nN; G = G_; c = c_; }
    __host__ __device__ bool next(int i, Unit& u) const {
        const long L = (long)i * G + c; if (L >= nwg) return false;
        int wgid = (int)L; { const int q = nwg / NXCD, r = nwg % NXCD, xcd = wgid % NXCD, off = wgid / NXCD; wgid = (xcd < r ? xcd * (q + 1) : r * (q + 1) + (xcd - r) * q) + off; }
        const int nig = WGM * nN, gid = wgid / nig, fm = gid * WGM, gsz = (nM - fm) < WGM ? (nM - fm) : WGM;
        u.pm = fm + ((wgid % nig) % gsz); u.pn = (wgid % nig) / gsz; return true;
    }
    __device__ __forceinline__ void a_ready(const Unit&) const {}
    __device__ __forceinline__ void done(const Unit&) const {}
};

template <class Epi, class Sched>
__device__ __forceinline__ void gemm_phase(PG8_LAS unsigned char* lds, const Gemm g, const Sched& S, const Epi& E, const int tid) {
    const int wid = __builtin_amdgcn_readfirstlane(tid >> 6), lane = tid & 63, wr = wid >> 2, wc = wid & 3, fr = lane & 15, fq = lane >> 4;
    const int K = g.K, nt = K / BK;
    unsigned voffA[2], voffB[2];
#pragma unroll
    for (int i = 0; i < 2; ++i) { int R, C; stage_rc(tid * 16 + i * 8192, R, C); const int Rb = Epi::PERM ? ((R & ~31) + perm32(R & 31)) : R;
        voffA[i] = (unsigned)(R * K + C) * 2u; voffB[i] = (unsigned)(Rb * K + C) * 2u; }
    const size_t kstep = (size_t)(BK * 2);
    const size_t hstep = (size_t)HALF * K * 2;
    const size_t tstep = 2 * hstep;
    const unsigned ldsw = (unsigned)wid * 1024u;
    const int aoff = lds_byte(wr * 64 + fr, fq * 8), boff = lds_byte(wc * 32 + fr, fq * 8);
#define PG8_SA(b, h) (((b) * 2 + (h)) * HTB)
#define PG8_SB(b, h) ((4 + (b) * 2 + (h)) * HTB)
#define PG8_STAGE(bufoff, gbase, voff) do { _Pragma("unroll") for (int _i = 0; _i < 2; ++_i) \
        __builtin_amdgcn_global_load_lds((const unsigned*)((const char*)(gbase) + (voff)[_i]), (PG8_LAS unsigned*)(lds + (bufoff) + ldsw + _i * 8192), 16, 0, 0); } while (0)
#define PG8_LDA(dst, b, h) do { _Pragma("unroll") for (int m = 0; m < 4; ++m) _Pragma("unroll") for (int k = 0; k < 2; ++k) dst[m][k] = *(const PG8_LAS bf16x8*)(lds + PG8_SA(b, h) + aoff + m * 2048 + k * 1024); } while (0)
#define PG8_LDB(dst, b, h) do { _Pragma("unroll") for (int n = 0; n < 2; ++n) _Pragma("unroll") for (int k = 0; k < 2; ++k) dst[n][k] = *(const PG8_LAS bf16x8*)(lds + PG8_SB(b, h) + boff + n * 2048 + k * 1024); } while (0)
#define PG8_MMA(ai, bj, At, Bt) do { __builtin_amdgcn_s_setprio(1); _Pragma("unroll") for (int m = 0; m < 4; ++m) _Pragma("unroll") for (int n = 0; n < 2; ++n) _Pragma("unroll") for (int k = 0; k < 2; ++k) \
        acc[ai][bj][m][n] = __builtin_amdgcn_mfma_f32_16x16x32_bf16(Bt[n][k], At[m][k], acc[ai][bj][m][n], 0, 0, 0); __builtin_amdgcn_s_setprio(0); } while (0)
#define PG8_WAIT_V(n) asm volatile("s_waitcnt vmcnt(" #n ")" ::: "memory")
#define PG8_WAIT_L(n) asm volatile("s_waitcnt lgkmcnt(" #n ")" ::: "memory")
#define PG8_BAR __builtin_amdgcn_s_barrier()
#define PG8_SCHED __builtin_amdgcn_sched_barrier(0)
    Unit cur, nxt; int ui = 0;
    if (!S.next(0, cur)) return;
    f32x4 acc[2][2][4][2];
#pragma unroll
    for (int a = 0; a < 2; ++a)
#pragma unroll
        for (int b = 0; b < 2; ++b)
#pragma unroll
            for (int m = 0; m < 4; ++m)
#pragma unroll
                for (int n = 0; n < 2; ++n) acc[a][b][m][n] = (f32x4){0.f, 0.f, 0.f, 0.f};
    bf16x8 At[4][2], B0[2][2], B1[2][2];
    const char* cA = (const char*)g.A + (size_t)cur.pm * tstep; const char* cB = (const char*)g.Bt + (size_t)cur.pn * tstep;
    S.a_ready(cur);
    PG8_STAGE(PG8_SB(0, 0), cB, voffB); PG8_STAGE(PG8_SA(0, 0), cA, voffA); PG8_STAGE(PG8_SB(0, 1), cB + hstep, voffB); PG8_STAGE(PG8_SA(0, 1), cA + hstep, voffA);
    if (wr == 1) PG8_BAR;
    PG8_WAIT_V(4); PG8_BAR;
    PG8_STAGE(PG8_SB(1, 0), cB + kstep, voffB); PG8_STAGE(PG8_SA(1, 0), cA + kstep, voffA); PG8_STAGE(PG8_SB(1, 1), cB + hstep + kstep, voffB);
    PG8_WAIT_V(6); PG8_BAR;
    for (;;) {
        const bool has_next = S.next(ui + 1, nxt);
        const char* nA = has_next ? (const char*)g.A + (size_t)nxt.pm * tstep : cA; const char* nB = has_next ? (const char*)g.Bt + (size_t)nxt.pn * tstep : cB;
        for (int t = 0; t < nt; t += 2) {
            const bool last = (t == nt - 2);
            const char* a1 = cA + (size_t)(t + 1) * kstep;
            const char* a2 = last ? nA : cA + (size_t)(t + 2) * kstep; const char* b2 = last ? nB : cB + (size_t)(t + 2) * kstep;
            const char* a3 = a2 + kstep; const char* b3 = b2 + kstep;
            if (last && has_next) S.a_ready(nxt);
            PG8_LDB(B0, 0, 0); PG8_SCHED; PG8_LDA(At, 0, 0); PG8_STAGE(PG8_SA(1, 1), a1 + hstep, voffA);
            PG8_WAIT_L(8); PG8_BAR; PG8_WAIT_L(0); PG8_MMA(0, 0, At, B0); PG8_BAR; PG8_SCHED;
            PG8_LDB(B1, 0, 1); PG8_STAGE(PG8_SB(0, 0), b2, voffB);
            PG8_BAR; PG8_WAIT_L(0); PG8_MMA(0, 1, At, B1); PG8_BAR;
            PG8_LDA(At, 0, 1); PG8_STAGE(PG8_SA(0, 0), a2, voffA);
            PG8_BAR; PG8_WAIT_L(0); PG8_MMA(1, 0, At, B0); PG8_BAR; PG8_SCHED;
            PG8_STAGE(PG8_SB(0, 1), b2 + hstep, voffB);
            PG8_WAIT_V(6); PG8_BAR; PG8_MMA(1, 1, At, B1); PG8_BAR;
            PG8_LDB(B0, 1, 0); PG8_SCHED; PG8_LDA(At, 1, 0); PG8_STAGE(PG8_SA(0, 1), a2 + hstep, voffA);
            PG8_WAIT_L(8); PG8_BAR; PG8_WAIT_L(0); PG8_MMA(0, 0, At, B0); PG8_BAR; PG8_SCHED;
            PG8_LDB(B1, 1, 1); PG8_STAGE(PG8_SB(1, 0), b3, voffB);
            PG8_BAR; PG8_WAIT_L(0); PG8_MMA(0, 1, At, B1); PG8_BAR;
            PG8_LDA(At, 1, 1); PG8_STAGE(PG8_SA(1, 0), a3, voffA);
            PG8_BAR; PG8_WAIT_L(0); PG8_MMA(1, 0, At, B0); PG8_BAR; PG8_SCHED;
            PG8_STAGE(PG8_SB(1, 1), b3 + hstep, voffB);
            PG8_WAIT_V(6); PG8_BAR; PG8_MMA(1, 1, At, B1); PG8_BAR;
        }
        E(acc, cur, wr, wc, fr, fq); S.done(cur);
        if (!has_next) break;
#pragma unroll
        for (int a = 0; a < 2; ++a)
#pragma unroll
            for (int b = 0; b < 2; ++b)
#pragma unroll
                for (int m = 0; m < 4; ++m)
#pragma unroll
                    for (int n = 0; n < 2; ++n) acc[a][b][m][n] = (f32x4){0.f, 0.f, 0.f, 0.f};
        cur = nxt; cA = nA; cB = nB; ++ui;
    }
    PG8_WAIT_V(0);
    if (wr == 0) PG8_BAR;
    PG8_BAR;
#undef PG8_SA
#undef PG8_SB
#undef PG8_STAGE
#undef PG8_LDA
#undef PG8_LDB
#undef PG8_MMA
#undef PG8_WAIT_V
#undef PG8_WAIT_L
#undef PG8_BAR
#undef PG8_SCHED
}
}

struct EpiF32 {
    static constexpr bool PERM = false;
    float* C; int ldc; int ncols;
    __device__ __forceinline__ void operator()(const f32x4 (&acc)[2][2][4][2], const pg8::Unit& u, int wr, int wc, int fr, int fq) const {
        const int row0 = u.pm * 256 + wr * 64 + fr, col0 = u.pn * 256 + wc * 32 + 4 * fq;
#pragma unroll
        for (int ai = 0; ai < 2; ++ai)
#pragma unroll
            for (int m = 0; m < 4; ++m) { float* rowp = C + (size_t)(row0 + ai * 128 + m * 16) * ldc + col0;
#pragma unroll
                for (int bj = 0; bj < 2; ++bj)
#pragma unroll
                    for (int n = 0; n < 2; ++n) if (col0 + bj * 128 + n * 16 < ncols) *(f32x4*)(rowp + bj * 128 + n * 16) = acc[ai][bj][m][n]; }
    }
};
template <int ACT> struct EpiB16 {
    static constexpr bool PERM = true;
    bf16* O; int ldc; int ncols;
    __device__ __forceinline__ void operator()(const f32x4 (&acc)[2][2][4][2], const pg8::Unit& u, int wr, int wc, int fr, int fq) const {
        const int row0 = u.pm * 256 + wr * 64 + fr, col0 = u.pn * 256 + wc * 32 + 8 * fq;
#pragma unroll
        for (int ai = 0; ai < 2; ++ai)
#pragma unroll
            for (int m = 0; m < 4; ++m) { bf16* rowp = O + (size_t)(row0 + ai * 128 + m * 16) * ldc + col0;
#pragma unroll
                for (int bj = 0; bj < 2; ++bj) { f32x4 v0 = acc[ai][bj][m][0], v1 = acc[ai][bj][m][1];
                    if (col0 + bj * 128 >= ncols) continue;
                    if (ACT) {
#pragma unroll
                    for (int j = 0; j < 4; ++j) { const float a = fmaxf(v0[j], 0.f), b = fmaxf(v1[j], 0.f); v0[j] = a * a; v1[j] = b * b; } }
                    u32x4 w; w.x = cvt_pk_bf16(v0[0], v0[1]); w.y = cvt_pk_bf16(v0[2], v0[3]); w.z = cvt_pk_bf16(v1[0], v1[1]); w.w = cvt_pk_bf16(v1[2], v1[3]);
                    *(u32x4*)(rowp + bj * 128) = w; } }
    }
};
struct EpiQ {
    static constexpr bool PERM = false;
    bf16* Q; const float* ropec; const float* ropes;
    __device__ __forceinline__ void operator()(const f32x4 (&acc)[2][2][4][2], const pg8::Unit& u, int wr, int wc, int, int) const {
        const int ln = fresh_lane(), fr = ln & 15, fq = ln >> 4;
        const int row0 = u.pm * 256 + wr * 64 + fr; const bool sample = u.pm >= 32;
#pragma unroll
        for (int bj = 0; bj < 2; ++bj) {
            const int g0 = u.pn * 256 + bj * 128 + wc * 32, within0 = g0 % 192; const bool isrope = within0 >= 128; const int a = (within0 - 128) >> 5;
#pragma unroll
            for (int ai = 0; ai < 2; ++ai)
#pragma unroll
                for (int m = 0; m < 4; ++m) { const int row = row0 + ai * 128 + m * 16;
                    f32x4 x1 = acc[ai][bj][m][0], x2 = acc[ai][bj][m][1];
                    if (sample && isrope) { const int ntok = (row - NTOK_P) & 1023;
                        const f32x4 cs = *(const f32x4*)(ropec + ntok * 32 + a * 16 + 4 * fq), sn = *(const f32x4*)(ropes + ntok * 32 + a * 16 + 4 * fq);
                        const f32x4 o1 = x1 * cs - x2 * sn, o2 = x1 * sn + x2 * cs; x1 = o1; x2 = o2; }
                    x1 = x1 * QSCALE; x2 = x2 * QSCALE;
                    bf16* p = Q + (size_t)row * 768 + g0 + 4 * fq;
                    *(u32x2*)p = pk4(x1); *(u32x2*)(p + 16) = pk4(x2); asm volatile("" ::: "memory"); }
        }
    }
};
struct EpiKV {
    static constexpr bool PERM = false;
    bf16* KN; bf16* VTP; bf16* VTS;
    __device__ __forceinline__ void operator()(const f32x4 (&acc)[2][2][4][2], const pg8::Unit& u, int wr, int wc, int, int) const {
        const int ln = fresh_lane(), fr = ln & 15, fq = ln >> 4;
        const int h = u.pn, pm = u.pm;
        bf16* vt; int keys, keybase;
        if (pm < 32) { vt = VTP + (size_t)((pm * 4 + h) * 128) * 256; keys = 256; keybase = 0; }
        else if (pm < 48) { const int b = (pm - 32) >> 2; vt = VTS + (size_t)((b * 4 + h) * 128) * 1536; keys = 1536; keybase = 512 + ((pm - 32) & 3) * 256; }
        else { const int b = (pm - 48) >> 1; vt = VTS + (size_t)((b * 4 + h) * 128) * 1536; keys = 1536; keybase = ((pm - 48) & 1) * 256; }
#pragma unroll
        for (int ai = 0; ai < 2; ++ai)
#pragma unroll
            for (int m = 0; m < 4; ++m) { const int rloc = wr * 64 + fr + ai * 128 + m * 16;
                bf16* kp = KN + (size_t)(pm * 256 + rloc) * 512 + h * 128 + wc * 32 + 4 * fq;
#pragma unroll
                for (int n = 0; n < 2; ++n) *(u32x2*)(kp + 16 * n) = pk4(acc[ai][0][m][n]);
#pragma unroll
                for (int n = 0; n < 2; ++n) { const f32x4 v = acc[ai][1][m][n]; const u32x2 w = pk4(v);
                    bf16* vp = vt + (size_t)(wc * 32 + 16 * n + 4 * fq) * keys + keybase + rloc;
                    vp[0] = (bf16)(w.x & 0xffffu); vp[keys] = (bf16)(w.x >> 16); vp[2 * keys] = (bf16)(w.y & 0xffffu); vp[3 * keys] = (bf16)(w.y >> 16); }
                asm volatile("" ::: "memory");
            }
    }
};

struct Args {
    const float *x_prompt, *x_sample, *cache_ckv, *cache_krope, *c, *c_ctx, *w_ada, *b_ada, *g_pre_mix, *w_in, *g_q, *w_uq, *g_kv, *w_ukv,
                *g_v, *w_s, *b_s, *w_conv, *w_out, *g_post_mix, *g_pre_ffn, *w_ff1, *w_ff2, *g_post_ffn;
    float* out; unsigned char* ws; int ph_lo, ph_hi;
};

__device__ __forceinline__ void p0_transpose_item(const float* W, int K, int N, bf16* WT, LAS float* scr, int item, int lane) {
    const int nblk = N / 32, kb = item / nblk, nb = item % nblk, k0 = 64 * kb, n0 = 32 * nb;
#pragma unroll 8
    for (int i = 0; i < 32; ++i) { const int kk = 2 * i + (lane >> 5); scr[kk * 33 + (lane & 31)] = W[(size_t)(k0 + kk) * N + n0 + (lane & 31)]; }
    asm volatile("s_waitcnt lgkmcnt(0)" ::: "memory");
    const int c = lane & 7;
#pragma unroll
    for (int j = 0; j < 4; ++j) { const int n = (lane >> 3) + 8 * j; const LAS float* s = scr + (8 * c) * 33 + n;
        u32x4 o; o.x = cvt_pk_bf16(s[0 * 33], s[1 * 33]); o.y = cvt_pk_bf16(s[2 * 33], s[3 * 33]); o.z = cvt_pk_bf16(s[4 * 33], s[5 * 33]); o.w = cvt_pk_bf16(s[6 * 33], s[7 * 33]);
        *(u32x4*)(WT + (size_t)(n0 + n) * K + k0 + 8 * c) = o; }
    asm volatile("s_waitcnt lgkmcnt(0)" ::: "memory");
}

__device__ __forceinline__ void phase_prologue(const Args& A, LAS unsigned char* lds, int wave) {
    const int lane = fresh_lane(), tid = wave * 64 + lane;
    unsigned char* ws = A.ws;
    const int bid = blockIdx.x, G = gridDim.x;
    { const int gt = bid * 512 + tid;
      if (gt < 32768) { const int n = gt >> 5, a = (gt >> 4) & 1, f = gt & 15; const int pos = a == 0 ? (n >> 6) : (n & 63);
          double inv = 1.0; for (int i = 0; i < f; ++i) inv *= 0.5623413251903491;
          double rev = (double)pos * inv * 0.15915494309189535; rev -= floor(rev);
          const float rf = (float)rev;
          ((float*)(ws + WS_ROPE))[gt] = __builtin_amdgcn_cosf(rf); ((float*)(ws + WS_ROPE))[32768 + gt] = __builtin_amdgcn_sinf(rf); } }
    for (int it = bid; it < 192; it += G) {
        const int l = it / 48, cgp = it % 48;
        LAS float* sl = (LAS float*)lds;
        for (int i = tid; i < 5120; i += 512) { const int ci = i >> 10, k = i & 1023; const float v = ci == 0 ? A.c_ctx[k] : A.c[(ci - 1) * 1024 + k]; sl[i] = v / (1.0f + __expf(-v)); }
        __syncthreads();
        float a0[5], a1[5];
#pragma unroll
        for (int ci = 0; ci < 5; ++ci) { a0[ci] = 0.f; a1[ci] = 0.f; }
        const float* wp = A.w_ada + ((size_t)l * 1024 + wave * 128) * 6144 + cgp * 128 + 2 * lane;
#pragma unroll 8
        for (int kk = 0; kk < 128; ++kk) { const f32x2 wv = *(const f32x2*)(wp + (size_t)kk * 6144); const int k = wave * 128 + kk;
#pragma unroll
            for (int ci = 0; ci < 5; ++ci) { const float s = sl[ci * 1024 + k]; a0[ci] += s * wv.x; a1[ci] += s * wv.y; } }
        LAS float* part = (LAS float*)(lds + 32768);
#pragma unroll
        for (int ci = 0; ci < 5; ++ci) { part[(wave * 5 + ci) * 128 + 2 * lane] = a0[ci]; part[(wave * 5 + ci) * 128 + 2 * lane + 1] = a1[ci]; }
        __syncthreads();
        for (int i = tid; i < 640; i += 512) { const int ci = i >> 7, col = i & 127; float s = 0.f;
#pragma unroll
            for (int w = 0; w < 8; ++w) s += part[(w * 5 + ci) * 128 + col];
            const int gcol = cgp * 128 + col; ((float*)(ws + WS_MOD))[(l * 5 + ci) * 6144 + gcol] = s + A.b_ada[l * 6144 + gcol]; }
        __syncthreads();
    }
    LAS float* scr = (LAS float*)(lds + wave * 16384);
    const int gw = bid * 8 + wave, NGW = G * 8;
    constexpr int I_IN = 16 * 62, I_UQ = 6 * 24, I_UKV = 4 * 32, I_OUT = 16 * 32, I_F1 = 16 * 128, I_F2 = 64 * 32, I_L = I_IN + I_UQ + I_UKV + I_OUT + I_F1 + I_F2;
    for (int it = gw; it < 4 * I_L; it += NGW) {
        const int l = it / I_L; int r = it % I_L;
        if (r < I_IN) { p0_transpose_item(A.w_in + (size_t)l * 1024 * INC, 1024, INC, (bf16*)(ws + WS_WIN) + (size_t)l * 2048 * 1024, scr, r, lane); continue; } r -= I_IN;
        if (r < I_UQ) { p0_transpose_item(A.w_uq + (size_t)l * 384 * 768, 384, 768, (bf16*)(ws + WS_WUQ) + (size_t)l * 768 * 384, scr, r, lane); continue; } r -= I_UQ;
        if (r < I_UKV) { p0_transpose_item(A.w_ukv + (size_t)l * 256 * 1024, 256, 1024, (bf16*)(ws + WS_WUKV) + (size_t)l * 1024 * 256, scr, r, lane); continue; } r -= I_UKV;
        if (r < I_OUT) { p0_transpose_item(A.w_out + (size_t)l * 1024 * 1024, 1024, 1024, (bf16*)(ws + WS_WOUT) + (size_t)l * 1024 * 1024, scr, r, lane); continue; } r -= I_OUT;
        if (r < I_F1) { p0_transpose_item(A.w_ff1 + (size_t)l * 1024 * 4096, 1024, 4096, (bf16*)(ws + WS_WFF1) + (size_t)l * 4096 * 1024, scr, r, lane); continue; } r -= I_F1;
        p0_transpose_item(A.w_ff2 + (size_t)l * 4096 * 1024, 4096, 1024, (bf16*)(ws + WS_WFF2) + (size_t)l * 1024 * 4096, scr, r, lane);
    }
}

__device__ __forceinline__ int cond_of_row(int r) { return r < NTOK_P ? 0 : 1 + ((r - NTOK_P) >> 10); }

__device__ __forceinline__ void norm_mod_store(const f32x4 (&v)[4], const LAS float* g, const LAS float* sc, const LAS float* sh, bf16* hrow, int lane) {
    float ss = 0.f;
#pragma unroll
    for (int j = 0; j < 4; ++j) ss += sumsq4(v[j]);
    const float rstd = 1.0f / sqrtf(wave_sum(ss, lane) * (1.0f / 1024.0f) + EPS);
#pragma unroll
    for (int j = 0; j < 4; ++j) { const int idx = 4 * lane + 256 * j;
        const f32x4 gg = *(const LAS f32x4*)(g + idx), s1 = *(const LAS f32x4*)(sc + idx), s0 = *(const LAS f32x4*)(sh + idx);
        const f32x4 o = v[j] * rstd * gg * (1.0f + s1) + s0;
        *(u32x2*)(hrow + idx) = pk4(o); }
}
__device__ __forceinline__ const float* x_in_row(const Args& A, int r) { return r < NTOK_P ? A.x_prompt + (size_t)r * 1024 : A.x_sample + (size_t)(r - NTOK_P) * 1024; }
__device__ __forceinline__ void fill_vec(LAS float* dst, const float* src, int tid) { if (tid < 256) *(LAS f32x4*)(dst + 4 * tid) = *(const f32x4*)(src + 4 * tid); }

__device__ __forceinline__ void phase_pre(const Args& A, LAS unsigned char* lds, int lane, int wave) {
    const int gw = blockIdx.x * 8 + wave, NGW = gridDim.x * 8;
    const float* mod = (const float*)(A.ws + WS_MOD); bf16* H = (bf16*)(A.ws + WS_H);
    LAS float* P = (LAS float*)lds;
    { const int t2 = (wave & 3) * 64 + lane, hv = wave >> 2;
      for (int v = hv; v < 11; v += 2) { const float* src = v == 0 ? A.g_pre_mix : (v <= 5 ? mod + (size_t)(v - 1) * 6144 + 1024 : mod + (size_t)(v - 6) * 6144);
          const int slot = v == 0 ? 1 : (v <= 5 ? 7 + (v - 1) : 12 + (v - 6));
          *(LAS f32x4*)(P + slot * 1024 + 4 * t2) = *(const f32x4*)(src + 4 * t2); } }
    __syncthreads();
    for (int r0 = gw; r0 < NTOK; r0 += 2 * NGW) {
        f32x4 v[2][4];
#pragma unroll
        for (int u = 0; u < 2; ++u) { const float* xr = x_in_row(A, r0 + u * NGW);
#pragma unroll
            for (int j = 0; j < 4; ++j) v[u][j] = *(const f32x4*)(xr + 4 * lane + 256 * j); }
#pragma unroll
        for (int u = 0; u < 2; ++u) { const int r = r0 + u * NGW, ci = cond_of_row(r);
            norm_mod_store(v[u], P + 1024, P + (7 + ci) * 1024, P + (12 + ci) * 1024, H + (size_t)r * 1024, lane); }
    }
    __syncthreads();
}

__device__ __forceinline__ void phase_post(const Args& A, int l, int which, LAS unsigned char* lds, int lane, int wave) {
    const int gw = blockIdx.x * 8 + wave, NGW = gridDim.x * 8;
    const float* mod = (const float*)(A.ws + WS_MOD); bf16* H = (bf16*)(A.ws + WS_H); const bf16* MIX = (const bf16*)(A.ws + WS_MIX);
    const bool first = (l == 0 && which == 0), has_h = (which == 0) || (l < DEPTH - 1);
    LAS float* P = (LAS float*)lds;
    { const int t2 = (wave & 3) * 64 + lane, hv = wave >> 2;
      const int l2 = which == 0 ? l : l + 1;
      for (int v = hv; v < 17; v += 2) { const float* src;
          if (v == 0) src = (which == 0 ? A.g_post_mix : A.g_post_ffn) + l * 1024;
          else if (v == 1) src = which == 0 ? A.g_pre_ffn + l * 1024 : A.g_pre_mix + (l2 < DEPTH ? l2 : l) * 1024;
          else if (v < 7) src = mod + (size_t)(l * 5 + (v - 2)) * 6144 + (which == 0 ? 2048 : 5120);
          else if (v < 12) src = mod + (size_t)((l2 < DEPTH ? l2 : l) * 5 + (v - 7)) * 6144 + (which == 0 ? 4096 : 1024);
          else src = mod + (size_t)((l2 < DEPTH ? l2 : l) * 5 + (v - 12)) * 6144 + (which == 0 ? 3072 : 0);
          *(LAS f32x4*)(P + v * 1024 + 4 * t2) = *(const f32x4*)(src + 4 * t2); } }
    __syncthreads();
    for (int r0 = gw; r0 < NTOK; r0 += 2 * NGW) {
        f32x4 v[2][4], t[2][4];
#pragma unroll
        for (int u = 0; u < 2; ++u) { const int r = r0 + u * NGW;
            const float* xr = first ? x_in_row(A, r) : A.out + (size_t)r * 1024; const bf16* tr = MIX + (size_t)r * 1024;
#pragma unroll
            for (int j = 0; j < 4; ++j) { v[u][j] = *(const f32x4*)(xr + 4 * lane + 256 * j); t[u][j] = ld4bf(tr + 4 * lane + 256 * j); } }
#pragma unroll
        for (int u = 0; u < 2; ++u) { const int r = r0 + u * NGW; const LAS float* ga = P + (2 + cond_of_row(r)) * 1024;
            float ss = 0.f;
#pragma unroll
            for (int j = 0; j < 4; ++j) ss += sumsq4(t[u][j]);
            const float rstd = 1.0f / sqrtf(wave_sum(ss, lane) * (1.0f / 1024.0f) + EPS);
#pragma unroll
            for (int j = 0; j < 4; ++j) { const int idx = 4 * lane + 256 * j;
                const f32x4 gg = *(const LAS f32x4*)(P + idx), gv = *(const LAS f32x4*)(ga + idx);
                v[u][j] = v[u][j] + gv * (t[u][j] * rstd * gg);
                *(f32x4*)(A.out + (size_t)r * 1024 + idx) = v[u][j]; } }
        if (has_h) {
#pragma unroll
            for (int u = 0; u < 2; ++u) { const int r = r0 + u * NGW, ci = cond_of_row(r);
                norm_mod_store(v[u], P + 1024, P + (7 + ci) * 1024, P + (12 + ci) * 1024, H + (size_t)r * 1024, lane); } }
    }
    __syncthreads();
}

__device__ __forceinline__ void phase_split(const Args& A, int l, int lane, int wave) {
    const int gw = blockIdx.x * 8 + wave, NGW = gridDim.x * 8;
    unsigned char* ws = A.ws;
    const bf16* Z = (const bf16*)(ws + WS_Z);
    bf16* QN = (bf16*)(ws + WS_QN); bf16* CKVN = (bf16*)(ws + WS_CKVN); bf16* KRB = (bf16*)(ws + WS_KRB); bf16* UG = (bf16*)(ws + WS_UG); bf16* VN = (bf16*)(ws + WS_VN);
    bf16* CC = (bf16*)(ws + WS_CONCAT);
    const float* ropec = (const float*)(ws + WS_ROPE); const float* ropes = ropec + 32768;
    float* out_ckv = A.out + (size_t)NTOK * 1024; float* out_kr = out_ckv + (size_t)32 * 4 * 256 * 256;
    for (int idx = gw; idx < 2048; idx += NGW) { const int r = NTOK + idx, b = idx >> 9, j = idx & 511;
        const f32x4 cv = *(const f32x4*)(A.cache_ckv + ((size_t)(b * 4 + l) * 512 + j) * 256 + 4 * lane);
        const float kv = A.cache_krope[((size_t)(b * 4 + l) * 512 + j) * 64 + lane];
        *(u32x2*)(CKVN + (size_t)r * 256 + 4 * lane) = pk4(cv);
        KRB[(size_t)r * 64 + lane] = (bf16)(cvt_pk_bf16(kv, 0.f) & 0xffffu); }
    const f32x4 gkv = *(const f32x4*)(A.g_kv + l * 256 + 4 * lane), gvv = *(const f32x4*)(A.g_v + l * 256 + 4 * lane);
    const float* wcp = A.w_conv + (size_t)l * 3 * 256 + 4 * lane;
    const f32x4 wc0 = *(const f32x4*)(wcp), wc1 = *(const f32x4*)(wcp + 256), wc2 = *(const f32x4*)(wcp + 512);
    f32x2 gq[3];
#pragma unroll
    for (int j = 0; j < 3; ++j) gq[j] = *(const f32x2*)(A.g_q + l * 384 + 2 * lane + 128 * j);
    for (int r0 = gw; r0 < NTOK; r0 += 2 * NGW) {
        f32x2 q[2][3]; f32x4 cv[2], uu[2], vv[2], bg[2], zc[2], zm[2], zp[2]; float kr[2], cs[2], sn[2];
#pragma unroll
        for (int u = 0; u < 2; ++u) { const int r = r0 + u * NGW; const bf16* z = Z + (size_t)r * INC;
            const bool prompt = r < NTOK_P; const int n = prompt ? (r & 255) : ((r - NTOK_P) & 1023), len = prompt ? 256 : 1024;
#pragma unroll
            for (int j = 0; j < 3; ++j) q[u][j] = ld2bf(z + ZQ + 2 * lane + 128 * j);
            cv[u] = ld4bf(z + ZCKV + 4 * lane); kr[u] = ld1bf(z + ZKR + lane);
            uu[u] = ld4bf(z + ZU + 4 * lane); vv[u] = ld4bf(z + ZV + 4 * lane); bg[u] = ld4bf(z + ZBG + 4 * lane);
            zc[u] = ld4bf(z + ZCG + 4 * lane) * ld4bf(z + ZHH + 4 * lane);
            zm[u] = (f32x4){0.f, 0.f, 0.f, 0.f}; zp[u] = zm[u];
            if (n > 0) zm[u] = ld4bf(z - INC + ZCG + 4 * lane) * ld4bf(z - INC + ZHH + 4 * lane);
            if (n < len - 1) zp[u] = ld4bf(z + INC + ZCG + 4 * lane) * ld4bf(z + INC + ZHH + 4 * lane);
            cs[u] = 1.f; sn[u] = 0.f;
            if (!prompt) { const int a = lane >> 5, f = lane & 15; cs[u] = ropec[n * 32 + a * 16 + f]; sn[u] = ropes[n * 32 + a * 16 + f]; } }
#pragma unroll
        for (int u = 0; u < 2; ++u) { const int r = r0 + u * NGW; const bool prompt = r < NTOK_P; const int n = prompt ? (r & 255) : ((r - NTOK_P) & 1023);
            { float ss = 0.f;
#pragma unroll
              for (int j = 0; j < 3; ++j) ss += q[u][j].x * q[u][j].x + q[u][j].y * q[u][j].y;
              const float rstd = 1.0f / sqrtf(wave_sum(ss, lane) * (1.0f / 384.0f) + EPS);
#pragma unroll
              for (int j = 0; j < 3; ++j) *(unsigned*)(QN + (size_t)r * 384 + 2 * lane + 128 * j) = cvt_pk_bf16(q[u][j].x * rstd * gq[j].x, q[u][j].y * rstd * gq[j].y); }
            { const float rstd = 1.0f / sqrtf(wave_sum(sumsq4(cv[u]), lane) * (1.0f / 256.0f) + EPS);
              const f32x4 c2 = cv[u] * rstd * gkv;
              if (prompt) *(f32x4*)(out_ckv + ((size_t)((r >> 8) * 4 + l) * 256 + n) * 256 + 4 * lane) = c2;
              *(u32x2*)(CKVN + (size_t)r * 256 + 4 * lane) = pk4(c2); }
            { float k2 = kr[u];
              if (prompt) out_kr[((size_t)((r >> 8) * 4 + l) * 256 + n) * 64 + lane] = k2;
              else { const float partner = shx(k2, 16, lane); const int p = (lane >> 4) & 1;
                  k2 = p == 0 ? k2 * cs[u] - partner * sn[u] : partner * sn[u] + k2 * cs[u]; }
              KRB[(size_t)r * 64 + lane] = (bf16)(cvt_pk_bf16(k2, 0.f) & 0xffffu); }
            *(u32x2*)(UG + (size_t)r * 256 + 4 * lane) = pk4(gelu4(uu[u]));
            { f32x4 v = gelu4(vv[u]);
              const float rstd = 1.0f / sqrtf(wave_sum(sumsq4(v), lane) * (1.0f / 256.0f) + EPS);
              *(u32x2*)(VN + (size_t)r * 256 + 4 * lane) = pk4(v * rstd * gvv); }
            { const f32x4 y = zm[u] * wc0 + zc[u] * wc1 + zp[u] * wc2;
              *(u32x2*)(CC + (size_t)r * 1024 + 768 + 4 * lane) = pk4(bg[u] * y); }
        }
    }
}

#define MFMA32(a, b, c) __builtin_amdgcn_mfma_f32_32x32x16_bf16((a), (b), (c), 0, 0, 0)
constexpr int AT_KROW = 400, AT_VROW = 144, AT_KBYTES = 64 * AT_KROW, AT_STAGE = AT_KBYTES + 128 * AT_VROW;
__device__ __forceinline__ void attn_store_tile(const f32x16& ot, float inv, bf16* crow  , int t, int hh) {
#pragma unroll
    for (int g = 0; g < 4; ++g) { u32x2 w; w.x = cvt_pk_bf16(ot[4 * g] * inv, ot[4 * g + 1] * inv); w.y = cvt_pk_bf16(ot[4 * g + 2] * inv, ot[4 * g + 3] * inv);
        *(u32x2*)(crow + 32 * t + 8 * g + 4 * hh) = w; }
}

__device__ __forceinline__ void phase_mixer(const Args& A, int l, LAS unsigned char* lds, int lane_in, int wave) {
    unsigned char* ws = A.ws;
    const bf16* Q = (const bf16*)(ws + WS_Q); const bf16* KN = (const bf16*)(ws + WS_KNOPE); const bf16* KRB = (const bf16*)(ws + WS_KRB);
    const bf16* VTP = (const bf16*)(ws + WS_VTP); const bf16* VTS = (const bf16*)(ws + WS_VTS);
    const bf16* UG = (const bf16*)(ws + WS_UG); const bf16* VN = (const bf16*)(ws + WS_VN);
    bf16* CC = (bf16*)(ws + WS_CONCAT);
#ifndef PROBE_MIX
#define PROBE_MIX 0
#endif
    for (int rnd = 0; rnd < (PROBE_MIX ? 3 : 2); ++rnd) {
        int it;
        if (rnd == 0) it = blockIdx.x; else if (rnd == 1) { if (blockIdx.x < 128 || blockIdx.x >= 224) continue; it = 256 + (int)blockIdx.x - 128; }
        else { if (PROBE_MIX == 1) { if (blockIdx.x >= 128) break; it = blockIdx.x; } else if (PROBE_MIX == 2) { if (blockIdx.x < 128) break; it = blockIdx.x; } else { if (blockIdx.x < 128 || blockIdx.x >= 224) break; it = 256 + (int)blockIdx.x - 128; } }
        if (it >= 352) break;
        int lane = lane_in; asm volatile("" : "+v"(lane));
        const int rho = lane & 31, hh = lane >> 5, tid = wave * 64 + lane;
        if (it < 256) {
            int h, q0, keys, nkeys, split, rowA, rowB; const bf16* vt;
            const bool heavy = it < 128;
            if (heavy) {
                const int xj = it >> 3, pr = 2 * (it & 7) + (xj >> 3), b = pr >> 2, qt = xj & 7; h = pr & 3;
                q0 = NTOK_P + b * 1024 + qt * 128 + (wave & 3) * 32; keys = 1536; nkeys = 1536; split = 512; rowA = NTOK + b * 512; rowB = NTOK_P + b * 1024;
                vt = VTS + (size_t)((b * 4 + h) * 128) * 1536; }
            else { const int i2 = it - 128, b = i2 >> 2; h = i2 & 3; q0 = b * 256 + wave * 32; keys = 256; nkeys = 256; split = 0; rowA = 0; rowB = b * 256;
                vt = VTP + (size_t)((b * 4 + h) * 128) * 256; }
            bf16x8 qf[12];
            { const bf16* qp = Q + (size_t)(q0 + rho) * 768 + h * 192 + 8 * hh;
#pragma unroll
              for (int ks = 0; ks < 12; ++ks) qf[ks] = *(const bf16x8*)(qp + 16 * ks); }
            f32x16 o[4];
#pragma unroll
            for (int t = 0; t < 4; ++t)
#pragma unroll
                for (int i = 0; i < 16; ++i) o[t][i] = 0.f;
            float m = -1e30f, lsum = 0.f;
            int kslot[2], kcol[2], vd[2], vc[2];
#pragma unroll
            for (int j = 0; j < 2; ++j) { const int c = tid + 512 * j, kap = c >> 4; kcol[j] = c & 15;
                kslot[j] = (kap & 32) + (kap & 3) + 4 * ((kap >> 4) & 1) + 8 * ((kap >> 2) & 3);
                vd[j] = c >> 3; vc[j] = c & 7; }
            const int rkap = tid >> 3, rc8 = tid & 7, rslot = (rkap & 32) + (rkap & 3) + 4 * ((rkap >> 4) & 1) + 8 * ((rkap >> 2) & 3);
            u32x4 skA[2], srA, svA[2], skB[2], srB, svB[2];
#define AT_GLD16(dst, ptr) asm volatile("global_load_dwordx4 %0, %1, off" : "=v"(dst) : "v"(ptr) : "memory")
#define AT_GLOAD(sk, sr, sv, k0) do { const int rb_ = (k0) < split ? rowA + (k0) : rowB + ((k0) - split); \
                _Pragma("unroll") for (int j = 0; j < 2; ++j) AT_GLD16(sk[j], KN + (size_t)(rb_ + ((tid + 512 * j) >> 4)) * 512 + h * 128 + kcol[j] * 8); \
                AT_GLD16(sr, KRB + (size_t)(rb_ + rkap) * 64 + rc8 * 8); \
                _Pragma("unroll") for (int j = 0; j < 2; ++j) AT_GLD16(sv[j], vt + (size_t)vd[j] * keys + (k0) + vc[j] * 8); } while (0)
#define AT_WAIT5(sk, sr, sv) asm volatile("s_waitcnt vmcnt(5)" : "+v"(sk[0]), "+v"(sk[1]), "+v"(sr), "+v"(sv[0]), "+v"(sv[1]) :: "memory")
#define AT_SWRITE(sk, sr, sv, buf) do { LAS unsigned char* sb_ = lds + (buf) * AT_STAGE; \
                _Pragma("unroll") for (int j = 0; j < 2; ++j) *(LAS u32x4*)(sb_ + kslot[j] * AT_KROW + kcol[j] * 16) = sk[j]; \
                *(LAS u32x4*)(sb_ + rslot * AT_KROW + 256 + rc8 * 16) = sr; \
                _Pragma("unroll") for (int j = 0; j < 2; ++j) *(LAS u32x4*)(sb_ + AT_KBYTES + vd[j] * AT_VROW + vc[j] * 16) = sv[j]; } while (0)
            const int ntile = nkeys >> 6;
            const int blk_lo = heavy ? (wave >> 2) : 0, blk_hi = heavy ? blk_lo + 1 : 2;
#pragma unroll
            for (int ks = 0; ks < 12; ++ks) asm volatile("" :: "v"(qf[ks]));
            asm volatile("s_waitcnt vmcnt(0)" ::: "memory");
            AT_GLOAD(skA, srA, svA, 0); AT_GLOAD(skB, srB, svB, 64);
            AT_WAIT5(skA, srA, svA);
            AT_SWRITE(skA, srA, svA, 0);
            __syncthreads();
            for (int tI = 0; tI < ntile; tI += 2) {
                AT_GLOAD(skA, srA, svA, (tI + 2 < ntile ? tI + 2 : tI) * 64);
                { const LAS unsigned char* sb = lds;
                for (int blk = blk_lo; blk < blk_hi; ++blk) {
                    const LAS unsigned char* kp = sb + (32 * blk + rho) * AT_KROW + hh * 16;
                    f32x16 sc, scb;
#pragma unroll
                    for (int i = 0; i < 16; ++i) { sc[i] = 0.f; scb[i] = 0.f; }
#pragma unroll
                    for (int ks = 0; ks < 12; ks += 2) { sc = MFMA32(*(const LAS bf16x8*)(kp + ks * 32), qf[ks], sc); scb = MFMA32(*(const LAS bf16x8*)(kp + ks * 32 + 32), qf[ks + 1], scb); }
                    sc = sc + scb;
                    float mx = sc[0];
#pragma unroll
                    for (int i = 1; i < 16; ++i) mx = fmaxf(mx, sc[i]);
                    mx = fmaxf(mx, shx(mx, 32, lane));
                    const float mn = fmaxf(m, mx), alpha = __builtin_amdgcn_exp2f(m - mn);
                    float ps = 0.f;
#pragma unroll
                    for (int i = 0; i < 16; ++i) { sc[i] = __builtin_amdgcn_exp2f(sc[i] - mn); ps += sc[i]; }
                    lsum = lsum * alpha + ps; m = mn;
#pragma unroll
                    for (int t = 0; t < 4; ++t) o[t] = o[t] * alpha;
                    bf16x8 pb[2];
#pragma unroll
                    for (int s2 = 0; s2 < 2; ++s2) { u32x4 w; w.x = cvt_pk_bf16(sc[8 * s2 + 0], sc[8 * s2 + 1]); w.y = cvt_pk_bf16(sc[8 * s2 + 2], sc[8 * s2 + 3]); w.z = cvt_pk_bf16(sc[8 * s2 + 4], sc[8 * s2 + 5]); w.w = cvt_pk_bf16(sc[8 * s2 + 6], sc[8 * s2 + 7]);
                        pb[s2] = __builtin_bit_cast(bf16x8, w); }
                    const LAS unsigned char* vp = sb + AT_KBYTES + rho * AT_VROW + (32 * blk + 16 * hh) * 2;
#pragma unroll
                    for (int t = 0; t < 4; ++t)
#pragma unroll
                        for (int s2 = 0; s2 < 2; ++s2) o[t] = MFMA32(*(const LAS bf16x8*)(vp + 32 * t * AT_VROW + 16 * s2), pb[s2], o[t]);
                }
                }
                AT_WAIT5(skB, srB, svB);
                AT_SWRITE(skB, srB, svB, 1);
                __syncthreads();
                AT_GLOAD(skB, srB, svB, (tI + 3 < ntile ? tI + 3 : tI + 1) * 64);
                { const LAS unsigned char* sb = lds + AT_STAGE;
                for (int blk = blk_lo; blk < blk_hi; ++blk) {
                    const LAS unsigned char* kp = sb + (32 * blk + rho) * AT_KROW + hh * 16;
                    f32x16 sc, scb;
#pragma unroll
                    for (int i = 0; i < 16; ++i) { sc[i] = 0.f; scb[i] = 0.f; }
#pragma unroll
                    for (int ks = 0; ks < 12; ks += 2) { sc = MFMA32(*(const LAS bf16x8*)(kp + ks * 32), qf[ks], sc); scb = MFMA32(*(const LAS bf16x8*)(kp + ks * 32 + 32), qf[ks + 1], scb); }
                    sc = sc + scb;
                    float mx = sc[0];
#pragma unroll
                    for (int i = 1; i < 16; ++i) mx = fmaxf(mx, sc[i]);
                    mx = fmaxf(mx, shx(mx, 32, lane));
                    const float mn = fmaxf(m, mx), alpha = __builtin_amdgcn_exp2f(m - mn);
                    float ps = 0.f;
#pragma unroll
                    for (int i = 0; i < 16; ++i) { sc[i] = __builtin_amdgcn_exp2f(sc[i] - mn); ps += sc[i]; }
                    lsum = lsum * alpha + ps; m = mn;
#pragma unroll
                    for (int t = 0; t < 4; ++t) o[t] = o[t] * alpha;
                    bf16x8 pb[2];
#pragma unroll
                    for (int s2 = 0; s2 < 2; ++s2) { u32x4 w; w.x = cvt_pk_bf16(sc[8 * s2 + 0], sc[8 * s2 + 1]); w.y = cvt_pk_bf16(sc[8 * s2 + 2], sc[8 * s2 + 3]); w.z = cvt_pk_bf16(sc[8 * s2 + 4], sc[8 * s2 + 5]); w.w = cvt_pk_bf16(sc[8 * s2 + 6], sc[8 * s2 + 7]);
                        pb[s2] = __builtin_bit_cast(bf16x8, w); }
                    const LAS unsigned char* vp = sb + AT_KBYTES + rho * AT_VROW + (32 * blk + 16 * hh) * 2;
#pragma unroll
                    for (int t = 0; t < 4; ++t)
#pragma unroll
                        for (int s2 = 0; s2 < 2; ++s2) o[t] = MFMA32(*(const LAS bf16x8*)(vp + 32 * t * AT_VROW + 16 * s2), pb[s2], o[t]);
                }
                }
                AT_WAIT5(skA, srA, svA);
                AT_SWRITE(skA, srA, svA, 0);
                __syncthreads();
            }
            asm volatile("s_waitcnt vmcnt(0)" : "+v"(skB[0]), "+v"(skB[1]), "+v"(srB), "+v"(svB[0]), "+v"(svB[1]) :: "memory");
            __syncthreads();
#undef AT_GLOAD
#undef AT_GLD16
#undef AT_WAIT5
#undef AT_SWRITE
            lsum += shx(lsum, 32, lane);
            bf16* crow = CC + (size_t)(q0 + rho) * 1024 + h * 128;
            if (!heavy) { const float inv = 1.0f / lsum;
#pragma unroll
                for (int t = 0; t < 4; ++t) attn_store_tile(o[t], inv, crow, t, hh);
            } else {
                const int half = wave >> 2;
                LAS float* mine = (LAS float*)(lds + wave * 8704);
                LAS const float* theirs = (LAS const float*)(lds + (wave ^ 4) * 8704);
#pragma unroll
                for (int t2 = 0; t2 < 2; ++t2)
#pragma unroll
                    for (int i = 0; i < 16; ++i) mine[(t2 * 16 + i) * 64 + lane] = half == 0 ? o[2 + t2][i] : o[t2][i];
                if (hh == 0) { mine[2048 + rho] = m; mine[2080 + rho] = lsum; }
                __syncthreads();
                const float mp = theirs[2048 + rho], lp = theirs[2080 + rho];
                const float mg = fmaxf(m, mp), wo = __builtin_amdgcn_exp2f(m - mg), wp = __builtin_amdgcn_exp2f(mp - mg);
                const float inv = 1.0f / (wo * lsum + wp * lp);
#pragma unroll
                for (int t2 = 0; t2 < 2; ++t2) { f32x16 acc;
#pragma unroll
                    for (int i = 0; i < 16; ++i) acc[i] = wo * (half == 0 ? o[t2][i] : o[2 + t2][i]) + wp * theirs[(t2 * 16 + i) * 64 + lane];
                    attn_store_tile(acc, inv, crow, half * 2 + t2, hh); }
                __syncthreads();
            }
        } else {
            const int c = it - 256;
            LAS bf16* vnT = (LAS bf16*)lds;
#pragma unroll
            for (int pass = 0; pass < 8; ++pass) { const int u = wave + 8 * pass, qq = (u & 1) * 64 + lane, c8 = (u >> 1) * 8;
                const bf16x8 v = *(const bf16x8*)(VN + (size_t)(c * 128 + qq) * 256 + c8);
#pragma unroll
                for (int j = 0; j < 8; ++j) vnT[(c8 + j) * 136 + qq] = (bf16)v[j]; }
            __syncthreads();
            const int hd = wave & 3, ph = wave >> 2;
#pragma unroll
            for (int pp = 0; pp < 2; ++pp) { const int pt = 2 * ph + pp;
                f32x16 acc[2];
#pragma unroll
                for (int d = 0; d < 2; ++d)
#pragma unroll
                    for (int i = 0; i < 16; ++i) acc[d][i] = 0.f;
                const float* wrow = A.w_s + ((size_t)(l * 4 + hd) * 128 + 32 * pt + rho) * 128 + 8 * hh;
                f32x4 wv[16];
#pragma unroll
                for (int ks = 0; ks < 8; ++ks) { wv[2 * ks] = *(const f32x4*)(wrow + 16 * ks); wv[2 * ks + 1] = *(const f32x4*)(wrow + 16 * ks + 4); }
#pragma unroll
                for (int ks = 0; ks < 8; ++ks) { const f32x4 w0 = wv[2 * ks], w1 = wv[2 * ks + 1];
                    u32x4 w; w.x = cvt_pk_bf16(w0.x, w0.y); w.y = cvt_pk_bf16(w0.z, w0.w); w.z = cvt_pk_bf16(w1.x, w1.y); w.w = cvt_pk_bf16(w1.z, w1.w);
                    const bf16x8 af = __builtin_bit_cast(bf16x8, w);
#pragma unroll
                    for (int d = 0; d < 2; ++d) { const bf16x8 bfr = *(const LAS bf16x8*)(vnT + (hd * 64 + 32 * d + rho) * 136 + 16 * ks + 8 * hh); acc[d] = MFMA32(af, bfr, acc[d]); } }
                float bs[16]; bf16 ugv[2][16];
#pragma unroll
                for (int i = 0; i < 16; ++i) { const int p = 32 * pt + (i & 3) + 8 * (i >> 2) + 4 * hh; bs[i] = A.b_s[(l * 4 + hd) * 128 + p];
#pragma unroll
                    for (int d = 0; d < 2; ++d) ugv[d][i] = UG[((size_t)c * 128 + p) * 256 + hd * 64 + 32 * d + rho]; }
#pragma unroll
                for (int d = 0; d < 2; ++d) { const int col = hd * 64 + 32 * d + rho;
#pragma unroll
                    for (int i = 0; i < 16; ++i) { const int p = 32 * pt + (i & 3) + 8 * (i >> 2) + 4 * hh; const size_t row = (size_t)c * 128 + p;
                        const float mixed = acc[d][i] + bs[i];
                        const float ug = __uint_as_float((unsigned)ugv[d][i] << 16);
                        CC[row * 1024 + 512 + col] = (bf16)(cvt_pk_bf16(ug * mixed, 0.f) & 0xffffu); } }
            }
            __syncthreads();
        }
    }
}

__global__ void __launch_bounds__(512, 2) fwd_megakernel(Args A) {
    extern __shared__ __attribute__((aligned(16))) unsigned char smem[];
    LAS unsigned char* lds = (LAS unsigned char*)smem;
    const int wave0 = __builtin_amdgcn_readfirstlane((int)threadIdx.x >> 6);
    unsigned* const bar = (unsigned*)(A.ws + WS_BAR);
    volatile LAS unsigned* const barst = (volatile LAS unsigned*)(lds + LDS_BARST);
    const unsigned xcc = xb_xcc_id();
    if (wave0 == 0) { const int l0 = fresh_lane(); if (l0 < 2) barst[l0] = 0u; if (l0 == 0 && A.ph_hi - A.ph_lo > 1) (void)xb_add(&bar[XB_XCNT(xcc)], 1u); }
    __syncthreads();
    if (A.ph_lo < 0) cg::this_grid().sync();
    bool dup_done = false; (void)dup_done;
    for (int ph = A.ph_lo; ph < A.ph_hi; ++ph) {
        const int wave = wave0;
#define LANE fresh_lane()
#define TID (wave * 64 + fresh_lane())
        unsigned char* ws = A.ws; asm volatile("" : "+s"(ws));
        if (ph == 0) phase_prologue(A, lds, wave);
        else if (ph == 1) phase_pre(A, lds, LANE, wave);
        else {
            const int l = (ph - 2) / 9, k = (ph - 2) % 9;
            const int G = gridDim.x, bid = blockIdx.x;
            if (k == 0) {
                pg8::Gemm g{(const bf16*)(ws + WS_H), (const bf16*)(ws + WS_WIN) + (size_t)l * 2048 * 1024, NTOK, 2048, 1024}; pg8::StaticOrder S; S.init(NTOK, 2048, G, bid);
                EpiB16<0> E{(bf16*)(ws + WS_Z), INC, INC}; pg8::gemm_phase<EpiB16<0>, pg8::StaticOrder>(lds, g, S, E, TID);
            } else if (k == 1) phase_split(A, l, LANE, wave);
            else if (k == 2) {
                { pg8::Gemm g{(const bf16*)(ws + WS_QN), (const bf16*)(ws + WS_WUQ) + (size_t)l * 768 * 384, NTOK, 768, 384}; pg8::StaticOrder S; S.init(NTOK, 768, G, bid);
                  EpiQ E{(bf16*)(ws + WS_Q), (const float*)(ws + WS_ROPE), (const float*)(ws + WS_ROPE) + 32768}; pg8::gemm_phase<EpiQ, pg8::StaticOrder>(lds, g, S, E, TID); }
                                { pg8::Gemm g{(const bf16*)(ws + WS_CKVN), (const bf16*)(ws + WS_WUKV) + (size_t)l * 1024 * 256, NROWKV, 1024, 256}; pg8::StaticOrder S; S.init(NROWKV, 1024, G, (bid + G - 144 % G) % G);
                  EpiKV E{(bf16*)(ws + WS_KNOPE), (bf16*)(ws + WS_VTP), (bf16*)(ws + WS_VTS)}; pg8::gemm_phase<EpiKV, pg8::StaticOrder>(lds, g, S, E, TID); }
            } else if (k == 3) phase_mixer(A, l, lds, LANE, wave);
            else if (k == 4 || k == 7) {
                const bool o = (k == 4);
                pg8::Gemm g{(const bf16*)(ws + (o ? WS_CONCAT : WS_ACT)), o ? (const bf16*)(ws + WS_WOUT) + (size_t)l * 1024 * 1024 : (const bf16*)(ws + WS_WFF2) + (size_t)l * 1024 * 4096, NTOK, 1024, o ? 1024 : 4096};
                pg8::StaticOrder S; S.init(NTOK, 1024, G, bid);
                EpiB16<0> E{(bf16*)(ws + WS_MIX), 1024, 1024}; pg8::gemm_phase<EpiB16<0>, pg8::StaticOrder>(lds, g, S, E, TID);
            } else if (k == 5) phase_post(A, l, 0, lds, LANE, wave);
            else if (k == 6) {
                pg8::Gemm g{(const bf16*)(ws + WS_H), (const bf16*)(ws + WS_WFF1) + (size_t)l * 4096 * 1024, NTOK, 4096, 1024}; pg8::StaticOrder S; S.init(NTOK, 4096, G, bid);
                EpiB16<1> E{(bf16*)(ws + WS_ACT), 4096, 4096}; pg8::gemm_phase<EpiB16<1>, pg8::StaticOrder>(lds, g, S, E, TID);
            } else phase_post(A, l, 1, lds, LANE, wave);
        }
        if (ph + 1 < A.ph_hi) xcd_barrier(bar, xcc, barst, wave == 0 && fresh_lane() == 0);
#if PROBE_DUP >= 0
        {
            bool again = false;
            if (PROBE_DUP == 100) { if (ph + 1 < A.ph_hi) xcd_barrier(bar, xcc, barst, wave == 0 && fresh_lane() == 0); }
            else if (!dup_done) {
                const int kk = ph >= 2 ? (ph - 2) % 9 : -1;
                if (PROBE_DUP == 50) again = (ph == 0);
                else if (PROBE_DUP == 60) again = (kk == 0 || kk == 2 || kk == 4 || kk == 6 || kk == 7);
                else again = (kk == PROBE_DUP);
            }
            if (again) { dup_done = true; --ph; } else dup_done = false;
        }
#endif
    }
}

constexpr int N_PHASES = 2 + 9 * DEPTH;

extern "C" void kernel_launch(void* const* d_in, const int* in_sizes, int n_in, void* d_out, int out_size, void* d_ws, size_t ws_size, hipStream_t stream) {
    static int grid = 0;
    if (grid == 0) {
        if (n_in != 24 || ws_size < WS_END || in_sizes[9] != DEPTH * 1024 * INC) { fprintf(stderr, "kernel_launch: unexpected problem (n_in %d, ws %zu, w_in %d)\n", n_in, ws_size, n_in > 9 ? in_sizes[9] : -1); grid = -1; return; }
        int dev = 0, cus = 0, per_cu = 0;
        hipGetDevice(&dev); hipDeviceGetAttribute(&cus, hipDeviceAttributeMultiprocessorCount, dev);
        if (hipFuncSetAttribute((const void*)fwd_megakernel, hipFuncAttributeMaxDynamicSharedMemorySize, LDS_BYTES) != hipSuccess) { fprintf(stderr, "kernel_launch: hipFuncSetAttribute failed\n"); grid = -1; return; }
        if (hipOccupancyMaxActiveBlocksPerMultiprocessor(&per_cu, (const void*)fwd_megakernel, 512, LDS_BYTES) != hipSuccess || per_cu < 1) { fprintf(stderr, "kernel_launch: occupancy query says %d\n", per_cu); per_cu = 1; }
        (void)hipGetLastError();
        grid = cus * 1;
        fprintf(stderr, "kernel_launch: grid %d (cus %d, per_cu %d)\n", grid, cus, per_cu);
    }
    if (grid < 0) return;
    if (hipMemsetAsync((char*)d_ws + WS_BAR, 0, 16384, stream) != hipSuccess) { fprintf(stderr, "kernel_launch: memset failed\n"); return; }
    Args a{};
    const float** ap = (const float**)&a;
    for (int i = 0; i < 24; ++i) ap[i] = (const float*)d_in[i];
    a.out = (float*)d_out; a.ws = (unsigned char*)d_ws;
#if MK_PER_PHASE
    for (int ph = 0; ph < N_PHASES; ++ph) { a.ph_lo = ph; a.ph_hi = ph + 1; hipLaunchKernelGGL(fwd_megakernel, dim3(grid), dim3(512), LDS_BYTES, stream, a); }
#else
    a.ph_lo = 0; a.ph_hi = N_PHASES;
    void* args[] = {&a};
    hipError_t e = hipLaunchCooperativeKernel((const void*)fwd_megakernel, dim3(grid), dim3(512), args, LDS_BYTES, stream);
    if (e != hipSuccess) fprintf(stderr, "kernel_launch: cooperative launch failed: %s (grid %d)\n", hipGetErrorString(e), grid);
#endif
}
```

```cpp
#include <hip/hip_runtime.h>
#include <hip/hip_cooperative_groups.h>
#include <cstdio>
namespace cg = cooperative_groups;

#ifndef MK_PER_PHASE
#define MK_PER_PHASE 0
#endif

#ifndef PROBE_DUP
#define PROBE_DUP -1
#endif
#define LAS __attribute__((address_space(3)))
typedef unsigned short bf16;
typedef short bf16x8 __attribute__((ext_vector_type(8)));
typedef float f32x2 __attribute__((ext_vector_type(2)));
typedef float f32x4 __attribute__((ext_vector_type(4)));
typedef float f32x16 __attribute__((ext_vector_type(16)));
typedef unsigned u32x2 __attribute__((ext_vector_type(2)));
typedef unsigned u32x4 __attribute__((ext_vector_type(4)));

constexpr int DM = 1024, NTOK_P = 8192, NTOK_S = 4096, NTOK = 12288, NROWKV = 14336;
constexpr int DEPTH = 4, INC = 1984, DFF = 4096;
constexpr int ZQ = 0, ZCKV = 384, ZKR = 640, ZU = 704, ZV = 960, ZBG = 1216, ZCG = 1472, ZHH = 1728;
constexpr float EPS = 1e-6f;
constexpr float QSCALE = 0.07216878364870322f * 1.4426950408889634f;

constexpr size_t MiB = 1u << 20;
constexpr size_t WS_MOD = 0, WS_BAR = 512 * 1024, WS_ROPE = 1 * MiB, WS_WIN = 2 * MiB, WS_WUQ = 18 * MiB, WS_WUKV = 21 * MiB, WS_WOUT = 23 * MiB,
                 WS_WFF1 = 31 * MiB, WS_WFF2 = 63 * MiB, WS_H = 95 * MiB, WS_MIX = 119 * MiB, WS_CONCAT = 167 * MiB, WS_QN = 191 * MiB,
                 WS_CKVN = 200 * MiB, WS_KRB = 207 * MiB, WS_UG = 209 * MiB, WS_VN = 215 * MiB, WS_Q = 221 * MiB, WS_KNOPE = 239 * MiB,
                 WS_VTP = 253 * MiB, WS_VTS = 261 * MiB, WS_Z = 267 * MiB, WS_ACT = 267 * MiB, WS_END = 363 * MiB;
constexpr int LDS_BYTES = 147456, LDS_BARST = LDS_BYTES - 64;

__device__ __forceinline__ unsigned cvt_pk_bf16(float lo, float hi) { unsigned r; asm volatile("v_cvt_pk_bf16_f32 %0, %1, %2" : "=v"(r) : "v"(lo), "v"(hi)); return r; }
__device__ __forceinline__ int fresh_lane() { int l; asm volatile("v_mbcnt_lo_u32_b32 %0, -1, 0\n\tv_mbcnt_hi_u32_b32 %0, -1, %0" : "=v"(l)); return l; }
__device__ __forceinline__ float shx(float v, int mask, int lane) { return __int_as_float(__builtin_amdgcn_ds_bpermute((lane ^ mask) << 2, __float_as_int(v))); }
__device__ __forceinline__ float dpp_add(float v, const int ctrl_is) {
    return v; }
#define DPP_ADD(v, ctrl) ((v) + __int_as_float(__builtin_amdgcn_update_dpp(0, __float_as_int(v), (ctrl), 0xf, 0xf, true)))
__device__ __forceinline__ float wave_sum(float v, int lane) {
    (void)lane;
    v = DPP_ADD(v, 0xB1);
    v = DPP_ADD(v, 0x4E);
    v = DPP_ADD(v, 0x141);
    v = DPP_ADD(v, 0x140);
    const int vi = __float_as_int(v);
    return (__int_as_float(__builtin_amdgcn_readlane(vi, 0)) + __int_as_float(__builtin_amdgcn_readlane(vi, 16))) + (__int_as_float(__builtin_amdgcn_readlane(vi, 32)) + __int_as_float(__builtin_amdgcn_readlane(vi, 48)));
}
__device__ __forceinline__ float gelu_tanh(float x) { const float y = 0.7978845608028654f * (x + 0.044715f * x * x * x); return x / (1.0f + __expf(-2.0f * y)); }
__device__ __forceinline__ f32x4 gelu4(f32x4 v) { return (f32x4){gelu_tanh(v.x), gelu_tanh(v.y), gelu_tanh(v.z), gelu_tanh(v.w)}; }
__device__ __forceinline__ float sumsq4(f32x4 v) { return (v.x * v.x + v.y * v.y) + (v.z * v.z + v.w * v.w); }
__device__ __forceinline__ f32x4 ld4bf(const bf16* p) { const u32x2 w = *(const u32x2*)p; return (f32x4){__uint_as_float(w.x << 16), __uint_as_float(w.x & 0xffff0000u), __uint_as_float(w.y << 16), __uint_as_float(w.y & 0xffff0000u)}; }
__device__ __forceinline__ f32x2 ld2bf(const bf16* p) { const unsigned w = *(const unsigned*)p; return (f32x2){__uint_as_float(w << 16), __uint_as_float(w & 0xffff0000u)}; }
__device__ __forceinline__ float ld1bf(const bf16* p) { return __uint_as_float((unsigned)*p << 16); }
__device__ __forceinline__ u32x2 pk4(f32x4 v) { u32x2 w; w.x = cvt_pk_bf16(v.x, v.y); w.y = cvt_pk_bf16(v.z, v.w); return w; }


#define XB_TMO      128
#define XB_XCNT(j)  (256  + 64 * (j))
#define XB_XSUB(j)  (1280 + 64 * (j))
#define XB_XGEN(j)  (2304 + 64 * (j))
#define XB_TOP      3328
#define XB_TOPGEN   3392
#define XCD_BAR_WORDS 3456
#define XB_SPIN_CAP (1u << 18)
__device__ __forceinline__ unsigned xb_ld(unsigned* p)              { return __hip_atomic_load(p, __ATOMIC_RELAXED, __HIP_MEMORY_SCOPE_AGENT); }
__device__ __forceinline__ unsigned xb_add(unsigned* p, unsigned v) { return __hip_atomic_fetch_add(p, v, __ATOMIC_RELAXED, __HIP_MEMORY_SCOPE_AGENT); }
__device__ __forceinline__ unsigned xb_xcc_id() { return (unsigned)__builtin_amdgcn_s_getreg((3 << 11) | 20) & 0xFu; }
#define XB_SPIN(cond, bar) do { unsigned _sp = 0; while (cond) { __builtin_amdgcn_s_sleep(1); \
    if ((++_sp & 255u) == 0u) { if (xb_ld(&(bar)[XB_TMO])) break; if (_sp > XB_SPIN_CAP) { atomicAdd(&(bar)[XB_TMO], 1u); break; } } } } while (0)
__device__ __forceinline__ void xcd_barrier_complete(unsigned* bar, unsigned x, unsigned& nloc, unsigned& nx) {
    const unsigned G = gridDim.x * gridDim.y * gridDim.z;
    unsigned sum, cnt, mine, sp = 0u;
    for (;;) {
        sum = 0u; cnt = 0u; mine = 0u;
#pragma unroll
        for (unsigned j = 0; j < 16; ++j) { const unsigned c = xb_ld(&bar[XB_XCNT(j)]); sum += c; cnt += (c > 0u) ? 1u : 0u; mine = (j == x) ? c : mine; }
        if (sum == G) break;
        __builtin_amdgcn_s_sleep(1);
        if ((++sp & 255u) == 0u) { if (xb_ld(&bar[XB_TMO])) break; if (sp > XB_SPIN_CAP) { atomicAdd(&bar[XB_TMO], 1u); break; } }
    }
    nloc = mine > 0u ? mine : 1u; nx = cnt > 0u ? cnt : 1u;
}
__device__ __forceinline__ void xcd_barrier(unsigned* bar, unsigned x, volatile LAS unsigned* st, bool leader) {
    asm volatile("s_waitcnt vmcnt(0)" ::: "memory");
    __syncthreads();
    if (leader) {
        __builtin_amdgcn_s_waitcnt(0);
        unsigned nloc = st[0], nx = st[1];
        if (nloc == 0u) { xcd_barrier_complete(bar, x, nloc, nx); st[0] = nloc; st[1] = nx; }
        const unsigned old = xb_add(&bar[XB_XSUB(x)], 1u);
        const unsigned gen = old / nloc;
        if (old + 1u == (gen + 1u) * nloc) {
            __builtin_amdgcn_fence(__ATOMIC_RELEASE, "agent");
            asm volatile("s_waitcnt vmcnt(0)" ::: "memory");
            const unsigned og = xb_add(&bar[XB_TOP], 1u);
            const unsigned tg = og / nx;
            if (og + 1u == (tg + 1u) * nx) xb_add(&bar[XB_TOPGEN], 1u);
            else XB_SPIN(xb_ld(&bar[XB_TOPGEN]) == tg, bar);
            __builtin_amdgcn_fence(__ATOMIC_ACQUIRE, "agent");
            xb_add(&bar[XB_XGEN(x)], 1u);
            asm volatile("s_waitcnt vmcnt(0)" ::: "memory");
        } else {
            XB_SPIN(xb_ld(&bar[XB_XGEN(x)]) == gen, bar);
            __builtin_amdgcn_fence(__ATOMIC_ACQUIRE, "agent");
            asm volatile("s_waitcnt vmcnt(0)" ::: "memory");
        }
    }
    __syncthreads();
}

namespace pg8 {
#define PG8_LAS __attribute__((address_space(3)))
typedef unsigned short bf16_t;
constexpr int BM = 256, BK = 64, HALF = 128, HTB = HALF * BK * 2, STAGE_BYTES = 8 * HTB, NXCD = 8, WGM = 8;
__host__ __device__ __forceinline__ int lds_byte(int r, int c) { const int st = (r >> 4) * 2 + (c >> 5), rr = r & 15, cc = c & 31, ob = rr * 64 + cc * 2; return st * 1024 + (ob ^ (((ob >> 9) & 1) << 5)); }
__host__ __device__ __forceinline__ void stage_rc(int b, int& R, int& C) { const int st = b / 1024, sb = b % 1024, swz = sb ^ (((sb >> 9) & 1) << 5); R = (st >> 1) * 16 + swz / 64; C = (st & 1) * 32 + (swz % 64) / 2; }
__host__ __device__ __forceinline__ int perm32(int rho) { const int n = rho >> 4, i = rho & 15; return 8 * (i >> 2) + 4 * n + (i & 3); }
struct Unit { int pm, pn; };
struct Gemm { const bf16_t* A; const bf16_t* Bt; int M, N, K; };
struct StaticOrder {
    int nM, nN, nwg, G, c;
    __host__ __device__ void init(int M, int N, int G_, int c_) { nM = M / BM; nN = N / BM; nwg = nM * nN; G = G_; c = c_; }
    __host__ __device__ bool next(int i, Unit& u) const {
        const long L = (long)i * G + c; if (L >= nwg) return false;
        int wgid = (int)L; { const int q = nwg / NXCD, r = nwg % NXCD, xcd = wgid % NXCD, off = wgid / NXCD; wgid = (xcd < r ? xcd * (q + 1) : r * (q + 1) + (xcd - r) * q) + off; }
        const int nig = WGM * nN, gid = wgid / nig, fm = gid * WGM, gsz = (nM - fm) < WGM ? (nM - fm) : WGM;
        u.pm = fm + ((wgid % nig) % gsz); u.pn = (wgid % nig) / gsz; return true;
    }
    __device__ __forceinline__ void a_ready(const Unit&) const {}
    __device__ __forceinline__ void done(const Unit&) const {}
};

template <class Epi, class Sched>
__device__ __forceinline__ void gemm_phase(PG8_LAS unsigned char* lds, const Gemm g, const Sched& S, const Epi& E, const int tid) {
    const int wid = __builtin_amdgcn_readfirstlane(tid >> 6), lane = tid & 63, wr = wid >> 2, wc = wid & 3, fr = lane & 15, fq = lane >> 4;
    const int K = g.K, nt = K / BK;
    unsigned voffA[2], voffB[2];
#pragma unroll
    for (int i = 0; i < 2; ++i) { int R, C; stage_rc(tid * 16 + i * 8192, R, C); const int Rb = Epi::PERM ? ((R & ~31) + perm32(R & 31)) : R;
        voffA[i] = (unsigned)(R * K + C) * 2u; voffB[i] = (unsigned)(Rb * K + C) * 2u; }
    const size_t kstep = (size_t)(BK * 2);
    const size_t hstep = (size_t)HALF * K * 2;
    const size_t tstep = 2 * hstep;
    const unsigned ldsw = (unsigned)wid * 1024u;
    const int aoff = lds_byte(wr * 64 + fr, fq * 8), boff = lds_byte(wc * 32 + fr, fq * 8);
#define PG8_SA(b, h) (((b) * 2 + (h)) * HTB)
#define PG8_SB(b, h) ((4 + (b) * 2 + (h)) * HTB)
#define PG8_STAGE(bufoff, gbase, voff) do { _Pragma("unroll") for (int _i = 0; _i < 2; ++_i) \
        __builtin_amdgcn_global_load_lds((const unsigned*)((const char*)(gbase) + (voff)[_i]), (PG8_LAS unsigned*)(lds + (bufoff) + ldsw + _i * 8192), 16, 0, 0); } while (0)
#define PG8_LDA(dst, b, h) do { _Pragma("unroll") for (int m = 0; m < 4; ++m) _Pragma("unroll") for (int k = 0; k < 2; ++k) dst[m][k] = *(const PG8_LAS bf16x8*)(lds + PG8_SA(b, h) + aoff + m * 2048 + k * 1024); } while (0)
#define PG8_LDB(dst, b, h) do { _Pragma("unroll") for (int n = 0; n < 2; ++n) _Pragma("unroll") for (int k = 0; k < 2; ++k) dst[n][k] = *(const PG8_LAS bf16x8*)(lds + PG8_SB(b, h) + boff + n * 2048 + k * 1024); } while (0)
#define PG8_MMA(ai, bj, At, Bt) do { __builtin_amdgcn_s_setprio(1); _Pragma("unroll") for (int m = 0; m < 4; ++m) _Pragma("unroll") for (int n = 0; n < 2; ++n) _Pragma("unroll") for (int k = 0; k < 2; ++k) \
        acc[ai][bj][m][n] = __builtin_amdgcn_mfma_f32_16x16x32_bf16(Bt[n][k], At[m][k], acc[ai][bj][m][n], 0, 0, 0); __builtin_amdgcn_s_setprio(0); } while (0)
#define PG8_WAIT_V(n) asm volatile("s_waitcnt vmcnt(" #n ")" ::: "memory")
#define PG8_WAIT_L(n) asm volatile("s_waitcnt lgkmcnt(" #n ")" ::: "memory")
#define PG8_BAR __builtin_amdgcn_s_barrier()
#define PG8_SCHED __builtin_amdgcn_sched_barrier(0)
    Unit cur, nxt; int ui = 0;
    if (!S.next(0, cur)) return;
    f32x4 acc[2][2][4][2];
#pragma unroll
    for (int a = 0; a < 2; ++a)
#pragma unroll
        for (int b = 0; b < 2; ++b)
#pragma unroll
            for (int m = 0; m < 4; ++m)
#pragma unroll
                for (int n = 0; n < 2; ++n) acc[a][b][m][n] = (f32x4){0.f, 0.f, 0.f, 0.f};
    bf16x8 At[4][2], B0[2][2], B1[2][2];
    const char* cA = (const char*)g.A + (size_t)cur.pm * tstep; const char* cB = (const char*)g.Bt + (size_t)cur.pn * tstep;
    S.a_ready(cur);
    PG8_STAGE(PG8_SB(0, 0), cB, voffB); PG8_STAGE(PG8_SA(0, 0), cA, voffA); PG8_STAGE(PG8_SB(0, 1), cB + hstep, voffB); PG8_STAGE(PG8_SA(0, 1), cA + hstep, voffA);
    if (wr == 1) PG8_BAR;
    PG8_WAIT_V(4); PG8_BAR;
    PG8_STAGE(PG8_SB(1, 0), cB + kstep, voffB); PG8_STAGE(PG8_SA(1, 0), cA + kstep, voffA); PG8_STAGE(PG8_SB(1, 1), cB + hstep + kstep, voffB);
    PG8_WAIT_V(6); PG8_BAR;
    for (;;) {
        const bool has_next = S.next(ui + 1, nxt);
        const char* nA = has_next ? (const char*)g.A + (size_t)nxt.pm * tstep : cA; const char* nB = has_next ? (const char*)g.Bt + (size_t)nxt.pn * tstep : cB;
        for (int t = 0; t < nt; t += 2) {
            const bool last = (t == nt - 2);
            const char* a1 = cA + (size_t)(t + 1) * kstep;
            const char* a2 = last ? nA : cA + (size_t)(t + 2) * kstep; const char* b2 = last ? nB : cB + (size_t)(t + 2) * kstep;
            const char* a3 = a2 + kstep; const char* b3 = b2 + kstep;
            if (last && has_next) S.a_ready(nxt);
            PG8_LDB(B0, 0, 0); PG8_SCHED; PG8_LDA(At, 0, 0); PG8_STAGE(PG8_SA(1, 1), a1 + hstep, voffA);
            PG8_WAIT_L(8); PG8_BAR; PG8_WAIT_L(0); PG8_MMA(0, 0, At, B0); PG8_BAR; PG8_SCHED;
            PG8_LDB(B1, 0, 1); PG8_STAGE(PG8_SB(0, 0), b2, voffB);
            PG8_BAR; PG8_WAIT_L(0); PG8_MMA(0, 1, At, B1); PG8_BAR;
            PG8_LDA(At, 0, 1); PG8_STAGE(PG8_SA(0, 0), a2, voffA);
            PG8_BAR; PG8_WAIT_L(0); PG8_MMA(1, 0, At, B0); PG8_BAR; PG8_SCHED;
            PG8_STAGE(PG8_SB(0, 1), b2 + hstep, voffB);
            PG8_WAIT_V(6); PG8_BAR; PG8_MMA(1, 1, At, B1); PG8_BAR;
            PG8_LDB(B0, 1, 0); PG8_SCHED; PG8_LDA(At, 1, 0); PG8_STAGE(PG8_SA(0, 1), a2 + hstep, voffA);
            PG8_WAIT_L(8); PG8_BAR; PG8_WAIT_L(0); PG8_MMA(0, 0, At, B0); PG8_BAR; PG8_SCHED;
            PG8_LDB(B1, 1, 1); PG8_STAGE(PG8_SB(1, 0), b3, voffB);
            PG8_BAR; PG8_WAIT_L(0); PG8_MMA(0, 1, At, B1); PG8_BAR;
            PG8_LDA(At, 1, 1); PG8_STAGE(PG8_SA(1, 0), a3, voffA);
            PG8_BAR; PG8_WAIT_L(0); PG8_MMA(1, 0, At, B0); PG8_BAR; PG8_SCHED;
            PG8_STAGE(PG8_SB(1, 1), b3 + hstep, voffB);
            PG8_WAIT_V(6); PG8_BAR; PG8_MMA(1, 1, At, B1); PG8_BAR;
        }
        E(acc, cur, wr, wc, fr, fq); S.done(cur);
        if (!has_next) break;
#pragma unroll
        for (int a = 0; a < 2; ++a)
#pragma unroll
            for (int b = 0; b < 2; ++b)
#pragma unroll
                for (int m = 0; m < 4; ++m)
#pragma unroll
                    for (int n = 0; n < 2; ++n) acc[a][b][m][n] = (f32x4){0.f, 0.f, 0.f, 0.f};
        cur = nxt; cA = nA; cB = nB; ++ui;
    }
    PG8_WAIT_V(0);
    if (wr == 0) PG8_BAR;
    PG8_BAR;
#undef PG8_SA
#undef PG8_SB
#undef PG8_STAGE
#undef PG8_LDA
#undef PG8_LDB
#undef PG8_MMA
#undef PG8_WAIT_V
#undef PG8_WAIT_L
#undef PG8_BAR
#undef PG8_SCHED
}
}

struct EpiF32 {
    static constexpr bool PERM = false;
    float* C; int ldc; int ncols;
    __device__ __forceinline__ void operator()(const f32x4 (&acc)[2][2][4][2], const pg8::Unit& u, int wr, int wc, int fr, int fq) const {
        const int row0 = u.pm * 256 + wr * 64 + fr, col0 = u.pn * 256 + wc * 32 + 4 * fq;
#pragma unroll
        for (int ai = 0; ai < 2; ++ai)
#pragma unroll
            for (int m = 0; m < 4; ++m) { float* rowp = C + (size_t)(row0 + ai * 128 + m * 16) * ldc + col0;
#pragma unroll
                for (int bj = 0; bj < 2; ++bj)
#pragma unroll
                    for (int n = 0; n < 2; ++n) if (col0 + bj * 128 + n * 16 < ncols) *(f32x4*)(rowp + bj * 128 + n * 16) = acc[ai][bj][m][n]; }
    }
};
template <int ACT> struct EpiB16 {
    static constexpr bool PERM = true;
    bf16* O; int ldc; int ncols;
    __device__ __forceinline__ void operator()(const f32x4 (&acc)[2][2][4][2], const pg8::Unit& u, int wr, int wc, int fr, int fq) const {
        const int row0 = u.pm * 256 + wr * 64 + fr, col0 = u.pn * 256 + wc * 32 + 8 * fq;
#pragma unroll
        for (int ai = 0; ai < 2; ++ai)
#pragma unroll
            for (int m = 0; m < 4; ++m) { bf16* rowp = O + (size_t)(row0 + ai * 128 + m * 16) * ldc + col0;
#pragma unroll
                for (int bj = 0; bj < 2; ++bj) { f32x4 v0 = acc[ai][bj][m][0], v1 = acc[ai][bj][m][1];
                    if (col0 + bj * 128 >= ncols) continue;
                    if (ACT) {
#pragma unroll
                    for (int j = 0; j < 4; ++j) { const float a = fmaxf(v0[j], 0.f), b = fmaxf(v1[j], 0.f); v0[j] = a * a; v1[j] = b * b; } }
                    u32x4 w; w.x = cvt_pk_bf16(v0[0], v0[1]); w.y = cvt_pk_bf16(v0[2], v0[3]); w.z = cvt_pk_bf16(v1[0], v1[1]); w.w = cvt_pk_bf16(v1[2], v1[3]);
                    *(u32x4*)(rowp + bj * 128) = w; } }
    }
};
struct EpiQ {
    static constexpr bool PERM = false;
    bf16* Q; const float* ropec; const float* ropes;
    __device__ __forceinline__ void operator()(const f32x4 (&acc)[2][2][4][2], const pg8::Unit& u, int wr, int wc, int, int) const {
        const int ln = fresh_lane(), fr = ln & 15, fq = ln >> 4;
        const int row0 = u.pm * 256 + wr * 64 + fr; const bool sample = u.pm >= 32;
#pragma unroll
        for (int bj = 0; bj < 2; ++bj) {
            const int g0 = u.pn * 256 + bj * 128 + wc * 32, within0 = g0 % 192; const bool isrope = within0 >= 128; const int a = (within0 - 128) >> 5;
#pragma unroll
            for (int ai = 0; ai < 2; ++ai)
#pragma unroll
                for (int m = 0; m < 4; ++m) { const int row = row0 + ai * 128 + m * 16;
                    f32x4 x1 = acc[ai][bj][m][0], x2 = acc[ai][bj][m][1];
                    if (sample && isrope) { const int ntok = (row - NTOK_P) & 1023;
                        const f32x4 cs = *(const f32x4*)(ropec + ntok * 32 + a * 16 + 4 * fq), sn = *(const f32x4*)(ropes + ntok * 32 + a * 16 + 4 * fq);
                        const f32x4 o1 = x1 * cs - x2 * sn, o2 = x1 * sn + x2 * cs; x1 = o1; x2 = o2; }
                    x1 = x1 * QSCALE; x2 = x2 * QSCALE;
                    bf16* p = Q + (size_t)row * 768 + g0 + 4 * fq;
                    *(u32x2*)p = pk4(x1); *(u32x2*)(p + 16) = pk4(x2); asm volatile("" ::: "memory"); }
        }
    }
};
struct EpiKV {
    static constexpr bool PERM = false;
    bf16* KN; bf16* VTP; bf16* VTS;
    __device__ __forceinline__ void operator()(const f32x4 (&acc)[2][2][4][2], const pg8::Unit& u, int wr, int wc, int, int) const {
        const int ln = fresh_lane(), fr = ln & 15, fq = ln >> 4;
        const int h = u.pn, pm = u.pm;
        bf16* vt; int keys, keybase;
        if (pm < 32) { vt = VTP + (size_t)((pm * 4 + h) * 128) * 256; keys = 256; keybase = 0; }
        else if (pm < 48) { const int b = (pm - 32) >> 2; vt = VTS + (size_t)((b * 4 + h) * 128) * 1536; keys = 1536; keybase = 512 + ((pm - 32) & 3) * 256; }
        else { const int b = (pm - 48) >> 1; vt = VTS + (size_t)((b * 4 + h) * 128) * 1536; keys = 1536; keybase = ((pm - 48) & 1) * 256; }
#pragma unroll
        for (int ai = 0; ai < 2; ++ai)
#pragma unroll
            for (int m = 0; m < 4; ++m) { const int rloc = wr * 64 + fr + ai * 128 + m * 16;
                bf16* kp = KN + (size_t)(pm * 256 + rloc) * 512 + h * 128 + wc * 32 + 4 * fq;
#pragma unroll
                for (int n = 0; n < 2; ++n) *(u32x2*)(kp + 16 * n) = pk4(acc[ai][0][m][n]);
#pragma unroll
                for (int n = 0; n < 2; ++n) { const f32x4 v = acc[ai][1][m][n]; const u32x2 w = pk4(v);
                    bf16* vp = vt + (size_t)(wc * 32 + 16 * n + 4 * fq) * keys + keybase + rloc;
                    vp[0] = (bf16)(w.x & 0xffffu); vp[keys] = (bf16)(w.x >> 16); vp[2 * keys] = (bf16)(w.y & 0xffffu); vp[3 * keys] = (bf16)(w.y >> 16); }
                asm volatile("" ::: "memory");
            }
    }
};

struct Args {
    const float *x_prompt, *x_sample, *cache_ckv, *cache_krope, *c, *c_ctx, *w_ada, *b_ada, *g_pre_mix, *w_in, *g_q, *w_uq, *g_kv, *w_ukv,
                *g_v, *w_s, *b_s, *w_conv, *w_out, *g_post_mix, *g_pre_ffn, *w_ff1, *w_ff2, *g_post_ffn;
    float* out; unsigned char* ws; int ph_lo, ph_hi;
};

__device__ __forceinline__ void p0_transpose_item(const float* W, int K, int N, bf16* WT, LAS float* scr, int item, int lane) {
    const int nblk = N / 32, kb = item / nblk, nb = item % nblk, k0 = 64 * kb, n0 = 32 * nb;
#pragma unroll 8
    for (int i = 0; i < 32; ++i) { const int kk = 2 * i + (lane >> 5); scr[kk * 33 + (lane & 31)] = W[(size_t)(k0 + kk) * N + n0 + (lane & 31)]; }
    asm volatile("s_waitcnt lgkmcnt(0)" ::: "memory");
    const int c = lane & 7;
#pragma unroll
    for (int j = 0; j < 4; ++j) { const int n = (lane >> 3) + 8 * j; const LAS float* s = scr + (8 * c) * 33 + n;
        u32x4 o; o.x = cvt_pk_bf16(s[0 * 33], s[1 * 33]); o.y = cvt_pk_bf16(s[2 * 33], s[3 * 33]); o.z = cvt_pk_bf16(s[4 * 33], s[5 * 33]); o.w = cvt_pk_bf16(s[6 * 33], s[7 * 33]);
        *(u32x4*)(WT + (size_t)(n0 + n) * K + k0 + 8 * c) = o; }
    asm volatile("s_waitcnt lgkmcnt(0)" ::: "memory");
}

__device__ __forceinline__ void convert_layer(const Args& A, LAS unsigned char* lds, int l, int gwi, int nw, int wave, int lane) {
    unsigned char* ws = A.ws;
    LAS float* scr = (LAS float*)(lds + wave * 16384);
    constexpr int I_IN = 16 * 62, I_UQ = 6 * 24, I_UKV = 4 * 32, I_OUT = 16 * 32, I_F1 = 16 * 128, I_F2 = 64 * 32, I_L = I_IN + I_UQ + I_UKV + I_OUT + I_F1 + I_F2;
    for (int it = gwi; it < I_L; it += nw) {
        int r = it;
        if (r < I_IN) { p0_transpose_item(A.w_in + (size_t)l * 1024 * INC, 1024, INC, (bf16*)(ws + WS_WIN) + (size_t)l * 2048 * 1024, scr, r, lane); continue; } r -= I_IN;
        if (r < I_UQ) { p0_transpose_item(A.w_uq + (size_t)l * 384 * 768, 384, 768, (bf16*)(ws + WS_WUQ) + (size_t)l * 768 * 384, scr, r, lane); continue; } r -= I_UQ;
        if (r < I_UKV) { p0_transpose_item(A.w_ukv + (size_t)l * 256 * 1024, 256, 1024, (bf16*)(ws + WS_WUKV) + (size_t)l * 1024 * 256, scr, r, lane); continue; } r -= I_UKV;
        if (r < I_OUT) { p0_transpose_item(A.w_out + (size_t)l * 1024 * 1024, 1024, 1024, (bf16*)(ws + WS_WOUT) + (size_t)l * 1024 * 1024, scr, r, lane); continue; } r -= I_OUT;
        if (r < I_F1) { p0_transpose_item(A.w_ff1 + (size_t)l * 1024 * 4096, 1024, 4096, (bf16*)(ws + WS_WFF1) + (size_t)l * 4096 * 1024, scr, r, lane); continue; } r -= I_F1;
        p0_transpose_item(A.w_ff2 + (size_t)l * 4096 * 1024, 4096, 1024, (bf16*)(ws + WS_WFF2) + (size_t)l * 1024 * 4096, scr, r, lane);
    }
}

__device__ __forceinline__ void phase_prologue(const Args& A, LAS unsigned char* lds, int wave) {
    const int lane = fresh_lane(), tid = wave * 64 + lane;
    unsigned char* ws = A.ws;
    const int bid = blockIdx.x, G = gridDim.x;
    { const int gt = bid * 512 + tid;
      if (gt < 32768) { const int n = gt >> 5, a = (gt >> 4) & 1, f = gt & 15; const int pos = a == 0 ? (n >> 6) : (n & 63);
          double inv = 1.0; for (int i = 0; i < f; ++i) inv *= 0.5623413251903491;
          double rev = (double)pos * inv * 0.15915494309189535; rev -= floor(rev);
          const float rf = (float)rev;
          ((float*)(ws + WS_ROPE))[gt] = __builtin_amdgcn_cosf(rf); ((float*)(ws + WS_ROPE))[32768 + gt] = __builtin_amdgcn_sinf(rf); } }
    for (int it = bid; it < 192; it += G) {
        const int l = it / 48, cgp = it % 48;
        LAS float* sl = (LAS float*)lds;
        for (int i = tid; i < 5120; i += 512) { const int ci = i >> 10, k = i & 1023; const float v = ci == 0 ? A.c_ctx[k] : A.c[(ci - 1) * 1024 + k]; sl[i] = v / (1.0f + __expf(-v)); }
        __syncthreads();
        float a0[5], a1[5];
#pragma unroll
        for (int ci = 0; ci < 5; ++ci) { a0[ci] = 0.f; a1[ci] = 0.f; }
        const float* wp = A.w_ada + ((size_t)l * 1024 + wave * 128) * 6144 + cgp * 128 + 2 * lane;
#pragma unroll 8
        for (int kk = 0; kk < 128; ++kk) { const f32x2 wv = *(const f32x2*)(wp + (size_t)kk * 6144); const int k = wave * 128 + kk;
#pragma unroll
            for (int ci = 0; ci < 5; ++ci) { const float s = sl[ci * 1024 + k]; a0[ci] += s * wv.x; a1[ci] += s * wv.y; } }
        LAS float* part = (LAS float*)(lds + 32768);
#pragma unroll
        for (int ci = 0; ci < 5; ++ci) { part[(wave * 5 + ci) * 128 + 2 * lane] = a0[ci]; part[(wave * 5 + ci) * 128 + 2 * lane + 1] = a1[ci]; }
        __syncthreads();
        for (int i = tid; i < 640; i += 512) { const int ci = i >> 7, col = i & 127; float s = 0.f;
#pragma unroll
            for (int w = 0; w < 8; ++w) s += part[(w * 5 + ci) * 128 + col];
            const int gcol = cgp * 128 + col; ((float*)(ws + WS_MOD))[(l * 5 + ci) * 6144 + gcol] = s + A.b_ada[l * 6144 + gcol]; }
        __syncthreads();
    }
    convert_layer(A, lds, 0, bid * 8 + wave, G * 8, wave, lane);
}

__device__ __forceinline__ int cond_of_row(int r) { return r < NTOK_P ? 0 : 1 + ((r - NTOK_P) >> 10); }

__device__ __forceinline__ void norm_mod_store(const f32x4 (&v)[4], const LAS float* g, const LAS float* sc, const LAS float* sh, bf16* hrow, int lane) {
    float ss = 0.f;
#pragma unroll
    for (int j = 0; j < 4; ++j) ss += sumsq4(v[j]);
    const float rstd = 1.0f / sqrtf(wave_sum(ss, lane) * (1.0f / 1024.0f) + EPS);
#pragma unroll
    for (int j = 0; j < 4; ++j) { const int idx = 4 * lane + 256 * j;
        const f32x4 gg = *(const LAS f32x4*)(g + idx), s1 = *(const LAS f32x4*)(sc + idx), s0 = *(const LAS f32x4*)(sh + idx);
        const f32x4 o = v[j] * rstd * gg * (1.0f + s1) + s0;
        *(u32x2*)(hrow + idx) = pk4(o); }
}
__device__ __forceinline__ const float* x_in_row(const Args& A, int r) { return r < NTOK_P ? A.x_prompt + (size_t)r * 1024 : A.x_sample + (size_t)(r - NTOK_P) * 1024; }
__device__ __forceinline__ void fill_vec(LAS float* dst, const float* src, int tid) { if (tid < 256) *(LAS f32x4*)(dst + 4 * tid) = *(const f32x4*)(src + 4 * tid); }

__device__ __forceinline__ void phase_pre(const Args& A, LAS unsigned char* lds, int lane, int wave) {
    const int gw = blockIdx.x * 8 + wave, NGW = gridDim.x * 8;
    const float* mod = (const float*)(A.ws + WS_MOD); bf16* H = (bf16*)(A.ws + WS_H);
    LAS float* P = (LAS float*)lds;
    { const int t2 = (wave & 3) * 64 + lane, hv = wave >> 2;
      for (int v = hv; v < 11; v += 2) { const float* src = v == 0 ? A.g_pre_mix : (v <= 5 ? mod + (size_t)(v - 1) * 6144 + 1024 : mod + (size_t)(v - 6) * 6144);
          const int slot = v == 0 ? 1 : (v <= 5 ? 7 + (v - 1) : 12 + (v - 6));
          *(LAS f32x4*)(P + slot * 1024 + 4 * t2) = *(const f32x4*)(src + 4 * t2); } }
    __syncthreads();
    for (int r0 = gw; r0 < NTOK; r0 += 2 * NGW) {
        f32x4 v[2][4];
#pragma unroll
        for (int u = 0; u < 2; ++u) { const float* xr = x_in_row(A, r0 + u * NGW);
#pragma unroll
            for (int j = 0; j < 4; ++j) v[u][j] = *(const f32x4*)(xr + 4 * lane + 256 * j); }
#pragma unroll
        for (int u = 0; u < 2; ++u) { const int r = r0 + u * NGW, ci = cond_of_row(r);
            norm_mod_store(v[u], P + 1024, P + (7 + ci) * 1024, P + (12 + ci) * 1024, H + (size_t)r * 1024, lane); }
    }
    __syncthreads();
}

__device__ __forceinline__ void phase_post(const Args& A, int l, int which, LAS unsigned char* lds, int lane, int wave) {
    const int gw = blockIdx.x * 8 + wave, NGW = gridDim.x * 8;
    const float* mod = (const float*)(A.ws + WS_MOD); bf16* H = (bf16*)(A.ws + WS_H); const bf16* MIX = (const bf16*)(A.ws + WS_MIX);
    const bool first = (l == 0 && which == 0), has_h = (which == 0) || (l < DEPTH - 1);
    LAS float* P = (LAS float*)lds;
    { const int t2 = (wave & 3) * 64 + lane, hv = wave >> 2;
      const int l2 = which == 0 ? l : l + 1;
      for (int v = hv; v < 17; v += 2) { const float* src;
          if (v == 0) src = (which == 0 ? A.g_post_mix : A.g_post_ffn) + l * 1024;
          else if (v == 1) src = which == 0 ? A.g_pre_ffn + l * 1024 : A.g_pre_mix + (l2 < DEPTH ? l2 : l) * 1024;
          else if (v < 7) src = mod + (size_t)(l * 5 + (v - 2)) * 6144 + (which == 0 ? 2048 : 5120);
          else if (v < 12) src = mod + (size_t)((l2 < DEPTH ? l2 : l) * 5 + (v - 7)) * 6144 + (which == 0 ? 4096 : 1024);
          else src = mod + (size_t)((l2 < DEPTH ? l2 : l) * 5 + (v - 12)) * 6144 + (which == 0 ? 3072 : 0);
          *(LAS f32x4*)(P + v * 1024 + 4 * t2) = *(const f32x4*)(src + 4 * t2); } }
    __syncthreads();
    for (int r0 = gw; r0 < NTOK; r0 += 2 * NGW) {
        f32x4 v[2][4], t[2][4];
#pragma unroll
        for (int u = 0; u < 2; ++u) { const int r = r0 + u * NGW;
            const float* xr = first ? x_in_row(A, r) : A.out + (size_t)r * 1024; const bf16* tr = MIX + (size_t)r * 1024;
#pragma unroll
            for (int j = 0; j < 4; ++j) { v[u][j] = *(const f32x4*)(xr + 4 * lane + 256 * j); t[u][j] = ld4bf(tr + 4 * lane + 256 * j); } }
#pragma unroll
        for (int u = 0; u < 2; ++u) { const int r = r0 + u * NGW; const LAS float* ga = P + (2 + cond_of_row(r)) * 1024;
            float ss = 0.f;
#pragma unroll
            for (int j = 0; j < 4; ++j) ss += sumsq4(t[u][j]);
            const float rstd = 1.0f / sqrtf(wave_sum(ss, lane) * (1.0f / 1024.0f) + EPS);
#pragma unroll
            for (int j = 0; j < 4; ++j) { const int idx = 4 * lane + 256 * j;
                const f32x4 gg = *(const LAS f32x4*)(P + idx), gv = *(const LAS f32x4*)(ga + idx);
                v[u][j] = v[u][j] + gv * (t[u][j] * rstd * gg);
                *(f32x4*)(A.out + (size_t)r * 1024 + idx) = v[u][j]; } }
        if (has_h) {
#pragma unroll
            for (int u = 0; u < 2; ++u) { const int r = r0 + u * NGW, ci = cond_of_row(r);
                norm_mod_store(v[u], P + 1024, P + (7 + ci) * 1024, P + (12 + ci) * 1024, H + (size_t)r * 1024, lane); } }
    }
    __syncthreads();
}

__device__ __forceinline__ void phase_split(const Args& A, int l, int lane, int wave) {
    const int gw = blockIdx.x * 8 + wave, NGW = gridDim.x * 8;
    unsigned char* ws = A.ws;
    const bf16* Z = (const bf16*)(ws + WS_Z);
    bf16* QN = (bf16*)(ws + WS_QN); bf16* CKVN = (bf16*)(ws + WS_CKVN); bf16* KRB = (bf16*)(ws + WS_KRB); bf16* UG = (bf16*)(ws + WS_UG); bf16* VN = (bf16*)(ws + WS_VN);
    bf16* CC = (bf16*)(ws + WS_CONCAT);
    const float* ropec = (const float*)(ws + WS_ROPE); const float* ropes = ropec + 32768;
    float* out_ckv = A.out + (size_t)NTOK * 1024; float* out_kr = out_ckv + (size_t)32 * 4 * 256 * 256;
    for (int idx = gw; idx < 2048; idx += NGW) { const int r = NTOK + idx, b = idx >> 9, j = idx & 511;
        const f32x4 cv = *(const f32x4*)(A.cache_ckv + ((size_t)(b * 4 + l) * 512 + j) * 256 + 4 * lane);
        const float kv = A.cache_krope[((size_t)(b * 4 + l) * 512 + j) * 64 + lane];
        *(u32x2*)(CKVN + (size_t)r * 256 + 4 * lane) = pk4(cv);
        KRB[(size_t)r * 64 + lane] = (bf16)(cvt_pk_bf16(kv, 0.f) & 0xffffu); }
    const f32x4 gkv = *(const f32x4*)(A.g_kv + l * 256 + 4 * lane), gvv = *(const f32x4*)(A.g_v + l * 256 + 4 * lane);
    const float* wcp = A.w_conv + (size_t)l * 3 * 256 + 4 * lane;
    const f32x4 wc0 = *(const f32x4*)(wcp), wc1 = *(const f32x4*)(wcp + 256), wc2 = *(const f32x4*)(wcp + 512);
    f32x2 gq[3];
#pragma unroll
    for (int j = 0; j < 3; ++j) gq[j] = *(const f32x2*)(A.g_q + l * 384 + 2 * lane + 128 * j);
    for (int r0 = gw; r0 < NTOK; r0 += 2 * NGW) {
        f32x2 q[2][3]; f32x4 cv[2], uu[2], vv[2], bg[2], zc[2], zm[2], zp[2]; float kr[2], cs[2], sn[2];
#pragma unroll
        for (int u = 0; u < 2; ++u) { const int r = r0 + u * NGW; const bf16* z = Z + (size_t)r * INC;
            const bool prompt = r < NTOK_P; const int n = prompt ? (r & 255) : ((r - NTOK_P) & 1023), len = prompt ? 256 : 1024;
#pragma unroll
            for (int j = 0; j < 3; ++j) q[u][j] = ld2bf(z + ZQ + 2 * lane + 128 * j);
            cv[u] = ld4bf(z + ZCKV + 4 * lane); kr[u] = ld1bf(z + ZKR + lane);
            uu[u] = ld4bf(z + ZU + 4 * lane); vv[u] = ld4bf(z + ZV + 4 * lane); bg[u] = ld4bf(z + ZBG + 4 * lane);
            zc[u] = ld4bf(z + ZCG + 4 * lane) * ld4bf(z + ZHH + 4 * lane);
            zm[u] = (f32x4){0.f, 0.f, 0.f, 0.f}; zp[u] = zm[u];
            if (n > 0) zm[u] = ld4bf(z - INC + ZCG + 4 * lane) * ld4bf(z - INC + ZHH + 4 * lane);
            if (n < len - 1) zp[u] = ld4bf(z + INC + ZCG + 4 * lane) * ld4bf(z + INC + ZHH + 4 * lane);
            cs[u] = 1.f; sn[u] = 0.f;
            if (!prompt) { const int a = lane >> 5, f = lane & 15; cs[u] = ropec[n * 32 + a * 16 + f]; sn[u] = ropes[n * 32 + a * 16 + f]; } }
#pragma unroll
        for (int u = 0; u < 2; ++u) { const int r = r0 + u * NGW; const bool prompt = r < NTOK_P; const int n = prompt ? (r & 255) : ((r - NTOK_P) & 1023);
            { float ss = 0.f;
#pragma unroll
              for (int j = 0; j < 3; ++j) ss += q[u][j].x * q[u][j].x + q[u][j].y * q[u][j].y;
              const float rstd = 1.0f / sqrtf(wave_sum(ss, lane) * (1.0f / 384.0f) + EPS);
#pragma unroll
              for (int j = 0; j < 3; ++j) *(unsigned*)(QN + (size_t)r * 384 + 2 * lane + 128 * j) = cvt_pk_bf16(q[u][j].x * rstd * gq[j].x, q[u][j].y * rstd * gq[j].y); }
            { const float rstd = 1.0f / sqrtf(wave_sum(sumsq4(cv[u]), lane) * (1.0f / 256.0f) + EPS);
              const f32x4 c2 = cv[u] * rstd * gkv;
              if (prompt) *(f32x4*)(out_ckv + ((size_t)((r >> 8) * 4 + l) * 256 + n) * 256 + 4 * lane) = c2;
              *(u32x2*)(CKVN + (size_t)r * 256 + 4 * lane) = pk4(c2); }
            { float k2 = kr[u];
              if (prompt) out_kr[((size_t)((r >> 8) * 4 + l) * 256 + n) * 64 + lane] = k2;
              else { const float partner = shx(k2, 16, lane); const int p = (lane >> 4) & 1;
                  k2 = p == 0 ? k2 * cs[u] - partner * sn[u] : partner * sn[u] + k2 * cs[u]; }
              KRB[(size_t)r * 64 + lane] = (bf16)(cvt_pk_bf16(k2, 0.f) & 0xffffu); }
            *(u32x2*)(UG + (size_t)r * 256 + 4 * lane) = pk4(gelu4(uu[u]));
            { f32x4 v = gelu4(vv[u]);
              const float rstd = 1.0f / sqrtf(wave_sum(sumsq4(v), lane) * (1.0f / 256.0f) + EPS);
              *(u32x2*)(VN + (size_t)r * 256 + 4 * lane) = pk4(v * rstd * gvv); }
            { const f32x4 y = zm[u] * wc0 + zc[u] * wc1 + zp[u] * wc2;
              *(u32x2*)(CC + (size_t)r * 1024 + 768 + 4 * lane) = pk4(bg[u] * y); }
        }
    }
}

#define MFMA32(a, b, c) __builtin_amdgcn_mfma_f32_32x32x16_bf16((a), (b), (c), 0, 0, 0)
constexpr int AT_KROW = 400, AT_VROW = 144, AT_KBYTES = 64 * AT_KROW, AT_STAGE = AT_KBYTES + 128 * AT_VROW;
__device__ __forceinline__ void attn_store_tile(const f32x16& ot, float inv, bf16* crow  , int t, int hh) {
#pragma unroll
    for (int g = 0; g < 4; ++g) { u32x2 w; w.x = cvt_pk_bf16(ot[4 * g] * inv, ot[4 * g + 1] * inv); w.y = cvt_pk_bf16(ot[4 * g + 2] * inv, ot[4 * g + 3] * inv);
        *(u32x2*)(crow + 32 * t + 8 * g + 4 * hh) = w; }
}

__device__ __forceinline__ void phase_mixer(const Args& A, int l, LAS unsigned char* lds, int lane_in, int wave) {
    unsigned char* ws = A.ws;
    const bf16* Q = (const bf16*)(ws + WS_Q); const bf16* KN = (const bf16*)(ws + WS_KNOPE); const bf16* KRB = (const bf16*)(ws + WS_KRB);
    const bf16* VTP = (const bf16*)(ws + WS_VTP); const bf16* VTS = (const bf16*)(ws + WS_VTS);
    const bf16* UG = (const bf16*)(ws + WS_UG); const bf16* VN = (const bf16*)(ws + WS_VN);
    bf16* CC = (bf16*)(ws + WS_CONCAT);
#ifndef PROBE_MIX
#define PROBE_MIX 0
#endif
    for (int rnd = 0; rnd < (PROBE_MIX ? 3 : 2); ++rnd) {
        int it;
        if (rnd == 0) it = blockIdx.x; else if (rnd == 1) { if (blockIdx.x < 128 || blockIdx.x >= 224) continue; it = 256 + (int)blockIdx.x - 128; }
        else { if (PROBE_MIX == 1) { if (blockIdx.x >= 128) break; it = blockIdx.x; } else if (PROBE_MIX == 2) { if (blockIdx.x < 128) break; it = blockIdx.x; } else { if (blockIdx.x < 128 || blockIdx.x >= 224) break; it = 256 + (int)blockIdx.x - 128; } }
        if (it >= 352) break;
        int lane = lane_in; asm volatile("" : "+v"(lane));
        const int rho = lane & 31, hh = lane >> 5, tid = wave * 64 + lane;
        if (it < 256) {
            int h, q0, keys, nkeys, split, rowA, rowB; const bf16* vt;
            const bool heavy = it < 128;
            if (heavy) {
                const int xj = it >> 3, pr = 2 * (it & 7) + (xj >> 3), b = pr >> 2, qt = xj & 7; h = pr & 3;
                q0 = NTOK_P + b * 1024 + qt * 128 + (wave & 3) * 32; keys = 1536; nkeys = 1536; split = 512; rowA = NTOK + b * 512; rowB = NTOK_P + b * 1024;
                vt = VTS + (size_t)((b * 4 + h) * 128) * 1536; }
            else { const int i2 = it - 128, b = i2 >> 2; h = i2 & 3; q0 = b * 256 + wave * 32; keys = 256; nkeys = 256; split = 0; rowA = 0; rowB = b * 256;
                vt = VTP + (size_t)((b * 4 + h) * 128) * 256; }
            bf16x8 qf[12];
            { const bf16* qp = Q + (size_t)(q0 + rho) * 768 + h * 192 + 8 * hh;
#pragma unroll
              for (int ks = 0; ks < 12; ++ks) qf[ks] = *(const bf16x8*)(qp + 16 * ks); }
            f32x16 o[4];
#pragma unroll
            for (int t = 0; t < 4; ++t)
#pragma unroll
                for (int i = 0; i < 16; ++i) o[t][i] = 0.f;
            float m = -1e30f, lsum = 0.f;
            int kslot[2], kcol[2], vd[2], vc[2];
#pragma unroll
            for (int j = 0; j < 2; ++j) { const int c = tid + 512 * j, kap = c >> 4; kcol[j] = c & 15;
                kslot[j] = (kap & 32) + (kap & 3) + 4 * ((kap >> 4) & 1) + 8 * ((kap >> 2) & 3);
                vd[j] = c >> 3; vc[j] = c & 7; }
            const int rkap = tid >> 3, rc8 = tid & 7, rslot = (rkap & 32) + (rkap & 3) + 4 * ((rkap >> 4) & 1) + 8 * ((rkap >> 2) & 3);
            u32x4 sk[2], sr, sv[2];
#define AT_GLOAD(k0) do { const int rb_ = (k0) < split ? rowA + (k0) : rowB + ((k0) - split); \
                _Pragma("unroll") for (int j = 0; j < 2; ++j) sk[j] = *(const u32x4*)(KN + (size_t)(rb_ + ((tid + 512 * j) >> 4)) * 512 + h * 128 + kcol[j] * 8); \
                sr = *(const u32x4*)(KRB + (size_t)(rb_ + rkap) * 64 + rc8 * 8); \
                _Pragma("unroll") for (int j = 0; j < 2; ++j) sv[j] = *(const u32x4*)(vt + (size_t)vd[j] * keys + (k0) + vc[j] * 8); } while (0)
#define AT_SWRITE(buf) do { LAS unsigned char* sb_ = lds + (buf) * AT_STAGE; \
                _Pragma("unroll") for (int j = 0; j < 2; ++j) *(LAS u32x4*)(sb_ + kslot[j] * AT_KROW + kcol[j] * 16) = sk[j]; \
                *(LAS u32x4*)(sb_ + rslot * AT_KROW + 256 + rc8 * 16) = sr; \
                _Pragma("unroll") for (int j = 0; j < 2; ++j) *(LAS u32x4*)(sb_ + AT_KBYTES + vd[j] * AT_VROW + vc[j] * 16) = sv[j]; } while (0)
            const int ntile = nkeys >> 6;
            const int blk_lo = heavy ? (wave >> 2) : 0, blk_hi = heavy ? blk_lo + 1 : 2;
            AT_GLOAD(0); AT_SWRITE(0);
            __syncthreads();
            for (int tI = 0; tI < ntile; ++tI) {
                if (tI + 1 < ntile) AT_GLOAD((tI + 1) * 64);
                { const LAS unsigned char* sb = lds + (tI & 1) * AT_STAGE;
                for (int blk = blk_lo; blk < blk_hi; ++blk) {
                    const LAS unsigned char* kp = sb + (32 * blk + rho) * AT_KROW + hh * 16;
                    f32x16 sc, scb;
#pragma unroll
                    for (int i = 0; i < 16; ++i) { sc[i] = 0.f; scb[i] = 0.f; }
#pragma unroll
                    for (int ks = 0; ks < 12; ks += 2) { sc = MFMA32(*(const LAS bf16x8*)(kp + ks * 32), qf[ks], sc); scb = MFMA32(*(const LAS bf16x8*)(kp + ks * 32 + 32), qf[ks + 1], scb); }
                    sc = sc + scb;
                    float mx = sc[0];
#pragma unroll
                    for (int i = 1; i < 16; ++i) mx = fmaxf(mx, sc[i]);
                    mx = fmaxf(mx, shx(mx, 32, lane));
                    const float mn = fmaxf(m, mx), alpha = __builtin_amdgcn_exp2f(m - mn);
                    float ps = 0.f;
#pragma unroll
                    for (int i = 0; i < 16; ++i) { sc[i] = __builtin_amdgcn_exp2f(sc[i] - mn); ps += sc[i]; }
                    lsum = lsum * alpha + ps; m = mn;
#pragma unroll
                    for (int t = 0; t < 4; ++t) o[t] = o[t] * alpha;
                    bf16x8 pb[2];
#pragma unroll
                    for (int s2 = 0; s2 < 2; ++s2) { u32x4 w; w.x = cvt_pk_bf16(sc[8 * s2 + 0], sc[8 * s2 + 1]); w.y = cvt_pk_bf16(sc[8 * s2 + 2], sc[8 * s2 + 3]); w.z = cvt_pk_bf16(sc[8 * s2 + 4], sc[8 * s2 + 5]); w.w = cvt_pk_bf16(sc[8 * s2 + 6], sc[8 * s2 + 7]);
                        pb[s2] = __builtin_bit_cast(bf16x8, w); }
                    const LAS unsigned char* vp = sb + AT_KBYTES + rho * AT_VROW + (32 * blk + 16 * hh) * 2;
#pragma unroll
                    for (int t = 0; t < 4; ++t)
#pragma unroll
                        for (int s2 = 0; s2 < 2; ++s2) o[t] = MFMA32(*(const LAS bf16x8*)(vp + 32 * t * AT_VROW + 16 * s2), pb[s2], o[t]);
                }
                }
                if (tI + 1 < ntile) AT_SWRITE((tI + 1) & 1);
                __syncthreads();
            }
#undef AT_GLOAD
#undef AT_SWRITE
            lsum += shx(lsum, 32, lane);
            bf16* crow = CC + (size_t)(q0 + rho) * 1024 + h * 128;
            if (!heavy) { const float inv = 1.0f / lsum;
#pragma unroll
                for (int t = 0; t < 4; ++t) attn_store_tile(o[t], inv, crow, t, hh);
            } else {
                const int half = wave >> 2;
                LAS float* mine = (LAS float*)(lds + wave * 8704);
                LAS const float* theirs = (LAS const float*)(lds + (wave ^ 4) * 8704);
#pragma unroll
                for (int t2 = 0; t2 < 2; ++t2)
#pragma unroll
                    for (int i = 0; i < 16; ++i) mine[(t2 * 16 + i) * 64 + lane] = half == 0 ? o[2 + t2][i] : o[t2][i];
                if (hh == 0) { mine[2048 + rho] = m; mine[2080 + rho] = lsum; }
                __syncthreads();
                const float mp = theirs[2048 + rho], lp = theirs[2080 + rho];
                const float mg = fmaxf(m, mp), wo = __builtin_amdgcn_exp2f(m - mg), wp = __builtin_amdgcn_exp2f(mp - mg);
                const float inv = 1.0f / (wo * lsum + wp * lp);
#pragma unroll
                for (int t2 = 0; t2 < 2; ++t2) { f32x16 acc;
#pragma unroll
                    for (int i = 0; i < 16; ++i) acc[i] = wo * (half == 0 ? o[t2][i] : o[2 + t2][i]) + wp * theirs[(t2 * 16 + i) * 64 + lane];
                    attn_store_tile(acc, inv, crow, half * 2 + t2, hh); }
                __syncthreads();
            }
        } else {
            const int c = it - 256;
            LAS bf16* vnT = (LAS bf16*)lds;
#pragma unroll
            for (int pass = 0; pass < 8; ++pass) { const int u = wave + 8 * pass, qq = (u & 1) * 64 + lane, c8 = (u >> 1) * 8;
                const bf16x8 v = *(const bf16x8*)(VN + (size_t)(c * 128 + qq) * 256 + c8);
#pragma unroll
                for (int j = 0; j < 8; ++j) vnT[(c8 + j) * 136 + qq] = (bf16)v[j]; }
            __syncthreads();
            const int hd = wave & 3, ph = wave >> 2;
#pragma unroll
            for (int pp = 0; pp < 2; ++pp) { const int pt = 2 * ph + pp;
                f32x16 acc[2];
#pragma unroll
                for (int d = 0; d < 2; ++d)
#pragma unroll
                    for (int i = 0; i < 16; ++i) acc[d][i] = 0.f;
                const float* wrow = A.w_s + ((size_t)(l * 4 + hd) * 128 + 32 * pt + rho) * 128 + 8 * hh;
                f32x4 wv[16];
#pragma unroll
                for (int ks = 0; ks < 8; ++ks) { wv[2 * ks] = *(const f32x4*)(wrow + 16 * ks); wv[2 * ks + 1] = *(const f32x4*)(wrow + 16 * ks + 4); }
#pragma unroll
                for (int ks = 0; ks < 8; ++ks) { const f32x4 w0 = wv[2 * ks], w1 = wv[2 * ks + 1];
                    u32x4 w; w.x = cvt_pk_bf16(w0.x, w0.y); w.y = cvt_pk_bf16(w0.z, w0.w); w.z = cvt_pk_bf16(w1.x, w1.y); w.w = cvt_pk_bf16(w1.z, w1.w);
                    const bf16x8 af = __builtin_bit_cast(bf16x8, w);
#pragma unroll
                    for (int d = 0; d < 2; ++d) { const bf16x8 bfr = *(const LAS bf16x8*)(vnT + (hd * 64 + 32 * d + rho) * 136 + 16 * ks + 8 * hh); acc[d] = MFMA32(af, bfr, acc[d]); } }
                float bs[16]; bf16 ugv[2][16];
#pragma unroll
                for (int i = 0; i < 16; ++i) { const int p = 32 * pt + (i & 3) + 8 * (i >> 2) + 4 * hh; bs[i] = A.b_s[(l * 4 + hd) * 128 + p];
#pragma unroll
                    for (int d = 0; d < 2; ++d) ugv[d][i] = UG[((size_t)c * 128 + p) * 256 + hd * 64 + 32 * d + rho]; }
#pragma unroll
                for (int d = 0; d < 2; ++d) { const int col = hd * 64 + 32 * d + rho;
#pragma unroll
                    for (int i = 0; i < 16; ++i) { const int p = 32 * pt + (i & 3) + 8 * (i >> 2) + 4 * hh; const size_t row = (size_t)c * 128 + p;
                        const float mixed = acc[d][i] + bs[i];
                        const float ug = __uint_as_float((unsigned)ugv[d][i] << 16);
                        CC[row * 1024 + 512 + col] = (bf16)(cvt_pk_bf16(ug * mixed, 0.f) & 0xffffu); } }
            }
            __syncthreads();
        }
    }
}

__global__ void __launch_bounds__(512, 2) fwd_megakernel(Args A) {
    extern __shared__ __attribute__((aligned(16))) unsigned char smem[];
    LAS unsigned char* lds = (LAS unsigned char*)smem;
    const int wave0 = __builtin_amdgcn_readfirstlane((int)threadIdx.x >> 6);
    unsigned* const bar = (unsigned*)(A.ws + WS_BAR);
    volatile LAS unsigned* const barst = (volatile LAS unsigned*)(lds + LDS_BARST);
    const unsigned xcc = xb_xcc_id();
    if (wave0 == 0) { const int l0 = fresh_lane(); if (l0 < 2) barst[l0] = 0u; if (l0 == 0 && A.ph_hi - A.ph_lo > 1) (void)xb_add(&bar[XB_XCNT(xcc)], 1u); }
    __syncthreads();
    if (A.ph_lo < 0) cg::this_grid().sync();
    bool dup_done = false; (void)dup_done;
    for (int ph = A.ph_lo; ph < A.ph_hi; ++ph) {
        const int wave = wave0;
#define LANE fresh_lane()
#define TID (wave * 64 + fresh_lane())
        unsigned char* ws = A.ws; asm volatile("" : "+s"(ws));
        if (ph == 0) phase_prologue(A, lds, wave);
        else if (ph == 1) phase_pre(A, lds, LANE, wave);
        else {
            const int l = (ph - 2) / 9, k = (ph - 2) % 9;
            const int G = gridDim.x, bid = blockIdx.x;
            if (k == 0) {
                pg8::Gemm g{(const bf16*)(ws + WS_H), (const bf16*)(ws + WS_WIN) + (size_t)l * 2048 * 1024, NTOK, 2048, 1024}; pg8::StaticOrder S; S.init(NTOK, 2048, G, bid);
                EpiB16<0> E{(bf16*)(ws + WS_Z), INC, INC}; pg8::gemm_phase<EpiB16<0>, pg8::StaticOrder>(lds, g, S, E, TID);
            } else if (k == 1) phase_split(A, l, LANE, wave);
            else if (k == 2) {
                { pg8::Gemm g{(const bf16*)(ws + WS_QN), (const bf16*)(ws + WS_WUQ) + (size_t)l * 768 * 384, NTOK, 768, 384}; pg8::StaticOrder S; S.init(NTOK, 768, G, bid);
                  EpiQ E{(bf16*)(ws + WS_Q), (const float*)(ws + WS_ROPE), (const float*)(ws + WS_ROPE) + 32768}; pg8::gemm_phase<EpiQ, pg8::StaticOrder>(lds, g, S, E, TID); }
                                { pg8::Gemm g{(const bf16*)(ws + WS_CKVN), (const bf16*)(ws + WS_WUKV) + (size_t)l * 1024 * 256, NROWKV, 1024, 256}; pg8::StaticOrder S; S.init(NROWKV, 1024, G, (bid + G - 144 % G) % G);
                  EpiKV E{(bf16*)(ws + WS_KNOPE), (bf16*)(ws + WS_VTP), (bf16*)(ws + WS_VTS)}; pg8::gemm_phase<EpiKV, pg8::StaticOrder>(lds, g, S, E, TID); }
            } else if (k == 3) phase_mixer(A, l, lds, LANE, wave);
            else if (k == 4 || k == 7) {
                const bool o = (k == 4);
                pg8::Gemm g{(const bf16*)(ws + (o ? WS_CONCAT : WS_ACT)), o ? (const bf16*)(ws + WS_WOUT) + (size_t)l * 1024 * 1024 : (const bf16*)(ws + WS_WFF2) + (size_t)l * 1024 * 4096, NTOK, 1024, o ? 1024 : 4096};
                pg8::StaticOrder S; S.init(NTOK, 1024, G, bid);
                EpiB16<0> E{(bf16*)(ws + WS_MIX), 1024, 1024}; pg8::gemm_phase<EpiB16<0>, pg8::StaticOrder>(lds, g, S, E, TID);
                if (!o && l + 1 < DEPTH && bid >= 192 && G > 192) convert_layer(A, lds, l + 1, (bid - 192) * 8 + wave, (G - 192) * 8, wave, LANE);
            } else if (k == 5) phase_post(A, l, 0, lds, LANE, wave);
            else if (k == 6) {
                pg8::Gemm g{(const bf16*)(ws + WS_H), (const bf16*)(ws + WS_WFF1) + (size_t)l * 4096 * 1024, NTOK, 4096, 1024}; pg8::StaticOrder S; S.init(NTOK, 4096, G, bid);
                EpiB16<1> E{(bf16*)(ws + WS_ACT), 4096, 4096}; pg8::gemm_phase<EpiB16<1>, pg8::StaticOrder>(lds, g, S, E, TID);
            } else phase_post(A, l, 1, lds, LANE, wave);
        }
        if (ph + 1 < A.ph_hi) xcd_barrier(bar, xcc, barst, wave == 0 && fresh_lane() == 0);
#if PROBE_DUP >= 0
        {
            bool again = false;
            if (PROBE_DUP == 100) { if (ph + 1 < A.ph_hi) xcd_barrier(bar, xcc, barst, wave == 0 && fresh_lane() == 0); }
            else if (!dup_done) {
                const int kk = ph >= 2 ? (ph - 2) % 9 : -1;
                if (PROBE_DUP == 50) again = (ph == 0);
                else if (PROBE_DUP == 60) again = (kk == 0 || kk == 2 || kk == 4 || kk == 6 || kk == 7);
                else again = (kk == PROBE_DUP);
            }
            if (again) { dup_done = true; --ph; } else dup_done = false;
        }
#endif
    }
}

constexpr int N_PHASES = 2 + 9 * DEPTH;

extern "C" void kernel_launch(void* const* d_in, const int* in_sizes, int n_in, void* d_out, int out_size, void* d_ws, size_t ws_size, hipStream_t stream) {
    static int grid = 0;
    if (grid == 0) {
        if (n_in != 24 || ws_size < WS_END || in_sizes[9] != DEPTH * 1024 * INC) { fprintf(stderr, "kernel_launch: unexpected problem (n_in %d, ws %zu, w_in %d)\n", n_in, ws_size, n_in > 9 ? in_sizes[9] : -1); grid = -1; return; }
        int dev = 0, cus = 0, per_cu = 0;
        hipGetDevice(&dev); hipDeviceGetAttribute(&cus, hipDeviceAttributeMultiprocessorCount, dev);
        if (hipFuncSetAttribute((const void*)fwd_megakernel, hipFuncAttributeMaxDynamicSharedMemorySize, LDS_BYTES) != hipSuccess) { fprintf(stderr, "kernel_launch: hipFuncSetAttribute failed\n"); grid = -1; return; }
        if (hipOccupancyMaxActiveBlocksPerMultiprocessor(&per_cu, (const void*)fwd_megakernel, 512, LDS_BYTES) != hipSuccess || per_cu < 1) { fprintf(stderr, "kernel_launch: occupancy query says %d\n", per_cu); per_cu = 1; }
        (void)hipGetLastError();
        grid = cus * 1;
        fprintf(stderr, "kernel_launch: grid %d (cus %d, per_cu %d)\n", grid, cus, per_cu);
    }
    if (grid < 0) return;
    if (hipMemsetAsync((char*)d_ws + WS_BAR, 0, 16384, stream) != hipSuccess) { fprintf(stderr, "kernel_launch: memset failed\n"); return; }
    Args a{};
    const float** ap = (const float**)&a;
    for (int i = 0; i < 24; ++i) ap[i] = (const float*)d_in[i];
    a.out = (float*)d_out; a.ws = (unsigned char*)d_ws;
#if MK_PER_PHASE
    for (int ph = 0; ph < N_PHASES; ++ph) { a.ph_lo = ph; a.ph_hi = ph + 1; hipLaunchKernelGGL(fwd_megakernel, dim3(grid), dim3(512), LDS_BYTES, stream, a); }
#else
    a.ph_lo = 0; a.ph_hi = N_PHASES;
    void* args[] = {&a};
    hipError_t e = hipLaunchCooperativeKernel((const void*)fwd_megakernel, dim3(grid), dim3(512), args, LDS_BYTES, stream);
    if (e != hipSuccess) fprintf(stderr, "kernel_launch: cooperative launch failed: %s (grid %d)\n", hipGetErrorString(e), grid);
#endif
}
```

```cpp
#include <hip/hip_runtime.h>
#include <hip/hip_cooperative_groups.h>
#include <cstdio>
namespace cg = cooperative_groups;

#ifndef MK_PER_PHASE
#define MK_PER_PHASE 0
#endif

#ifndef PROBE_DUP
#define PROBE_DUP -1
#endif
#define LAS __attribute__((address_space(3)))
typedef unsigned short bf16;
typedef short bf16x8 __attribute__((ext_vector_type(8)));
typedef float f32x2 __attribute__((ext_vector_type(2)));
typedef float f32x4 __attribute__((ext_vector_type(4)));
typedef float f32x16 __attribute__((ext_vector_type(16)));
typedef unsigned u32x2 __attribute__((ext_vector_type(2)));
typedef unsigned u32x4 __attribute__((ext_vector_type(4)));

constexpr int DM = 1024, NTOK_P = 8192, NTOK_S = 4096, NTOK = 12288, NROWKV = 14336;
constexpr int DEPTH = 4, INC = 1984, DFF = 4096;
constexpr int ZQ = 0, ZCKV = 384, ZKR = 640, ZU = 704, ZV = 960, ZBG = 1216, ZCG = 1472, ZHH = 1728;
constexpr float EPS = 1e-6f;
constexpr float QSCALE = 0.07216878364870322f * 1.4426950408889634f;

constexpr size_t MiB = 1u << 20;
constexpr size_t WS_MOD = 0, WS_BAR = 512 * 1024, WS_ROPE = 1 * MiB, WS_WIN = 2 * MiB, WS_WUQ = 18 * MiB, WS_WUKV = 21 * MiB, WS_WOUT = 23 * MiB,
                 WS_WFF1 = 31 * MiB, WS_WFF2 = 63 * MiB, WS_H = 95 * MiB, WS_MIX = 119 * MiB, WS_CONCAT = 167 * MiB, WS_QN = 191 * MiB,
                 WS_CKVN = 200 * MiB, WS_KRB = 207 * MiB, WS_UG = 209 * MiB, WS_VN = 215 * MiB, WS_Q = 221 * MiB, WS_KNOPE = 239 * MiB,
                 WS_VTP = 253 * MiB, WS_VTS = 261 * MiB, WS_Z = 267 * MiB, WS_ACT = 267 * MiB, WS_END = 363 * MiB;
constexpr int LDS_BYTES = 147456, LDS_BARST = LDS_BYTES - 64;

__device__ __forceinline__ unsigned cvt_pk_bf16(float lo, float hi) { unsigned r; asm volatile("v_cvt_pk_bf16_f32 %0, %1, %2" : "=v"(r) : "v"(lo), "v"(hi)); return r; }
__device__ __forceinline__ int fresh_lane() { int l; asm volatile("v_mbcnt_lo_u32_b32 %0, -1, 0\n\tv_mbcnt_hi_u32_b32 %0, -1, %0" : "=v"(l)); return l; }
__device__ __forceinline__ float shx(float v, int mask, int lane) { return __int_as_float(__builtin_amdgcn_ds_bpermute((lane ^ mask) << 2, __float_as_int(v))); }
__device__ __forceinline__ float dpp_add(float v, const int ctrl_is) {
    return v; }
#define DPP_ADD(v, ctrl) ((v) + __int_as_float(__builtin_amdgcn_update_dpp(0, __float_as_int(v), (ctrl), 0xf, 0xf, true)))
__device__ __forceinline__ float wave_sum(float v, int lane) {
    (void)lane;
    v = DPP_ADD(v, 0xB1);
    v = DPP_ADD(v, 0x4E);
    v = DPP_ADD(v, 0x141);
    v = DPP_ADD(v, 0x140);
    const int vi = __float_as_int(v);
    return (__int_as_float(__builtin_amdgcn_readlane(vi, 0)) + __int_as_float(__builtin_amdgcn_readlane(vi, 16))) + (__int_as_float(__builtin_amdgcn_readlane(vi, 32)) + __int_as_float(__builtin_amdgcn_readlane(vi, 48)));
}
__device__ __forceinline__ float gelu_tanh(float x) { const float y = 0.7978845608028654f * (x + 0.044715f * x * x * x); return x / (1.0f + __expf(-2.0f * y)); }
__device__ __forceinline__ f32x4 gelu4(f32x4 v) { return (f32x4){gelu_tanh(v.x), gelu_tanh(v.y), gelu_tanh(v.z), gelu_tanh(v.w)}; }
__device__ __forceinline__ float sumsq4(f32x4 v) { return (v.x * v.x + v.y * v.y) + (v.z * v.z + v.w * v.w); }
__device__ __forceinline__ f32x4 ld4bf(const bf16* p) { const u32x2 w = *(const u32x2*)p; return (f32x4){__uint_as_float(w.x << 16), __uint_as_float(w.x & 0xffff0000u), __uint_as_float(w.y << 16), __uint_as_float(w.y & 0xffff0000u)}; }
__device__ __forceinline__ f32x2 ld2bf(const bf16* p) { const unsigned w = *(const unsigned*)p; return (f32x2){__uint_as_float(w << 16), __uint_as_float(w & 0xffff0000u)}; }
__device__ __forceinline__ float ld1bf(const bf16* p) { return __uint_as_float((unsigned)*p << 16); }
__device__ __forceinline__ u32x2 pk4(f32x4 v) { u32x2 w; w.x = cvt_pk_bf16(v.x, v.y); w.y = cvt_pk_bf16(v.z, v.w); return w; }


#define XB_TMO      128
#define XB_XCNT(j)  (256  + 64 * (j))
#define XB_XSUB(j)  (1280 + 64 * (j))
#define XB_XGEN(j)  (2304 + 64 * (j))
#define XB_TOP      3328
#define XB_TOPGEN   3392
#define XCD_BAR_WORDS 3456
#define XB_SPIN_CAP (1u << 18)
__device__ __forceinline__ unsigned xb_ld(unsigned* p)              { return __hip_atomic_load(p, __ATOMIC_RELAXED, __HIP_MEMORY_SCOPE_AGENT); }
__device__ __forceinline__ unsigned xb_add(unsigned* p, unsigned v) { return __hip_atomic_fetch_add(p, v, __ATOMIC_RELAXED, __HIP_MEMORY_SCOPE_AGENT); }
__device__ __forceinline__ unsigned xb_xcc_id() { return (unsigned)__builtin_amdgcn_s_getreg((3 << 11) | 20) & 0xFu; }
#define XB_SPIN(cond, bar) do { unsigned _sp = 0; while (cond) { __builtin_amdgcn_s_sleep(1); \
    if ((++_sp & 255u) == 0u) { if (xb_ld(&(bar)[XB_TMO])) break; if (_sp > XB_SPIN_CAP) { atomicAdd(&(bar)[XB_TMO], 1u); break; } } } } while (0)
__device__ __forceinline__ void xcd_barrier_complete(unsigned* bar, unsigned x, unsigned& nloc, unsigned& nx) {
    const unsigned G = gridDim.x * gridDim.y * gridDim.z;
    unsigned sum, cnt, mine, sp = 0u;
    for (;;) {
        sum = 0u; cnt = 0u; mine = 0u;
#pragma unroll
        for (unsigned j = 0; j < 16; ++j) { const unsigned c = xb_ld(&bar[XB_XCNT(j)]); sum += c; cnt += (c > 0u) ? 1u : 0u; mine = (j == x) ? c : mine; }
        if (sum == G) break;
        __builtin_amdgcn_s_sleep(1);
        if ((++sp & 255u) == 0u) { if (xb_ld(&bar[XB_TMO])) break; if (sp > XB_SPIN_CAP) { atomicAdd(&bar[XB_TMO], 1u); break; } }
    }
    nloc = mine > 0u ? mine : 1u; nx = cnt > 0u ? cnt : 1u;
}
__device__ __forceinline__ void xcd_barrier(unsigned* bar, unsigned x, volatile LAS unsigned* st, bool leader) {
    asm volatile("s_waitcnt vmcnt(0)" ::: "memory");
    __syncthreads();
    if (leader) {
        __builtin_amdgcn_s_waitcnt(0);
        unsigned nloc = st[0], nx = st[1];
        if (nloc == 0u) { xcd_barrier_complete(bar, x, nloc, nx); st[0] = nloc; st[1] = nx; }
        const unsigned old = xb_add(&bar[XB_XSUB(x)], 1u);
        const unsigned gen = old / nloc;
        if (old + 1u == (gen + 1u) * nloc) {
            __builtin_amdgcn_fence(__ATOMIC_RELEASE, "agent");
            asm volatile("s_waitcnt vmcnt(0)" ::: "memory");
            const unsigned og = xb_add(&bar[XB_TOP], 1u);
            const unsigned tg = og / nx;
            if (og + 1u == (tg + 1u) * nx) xb_add(&bar[XB_TOPGEN], 1u);
            else XB_SPIN(xb_ld(&bar[XB_TOPGEN]) == tg, bar);
            __builtin_amdgcn_fence(__ATOMIC_ACQUIRE, "agent");
            xb_add(&bar[XB_XGEN(x)], 1u);
            asm volatile("s_waitcnt vmcnt(0)" ::: "memory");
        } else {
            XB_SPIN(xb_ld(&bar[XB_XGEN(x)]) == gen, bar);
            __builtin_amdgcn_fence(__ATOMIC_ACQUIRE, "agent");
            asm volatile("s_waitcnt vmcnt(0)" ::: "memory");
        }
    }
    __syncthreads();
}

namespace pg8 {
#define PG8_LAS __attribute__((address_space(3)))
typedef unsigned short bf16_t;
constexpr int BM = 256, BK = 64, HALF = 128, HTB = HALF * BK * 2, STAGE_BYTES = 8 * HTB, NXCD = 8, WGM = 8;
__host__ __device__ __forceinline__ int lds_byte(int r, int c) { const int st = (r >> 4) * 2 + (c >> 5), rr = r & 15, cc = c & 31, ob = rr * 64 + cc * 2; return st * 1024 + (ob ^ (((ob >> 9) & 1) << 5)); }
__host__ __device__ __forceinline__ void stage_rc(int b, int& R, int& C) { const int st = b / 1024, sb = b % 1024, swz = sb ^ (((sb >> 9) & 1) << 5); R = (st >> 1) * 16 + swz / 64; C = (st & 1) * 32 + (swz % 64) / 2; }
__host__ __device__ __forceinline__ int perm32(int rho) { const int n = rho >> 4, i = rho & 15; return 8 * (i >> 2) + 4 * n + (i & 3); }
struct Unit { int pm, pn; };
struct Gemm { const bf16_t* A; const bf16_t* Bt; int M, N, K; };
struct StaticOrder {
    int nM, nN, nwg, G, c;
    __host__ __device__ void init(int M, int N, int G_, int c_) { nM = M / BM; nN = N / BM; nwg = nM * nN; G = G_; c = c_; }
    __host__ __device__ bool next(int i, Unit& u) const {
        const long L = (long)i * G + c; if (L >= nwg) return false;
        int wgid = (int)L; { const int q = nwg / NXCD, r = nwg % NXCD, xcd = wgid % NXCD, off = wgid / NXCD; wgid = (xcd < r ? xcd * (q + 1) : r * (q + 1) + (xcd - r) * q) + off; }
        const int nig = WGM * nN, gid = wgid / nig, fm = gid * WGM, gsz = (nM - fm) < WGM ? (nM - fm) : WGM;
        u.pm = fm + ((wgid % nig) % gsz); u.pn = (wgid % nig) / gsz; return true;
    }
    __device__ __forceinline__ void a_ready(const Unit&) const {}
    __device__ __forceinline__ void done(const Unit&) const {}
};

template <class Epi, class Sched>
__device__ __forceinline__ void gemm_phase(PG8_LAS unsigned char* lds, const Gemm g, const Sched& S, const Epi& E, const int tid) {
    const int wid = __builtin_amdgcn_readfirstlane(tid >> 6), lane = tid & 63, wr = wid >> 2, wc = wid & 3, fr = lane & 15, fq = lane >> 4;
    const int K = g.K, nt = K / BK;
    unsigned voffA[2], voffB[2];
#pragma unroll
    for (int i = 0; i < 2; ++i) { int R, C; stage_rc(tid * 16 + i * 8192, R, C); const int Rb = Epi::PERM ? ((R & ~31) + perm32(R & 31)) : R;
        voffA[i] = (unsigned)(R * K + C) * 2u; voffB[i] = (unsigned)(Rb * K + C) * 2u; }
    const size_t kstep = (size_t)(BK * 2);
    const size_t hstep = (size_t)HALF * K * 2;
    const size_t tstep = 2 * hstep;
    const unsigned ldsw = (unsigned)wid * 1024u;
    const int aoff = lds_byte(wr * 64 + fr, fq * 8), boff = lds_byte(wc * 32 + fr, fq * 8);
#define PG8_SA(b, h) (((b) * 2 + (h)) * HTB)
#define PG8_SB(b, h) ((4 + (b) * 2 + (h)) * HTB)
#define PG8_STAGE(bufoff, gbase, voff) do { _Pragma("unroll") for (int _i = 0; _i < 2; ++_i) \
        __builtin_amdgcn_global_load_lds((const unsigned*)((const char*)(gbase) + (voff)[_i]), (PG8_LAS unsigned*)(lds + (bufoff) + ldsw + _i * 8192), 16, 0, 0); } while (0)
#define PG8_LDA(dst, b, h) do { _Pragma("unroll") for (int m = 0; m < 4; ++m) _Pragma("unroll") for (int k = 0; k < 2; ++k) dst[m][k] = *(const PG8_LAS bf16x8*)(lds + PG8_SA(b, h) + aoff + m * 2048 + k * 1024); } while (0)
#define PG8_LDB(dst, b, h) do { _Pragma("unroll") for (int n = 0; n < 2; ++n) _Pragma("unroll") for (int k = 0; k < 2; ++k) dst[n][k] = *(const PG8_LAS bf16x8*)(lds + PG8_SB(b, h) + boff + n * 2048 + k * 1024); } while (0)
#define PG8_MMA(ai, bj, At, Bt) do { __builtin_amdgcn_s_setprio(1); _Pragma("unroll") for (int m = 0; m < 4; ++m) _Pragma("unroll") for (int n = 0; n < 2; ++n) _Pragma("unroll") for (int k = 0; k < 2; ++k) \
        acc[ai][bj][m][n] = __builtin_amdgcn_mfma_f32_16x16x32_bf16(Bt[n][k], At[m][k], acc[ai][bj][m][n], 0, 0, 0); __builtin_amdgcn_s_setprio(0); } while (0)
#define PG8_WAIT_V(n) asm volatile("s_waitcnt vmcnt(" #n ")" ::: "memory")
#define PG8_WAIT_L(n) asm volatile("s_waitcnt lgkmcnt(" #n ")" ::: "memory")
#define PG8_BAR __builtin_amdgcn_s_barrier()
#define PG8_SCHED __builtin_amdgcn_sched_barrier(0)
    Unit cur, nxt; int ui = 0;
    if (!S.next(0, cur)) return;
    f32x4 acc[2][2][4][2];
#pragma unroll
    for (int a = 0; a < 2; ++a)
#pragma unroll
        for (int b = 0; b < 2; ++b)
#pragma unroll
            for (int m = 0; m < 4; ++m)
#pragma unroll
                for (int n = 0; n < 2; ++n) acc[a][b][m][n] = (f32x4){0.f, 0.f, 0.f, 0.f};
    bf16x8 At[4][2], B0[2][2], B1[2][2];
    const char* cA = (const char*)g.A + (size_t)cur.pm * tstep; const char* cB = (const char*)g.Bt + (size_t)cur.pn * tstep;
    S.a_ready(cur);
    PG8_STAGE(PG8_SB(0, 0), cB, voffB); PG8_STAGE(PG8_SA(0, 0), cA, voffA); PG8_STAGE(PG8_SB(0, 1), cB + hstep, voffB); PG8_STAGE(PG8_SA(0, 1), cA + hstep, voffA);
    if (wr == 1) PG8_BAR;
    PG8_WAIT_V(4); PG8_BAR;
    PG8_STAGE(PG8_SB(1, 0), cB + kstep, voffB); PG8_STAGE(PG8_SA(1, 0), cA + kstep, voffA); PG8_STAGE(PG8_SB(1, 1), cB + hstep + kstep, voffB);
    PG8_WAIT_V(6); PG8_BAR;
    for (;;) {
        const bool has_next = S.next(ui + 1, nxt);
        const char* nA = has_next ? (const char*)g.A + (size_t)nxt.pm * tstep : cA; const char* nB = has_next ? (const char*)g.Bt + (size_t)nxt.pn * tstep : cB;
        for (int t = 0; t < nt; t += 2) {
            const bool last = (t == nt - 2);
            const char* a1 = cA + (size_t)(t + 1) * kstep;
            const char* a2 = last ? nA : cA + (size_t)(t + 2) * kstep; const char* b2 = last ? nB : cB + (size_t)(t + 2) * kstep;
            const char* a3 = a2 + kstep; const char* b3 = b2 + kstep;
            if (last && has_next) S.a_ready(nxt);
            PG8_LDB(B0, 0, 0); PG8_SCHED; PG8_LDA(At, 0, 0); PG8_STAGE(PG8_SA(1, 1), a1 + hstep, voffA);
            PG8_WAIT_L(8); PG8_BAR; PG8_WAIT_L(0); PG8_MMA(0, 0, At, B0); PG8_BAR; PG8_SCHED;
            PG8_LDB(B1, 0, 1); PG8_STAGE(PG8_SB(0, 0), b2, voffB);
            PG8_BAR; PG8_WAIT_L(0); PG8_MMA(0, 1, At, B1); PG8_BAR;
            PG8_LDA(At, 0, 1); PG8_STAGE(PG8_SA(0, 0), a2, voffA);
            PG8_BAR; PG8_WAIT_L(0); PG8_MMA(1, 0, At, B0); PG8_BAR; PG8_SCHED;
            PG8_STAGE(PG8_SB(0, 1), b2 + hstep, voffB);
            PG8_WAIT_V(6); PG8_BAR; PG8_MMA(1, 1, At, B1); PG8_BAR;
            PG8_LDB(B0, 1, 0); PG8_SCHED; PG8_LDA(At, 1, 0); PG8_STAGE(PG8_SA(0, 1), a2 + hstep, voffA);
            PG8_WAIT_L(8); PG8_BAR; PG8_WAIT_L(0); PG8_MMA(0, 0, At, B0); PG8_BAR; PG8_SCHED;
            PG8_LDB(B1, 1, 1); PG8_STAGE(PG8_SB(1, 0), b3, voffB);
            PG8_BAR; PG8_WAIT_L(0); PG8_MMA(0, 1, At, B1); PG8_BAR;
            PG8_LDA(At, 1, 1); PG8_STAGE(PG8_SA(1, 0), a3, voffA);
            PG8_BAR; PG8_WAIT_L(0); PG8_MMA(1, 0, At, B0); PG8_BAR; PG8_SCHED;
            PG8_STAGE(PG8_SB(1, 1), b3 + hstep, voffB);
            PG8_WAIT_V(6); PG8_BAR; PG8_MMA(1, 1, At, B1); PG8_BAR;
        }
        E(acc, cur, wr, wc, fr, fq); S.done(cur);
        if (!has_next) break;
#pragma unroll
        for (int a = 0; a < 2; ++a)
#pragma unroll
            for (int b = 0; b < 2; ++b)
#pragma unroll
                for (int m = 0; m < 4; ++m)
#pragma unroll
                    for (int n = 0; n < 2; ++n) acc[a][b][m][n] = (f32x4){0.f, 0.f, 0.f, 0.f};
        cur = nxt; cA = nA; cB = nB; ++ui;
    }
    PG8_WAIT_V(0);
    if (wr == 0) PG8_BAR;
    PG8_BAR;
#undef PG8_SA
#undef PG8_SB
#undef PG8_STAGE
#undef PG8_LDA
#undef PG8_LDB
#undef PG8_MMA
#undef PG8_WAIT_V
#undef PG8_WAIT_L
#undef PG8_BAR
#undef PG8_SCHED
}
}

struct EpiF32 {
    static constexpr bool PERM = false;
    float* C; int ldc; int ncols;
    __device__ __forceinline__ void operator()(const f32x4 (&acc)[2][2][4][2], const pg8::Unit& u, int wr, int wc, int fr, int fq) const {
        const int row0 = u.pm * 256 + wr * 64 + fr, col0 = u.pn * 256 + wc * 32 + 4 * fq;
#pragma unroll
        for (int ai = 0; ai < 2; ++ai)
#pragma unroll
            for (int m = 0; m < 4; ++m) { float* rowp = C + (size_t)(row0 + ai * 128 + m * 16) * ldc + col0;
#pragma unroll
                for (int bj = 0; bj < 2; ++bj)
#pragma unroll
                    for (int n = 0; n < 2; ++n) if (col0 + bj * 128 + n * 16 < ncols) *(f32x4*)(rowp + bj * 128 + n * 16) = acc[ai][bj][m][n]; }
    }
};
template <int ACT> struct EpiB16 {
    static constexpr bool PERM = true;
    bf16* O; int ldc; int ncols;
    __device__ __forceinline__ void operator()(const f32x4 (&acc)[2][2][4][2], const pg8::Unit& u, int wr, int wc, int fr, int fq) const {
        const int row0 = u.pm * 256 + wr * 64 + fr, col0 = u.pn * 256 + wc * 32 + 8 * fq;
#pragma unroll
        for (int ai = 0; ai < 2; ++ai)
#pragma unroll
            for (int m = 0; m < 4; ++m) { bf16* rowp = O + (size_t)(row0 + ai * 128 + m * 16) * ldc + col0;
#pragma unroll
                for (int bj = 0; bj < 2; ++bj) { f32x4 v0 = acc[ai][bj][m][0], v1 = acc[ai][bj][m][1];
                    if (col0 + bj * 128 >= ncols) continue;
                    if (ACT) {
#pragma unroll
                    for (int j = 0; j < 4; ++j) { const float a = fmaxf(v0[j], 0.f), b = fmaxf(v1[j], 0.f); v0[j] = a * a; v1[j] = b * b; } }
                    u32x4 w; w.x = cvt_pk_bf16(v0[0], v0[1]); w.y = cvt_pk_bf16(v0[2], v0[3]); w.z = cvt_pk_bf16(v1[0], v1[1]); w.w = cvt_pk_bf16(v1[2], v1[3]);
                    *(u32x4*)(rowp + bj * 128) = w; } }
    }
};
struct EpiQ {
    static constexpr bool PERM = false;
    bf16* Q; const float* ropec; const float* ropes;
    __device__ __forceinline__ void operator()(const f32x4 (&acc)[2][2][4][2], const pg8::Unit& u, int wr, int wc, int, int) const {
        const int ln = fresh_lane(), fr = ln & 15, fq = ln >> 4;
        const int row0 = u.pm * 256 + wr * 64 + fr; const bool sample = u.pm >= 32;
#pragma unroll
        for (int bj = 0; bj < 2; ++bj) {
            const int g0 = u.pn * 256 + bj * 128 + wc * 32, within0 = g0 % 192; const bool isrope = within0 >= 128; const int a = (within0 - 128) >> 5;
#pragma unroll
            for (int ai = 0; ai < 2; ++ai)
#pragma unroll
                for (int m = 0; m < 4; ++m) { const int row = row0 + ai * 128 + m * 16;
                    f32x4 x1 = acc[ai][bj][m][0], x2 = acc[ai][bj][m][1];
                    if (sample && isrope) { const int ntok = (row - NTOK_P) & 1023;
                        const f32x4 cs = *(const f32x4*)(ropec + ntok * 32 + a * 16 + 4 * fq), sn = *(const f32x4*)(ropes + ntok * 32 + a * 16 + 4 * fq);
                        const f32x4 o1 = x1 * cs - x2 * sn, o2 = x1 * sn + x2 * cs; x1 = o1; x2 = o2; }
                    x1 = x1 * QSCALE; x2 = x2 * QSCALE;
                    bf16* p = Q + (size_t)row * 768 + g0 + 4 * fq;
                    *(u32x2*)p = pk4(x1); *(u32x2*)(p + 16) = pk4(x2); asm volatile("" ::: "memory"); }
        }
    }
};
struct EpiKV {
    static constexpr bool PERM = false;
    bf16* KN; bf16* VTP; bf16* VTS;
    __device__ __forceinline__ void operator()(const f32x4 (&acc)[2][2][4][2], const pg8::Unit& u, int wr, int wc, int, int) const {
        const int ln = fresh_lane(), fr = ln & 15, fq = ln >> 4;
        const int h = u.pn, pm = u.pm;
        bf16* vt; int keys, keybase;
        if (pm < 32) { vt = VTP + (size_t)((pm * 4 + h) * 128) * 256; keys = 256; keybase = 0; }
        else if (pm < 48) { const int b = (pm - 32) >> 2; vt = VTS + (size_t)((b * 4 + h) * 128) * 1536; keys = 1536; keybase = 512 + ((pm - 32) & 3) * 256; }
        else { const int b = (pm - 48) >> 1; vt = VTS + (size_t)((b * 4 + h) * 128) * 1536; keys = 1536; keybase = ((pm - 48) & 1) * 256; }
#pragma unroll
        for (int ai = 0; ai < 2; ++ai)
#pragma unroll
            for (int m = 0; m < 4; ++m) { const int rloc = wr * 64 + fr + ai * 128 + m * 16;
                bf16* kp = KN + (size_t)(pm * 256 + rloc) * 512 + h * 128 + wc * 32 + 4 * fq;
#pragma unroll
                for (int n = 0; n < 2; ++n) *(u32x2*)(kp + 16 * n) = pk4(acc[ai][0][m][n]);
#pragma unroll
                for (int n = 0; n < 2; ++n) { const f32x4 v = acc[ai][1][m][n]; const u32x2 w = pk4(v);
                    bf16* vp = vt + (size_t)(wc * 32 + 16 * n + 4 * fq) * keys + keybase + rloc;
                    vp[0] = (bf16)(w.x & 0xffffu); vp[keys] = (bf16)(w.x >> 16); vp[2 * keys] = (bf16)(w.y & 0xffffu); vp[3 * keys] = (bf16)(w.y >> 16); }
                asm volatile("" ::: "memory");
            }
    }
};

struct Args {
    const float *x_prompt, *x_sample, *cache_ckv, *cache_krope, *c, *c_ctx, *w_ada, *b_ada, *g_pre_mix, *w_in, *g_q, *w_uq, *g_kv, *w_ukv,
                *g_v, *w_s, *b_s, *w_conv, *w_out, *g_post_mix, *g_pre_ffn, *w_ff1, *w_ff2, *g_post_ffn;
    float* out; unsigned char* ws; int ph_lo, ph_hi;
};

__device__ __forceinline__ void p0_transpose_item(const float* W, int K, int N, bf16* WT, LAS float* scr, int item, int lane) {
    const int nblk = N / 32, kb = item / nblk, nb = item % nblk, k0 = 64 * kb, n0 = 32 * nb;
#pragma unroll 8
    for (int i = 0; i < 32; ++i) { const int kk = 2 * i + (lane >> 5); scr[kk * 33 + (lane & 31)] = W[(size_t)(k0 + kk) * N + n0 + (lane & 31)]; }
    asm volatile("s_waitcnt lgkmcnt(0)" ::: "memory");
    const int c = lane & 7;
#pragma unroll
    for (int j = 0; j < 4; ++j) { const int n = (lane >> 3) + 8 * j; const LAS float* s = scr + (8 * c) * 33 + n;
        u32x4 o; o.x = cvt_pk_bf16(s[0 * 33], s[1 * 33]); o.y = cvt_pk_bf16(s[2 * 33], s[3 * 33]); o.z = cvt_pk_bf16(s[4 * 33], s[5 * 33]); o.w = cvt_pk_bf16(s[6 * 33], s[7 * 33]);
        *(u32x4*)(WT + (size_t)(n0 + n) * K + k0 + 8 * c) = o; }
    asm volatile("s_waitcnt lgkmcnt(0)" ::: "memory");
}

__device__ __forceinline__ void convert_layer(const Args& A, LAS unsigned char* lds, int l, int gwi, int nw, int wave, int lane) {
    unsigned char* ws = A.ws;
    LAS float* scr = (LAS float*)(lds + wave * 16384);
    constexpr int I_IN = 16 * 62, I_UQ = 6 * 24, I_UKV = 4 * 32, I_OUT = 16 * 32, I_F1 = 16 * 128, I_F2 = 64 * 32, I_L = I_IN + I_UQ + I_UKV + I_OUT + I_F1 + I_F2;
    for (int it = gwi; it < I_L; it += nw) {
        int r = it;
        if (r < I_IN) { p0_transpose_item(A.w_in + (size_t)l * 1024 * INC, 1024, INC, (bf16*)(ws + WS_WIN) + (size_t)l * 2048 * 1024, scr, r, lane); continue; } r -= I_IN;
        if (r < I_UQ) { p0_transpose_item(A.w_uq + (size_t)l * 384 * 768, 384, 768, (bf16*)(ws + WS_WUQ) + (size_t)l * 768 * 384, scr, r, lane); continue; } r -= I_UQ;
        if (r < I_UKV) { p0_transpose_item(A.w_ukv + (size_t)l * 256 * 1024, 256, 1024, (bf16*)(ws + WS_WUKV) + (size_t)l * 1024 * 256, scr, r, lane); continue; } r -= I_UKV;
        if (r < I_OUT) { p0_transpose_item(A.w_out + (size_t)l * 1024 * 1024, 1024, 1024, (bf16*)(ws + WS_WOUT) + (size_t)l * 1024 * 1024, scr, r, lane); continue; } r -= I_OUT;
        if (r < I_F1) { p0_transpose_item(A.w_ff1 + (size_t)l * 1024 * 4096, 1024, 4096, (bf16*)(ws + WS_WFF1) + (size_t)l * 4096 * 1024, scr, r, lane); continue; } r -= I_F1;
        p0_transpose_item(A.w_ff2 + (size_t)l * 4096 * 1024, 4096, 1024, (bf16*)(ws + WS_WFF2) + (size_t)l * 1024 * 4096, scr, r, lane);
    }
}

__device__ __forceinline__ void phase_prologue(const Args& A, LAS unsigned char* lds, int wave) {
    const int lane = fresh_lane(), tid = wave * 64 + lane;
    unsigned char* ws = A.ws;
    const int bid = blockIdx.x, G = gridDim.x;
    { const int gt = bid * 512 + tid;
      if (gt < 32768) { const int n = gt >> 5, a = (gt >> 4) & 1, f = gt & 15; const int pos = a == 0 ? (n >> 6) : (n & 63);
          double inv = 1.0; for (int i = 0; i < f; ++i) inv *= 0.5623413251903491;
          double rev = (double)pos * inv * 0.15915494309189535; rev -= floor(rev);
          const float rf = (float)rev;
          ((float*)(ws + WS_ROPE))[gt] = __builtin_amdgcn_cosf(rf); ((float*)(ws + WS_ROPE))[32768 + gt] = __builtin_amdgcn_sinf(rf); } }
    for (int it = bid; it < 192; it += G) {
        const int l = it / 48, cgp = it % 48;
        LAS float* sl = (LAS float*)lds;
        for (int i = tid; i < 5120; i += 512) { const int ci = i >> 10, k = i & 1023; const float v = ci == 0 ? A.c_ctx[k] : A.c[(ci - 1) * 1024 + k]; sl[i] = v / (1.0f + __expf(-v)); }
        __syncthreads();
        float a0[5], a1[5];
#pragma unroll
        for (int ci = 0; ci < 5; ++ci) { a0[ci] = 0.f; a1[ci] = 0.f; }
        const float* wp = A.w_ada + ((size_t)l * 1024 + wave * 128) * 6144 + cgp * 128 + 2 * lane;
#pragma unroll 8
        for (int kk = 0; kk < 128; ++kk) { const f32x2 wv = *(const f32x2*)(wp + (size_t)kk * 6144); const int k = wave * 128 + kk;
#pragma unroll
            for (int ci = 0; ci < 5; ++ci) { const float s = sl[ci * 1024 + k]; a0[ci] += s * wv.x; a1[ci] += s * wv.y; } }
        LAS float* part = (LAS float*)(lds + 32768);
#pragma unroll
        for (int ci = 0; ci < 5; ++ci) { part[(wave * 5 + ci) * 128 + 2 * lane] = a0[ci]; part[(wave * 5 + ci) * 128 + 2 * lane + 1] = a1[ci]; }
        __syncthreads();
        for (int i = tid; i < 640; i += 512) { const int ci = i >> 7, col = i & 127; float s = 0.f;
#pragma unroll
            for (int w = 0; w < 8; ++w) s += part[(w * 5 + ci) * 128 + col];
            const int gcol = cgp * 128 + col; ((float*)(ws + WS_MOD))[(l * 5 + ci) * 6144 + gcol] = s + A.b_ada[l * 6144 + gcol]; }
        __syncthreads();
    }
    convert_layer(A, lds, 0, bid * 8 + wave, G * 8, wave, lane);
}

__device__ __forceinline__ int cond_of_row(int r) { return r < NTOK_P ? 0 : 1 + ((r - NTOK_P) >> 10); }

__device__ __forceinline__ void norm_mod_store(const f32x4 (&v)[4], const LAS float* g, const LAS float* sc, const LAS float* sh, bf16* hrow, int lane) {
    float ss = 0.f;
#pragma unroll
    for (int j = 0; j < 4; ++j) ss += sumsq4(v[j]);
    const float rstd = 1.0f / sqrtf(wave_sum(ss, lane) * (1.0f / 1024.0f) + EPS);
#pragma unroll
    for (int j = 0; j < 4; ++j) { const int idx = 4 * lane + 256 * j;
        const f32x4 gg = *(const LAS f32x4*)(g + idx), s1 = *(const LAS f32x4*)(sc + idx), s0 = *(const LAS f32x4*)(sh + idx);
        const f32x4 o = v[j] * rstd * gg * (1.0f + s1) + s0;
        *(u32x2*)(hrow + idx) = pk4(o); }
}
__device__ __forceinline__ const float* x_in_row(const Args& A, int r) { return r < NTOK_P ? A.x_prompt + (size_t)r * 1024 : A.x_sample + (size_t)(r - NTOK_P) * 1024; }
__device__ __forceinline__ void fill_vec(LAS float* dst, const float* src, int tid) { if (tid < 256) *(LAS f32x4*)(dst + 4 * tid) = *(const f32x4*)(src + 4 * tid); }

__device__ __forceinline__ void phase_pre(const Args& A, LAS unsigned char* lds, int lane, int wave) {
    const int gw = blockIdx.x * 8 + wave, NGW = gridDim.x * 8;
    const float* mod = (const float*)(A.ws + WS_MOD); bf16* H = (bf16*)(A.ws + WS_H);
    LAS float* P = (LAS float*)lds;
    { const int t2 = (wave & 3) * 64 + lane, hv = wave >> 2;
      for (int v = hv; v < 11; v += 2) { const float* src = v == 0 ? A.g_pre_mix : (v <= 5 ? mod + (size_t)(v - 1) * 6144 + 1024 : mod + (size_t)(v - 6) * 6144);
          const int slot = v == 0 ? 1 : (v <= 5 ? 7 + (v - 1) : 12 + (v - 6));
          *(LAS f32x4*)(P + slot * 1024 + 4 * t2) = *(const f32x4*)(src + 4 * t2); } }
    __syncthreads();
    for (int r0 = gw; r0 < NTOK; r0 += 2 * NGW) {
        f32x4 v[2][4];
#pragma unroll
        for (int u = 0; u < 2; ++u) { const float* xr = x_in_row(A, r0 + u * NGW);
#pragma unroll
            for (int j = 0; j < 4; ++j) v[u][j] = *(const f32x4*)(xr + 4 * lane + 256 * j); }
#pragma unroll
        for (int u = 0; u < 2; ++u) { const int r = r0 + u * NGW, ci = cond_of_row(r);
            norm_mod_store(v[u], P + 1024, P + (7 + ci) * 1024, P + (12 + ci) * 1024, H + (size_t)r * 1024, lane); }
    }
    __syncthreads();
}

__device__ __forceinline__ void phase_post(const Args& A, int l, int which, LAS unsigned char* lds, int lane, int wave) {
    const int gw = blockIdx.x * 8 + wave, NGW = gridDim.x * 8;
    const float* mod = (const float*)(A.ws + WS_MOD); bf16* H = (bf16*)(A.ws + WS_H); const bf16* MIX = (const bf16*)(A.ws + WS_MIX);
    const bool first = (l == 0 && which == 0), has_h = (which == 0) || (l < DEPTH - 1);
    LAS float* P = (LAS float*)lds;
    { const int t2 = (wave & 3) * 64 + lane, hv = wave >> 2;
      const int l2 = which == 0 ? l : l + 1;
      for (int v = hv; v < 17; v += 2) { const float* src;
          if (v == 0) src = (which == 0 ? A.g_post_mix : A.g_post_ffn) + l * 1024;
          else if (v == 1) src = which == 0 ? A.g_pre_ffn + l * 1024 : A.g_pre_mix + (l2 < DEPTH ? l2 : l) * 1024;
          else if (v < 7) src = mod + (size_t)(l * 5 + (v - 2)) * 6144 + (which == 0 ? 2048 : 5120);
          else if (v < 12) src = mod + (size_t)((l2 < DEPTH ? l2 : l) * 5 + (v - 7)) * 6144 + (which == 0 ? 4096 : 1024);
          else src = mod + (size_t)((l2 < DEPTH ? l2 : l) * 5 + (v - 12)) * 6144 + (which == 0 ? 3072 : 0);
          *(LAS f32x4*)(P + v * 1024 + 4 * t2) = *(const f32x4*)(src + 4 * t2); } }
    __syncthreads();
    for (int r0 = gw; r0 < NTOK; r0 += 2 * NGW) {
        f32x4 v[2][4], t[2][4];
#pragma unroll
        for (int u = 0; u < 2; ++u) { const int r = r0 + u * NGW;
            const float* xr = first ? x_in_row(A, r) : A.out + (size_t)r * 1024; const bf16* tr = MIX + (size_t)r * 1024;
#pragma unroll
            for (int j = 0; j < 4; ++j) { v[u][j] = *(const f32x4*)(xr + 4 * lane + 256 * j); t[u][j] = ld4bf(tr + 4 * lane + 256 * j); } }
#pragma unroll
        for (int u = 0; u < 2; ++u) { const int r = r0 + u * NGW; const LAS float* ga = P + (2 + cond_of_row(r)) * 1024;
            float ss = 0.f;
#pragma unroll
            for (int j = 0; j < 4; ++j) ss += sumsq4(t[u][j]);
            const float rstd = 1.0f / sqrtf(wave_sum(ss, lane) * (1.0f / 1024.0f) + EPS);
#pragma unroll
            for (int j = 0; j < 4; ++j) { const int idx = 4 * lane + 256 * j;
                const f32x4 gg = *(const LAS f32x4*)(P + idx), gv = *(const LAS f32x4*)(ga + idx);
                v[u][j] = v[u][j] + gv * (t[u][j] * rstd * gg);
                *(f32x4*)(A.out + (size_t)r * 1024 + idx) = v[u][j]; } }
        if (has_h) {
#pragma unroll
            for (int u = 0; u < 2; ++u) { const int r = r0 + u * NGW, ci = cond_of_row(r);
                norm_mod_store(v[u], P + 1024, P + (7 + ci) * 1024, P + (12 + ci) * 1024, H + (size_t)r * 1024, lane); } }
    }
    __syncthreads();
}

__device__ __forceinline__ void phase_split(const Args& A, int l, int lane, int wave) {
    const int gw = blockIdx.x * 8 + wave, NGW = gridDim.x * 8;
    unsigned char* ws = A.ws;
    const bf16* Z = (const bf16*)(ws + WS_Z);
    bf16* QN = (bf16*)(ws + WS_QN); bf16* CKVN = (bf16*)(ws + WS_CKVN); bf16* KRB = (bf16*)(ws + WS_KRB); bf16* UG = (bf16*)(ws + WS_UG); bf16* VN = (bf16*)(ws + WS_VN);
    bf16* CC = (bf16*)(ws + WS_CONCAT);
    const float* ropec = (const float*)(ws + WS_ROPE); const float* ropes = ropec + 32768;
    float* out_ckv = A.out + (size_t)NTOK * 1024; float* out_kr = out_ckv + (size_t)32 * 4 * 256 * 256;
    for (int idx = gw; idx < 2048; idx += NGW) { const int r = NTOK + idx, b = idx >> 9, j = idx & 511;
        const f32x4 cv = *(const f32x4*)(A.cache_ckv + ((size_t)(b * 4 + l) * 512 + j) * 256 + 4 * lane);
        const float kv = A.cache_krope[((size_t)(b * 4 + l) * 512 + j) * 64 + lane];
        *(u32x2*)(CKVN + (size_t)r * 256 + 4 * lane) = pk4(cv);
        KRB[(size_t)r * 64 + lane] = (bf16)(cvt_pk_bf16(kv, 0.f) & 0xffffu); }
    const f32x4 gkv = *(const f32x4*)(A.g_kv + l * 256 + 4 * lane), gvv = *(const f32x4*)(A.g_v + l * 256 + 4 * lane);
    const float* wcp = A.w_conv + (size_t)l * 3 * 256 + 4 * lane;
    const f32x4 wc0 = *(const f32x4*)(wcp), wc1 = *(const f32x4*)(wcp + 256), wc2 = *(const f32x4*)(wcp + 512);
    f32x2 gq[3];
#pragma unroll
    for (int j = 0; j < 3; ++j) gq[j] = *(const f32x2*)(A.g_q + l * 384 + 2 * lane + 128 * j);
    for (int r0 = gw; r0 < NTOK; r0 += 2 * NGW) {
        f32x2 q[2][3]; f32x4 cv[2], uu[2], vv[2], bg[2], zc[2], zm[2], zp[2]; float kr[2], cs[2], sn[2];
#pragma unroll
        for (int u = 0; u < 2; ++u) { const int r = r0 + u * NGW; const bf16* z = Z + (size_t)r * INC;
            const bool prompt = r < NTOK_P; const int n = prompt ? (r & 255) : ((r - NTOK_P) & 1023), len = prompt ? 256 : 1024;
#pragma unroll
            for (int j = 0; j < 3; ++j) q[u][j] = ld2bf(z + ZQ + 2 * lane + 128 * j);
            cv[u] = ld4bf(z + ZCKV + 4 * lane); kr[u] = ld1bf(z + ZKR + lane);
            uu[u] = ld4bf(z + ZU + 4 * lane); vv[u] = ld4bf(z + ZV + 4 * lane); bg[u] = ld4bf(z + ZBG + 4 * lane);
            zc[u] = ld4bf(z + ZCG + 4 * lane) * ld4bf(z + ZHH + 4 * lane);
            zm[u] = (f32x4){0.f, 0.f, 0.f, 0.f}; zp[u] = zm[u];
            if (n > 0) zm[u] = ld4bf(z - INC + ZCG + 4 * lane) * ld4bf(z - INC + ZHH + 4 * lane);
            if (n < len - 1) zp[u] = ld4bf(z + INC + ZCG + 4 * lane) * ld4bf(z + INC + ZHH + 4 * lane);
            cs[u] = 1.f; sn[u] = 0.f;
            if (!prompt) { const int a = lane >> 5, f = lane & 15; cs[u] = ropec[n * 32 + a * 16 + f]; sn[u] = ropes[n * 32 + a * 16 + f]; } }
#pragma unroll
        for (int u = 0; u < 2; ++u) { const int r = r0 + u * NGW; const bool prompt = r < NTOK_P; const int n = prompt ? (r & 255) : ((r - NTOK_P) & 1023);
            { float ss = 0.f;
#pragma unroll
              for (int j = 0; j < 3; ++j) ss += q[u][j].x * q[u][j].x + q[u][j].y * q[u][j].y;
              const float rstd = 1.0f / sqrtf(wave_sum(ss, lane) * (1.0f / 384.0f) + EPS);
#pragma unroll
              for (int j = 0; j < 3; ++j) *(unsigned*)(QN + (size_t)r * 384 + 2 * lane + 128 * j) = cvt_pk_bf16(q[u][j].x * rstd * gq[j].x, q[u][j].y * rstd * gq[j].y); }
            { const float rstd = 1.0f / sqrtf(wave_sum(sumsq4(cv[u]), lane) * (1.0f / 256.0f) + EPS);
              const f32x4 c2 = cv[u] * rstd * gkv;
              if (prompt) *(f32x4*)(out_ckv + ((size_t)((r >> 8) * 4 + l) * 256 + n) * 256 + 4 * lane) = c2;
              *(u32x2*)(CKVN + (size_t)r * 256 + 4 * lane) = pk4(c2); }
            { float k2 = kr[u];
              if (prompt) out_kr[((size_t)((r >> 8) * 4 + l) * 256 + n) * 64 + lane] = k2;
              else { const float partner = shx(k2, 16, lane); const int p = (lane >> 4) & 1;
                  k2 = p == 0 ? k2 * cs[u] - partner * sn[u] : partner * sn[u] + k2 * cs[u]; }
              KRB[(size_t)r * 64 + lane] = (bf16)(cvt_pk_bf16(k2, 0.f) & 0xffffu); }
            *(u32x2*)(UG + (size_t)r * 256 + 4 * lane) = pk4(gelu4(uu[u]));
            { f32x4 v = gelu4(vv[u]);
              const float rstd = 1.0f / sqrtf(wave_sum(sumsq4(v), lane) * (1.0f / 256.0f) + EPS);
              *(u32x2*)(VN + (size_t)r * 256 + 4 * lane) = pk4(v * rstd * gvv); }
            { const f32x4 y = zm[u] * wc0 + zc[u] * wc1 + zp[u] * wc2;
              *(u32x2*)(CC + (size_t)r * 1024 + 768 + 4 * lane) = pk4(bg[u] * y); }
        }
    }
}

#define MFMA32(a, b, c) __builtin_amdgcn_mfma_f32_32x32x16_bf16((a), (b), (c), 0, 0, 0)
constexpr int AT_KROW = 400, AT_VROW = 144, AT_KBYTES = 64 * AT_KROW, AT_STAGE = AT_KBYTES + 128 * AT_VROW;
__device__ __forceinline__ void attn_store_tile(const f32x16& ot, float inv, bf16* crow  , int t, int hh) {
#pragma unroll
    for (int g = 0; g < 4; ++g) { u32x2 w; w.x = cvt_pk_bf16(ot[4 * g] * inv, ot[4 * g + 1] * inv); w.y = cvt_pk_bf16(ot[4 * g + 2] * inv, ot[4 * g + 3] * inv);
        *(u32x2*)(crow + 32 * t + 8 * g + 4 * hh) = w; }
}

__device__ __forceinline__ void phase_mixer(const Args& A, int l, LAS unsigned char* lds, int lane_in, int wave) {
    unsigned char* ws = A.ws;
    const bf16* Q = (const bf16*)(ws + WS_Q); const bf16* KN = (const bf16*)(ws + WS_KNOPE); const bf16* KRB = (const bf16*)(ws + WS_KRB);
    const bf16* VTP = (const bf16*)(ws + WS_VTP); const bf16* VTS = (const bf16*)(ws + WS_VTS);
    const bf16* UG = (const bf16*)(ws + WS_UG); const bf16* VN = (const bf16*)(ws + WS_VN);
    bf16* CC = (bf16*)(ws + WS_CONCAT);
    for (int slot = 0; ; ++slot) {
        int it;
        if (gridDim.x == 256) {
            if (slot == 0) it = blockIdx.x; else if (slot == 1 && blockIdx.x >= 128 && blockIdx.x < 224) it = 256 + (int)blockIdx.x - 128; else break;
        } else { it = (int)blockIdx.x + slot * (int)gridDim.x; if (it >= 352) break; }
        int lane = lane_in; asm volatile("" : "+v"(lane));
        const int rho = lane & 31, hh = lane >> 5, tid = wave * 64 + lane;
        if (it < 256) {
            int h, q0, keys, nkeys, split, rowA, rowB; const bf16* vt;
            const bool heavy = it < 128;
            if (heavy) {
                const int xj = it >> 3, pr = 2 * (it & 7) + (xj >> 3), b = pr >> 2, qt = xj & 7; h = pr & 3;
                q0 = NTOK_P + b * 1024 + qt * 128 + (wave & 3) * 32; keys = 1536; nkeys = 1536; split = 512; rowA = NTOK + b * 512; rowB = NTOK_P + b * 1024;
                vt = VTS + (size_t)((b * 4 + h) * 128) * 1536; }
            else { const int i2 = it - 128, b = i2 >> 2; h = i2 & 3; q0 = b * 256 + wave * 32; keys = 256; nkeys = 256; split = 0; rowA = 0; rowB = b * 256;
                vt = VTP + (size_t)((b * 4 + h) * 128) * 256; }
            bf16x8 qf[12];
            { const bf16* qp = Q + (size_t)(q0 + rho) * 768 + h * 192 + 8 * hh;
#pragma unroll
              for (int ks = 0; ks < 12; ++ks) qf[ks] = *(const bf16x8*)(qp + 16 * ks); }
            f32x16 o[4];
#pragma unroll
            for (int t = 0; t < 4; ++t)
#pragma unroll
                for (int i = 0; i < 16; ++i) o[t][i] = 0.f;
            float m = -1e30f, lsum = 0.f;
            int kslot[2], kcol[2], vd[2], vc[2];
#pragma unroll
            for (int j = 0; j < 2; ++j) { const int c = tid + 512 * j, kap = c >> 4; kcol[j] = c & 15;
                kslot[j] = (kap & 32) + (kap & 3) + 4 * ((kap >> 4) & 1) + 8 * ((kap >> 2) & 3);
                vd[j] = c >> 3; vc[j] = c & 7; }
            const int rkap = tid >> 3, rc8 = tid & 7, rslot = (rkap & 32) + (rkap & 3) + 4 * ((rkap >> 4) & 1) + 8 * ((rkap >> 2) & 3);
            u32x4 sk[2], sr, sv[2];
#define AT_GLOAD(k0) do { const int rb_ = (k0) < split ? rowA + (k0) : rowB + ((k0) - split); \
                _Pragma("unroll") for (int j = 0; j < 2; ++j) sk[j] = *(const u32x4*)(KN + (size_t)(rb_ + ((tid + 512 * j) >> 4)) * 512 + h * 128 + kcol[j] * 8); \
                sr = *(const u32x4*)(KRB + (size_t)(rb_ + rkap) * 64 + rc8 * 8); \
                _Pragma("unroll") for (int j = 0; j < 2; ++j) sv[j] = *(const u32x4*)(vt + (size_t)vd[j] * keys + (k0) + vc[j] * 8); } while (0)
#define AT_SWRITE(buf) do { LAS unsigned char* sb_ = lds + (buf) * AT_STAGE; \
                _Pragma("unroll") for (int j = 0; j < 2; ++j) *(LAS u32x4*)(sb_ + kslot[j] * AT_KROW + kcol[j] * 16) = sk[j]; \
                *(LAS u32x4*)(sb_ + rslot * AT_KROW + 256 + rc8 * 16) = sr; \
                _Pragma("unroll") for (int j = 0; j < 2; ++j) *(LAS u32x4*)(sb_ + AT_KBYTES + vd[j] * AT_VROW + vc[j] * 16) = sv[j]; } while (0)
            const int ntile = nkeys >> 6;
            const int blk_lo = heavy ? (wave >> 2) : 0, blk_hi = heavy ? blk_lo + 1 : 2;
            AT_GLOAD(0); AT_SWRITE(0);
            __syncthreads();
            for (int tI = 0; tI < ntile; ++tI) {
                if (tI + 1 < ntile) AT_GLOAD((tI + 1) * 64);
                { const LAS unsigned char* sb = lds + (tI & 1) * AT_STAGE;
                for (int blk = blk_lo; blk < blk_hi; ++blk) {
                    const LAS unsigned char* kp = sb + (32 * blk + rho) * AT_KROW + hh * 16;
                    f32x16 sc, scb;
#pragma unroll
                    for (int i = 0; i < 16; ++i) { sc[i] = 0.f; scb[i] = 0.f; }
#pragma unroll
                    for (int ks = 0; ks < 12; ks += 2) { sc = MFMA32(*(const LAS bf16x8*)(kp + ks * 32), qf[ks], sc); scb = MFMA32(*(const LAS bf16x8*)(kp + ks * 32 + 32), qf[ks + 1], scb); }
                    sc = sc + scb;
                    float mx = sc[0];
#pragma unroll
                    for (int i = 1; i < 16; ++i) mx = fmaxf(mx, sc[i]);
                    mx = fmaxf(mx, shx(mx, 32, lane));
                    const float mn = fmaxf(m, mx), alpha = __builtin_amdgcn_exp2f(m - mn);
                    float ps = 0.f;
#pragma unroll
                    for (int i = 0; i < 16; ++i) { sc[i] = __builtin_amdgcn_exp2f(sc[i] - mn); ps += sc[i]; }
                    lsum = lsum * alpha + ps; m = mn;
#pragma unroll
                    for (int t = 0; t < 4; ++t) o[t] = o[t] * alpha;
                    bf16x8 pb[2];
#pragma unroll
                    for (int s2 = 0; s2 < 2; ++s2) { u32x4 w; w.x = cvt_pk_bf16(sc[8 * s2 + 0], sc[8 * s2 + 1]); w.y = cvt_pk_bf16(sc[8 * s2 + 2], sc[8 * s2 + 3]); w.z = cvt_pk_bf16(sc[8 * s2 + 4], sc[8 * s2 + 5]); w.w = cvt_pk_bf16(sc[8 * s2 + 6], sc[8 * s2 + 7]);
                        pb[s2] = __builtin_bit_cast(bf16x8, w); }
                    const LAS unsigned char* vp = sb + AT_KBYTES + rho * AT_VROW + (32 * blk + 16 * hh) * 2;
#pragma unroll
                    for (int t = 0; t < 4; ++t)
#pragma unroll
                        for (int s2 = 0; s2 < 2; ++s2) o[t] = MFMA32(*(const LAS bf16x8*)(vp + 32 * t * AT_VROW + 16 * s2), pb[s2], o[t]);
                }
                }
                if (tI + 1 < ntile) AT_SWRITE((tI + 1) & 1);
                __syncthreads();
            }
#undef AT_GLOAD
#undef AT_SWRITE
            lsum += shx(lsum, 32, lane);
            bf16* crow = CC + (size_t)(q0 + rho) * 1024 + h * 128;
            if (!heavy) { const float inv = 1.0f / lsum;
#pragma unroll
                for (int t = 0; t < 4; ++t) attn_store_tile(o[t], inv, crow, t, hh);
            } else {
                const int half = wave >> 2;
                LAS float* mine = (LAS float*)(lds + wave * 8704);
                LAS const float* theirs = (LAS const float*)(lds + (wave ^ 4) * 8704);
#pragma unroll
                for (int t2 = 0; t2 < 2; ++t2)
#pragma unroll
                    for (int i = 0; i < 16; ++i) mine[(t2 * 16 + i) * 64 + lane] = half == 0 ? o[2 + t2][i] : o[t2][i];
                if (hh == 0) { mine[2048 + rho] = m; mine[2080 + rho] = lsum; }
                __syncthreads();
                const float mp = theirs[2048 + rho], lp = theirs[2080 + rho];
                const float mg = fmaxf(m, mp), wo = __builtin_amdgcn_exp2f(m - mg), wp = __builtin_amdgcn_exp2f(mp - mg);
                const float inv = 1.0f / (wo * lsum + wp * lp);
#pragma unroll
                for (int t2 = 0; t2 < 2; ++t2) { f32x16 acc;
#pragma unroll
                    for (int i = 0; i < 16; ++i) acc[i] = wo * (half == 0 ? o[t2][i] : o[2 + t2][i]) + wp * theirs[(t2 * 16 + i) * 64 + lane];
                    attn_store_tile(acc, inv, crow, half * 2 + t2, hh); }
                __syncthreads();
            }
        } else {
            const int c = it - 256;
            LAS bf16* vnT = (LAS bf16*)lds;
#pragma unroll
            for (int pass = 0; pass < 8; ++pass) { const int u = wave + 8 * pass, qq = (u & 1) * 64 + lane, c8 = (u >> 1) * 8;
                const bf16x8 v = *(const bf16x8*)(VN + (size_t)(c * 128 + qq) * 256 + c8);
#pragma unroll
                for (int j = 0; j < 8; ++j) vnT[(c8 + j) * 136 + qq] = (bf16)v[j]; }
            __syncthreads();
            const int hd = wave & 3, ph = wave >> 2;
#pragma unroll
            for (int pp = 0; pp < 2; ++pp) { const int pt = 2 * ph + pp;
                f32x16 acc[2];
#pragma unroll
                for (int d = 0; d < 2; ++d)
#pragma unroll
                    for (int i = 0; i < 16; ++i) acc[d][i] = 0.f;
                const float* wrow = A.w_s + ((size_t)(l * 4 + hd) * 128 + 32 * pt + rho) * 128 + 8 * hh;
                f32x4 wv[16];
#pragma unroll
                for (int ks = 0; ks < 8; ++ks) { wv[2 * ks] = *(const f32x4*)(wrow + 16 * ks); wv[2 * ks + 1] = *(const f32x4*)(wrow + 16 * ks + 4); }
#pragma unroll
                for (int ks = 0; ks < 8; ++ks) { const f32x4 w0 = wv[2 * ks], w1 = wv[2 * ks + 1];
                    u32x4 w; w.x = cvt_pk_bf16(w0.x, w0.y); w.y = cvt_pk_bf16(w0.z, w0.w); w.z = cvt_pk_bf16(w1.x, w1.y); w.w = cvt_pk_bf16(w1.z, w1.w);
                    const bf16x8 af = __builtin_bit_cast(bf16x8, w);
#pragma unroll
                    for (int d = 0; d < 2; ++d) { const bf16x8 bfr = *(const LAS bf16x8*)(vnT + (hd * 64 + 32 * d + rho) * 136 + 16 * ks + 8 * hh); acc[d] = MFMA32(af, bfr, acc[d]); } }
                float bs[16]; bf16 ugv[2][16];
#pragma unroll
                for (int i = 0; i < 16; ++i) { const int p = 32 * pt + (i & 3) + 8 * (i >> 2) + 4 * hh; bs[i] = A.b_s[(l * 4 + hd) * 128 + p];
#pragma unroll
                    for (int d = 0; d < 2; ++d) ugv[d][i] = UG[((size_t)c * 128 + p) * 256 + hd * 64 + 32 * d + rho]; }
#pragma unroll
                for (int d = 0; d < 2; ++d) { const int col = hd * 64 + 32 * d + rho;
#pragma unroll
                    for (int i = 0; i < 16; ++i) { const int p = 32 * pt + (i & 3) + 8 * (i >> 2) + 4 * hh; const size_t row = (size_t)c * 128 + p;
                        const float mixed = acc[d][i] + bs[i];
                        const float ug = __uint_as_float((unsigned)ugv[d][i] << 16);
                        CC[row * 1024 + 512 + col] = (bf16)(cvt_pk_bf16(ug * mixed, 0.f) & 0xffffu); } }
            }
            __syncthreads();
        }
    }
}

__global__ void __launch_bounds__(512, 2) fwd_megakernel(Args A) {
    extern __shared__ __attribute__((aligned(16))) unsigned char smem[];
    LAS unsigned char* lds = (LAS unsigned char*)smem;
    const int wave0 = __builtin_amdgcn_readfirstlane((int)threadIdx.x >> 6);
    unsigned* const bar = (unsigned*)(A.ws + WS_BAR);
    volatile LAS unsigned* const barst = (volatile LAS unsigned*)(lds + LDS_BARST);
    const unsigned xcc = xb_xcc_id();
    if (wave0 == 0) { const int l0 = fresh_lane(); if (l0 < 2) barst[l0] = 0u; if (l0 == 0 && A.ph_hi - A.ph_lo > 1) (void)xb_add(&bar[XB_XCNT(xcc)], 1u); }
    __syncthreads();
    if (A.ph_lo < 0) cg::this_grid().sync();
    bool dup_done = false; (void)dup_done;
    for (int ph = A.ph_lo; ph < A.ph_hi; ++ph) {
        const int wave = wave0;
#define LANE fresh_lane()
#define TID (wave * 64 + fresh_lane())
        unsigned char* ws = A.ws; asm volatile("" : "+s"(ws));
        if (ph == 0) phase_prologue(A, lds, wave);
        else if (ph == 1) phase_pre(A, lds, LANE, wave);
        else {
            const int l = (ph - 2) / 9, k = (ph - 2) % 9;
            const int G = gridDim.x, bid = blockIdx.x;
            if (k == 0) {
                pg8::Gemm g{(const bf16*)(ws + WS_H), (const bf16*)(ws + WS_WIN) + (size_t)l * 2048 * 1024, NTOK, 2048, 1024}; pg8::StaticOrder S; S.init(NTOK, 2048, G, bid);
                EpiB16<0> E{(bf16*)(ws + WS_Z), INC, INC}; pg8::gemm_phase<EpiB16<0>, pg8::StaticOrder>(lds, g, S, E, TID);
            } else if (k == 1) phase_split(A, l, LANE, wave);
            else if (k == 2) {
                { pg8::Gemm g{(const bf16*)(ws + WS_QN), (const bf16*)(ws + WS_WUQ) + (size_t)l * 768 * 384, NTOK, 768, 384}; pg8::StaticOrder S; S.init(NTOK, 768, G, bid);
                  EpiQ E{(bf16*)(ws + WS_Q), (const float*)(ws + WS_ROPE), (const float*)(ws + WS_ROPE) + 32768}; pg8::gemm_phase<EpiQ, pg8::StaticOrder>(lds, g, S, E, TID); }
                                { pg8::Gemm g{(const bf16*)(ws + WS_CKVN), (const bf16*)(ws + WS_WUKV) + (size_t)l * 1024 * 256, NROWKV, 1024, 256}; pg8::StaticOrder S; S.init(NROWKV, 1024, G, (bid + G - 144 % G) % G);
                  EpiKV E{(bf16*)(ws + WS_KNOPE), (bf16*)(ws + WS_VTP), (bf16*)(ws + WS_VTS)}; pg8::gemm_phase<EpiKV, pg8::StaticOrder>(lds, g, S, E, TID); }
            } else if (k == 3) phase_mixer(A, l, lds, LANE, wave);
            else if (k == 4 || k == 7) {
                const bool o = (k == 4);
                pg8::Gemm g{(const bf16*)(ws + (o ? WS_CONCAT : WS_ACT)), o ? (const bf16*)(ws + WS_WOUT) + (size_t)l * 1024 * 1024 : (const bf16*)(ws + WS_WFF2) + (size_t)l * 1024 * 4096, NTOK, 1024, o ? 1024 : 4096};
                pg8::StaticOrder S; S.init(NTOK, 1024, G, bid);
                EpiB16<0> E{(bf16*)(ws + WS_MIX), 1024, 1024}; pg8::gemm_phase<EpiB16<0>, pg8::StaticOrder>(lds, g, S, E, TID);
                if (!o && l + 1 < DEPTH) { const int first = G > 192 ? 192 : 0;
                    if (bid >= first) convert_layer(A, lds, l + 1, (bid - first) * 8 + wave, (G - first) * 8, wave, LANE); }
            } else if (k == 5) phase_post(A, l, 0, lds, LANE, wave);
            else if (k == 6) {
                pg8::Gemm g{(const bf16*)(ws + WS_H), (const bf16*)(ws + WS_WFF1) + (size_t)l * 4096 * 1024, NTOK, 4096, 1024}; pg8::StaticOrder S; S.init(NTOK, 4096, G, bid);
                EpiB16<1> E{(bf16*)(ws + WS_ACT), 4096, 4096}; pg8::gemm_phase<EpiB16<1>, pg8::StaticOrder>(lds, g, S, E, TID);
            } else phase_post(A, l, 1, lds, LANE, wave);
        }
        if (ph + 1 < A.ph_hi) xcd_barrier(bar, xcc, barst, wave == 0 && fresh_lane() == 0);
#if PROBE_DUP >= 0
        {
            bool again = false;
            if (PROBE_DUP == 100) { if (ph + 1 < A.ph_hi) xcd_barrier(bar, xcc, barst, wave == 0 && fresh_lane() == 0); }
            else if (!dup_done) {
                const int kk = ph >= 2 ? (ph - 2) % 9 : -1;
                if (PROBE_DUP == 50) again = (ph == 0);
                else if (PROBE_DUP == 60) again = (kk == 0 || kk == 2 || kk == 4 || kk == 6 || kk == 7);
                else again = (kk == PROBE_DUP);
            }
            if (again) { dup_done = true; --ph; } else dup_done = false;
        }
#endif
    }
}

constexpr int N_PHASES = 2 + 9 * DEPTH;

extern "C" void kernel_launch(void* const* d_in, const int* in_sizes, int n_in, void* d_out, int out_size, void* d_ws, size_t ws_size, hipStream_t stream) {
    static int grid = 0;
    if (grid == 0) {
        if (n_in != 24 || ws_size < WS_END || in_sizes[9] != DEPTH * 1024 * INC) { fprintf(stderr, "kernel_launch: unexpected problem (n_in %d, ws %zu, w_in %d)\n", n_in, ws_size, n_in > 9 ? in_sizes[9] : -1); grid = -1; return; }
        int dev = 0, cus = 0, per_cu = 0;
        hipGetDevice(&dev); hipDeviceGetAttribute(&cus, hipDeviceAttributeMultiprocessorCount, dev);
        if (hipFuncSetAttribute((const void*)fwd_megakernel, hipFuncAttributeMaxDynamicSharedMemorySize, LDS_BYTES) != hipSuccess) { fprintf(stderr, "kernel_launch: hipFuncSetAttribute failed\n"); grid = -1; return; }
        if (hipOccupancyMaxActiveBlocksPerMultiprocessor(&per_cu, (const void*)fwd_megakernel, 512, LDS_BYTES) != hipSuccess || per_cu < 1) { fprintf(stderr, "kernel_launch: occupancy query says %d\n", per_cu); per_cu = 1; }
        (void)hipGetLastError();
        grid = cus * 1;
        fprintf(stderr, "kernel_launch: grid %d (cus %d, per_cu %d)\n", grid, cus, per_cu);
    }
    if (grid < 0) return;
    if (hipMemsetAsync((char*)d_ws + WS_BAR, 0, 16384, stream) != hipSuccess) { fprintf(stderr, "kernel_launch: memset failed\n"); return; }
    Args a{};
    const float** ap = (const float**)&a;
    for (int i = 0; i < 24; ++i) ap[i] = (const float*)d_in[i];
    a.out = (float*)d_out; a.ws = (unsigned char*)d_ws;
#if MK_PER_PHASE
    for (int ph = 0; ph < N_PHASES; ++ph) { a.ph_lo = ph; a.ph_hi = ph + 1; hipLaunchKernelGGL(fwd_megakernel, dim3(grid), dim3(512), LDS_BYTES, stream, a); }
#else
    a.ph_lo = 0; a.ph_hi = N_PHASES;
    void* args[] = {&a};
    hipError_t e = hipLaunchCooperativeKernel((const void*)fwd_megakernel, dim3(grid), dim3(512), args, LDS_BYTES, stream);
    if (e != hipSuccess) fprintf(stderr, "kernel_launch: cooperative launch failed: %s (grid %d)\n", hipGetErrorString(e), grid);
#endif
}
```

```cpp
#include <hip/hip_runtime.h>
#include <hip/hip_cooperative_groups.h>
#include <cstdio>
namespace cg = cooperative_groups;

#ifndef MK_PER_PHASE
#define MK_PER_PHASE 0
#endif

#ifndef PROBE_DUP
#define PROBE_DUP -1
#endif
#define LAS __attribute__((address_space(3)))
typedef unsigned short bf16;
typedef short bf16x8 __attribute__((ext_vector_type(8)));
typedef float f32x2 __attribute__((ext_vector_type(2)));
typedef float f32x4 __attribute__((ext_vector_type(4)));
typedef float f32x16 __attribute__((ext_vector_type(16)));
typedef unsigned u32x2 __attribute__((ext_vector_type(2)));
typedef unsigned u32x4 __attribute__((ext_vector_type(4)));

constexpr int DM = 1024, NTOK_P = 8192, NTOK_S = 4096, NTOK = 12288, NROWKV = 14336;
constexpr int DEPTH = 4, INC = 1984, DFF = 4096;
constexpr int ZQ = 0, ZCKV = 384, ZKR = 640, ZU = 704, ZV = 960, ZBG = 1216, ZCG = 1472, ZHH = 1728;
constexpr float EPS = 1e-6f;
constexpr float QSCALE = 0.07216878364870322f * 1.4426950408889634f;

constexpr size_t MiB = 1u << 20;
constexpr size_t WS_MOD = 0, WS_BAR = 512 * 1024, WS_ROPE = 1 * MiB, WS_WIN = 2 * MiB, WS_WUQ = 18 * MiB, WS_WUKV = 21 * MiB, WS_WOUT = 23 * MiB,
                 WS_WFF1 = 31 * MiB, WS_WFF2 = 63 * MiB, WS_H = 95 * MiB, WS_MIX = 119 * MiB, WS_CONCAT = 167 * MiB, WS_QN = 191 * MiB,
                 WS_CKVN = 200 * MiB, WS_KRB = 207 * MiB, WS_UG = 209 * MiB, WS_VN = 215 * MiB, WS_Q = 221 * MiB, WS_KNOPE = 239 * MiB,
                 WS_VTP = 253 * MiB, WS_VTS = 261 * MiB, WS_Z = 267 * MiB, WS_ACT = 267 * MiB, WS_END = 363 * MiB;
constexpr int LDS_BYTES = 147456, LDS_BARST = LDS_BYTES - 64;

__device__ __forceinline__ unsigned cvt_pk_bf16(float lo, float hi) { unsigned r; asm volatile("v_cvt_pk_bf16_f32 %0, %1, %2" : "=v"(r) : "v"(lo), "v"(hi)); return r; }
__device__ __forceinline__ int fresh_lane() { int l; asm volatile("v_mbcnt_lo_u32_b32 %0, -1, 0\n\tv_mbcnt_hi_u32_b32 %0, -1, %0" : "=v"(l)); return l; }
__device__ __forceinline__ float shx(float v, int mask, int lane) { return __int_as_float(__builtin_amdgcn_ds_bpermute((lane ^ mask) << 2, __float_as_int(v))); }
__device__ __forceinline__ float dpp_add(float v, const int ctrl_is) {
    return v; }
#define DPP_ADD(v, ctrl) ((v) + __int_as_float(__builtin_amdgcn_update_dpp(0, __float_as_int(v), (ctrl), 0xf, 0xf, true)))
__device__ __forceinline__ float wave_sum(float v, int lane) {
    (void)lane;
    v = DPP_ADD(v, 0xB1);
    v = DPP_ADD(v, 0x4E);
    v = DPP_ADD(v, 0x141);
    v = DPP_ADD(v, 0x140);
    const int vi = __float_as_int(v);
    return (__int_as_float(__builtin_amdgcn_readlane(vi, 0)) + __int_as_float(__builtin_amdgcn_readlane(vi, 16))) + (__int_as_float(__builtin_amdgcn_readlane(vi, 32)) + __int_as_float(__builtin_amdgcn_readlane(vi, 48)));
}
__device__ __forceinline__ float gelu_tanh(float x) { const float y = 0.7978845608028654f * (x + 0.044715f * x * x * x); return x / (1.0f + __expf(-2.0f * y)); }
__device__ __forceinline__ f32x4 gelu4(f32x4 v) { return (f32x4){gelu_tanh(v.x), gelu_tanh(v.y), gelu_tanh(v.z), gelu_tanh(v.w)}; }
__device__ __forceinline__ float sumsq4(f32x4 v) { return (v.x * v.x + v.y * v.y) + (v.z * v.z + v.w * v.w); }
__device__ __forceinline__ f32x4 ld4bf(const bf16* p) { const u32x2 w = *(const u32x2*)p; return (f32x4){__uint_as_float(w.x << 16), __uint_as_float(w.x & 0xffff0000u), __uint_as_float(w.y << 16), __uint_as_float(w.y & 0xffff0000u)}; }
__device__ __forceinline__ f32x2 ld2bf(const bf16* p) { const unsigned w = *(const unsigned*)p; return (f32x2){__uint_as_float(w << 16), __uint_as_float(w & 0xffff0000u)}; }
__device__ __forceinline__ float ld1bf(const bf16* p) { return __uint_as_float((unsigned)*p << 16); }
__device__ __forceinline__ u32x2 pk4(f32x4 v) { u32x2 w; w.x = cvt_pk_bf16(v.x, v.y); w.y = cvt_pk_bf16(v.z, v.w); return w; }


#define XB_TMO      128
#define XB_XCNT(j)  (256  + 64 * (j))
#define XB_XSUB(j)  (1280 + 64 * (j))
#define XB_XGEN(j)  (2304 + 64 * (j))
#define XB_TOP      3328
#define XB_TOPGEN   3392
#define XCD_BAR_WORDS 3456
#define XB_SPIN_CAP (1u << 18)
__device__ __forceinline__ unsigned xb_ld(unsigned* p)              { return __hip_atomic_load(p, __ATOMIC_RELAXED, __HIP_MEMORY_SCOPE_AGENT); }
__device__ __forceinline__ unsigned xb_add(unsigned* p, unsigned v) { return __hip_atomic_fetch_add(p, v, __ATOMIC_RELAXED, __HIP_MEMORY_SCOPE_AGENT); }
__device__ __forceinline__ unsigned xb_xcc_id() { return (unsigned)__builtin_amdgcn_s_getreg((3 << 11) | 20) & 0xFu; }
#define XB_SPIN(cond, bar) do { unsigned _sp = 0; while (cond) { __builtin_amdgcn_s_sleep(1); \
    if ((++_sp & 255u) == 0u) { if (xb_ld(&(bar)[XB_TMO])) break; if (_sp > XB_SPIN_CAP) { atomicAdd(&(bar)[XB_TMO], 1u); break; } } } } while (0)
__device__ __forceinline__ void xcd_barrier_complete(unsigned* bar, unsigned x, unsigned& nloc, unsigned& nx) {
    const unsigned G = gridDim.x * gridDim.y * gridDim.z;
    unsigned sum, cnt, mine, sp = 0u;
    for (;;) {
        sum = 0u; cnt = 0u; mine = 0u;
#pragma unroll
        for (unsigned j = 0; j < 16; ++j) { const unsigned c = xb_ld(&bar[XB_XCNT(j)]); sum += c; cnt += (c > 0u) ? 1u : 0u; mine = (j == x) ? c : mine; }
        if (sum == G) break;
        __builtin_amdgcn_s_sleep(1);
        if ((++sp & 255u) == 0u) { if (xb_ld(&bar[XB_TMO])) break; if (sp > XB_SPIN_CAP) { atomicAdd(&bar[XB_TMO], 1u); break; } }
    }
    nloc = mine > 0u ? mine : 1u; nx = cnt > 0u ? cnt : 1u;
}
__device__ __forceinline__ void xcd_barrier(unsigned* bar, unsigned x, volatile LAS unsigned* st, bool leader) {
    asm volatile("s_waitcnt vmcnt(0)" ::: "memory");
    __syncthreads();
    if (leader) {
        __builtin_amdgcn_s_waitcnt(0);
        unsigned nloc = st[0], nx = st[1];
        if (nloc == 0u) { xcd_barrier_complete(bar, x, nloc, nx); st[0] = nloc; st[1] = nx; }
        const unsigned old = xb_add(&bar[XB_XSUB(x)], 1u);
        const unsigned gen = old / nloc;
        if (old + 1u == (gen + 1u) * nloc) {
            __builtin_amdgcn_fence(__ATOMIC_RELEASE, "agent");
            asm volatile("s_waitcnt vmcnt(0)" ::: "memory");
            const unsigned og = xb_add(&bar[XB_TOP], 1u);
            const unsigned tg = og / nx;
            if (og + 1u == (tg + 1u) * nx) xb_add(&bar[XB_TOPGEN], 1u);
            else XB_SPIN(xb_ld(&bar[XB_TOPGEN]) == tg, bar);
            __builtin_amdgcn_fence(__ATOMIC_ACQUIRE, "agent");
            xb_add(&bar[XB_XGEN(x)], 1u);
            asm volatile("s_waitcnt vmcnt(0)" ::: "memory");
        } else {
            XB_SPIN(xb_ld(&bar[XB_XGEN(x)]) == gen, bar);
            __builtin_amdgcn_fence(__ATOMIC_ACQUIRE, "agent");
            asm volatile("s_waitcnt vmcnt(0)" ::: "memory");
        }
    }
    __syncthreads();
}

namespace pg8 {
#define PG8_LAS __attribute__((address_space(3)))
typedef unsigned short bf16_t;
constexpr int BM = 256, BK = 64, HALF = 128, HTB = HALF * BK * 2, STAGE_BYTES = 8 * HTB, NXCD = 8, WGM = 8;
__host__ __device__ __forceinline__ int lds_byte(int r, int c) { const int st = (r >> 4) * 2 + (c >> 5), rr = r & 15, cc = c & 31, ob = rr * 64 + cc * 2; return st * 1024 + (ob ^ (((ob >> 9) & 1) << 5)); }
__host__ __device__ __forceinline__ void stage_rc(int b, int& R, int& C) { const int st = b / 1024, sb = b % 1024, swz = sb ^ (((sb >> 9) & 1) << 5); R = (st >> 1) * 16 + swz / 64; C = (st & 1) * 32 + (swz % 64) / 2; }
__host__ __device__ __forceinline__ int perm32(int rho) { const int n = rho >> 4, i = rho & 15; return 8 * (i >> 2) + 4 * n + (i & 3); }
struct Unit { int pm, pn; };
struct Gemm { const bf16_t* A; const bf16_t* Bt; int M, N, K; };
struct StaticOrder {
    int nM, nN, nwg, G, c;
    __host__ __device__ void init(int M, int N, int G_, int c_) { nM = M / BM; nN = N / BM; nwg = nM * nN; G = G_; c = c_; }
    __host__ __device__ bool next(int i, Unit& u) const {
        const long L = (long)i * G + c; if (L >= nwg) return false;
        int wgid = (int)L; { const int q = nwg / NXCD, r = nwg % NXCD, xcd = wgid % NXCD, off = wgid / NXCD; wgid = (xcd < r ? xcd * (q + 1) : r * (q + 1) + (xcd - r) * q) + off; }
        const int nig = WGM * nN, gid = wgid / nig, fm = gid * WGM, gsz = (nM - fm) < WGM ? (nM - fm) : WGM;
        u.pm = fm + ((wgid % nig) % gsz); u.pn = (wgid % nig) / gsz; return true;
    }
    __device__ __forceinline__ void a_ready(const Unit&) const {}
    __device__ __forceinline__ void done(const Unit&) const {}
};

template <class Epi, class Sched, bool SP2>
__device__ __forceinline__ void gemm_phase(PG8_LAS unsigned char* lds, const Gemm g, const Sched& S, const Epi& E, const int tid) {
    const int wid = __builtin_amdgcn_readfirstlane(tid >> 6), lane = tid & 63, wr = wid >> 2, wc = wid & 3, fr = lane & 15, fq = lane >> 4;
    const int K = g.K, nt = K / BK;
    unsigned voffA[2], voffB[2];
#pragma unroll
    for (int i = 0; i < 2; ++i) { int R, C; stage_rc(tid * 16 + i * 8192, R, C); const int Rb = Epi::PERM ? ((R & ~31) + perm32(R & 31)) : R;
        voffA[i] = (unsigned)(R * K + C) * 2u; voffB[i] = (unsigned)(Rb * K + C) * 2u; }
    const size_t kstep = (size_t)(BK * 2);
    const size_t hstep = (size_t)HALF * K * 2;
    const size_t tstep = 2 * hstep;
    const unsigned ldsw = (unsigned)wid * 1024u;
    const int aoff = lds_byte(wr * 64 + fr, fq * 8), boff = lds_byte(wc * 32 + fr, fq * 8);
#define PG8_SA(b, h) (((b) * 2 + (h)) * HTB)
#define PG8_SB(b, h) ((4 + (b) * 2 + (h)) * HTB)
#define PG8_STAGE(bufoff, gbase, voff) do { _Pragma("unroll") for (int _i = 0; _i < 2; ++_i) \
        __builtin_amdgcn_global_load_lds((const unsigned*)((const char*)(gbase) + (voff)[_i]), (PG8_LAS unsigned*)(lds + (bufoff) + ldsw + _i * 8192), 16, 0, 0); } while (0)
#define PG8_LDA(dst, b, h) do { _Pragma("unroll") for (int m = 0; m < 4; ++m) _Pragma("unroll") for (int k = 0; k < 2; ++k) dst[m][k] = *(const PG8_LAS bf16x8*)(lds + PG8_SA(b, h) + aoff + m * 2048 + k * 1024); } while (0)
#define PG8_LDB(dst, b, h) do { _Pragma("unroll") for (int n = 0; n < 2; ++n) _Pragma("unroll") for (int k = 0; k < 2; ++k) dst[n][k] = *(const PG8_LAS bf16x8*)(lds + PG8_SB(b, h) + boff + n * 2048 + k * 1024); } while (0)
#define PG8_MMA(ai, bj, At, Bt) do { __builtin_amdgcn_s_setprio(1); _Pragma("unroll") for (int m = 0; m < 4; ++m) _Pragma("unroll") for (int n = 0; n < 2; ++n) _Pragma("unroll") for (int k = 0; k < 2; ++k) \
        acc[ai][bj][m][n] = __builtin_amdgcn_mfma_f32_16x16x32_bf16(Bt[n][k], At[m][k], acc[ai][bj][m][n], 0, 0, 0); __builtin_amdgcn_s_setprio(0); } while (0)
#define PG8_WAIT_V(n) asm volatile("s_waitcnt vmcnt(" #n ")" ::: "memory")
#define PG8_WAIT_L(n) asm volatile("s_waitcnt lgkmcnt(" #n ")" ::: "memory")
#define PG8_BAR __builtin_amdgcn_s_barrier()
#define PG8_SCHED __builtin_amdgcn_sched_barrier(0)
    Unit cur, nxt; int ui = 0;
    if (!S.next(0, cur)) return;
    f32x4 acc[2][2][4][2];
#pragma unroll
    for (int a = 0; a < 2; ++a)
#pragma unroll
        for (int b = 0; b < 2; ++b)
#pragma unroll
            for (int m = 0; m < 4; ++m)
#pragma unroll
                for (int n = 0; n < 2; ++n) acc[a][b][m][n] = (f32x4){0.f, 0.f, 0.f, 0.f};
    bf16x8 At[4][2], B0[2][2], B1[2][2];
    const char* cA = (const char*)g.A + (size_t)cur.pm * tstep; const char* cB = (const char*)g.Bt + (size_t)cur.pn * tstep;
    S.a_ready(cur);
    if constexpr (SP2) {
    PG8_STAGE(PG8_SB(0, 0), cB, voffB); PG8_STAGE(PG8_SB(0, 1), cB + hstep, voffB); PG8_STAGE(PG8_SA(0, 0), cA, voffA); PG8_STAGE(PG8_SA(0, 1), cA + hstep, voffA);
    if (wr == 1) PG8_BAR;
    PG8_WAIT_V(2); PG8_BAR;
    PG8_STAGE(PG8_SB(1, 0), cB + kstep, voffB); PG8_STAGE(PG8_SA(1, 0), cA + kstep, voffA); PG8_STAGE(PG8_SB(1, 1), cB + hstep + kstep, voffB);
    PG8_WAIT_V(6); PG8_BAR;
    } else {
    PG8_STAGE(PG8_SB(0, 0), cB, voffB); PG8_STAGE(PG8_SA(0, 0), cA, voffA); PG8_STAGE(PG8_SB(0, 1), cB + hstep, voffB); PG8_STAGE(PG8_SA(0, 1), cA + hstep, voffA);
    if (wr == 1) PG8_BAR;
    PG8_WAIT_V(4); PG8_BAR;
    PG8_STAGE(PG8_SB(1, 0), cB + kstep, voffB); PG8_STAGE(PG8_SA(1, 0), cA + kstep, voffA); PG8_STAGE(PG8_SB(1, 1), cB + hstep + kstep, voffB);
    PG8_WAIT_V(6); PG8_BAR;
    }
    for (;;) {
        const bool has_next = S.next(ui + 1, nxt);
        const char* nA = has_next ? (const char*)g.A + (size_t)nxt.pm * tstep : cA; const char* nB = has_next ? (const char*)g.Bt + (size_t)nxt.pn * tstep : cB;
        for (int t = 0; t < nt; t += 2) {
            const bool last = (t == nt - 2);
            const char* a1 = cA + (size_t)(t + 1) * kstep;
            const char* a2 = last ? nA : cA + (size_t)(t + 2) * kstep; const char* b2 = last ? nB : cB + (size_t)(t + 2) * kstep;
            const char* a3 = a2 + kstep; const char* b3 = b2 + kstep;
            if (last && has_next) S.a_ready(nxt);
            if constexpr (SP2) {
            PG8_LDB(B0, 0, 0); PG8_LDB(B1, 0, 1); PG8_SCHED; PG8_LDA(At, 0, 0); PG8_STAGE(PG8_SA(1, 1), a1 + hstep, voffA);
            PG8_WAIT_V(8); PG8_WAIT_L(0); PG8_BAR; PG8_MMA(0, 0, At, B0); PG8_MMA(0, 1, At, B1); PG8_BAR; PG8_SCHED;
            PG8_LDA(At, 0, 1); PG8_STAGE(PG8_SB(0, 0), b2, voffB); PG8_STAGE(PG8_SB(0, 1), b2 + hstep, voffB); PG8_STAGE(PG8_SA(0, 0), a2, voffA);
            PG8_WAIT_V(8); PG8_WAIT_L(0); PG8_BAR; PG8_MMA(1, 0, At, B0); PG8_MMA(1, 1, At, B1); PG8_BAR; PG8_SCHED;
            PG8_LDB(B0, 1, 0); PG8_LDB(B1, 1, 1); PG8_SCHED; PG8_LDA(At, 1, 0); PG8_STAGE(PG8_SA(0, 1), a2 + hstep, voffA);
            PG8_WAIT_V(8); PG8_WAIT_L(0); PG8_BAR; PG8_MMA(0, 0, At, B0); PG8_MMA(0, 1, At, B1); PG8_BAR; PG8_SCHED;
            PG8_LDA(At, 1, 1); PG8_STAGE(PG8_SB(1, 0), b3, voffB); PG8_STAGE(PG8_SB(1, 1), b3 + hstep, voffB); PG8_STAGE(PG8_SA(1, 0), a3, voffA);
            PG8_WAIT_V(8); PG8_WAIT_L(0); PG8_BAR; PG8_MMA(1, 0, At, B0); PG8_MMA(1, 1, At, B1); PG8_BAR; PG8_SCHED;
            } else {
            PG8_LDB(B0, 0, 0); PG8_SCHED; PG8_LDA(At, 0, 0); PG8_STAGE(PG8_SA(1, 1), a1 + hstep, voffA);
            PG8_WAIT_L(8); PG8_BAR; PG8_WAIT_L(0); PG8_MMA(0, 0, At, B0); PG8_BAR; PG8_SCHED;
            PG8_LDB(B1, 0, 1); PG8_STAGE(PG8_SB(0, 0), b2, voffB);
            PG8_BAR; PG8_WAIT_L(0); PG8_MMA(0, 1, At, B1); PG8_BAR;
            PG8_LDA(At, 0, 1); PG8_STAGE(PG8_SA(0, 0), a2, voffA);
            PG8_BAR; PG8_WAIT_L(0); PG8_MMA(1, 0, At, B0); PG8_BAR; PG8_SCHED;
            PG8_STAGE(PG8_SB(0, 1), b2 + hstep, voffB);
            PG8_WAIT_V(6); PG8_BAR; PG8_MMA(1, 1, At, B1); PG8_BAR;
            PG8_LDB(B0, 1, 0); PG8_SCHED; PG8_LDA(At, 1, 0); PG8_STAGE(PG8_SA(0, 1), a2 + hstep, voffA);
            PG8_WAIT_L(8); PG8_BAR; PG8_WAIT_L(0); PG8_MMA(0, 0, At, B0); PG8_BAR; PG8_SCHED;
            PG8_LDB(B1, 1, 1); PG8_STAGE(PG8_SB(1, 0), b3, voffB);
            PG8_BAR; PG8_WAIT_L(0); PG8_MMA(0, 1, At, B1); PG8_BAR;
            PG8_LDA(At, 1, 1); PG8_STAGE(PG8_SA(1, 0), a3, voffA);
            PG8_BAR; PG8_WAIT_L(0); PG8_MMA(1, 0, At, B0); PG8_BAR; PG8_SCHED;
            PG8_STAGE(PG8_SB(1, 1), b3 + hstep, voffB);
            PG8_WAIT_V(6); PG8_BAR; PG8_MMA(1, 1, At, B1); PG8_BAR;
            }
        }
        if (wr == 0) PG8_BAR;
        E(acc, cur, wr, wc, fr, fq); S.done(cur);
        if (!has_next) break;
#pragma unroll
        for (int a = 0; a < 2; ++a)
#pragma unroll
            for (int b = 0; b < 2; ++b)
#pragma unroll
                for (int m = 0; m < 4; ++m)
#pragma unroll
                    for (int n = 0; n < 2; ++n) acc[a][b][m][n] = (f32x4){0.f, 0.f, 0.f, 0.f};
        cur = nxt; cA = nA; cB = nB; ++ui;
        if (wr == 1) PG8_BAR;
    }
    PG8_WAIT_V(0);
    PG8_BAR;
#undef PG8_SA
#undef PG8_SB
#undef PG8_STAGE
#undef PG8_LDA
#undef PG8_LDB
#undef PG8_MMA
#undef PG8_WAIT_V
#undef PG8_WAIT_L
#undef PG8_BAR
#undef PG8_SCHED
}
}

struct EpiF32 {
    static constexpr bool PERM = false;
    float* C; int ldc; int ncols;
    __device__ __forceinline__ void operator()(const f32x4 (&acc)[2][2][4][2], const pg8::Unit& u, int wr, int wc, int fr, int fq) const {
        const int row0 = u.pm * 256 + wr * 64 + fr, col0 = u.pn * 256 + wc * 32 + 4 * fq;
#pragma unroll
        for (int ai = 0; ai < 2; ++ai)
#pragma unroll
            for (int m = 0; m < 4; ++m) { float* rowp = C + (size_t)(row0 + ai * 128 + m * 16) * ldc + col0;
#pragma unroll
                for (int bj = 0; bj < 2; ++bj)
#pragma unroll
                    for (int n = 0; n < 2; ++n) if (col0 + bj * 128 + n * 16 < ncols) *(f32x4*)(rowp + bj * 128 + n * 16) = acc[ai][bj][m][n]; }
    }
};
template <int ACT> struct EpiB16 {
    static constexpr bool PERM = true;
    bf16* O; int ldc; int ncols;
    __device__ __forceinline__ void operator()(const f32x4 (&acc)[2][2][4][2], const pg8::Unit& u, int wr, int wc, int fr, int fq) const {
        const int row0 = u.pm * 256 + wr * 64 + fr, col0 = u.pn * 256 + wc * 32 + 8 * fq;
#pragma unroll
        for (int ai = 0; ai < 2; ++ai)
#pragma unroll
            for (int m = 0; m < 4; ++m) { bf16* rowp = O + (size_t)(row0 + ai * 128 + m * 16) * ldc + col0;
#pragma unroll
                for (int bj = 0; bj < 2; ++bj) { f32x4 v0 = acc[ai][bj][m][0], v1 = acc[ai][bj][m][1];
                    if (col0 + bj * 128 >= ncols) continue;
                    if (ACT) {
#pragma unroll
                    for (int j = 0; j < 4; ++j) { const float a = fmaxf(v0[j], 0.f), b = fmaxf(v1[j], 0.f); v0[j] = a * a; v1[j] = b * b; } }
                    u32x4 w; w.x = cvt_pk_bf16(v0[0], v0[1]); w.y = cvt_pk_bf16(v0[2], v0[3]); w.z = cvt_pk_bf16(v1[0], v1[1]); w.w = cvt_pk_bf16(v1[2], v1[3]);
                    *(u32x4*)(rowp + bj * 128) = w; } }
    }
};
struct EpiQ {
    static constexpr bool PERM = false;
    bf16* Q; const float* ropec; const float* ropes;
    __device__ __forceinline__ void operator()(const f32x4 (&acc)[2][2][4][2], const pg8::Unit& u, int wr, int wc, int, int) const {
        const int ln = fresh_lane(), fr = ln & 15, fq = ln >> 4;
        const int row0 = u.pm * 256 + wr * 64 + fr; const bool sample = u.pm >= 32;
#pragma unroll
        for (int bj = 0; bj < 2; ++bj) {
            const int g0 = u.pn * 256 + bj * 128 + wc * 32, within0 = g0 % 192; const bool isrope = within0 >= 128; const int a = (within0 - 128) >> 5;
#pragma unroll
            for (int ai = 0; ai < 2; ++ai)
#pragma unroll
                for (int m = 0; m < 4; ++m) { const int row = row0 + ai * 128 + m * 16;
                    f32x4 x1 = acc[ai][bj][m][0], x2 = acc[ai][bj][m][1];
                    if (sample && isrope) { const int ntok = (row - NTOK_P) & 1023;
                        const f32x4 cs = *(const f32x4*)(ropec + ntok * 32 + a * 16 + 4 * fq), sn = *(const f32x4*)(ropes + ntok * 32 + a * 16 + 4 * fq);
                        const f32x4 o1 = x1 * cs - x2 * sn, o2 = x1 * sn + x2 * cs; x1 = o1; x2 = o2; }
                    x1 = x1 * QSCALE; x2 = x2 * QSCALE;
                    bf16* p = Q + (size_t)row * 768 + g0 + 4 * fq;
                    *(u32x2*)p = pk4(x1); *(u32x2*)(p + 16) = pk4(x2); asm volatile("" ::: "memory"); }
        }
    }
};
struct EpiKV {
    static constexpr bool PERM = false;
    bf16* KN; bf16* VTP; bf16* VTS;
    __device__ __forceinline__ void operator()(const f32x4 (&acc)[2][2][4][2], const pg8::Unit& u, int wr, int wc, int, int) const {
        const int ln = fresh_lane(), fr = ln & 15, fq = ln >> 4;
        const int h = u.pn, pm = u.pm;
        bf16* vt; int keys, keybase;
        if (pm < 32) { vt = VTP + (size_t)((pm * 4 + h) * 128) * 256; keys = 256; keybase = 0; }
        else if (pm < 48) { const int b = (pm - 32) >> 2; vt = VTS + (size_t)((b * 4 + h) * 128) * 1536; keys = 1536; keybase = 512 + ((pm - 32) & 3) * 256; }
        else { const int b = (pm - 48) >> 1; vt = VTS + (size_t)((b * 4 + h) * 128) * 1536; keys = 1536; keybase = ((pm - 48) & 1) * 256; }
#pragma unroll
        for (int ai = 0; ai < 2; ++ai)
#pragma unroll
            for (int m = 0; m < 4; ++m) { const int rloc = wr * 64 + fr + ai * 128 + m * 16;
                bf16* kp = KN + (size_t)(pm * 256 + rloc) * 512 + h * 128 + wc * 32 + 4 * fq;
#pragma unroll
                for (int n = 0; n < 2; ++n) *(u32x2*)(kp + 16 * n) = pk4(acc[ai][0][m][n]);
#pragma unroll
                for (int n = 0; n < 2; ++n) { const f32x4 v = acc[ai][1][m][n]; const u32x2 w = pk4(v);
                    bf16* vp = vt + (size_t)(wc * 32 + 16 * n + 4 * fq) * keys + keybase + rloc;
                    vp[0] = (bf16)(w.x & 0xffffu); vp[keys] = (bf16)(w.x >> 16); vp[2 * keys] = (bf16)(w.y & 0xffffu); vp[3 * keys] = (bf16)(w.y >> 16); }
                asm volatile("" ::: "memory");
            }
    }
};

struct Args {
    const float *x_prompt, *x_sample, *cache_ckv, *cache_krope, *c, *c_ctx, *w_ada, *b_ada, *g_pre_mix, *w_in, *g_q, *w_uq, *g_kv, *w_ukv,
                *g_v, *w_s, *b_s, *w_conv, *w_out, *g_post_mix, *g_pre_ffn, *w_ff1, *w_ff2, *g_post_ffn;
    float* out; unsigned char* ws; int ph_lo, ph_hi;
};

__device__ __forceinline__ void p0_transpose_item(const float* W, int K, int N, bf16* WT, LAS float* scr, int item, int lane) {
    const int nblk = N / 32, kb = item / nblk, nb = item % nblk, k0 = 64 * kb, n0 = 32 * nb;
#pragma unroll 8
    for (int i = 0; i < 32; ++i) { const int kk = 2 * i + (lane >> 5); scr[kk * 33 + (lane & 31)] = W[(size_t)(k0 + kk) * N + n0 + (lane & 31)]; }
    asm volatile("s_waitcnt lgkmcnt(0)" ::: "memory");
    const int c = lane & 7;
#pragma unroll
    for (int j = 0; j < 4; ++j) { const int n = (lane >> 3) + 8 * j; const LAS float* s = scr + (8 * c) * 33 + n;
        u32x4 o; o.x = cvt_pk_bf16(s[0 * 33], s[1 * 33]); o.y = cvt_pk_bf16(s[2 * 33], s[3 * 33]); o.z = cvt_pk_bf16(s[4 * 33], s[5 * 33]); o.w = cvt_pk_bf16(s[6 * 33], s[7 * 33]);
        *(u32x4*)(WT + (size_t)(n0 + n) * K + k0 + 8 * c) = o; }
    asm volatile("s_waitcnt lgkmcnt(0)" ::: "memory");
}

__device__ __forceinline__ void convert_layer(const Args& A, LAS unsigned char* lds, int l, int gwi, int nw, int wave, int lane) {
    unsigned char* ws = A.ws;
    LAS float* scr = (LAS float*)(lds + wave * 16384);
    constexpr int I_IN = 16 * 62, I_UQ = 6 * 24, I_UKV = 4 * 32, I_OUT = 16 * 32, I_F1 = 16 * 128, I_F2 = 64 * 32, I_L = I_IN + I_UQ + I_UKV + I_OUT + I_F1 + I_F2;
    for (int it = gwi; it < I_L; it += nw) {
        int r = it;
        if (r < I_IN) { p0_transpose_item(A.w_in + (size_t)l * 1024 * INC, 1024, INC, (bf16*)(ws + WS_WIN) + (size_t)l * 2048 * 1024, scr, r, lane); continue; } r -= I_IN;
        if (r < I_UQ) { p0_transpose_item(A.w_uq + (size_t)l * 384 * 768, 384, 768, (bf16*)(ws + WS_WUQ) + (size_t)l * 768 * 384, scr, r, lane); continue; } r -= I_UQ;
        if (r < I_UKV) { p0_transpose_item(A.w_ukv + (size_t)l * 256 * 1024, 256, 1024, (bf16*)(ws + WS_WUKV) + (size_t)l * 1024 * 256, scr, r, lane); continue; } r -= I_UKV;
        if (r < I_OUT) { p0_transpose_item(A.w_out + (size_t)l * 1024 * 1024, 1024, 1024, (bf16*)(ws + WS_WOUT) + (size_t)l * 1024 * 1024, scr, r, lane); continue; } r -= I_OUT;
        if (r < I_F1) { p0_transpose_item(A.w_ff1 + (size_t)l * 1024 * 4096, 1024, 4096, (bf16*)(ws + WS_WFF1) + (size_t)l * 4096 * 1024, scr, r, lane); continue; } r -= I_F1;
        p0_transpose_item(A.w_ff2 + (size_t)l * 4096 * 1024, 4096, 1024, (bf16*)(ws + WS_WFF2) + (size_t)l * 1024 * 4096, scr, r, lane);
    }
}

__device__ __forceinline__ void phase_prologue(const Args& A, LAS unsigned char* lds, int wave) {
    const int lane = fresh_lane(), tid = wave * 64 + lane;
    unsigned char* ws = A.ws;
    const int bid = blockIdx.x, G = gridDim.x;
    { const int gt = bid * 512 + tid;
      if (gt < 32768) { const int n = gt >> 5, a = (gt >> 4) & 1, f = gt & 15; const int pos = a == 0 ? (n >> 6) : (n & 63);
          double inv = 1.0; for (int i = 0; i < f; ++i) inv *= 0.5623413251903491;
          double rev = (double)pos * inv * 0.15915494309189535; rev -= floor(rev);
          const float rf = (float)rev;
          ((float*)(ws + WS_ROPE))[gt] = __builtin_amdgcn_cosf(rf); ((float*)(ws + WS_ROPE))[32768 + gt] = __builtin_amdgcn_sinf(rf); } }
    for (int it = bid; it < 192; it += G) {
        const int l = it / 48, cgp = it % 48;
        LAS float* sl = (LAS float*)lds;
        for (int i = tid; i < 5120; i += 512) { const int ci = i >> 10, k = i & 1023; const float v = ci == 0 ? A.c_ctx[k] : A.c[(ci - 1) * 1024 + k]; sl[i] = v / (1.0f + __expf(-v)); }
        __syncthreads();
        float a0[5], a1[5];
#pragma unroll
        for (int ci = 0; ci < 5; ++ci) { a0[ci] = 0.f; a1[ci] = 0.f; }
        const float* wp = A.w_ada + ((size_t)l * 1024 + wave * 128) * 6144 + cgp * 128 + 2 * lane;
#pragma unroll 8
        for (int kk = 0; kk < 128; ++kk) { const f32x2 wv = *(const f32x2*)(wp + (size_t)kk * 6144); const int k = wave * 128 + kk;
#pragma unroll
            for (int ci = 0; ci < 5; ++ci) { const float s = sl[ci * 1024 + k]; a0[ci] += s * wv.x; a1[ci] += s * wv.y; } }
        LAS float* part = (LAS float*)(lds + 32768);
#pragma unroll
        for (int ci = 0; ci < 5; ++ci) { part[(wave * 5 + ci) * 128 + 2 * lane] = a0[ci]; part[(wave * 5 + ci) * 128 + 2 * lane + 1] = a1[ci]; }
        __syncthreads();
        for (int i = tid; i < 640; i += 512) { const int ci = i >> 7, col = i & 127; float s = 0.f;
#pragma unroll
            for (int w = 0; w < 8; ++w) s += part[(w * 5 + ci) * 128 + col];
            const int gcol = cgp * 128 + col; ((float*)(ws + WS_MOD))[(l * 5 + ci) * 6144 + gcol] = s + A.b_ada[l * 6144 + gcol]; }
        __syncthreads();
    }
    convert_layer(A, lds, 0, bid * 8 + wave, G * 8, wave, lane);
}

__device__ __forceinline__ int cond_of_row(int r) { return r < NTOK_P ? 0 : 1 + ((r - NTOK_P) >> 10); }

__device__ __forceinline__ void norm_mod_store(const f32x4 (&v)[4], const LAS float* g, const LAS float* sc, const LAS float* sh, bf16* hrow, int lane) {
    float ss = 0.f;
#pragma unroll
    for (int j = 0; j < 4; ++j) ss += sumsq4(v[j]);
    const float rstd = 1.0f / sqrtf(wave_sum(ss, lane) * (1.0f / 1024.0f) + EPS);
#pragma unroll
    for (int j = 0; j < 4; ++j) { const int idx = 4 * lane + 256 * j;
        const f32x4 gg = *(const LAS f32x4*)(g + idx), s1 = *(const LAS f32x4*)(sc + idx), s0 = *(const LAS f32x4*)(sh + idx);
        const f32x4 o = v[j] * rstd * gg * (1.0f + s1) + s0;
        *(u32x2*)(hrow + idx) = pk4(o); }
}
__device__ __forceinline__ const float* x_in_row(const Args& A, int r) { return r < NTOK_P ? A.x_prompt + (size_t)r * 1024 : A.x_sample + (size_t)(r - NTOK_P) * 1024; }
__device__ __forceinline__ void fill_vec(LAS float* dst, const float* src, int tid) { if (tid < 256) *(LAS f32x4*)(dst + 4 * tid) = *(const f32x4*)(src + 4 * tid); }

__device__ __forceinline__ void phase_pre(const Args& A, LAS unsigned char* lds, int lane, int wave) {
    const int gw = blockIdx.x * 8 + wave, NGW = gridDim.x * 8;
    const float* mod = (const float*)(A.ws + WS_MOD); bf16* H = (bf16*)(A.ws + WS_H);
    LAS float* P = (LAS float*)lds;
    { const int t2 = (wave & 3) * 64 + lane, hv = wave >> 2;
      for (int v = hv; v < 11; v += 2) { const float* src = v == 0 ? A.g_pre_mix : (v <= 5 ? mod + (size_t)(v - 1) * 6144 + 1024 : mod + (size_t)(v - 6) * 6144);
          const int slot = v == 0 ? 1 : (v <= 5 ? 7 + (v - 1) : 12 + (v - 6));
          *(LAS f32x4*)(P + slot * 1024 + 4 * t2) = *(const f32x4*)(src + 4 * t2); } }
    __syncthreads();
    for (int r0 = gw; r0 < NTOK; r0 += 2 * NGW) {
        f32x4 v[2][4];
#pragma unroll
        for (int u = 0; u < 2; ++u) { const float* xr = x_in_row(A, r0 + u * NGW);
#pragma unroll
            for (int j = 0; j < 4; ++j) v[u][j] = *(const f32x4*)(xr + 4 * lane + 256 * j); }
#pragma unroll
        for (int u = 0; u < 2; ++u) { const int r = r0 + u * NGW, ci = cond_of_row(r);
            norm_mod_store(v[u], P + 1024, P + (7 + ci) * 1024, P + (12 + ci) * 1024, H + (size_t)r * 1024, lane); }
    }
    __syncthreads();
}

__device__ __forceinline__ void phase_post(const Args& A, int l, int which, LAS unsigned char* lds, int lane, int wave) {
    const int gw = blockIdx.x * 8 + wave, NGW = gridDim.x * 8;
    const float* mod = (const float*)(A.ws + WS_MOD); bf16* H = (bf16*)(A.ws + WS_H); const bf16* MIX = (const bf16*)(A.ws + WS_MIX);
    const bool first = (l == 0 && which == 0), has_h = (which == 0) || (l < DEPTH - 1);
    LAS float* P = (LAS float*)lds;
    { const int t2 = (wave & 3) * 64 + lane, hv = wave >> 2;
      const int l2 = which == 0 ? l : l + 1;
      for (int v = hv; v < 17; v += 2) { const float* src;
          if (v == 0) src = (which == 0 ? A.g_post_mix : A.g_post_ffn) + l * 1024;
          else if (v == 1) src = which == 0 ? A.g_pre_ffn + l * 1024 : A.g_pre_mix + (l2 < DEPTH ? l2 : l) * 1024;
          else if (v < 7) src = mod + (size_t)(l * 5 + (v - 2)) * 6144 + (which == 0 ? 2048 : 5120);
          else if (v < 12) src = mod + (size_t)((l2 < DEPTH ? l2 : l) * 5 + (v - 7)) * 6144 + (which == 0 ? 4096 : 1024);
          else src = mod + (size_t)((l2 < DEPTH ? l2 : l) * 5 + (v - 12)) * 6144 + (which == 0 ? 3072 : 0);
          *(LAS f32x4*)(P + v * 1024 + 4 * t2) = *(const f32x4*)(src + 4 * t2); } }
    __syncthreads();
    for (int r0 = gw; r0 < NTOK; r0 += 2 * NGW) {
        f32x4 v[2][4], t[2][4];
#pragma unroll
        for (int u = 0; u < 2; ++u) { const int r = r0 + u * NGW;
            const float* xr = first ? x_in_row(A, r) : A.out + (size_t)r * 1024; const bf16* tr = MIX + (size_t)r * 1024;
#pragma unroll
            for (int j = 0; j < 4; ++j) { v[u][j] = *(const f32x4*)(xr + 4 * lane + 256 * j); t[u][j] = ld4bf(tr + 4 * lane + 256 * j); } }
#pragma unroll
        for (int u = 0; u < 2; ++u) { const int r = r0 + u * NGW; const LAS float* ga = P + (2 + cond_of_row(r)) * 1024;
            float ss = 0.f;
#pragma unroll
            for (int j = 0; j < 4; ++j) ss += sumsq4(t[u][j]);
            const float rstd = 1.0f / sqrtf(wave_sum(ss, lane) * (1.0f / 1024.0f) + EPS);
#pragma unroll
            for (int j = 0; j < 4; ++j) { const int idx = 4 * lane + 256 * j;
                const f32x4 gg = *(const LAS f32x4*)(P + idx), gv = *(const LAS f32x4*)(ga + idx);
                v[u][j] = v[u][j] + gv * (t[u][j] * rstd * gg);
                *(f32x4*)(A.out + (size_t)r * 1024 + idx) = v[u][j]; } }
        if (has_h) {
#pragma unroll
            for (int u = 0; u < 2; ++u) { const int r = r0 + u * NGW, ci = cond_of_row(r);
                norm_mod_store(v[u], P + 1024, P + (7 + ci) * 1024, P + (12 + ci) * 1024, H + (size_t)r * 1024, lane); } }
    }
    __syncthreads();
}

__device__ __forceinline__ void phase_split(const Args& A, int l, int lane, int wave) {
    const int gw = blockIdx.x * 8 + wave, NGW = gridDim.x * 8;
    unsigned char* ws = A.ws;
    const bf16* Z = (const bf16*)(ws + WS_Z);
    bf16* QN = (bf16*)(ws + WS_QN); bf16* CKVN = (bf16*)(ws + WS_CKVN); bf16* KRB = (bf16*)(ws + WS_KRB); bf16* UG = (bf16*)(ws + WS_UG); bf16* VN = (bf16*)(ws + WS_VN);
    bf16* CC = (bf16*)(ws + WS_CONCAT);
    const float* ropec = (const float*)(ws + WS_ROPE); const float* ropes = ropec + 32768;
    float* out_ckv = A.out + (size_t)NTOK * 1024; float* out_kr = out_ckv + (size_t)32 * 4 * 256 * 256;
    for (int idx = gw; idx < 2048; idx += NGW) { const int r = NTOK + idx, b = idx >> 9, j = idx & 511;
        const f32x4 cv = *(const f32x4*)(A.cache_ckv + ((size_t)(b * 4 + l) * 512 + j) * 256 + 4 * lane);
        const float kv = A.cache_krope[((size_t)(b * 4 + l) * 512 + j) * 64 + lane];
        *(u32x2*)(CKVN + (size_t)r * 256 + 4 * lane) = pk4(cv);
        KRB[(size_t)r * 64 + lane] = (bf16)(cvt_pk_bf16(kv, 0.f) & 0xffffu); }
    const f32x4 gkv = *(const f32x4*)(A.g_kv + l * 256 + 4 * lane), gvv = *(const f32x4*)(A.g_v + l * 256 + 4 * lane);
    const float* wcp = A.w_conv + (size_t)l * 3 * 256 + 4 * lane;
    const f32x4 wc0 = *(const f32x4*)(wcp), wc1 = *(const f32x4*)(wcp + 256), wc2 = *(const f32x4*)(wcp + 512);
    f32x2 gq[3];
#pragma unroll
    for (int j = 0; j < 3; ++j) gq[j] = *(const f32x2*)(A.g_q + l * 384 + 2 * lane + 128 * j);
    for (int r0 = gw; r0 < NTOK; r0 += 2 * NGW) {
        f32x2 q[2][3]; f32x4 cv[2], uu[2], vv[2], bg[2], zc[2], zm[2], zp[2]; float kr[2], cs[2], sn[2];
#pragma unroll
        for (int u = 0; u < 2; ++u) { const int r = r0 + u * NGW; const bf16* z = Z + (size_t)r * INC;
            const bool prompt = r < NTOK_P; const int n = prompt ? (r & 255) : ((r - NTOK_P) & 1023), len = prompt ? 256 : 1024;
#pragma unroll
            for (int j = 0; j < 3; ++j) q[u][j] = ld2bf(z + ZQ + 2 * lane + 128 * j);
            cv[u] = ld4bf(z + ZCKV + 4 * lane); kr[u] = ld1bf(z + ZKR + lane);
            uu[u] = ld4bf(z + ZU + 4 * lane); vv[u] = ld4bf(z + ZV + 4 * lane); bg[u] = ld4bf(z + ZBG + 4 * lane);
            zc[u] = ld4bf(z + ZCG + 4 * lane) * ld4bf(z + ZHH + 4 * lane);
            zm[u] = (f32x4){0.f, 0.f, 0.f, 0.f}; zp[u] = zm[u];
            if (n > 0) zm[u] = ld4bf(z - INC + ZCG + 4 * lane) * ld4bf(z - INC + ZHH + 4 * lane);
            if (n < len - 1) zp[u] = ld4bf(z + INC + ZCG + 4 * lane) * ld4bf(z + INC + ZHH + 4 * lane);
            cs[u] = 1.f; sn[u] = 0.f;
            if (!prompt) { const int a = lane >> 5, f = lane & 15; cs[u] = ropec[n * 32 + a * 16 + f]; sn[u] = ropes[n * 32 + a * 16 + f]; } }
#pragma unroll
        for (int u = 0; u < 2; ++u) { const int r = r0 + u * NGW; const bool prompt = r < NTOK_P; const int n = prompt ? (r & 255) : ((r - NTOK_P) & 1023);
            { float ss = 0.f;
#pragma unroll
              for (int j = 0; j < 3; ++j) ss += q[u][j].x * q[u][j].x + q[u][j].y * q[u][j].y;
              const float rstd = 1.0f / sqrtf(wave_sum(ss, lane) * (1.0f / 384.0f) + EPS);
#pragma unroll
              for (int j = 0; j < 3; ++j) *(unsigned*)(QN + (size_t)r * 384 + 2 * lane + 128 * j) = cvt_pk_bf16(q[u][j].x * rstd * gq[j].x, q[u][j].y * rstd * gq[j].y); }
            { const float rstd = 1.0f / sqrtf(wave_sum(sumsq4(cv[u]), lane) * (1.0f / 256.0f) + EPS);
              const f32x4 c2 = cv[u] * rstd * gkv;
              if (prompt) *(f32x4*)(out_ckv + ((size_t)((r >> 8) * 4 + l) * 256 + n) * 256 + 4 * lane) = c2;
              *(u32x2*)(CKVN + (size_t)r * 256 + 4 * lane) = pk4(c2); }
            { float k2 = kr[u];
              if (prompt) out_kr[((size_t)((r >> 8) * 4 + l) * 256 + n) * 64 + lane] = k2;
              else { const float partner = shx(k2, 16, lane); const int p = (lane >> 4) & 1;
                  k2 = p == 0 ? k2 * cs[u] - partner * sn[u] : partner * sn[u] + k2 * cs[u]; }
              KRB[(size_t)r * 64 + lane] = (bf16)(cvt_pk_bf16(k2, 0.f) & 0xffffu); }
            *(u32x2*)(UG + (size_t)r * 256 + 4 * lane) = pk4(gelu4(uu[u]));
            { f32x4 v = gelu4(vv[u]);
              const float rstd = 1.0f / sqrtf(wave_sum(sumsq4(v), lane) * (1.0f / 256.0f) + EPS);
              *(u32x2*)(VN + (size_t)r * 256 + 4 * lane) = pk4(v * rstd * gvv); }
            { const f32x4 y = zm[u] * wc0 + zc[u] * wc1 + zp[u] * wc2;
              *(u32x2*)(CC + (size_t)r * 1024 + 768 + 4 * lane) = pk4(bg[u] * y); }
        }
    }
}

#define MFMA32(a, b, c) __builtin_amdgcn_mfma_f32_32x32x16_bf16((a), (b), (c), 0, 0, 0)
constexpr int AT_KROW = 400, AT_VROW = 144, AT_KBYTES = 64 * AT_KROW, AT_STAGE = AT_KBYTES + 128 * AT_VROW;
__device__ __forceinline__ void attn_store_tile(const f32x16& ot, float inv, bf16* crow  , int t, int hh) {
#pragma unroll
    for (int g = 0; g < 4; ++g) { u32x2 w; w.x = cvt_pk_bf16(ot[4 * g] * inv, ot[4 * g + 1] * inv); w.y = cvt_pk_bf16(ot[4 * g + 2] * inv, ot[4 * g + 3] * inv);
        *(u32x2*)(crow + 32 * t + 8 * g + 4 * hh) = w; }
}

__device__ __forceinline__ void phase_mixer(const Args& A, int l, LAS unsigned char* lds, int lane_in, int wave) {
    unsigned char* ws = A.ws;
    const bf16* Q = (const bf16*)(ws + WS_Q); const bf16* KN = (const bf16*)(ws + WS_KNOPE); const bf16* KRB = (const bf16*)(ws + WS_KRB);
    const bf16* VTP = (const bf16*)(ws + WS_VTP); const bf16* VTS = (const bf16*)(ws + WS_VTS);
    const bf16* UG = (const bf16*)(ws + WS_UG); const bf16* VN = (const bf16*)(ws + WS_VN);
    bf16* CC = (bf16*)(ws + WS_CONCAT);
    for (int slot = 0; ; ++slot) {
        int it;
        if (gridDim.x == 256) {
            if (slot == 0) it = blockIdx.x; else if (slot == 1 && blockIdx.x >= 128 && blockIdx.x < 224) it = 256 + (int)blockIdx.x - 128; else break;
        } else { it = (int)blockIdx.x + slot * (int)gridDim.x; if (it >= 352) break; }
        int lane = lane_in; asm volatile("" : "+v"(lane));
        const int rho = lane & 31, hh = lane >> 5, tid = wave * 64 + lane;
        if (it < 256) {
            int h, q0, keys, nkeys, split, rowA, rowB; const bf16* vt;
            const bool heavy = it < 128;
            if (heavy) {
                const int xj = it >> 3, pr = 2 * (it & 7) + (xj >> 3), b = pr >> 2, qt = xj & 7; h = pr & 3;
                q0 = NTOK_P + b * 1024 + qt * 128 + (wave & 3) * 32; keys = 1536; nkeys = 1536; split = 512; rowA = NTOK + b * 512; rowB = NTOK_P + b * 1024;
                vt = VTS + (size_t)((b * 4 + h) * 128) * 1536; }
            else { const int i2 = it - 128, b = i2 >> 2; h = i2 & 3; q0 = b * 256 + wave * 32; keys = 256; nkeys = 256; split = 0; rowA = 0; rowB = b * 256;
                vt = VTP + (size_t)((b * 4 + h) * 128) * 256; }
            bf16x8 qf[12];
            { const bf16* qp = Q + (size_t)(q0 + rho) * 768 + h * 192 + 8 * hh;
#pragma unroll
              for (int ks = 0; ks < 12; ++ks) qf[ks] = *(const bf16x8*)(qp + 16 * ks); }
            f32x16 o[4];
#pragma unroll
            for (int t = 0; t < 4; ++t)
#pragma unroll
                for (int i = 0; i < 16; ++i) o[t][i] = 0.f;
            float m = -1e30f, lsum = 0.f;
            int kslot[2], kcol[2], vd[2], vc[2];
#pragma unroll
            for (int j = 0; j < 2; ++j) { const int c = tid + 512 * j, kap = c >> 4; kcol[j] = c & 15;
                kslot[j] = (kap & 32) + (kap & 3) + 4 * ((kap >> 4) & 1) + 8 * ((kap >> 2) & 3);
                vd[j] = c >> 3; vc[j] = c & 7; }
            const int rkap = tid >> 3, rc8 = tid & 7, rslot = (rkap & 32) + (rkap & 3) + 4 * ((rkap >> 4) & 1) + 8 * ((rkap >> 2) & 3);
            u32x4 sk[2], sr, sv[2];
#define AT_GLOAD(k0) do { const int rb_ = (k0) < split ? rowA + (k0) : rowB + ((k0) - split); \
                _Pragma("unroll") for (int j = 0; j < 2; ++j) sk[j] = *(const u32x4*)(KN + (size_t)(rb_ + ((tid + 512 * j) >> 4)) * 512 + h * 128 + kcol[j] * 8); \
                sr = *(const u32x4*)(KRB + (size_t)(rb_ + rkap) * 64 + rc8 * 8); \
                _Pragma("unroll") for (int j = 0; j < 2; ++j) sv[j] = *(const u32x4*)(vt + (size_t)vd[j] * keys + (k0) + vc[j] * 8); } while (0)
#define AT_SWRITE(buf) do { LAS unsigned char* sb_ = lds + (buf) * AT_STAGE; \
                _Pragma("unroll") for (int j = 0; j < 2; ++j) *(LAS u32x4*)(sb_ + kslot[j] * AT_KROW + kcol[j] * 16) = sk[j]; \
                *(LAS u32x4*)(sb_ + rslot * AT_KROW + 256 + rc8 * 16) = sr; \
                _Pragma("unroll") for (int j = 0; j < 2; ++j) *(LAS u32x4*)(sb_ + AT_KBYTES + vd[j] * AT_VROW + vc[j] * 16) = sv[j]; } while (0)
            const int ntile = nkeys >> 6;
            const int blk_lo = heavy ? (wave >> 2) : 0, blk_hi = heavy ? blk_lo + 1 : 2;
            AT_GLOAD(0); AT_SWRITE(0);
            __syncthreads();
            for (int tI = 0; tI < ntile; ++tI) {
                if (tI + 1 < ntile) AT_GLOAD((tI + 1) * 64);
                { const LAS unsigned char* sb = lds + (tI & 1) * AT_STAGE;
                for (int blk = blk_lo; blk < blk_hi; ++blk) {
                    const LAS unsigned char* kp = sb + (32 * blk + rho) * AT_KROW + hh * 16;
                    f32x16 sc, scb;
#pragma unroll
                    for (int i = 0; i < 16; ++i) { sc[i] = 0.f; scb[i] = 0.f; }
#pragma unroll
                    for (int ks = 0; ks < 12; ks += 2) { sc = MFMA32(*(const LAS bf16x8*)(kp + ks * 32), qf[ks], sc); scb = MFMA32(*(const LAS bf16x8*)(kp + ks * 32 + 32), qf[ks + 1], scb); }
                    sc = sc + scb;
                    float mx = sc[0];
#pragma unroll
                    for (int i = 1; i < 16; ++i) mx = fmaxf(mx, sc[i]);
                    mx = fmaxf(mx, shx(mx, 32, lane));
                    const float mn = fmaxf(m, mx), alpha = __builtin_amdgcn_exp2f(m - mn);
                    float ps = 0.f;
#pragma unroll
                    for (int i = 0; i < 16; ++i) { sc[i] = __builtin_amdgcn_exp2f(sc[i] - mn); ps += sc[i]; }
                    lsum = lsum * alpha + ps; m = mn;
#pragma unroll
                    for (int t = 0; t < 4; ++t) o[t] = o[t] * alpha;
                    bf16x8 pb[2];
#pragma unroll
                    for (int s2 = 0; s2 < 2; ++s2) { u32x4 w; w.x = cvt_pk_bf16(sc[8 * s2 + 0], sc[8 * s2 + 1]); w.y = cvt_pk_bf16(sc[8 * s2 + 2], sc[8 * s2 + 3]); w.z = cvt_pk_bf16(sc[8 * s2 + 4], sc[8 * s2 + 5]); w.w = cvt_pk_bf16(sc[8 * s2 + 6], sc[8 * s2 + 7]);
                        pb[s2] = __builtin_bit_cast(bf16x8, w); }
                    const LAS unsigned char* vp = sb + AT_KBYTES + rho * AT_VROW + (32 * blk + 16 * hh) * 2;
#pragma unroll
                    for (int t = 0; t < 4; ++t)
#pragma unroll
                        for (int s2 = 0; s2 < 2; ++s2) o[t] = MFMA32(*(const LAS bf16x8*)(vp + 32 * t * AT_VROW + 16 * s2), pb[s2], o[t]);
                }
                }
                if (tI + 1 < ntile) AT_SWRITE((tI + 1) & 1);
                __syncthreads();
            }
#undef AT_GLOAD
#undef AT_SWRITE
            lsum += shx(lsum, 32, lane);
            bf16* crow = CC + (size_t)(q0 + rho) * 1024 + h * 128;
            if (!heavy) { const float inv = 1.0f / lsum;
#pragma unroll
                for (int t = 0; t < 4; ++t) attn_store_tile(o[t], inv, crow, t, hh);
            } else {
                const int half = wave >> 2;
                LAS float* mine = (LAS float*)(lds + wave * 8704);
                LAS const float* theirs = (LAS const float*)(lds + (wave ^ 4) * 8704);
#pragma unroll
                for (int t2 = 0; t2 < 2; ++t2)
#pragma unroll
                    for (int i = 0; i < 16; ++i) mine[(t2 * 16 + i) * 64 + lane] = half == 0 ? o[2 + t2][i] : o[t2][i];
                if (hh == 0) { mine[2048 + rho] = m; mine[2080 + rho] = lsum; }
                __syncthreads();
                const float mp = theirs[2048 + rho], lp = theirs[2080 + rho];
                const float mg = fmaxf(m, mp), wo = __builtin_amdgcn_exp2f(m - mg), wp = __builtin_amdgcn_exp2f(mp - mg);
                const float inv = 1.0f / (wo * lsum + wp * lp);
#pragma unroll
                for (int t2 = 0; t2 < 2; ++t2) { f32x16 acc;
#pragma unroll
                    for (int i = 0; i < 16; ++i) acc[i] = wo * (half == 0 ? o[t2][i] : o[2 + t2][i]) + wp * theirs[(t2 * 16 + i) * 64 + lane];
                    attn_store_tile(acc, inv, crow, half * 2 + t2, hh); }
                __syncthreads();
            }
        } else {
            const int c = it - 256;
            LAS bf16* vnT = (LAS bf16*)lds;
#pragma unroll
            for (int pass = 0; pass < 8; ++pass) { const int u = wave + 8 * pass, qq = (u & 1) * 64 + lane, c8 = (u >> 1) * 8;
                const bf16x8 v = *(const bf16x8*)(VN + (size_t)(c * 128 + qq) * 256 + c8);
#pragma unroll
                for (int j = 0; j < 8; ++j) vnT[(c8 + j) * 136 + qq] = (bf16)v[j]; }
            __syncthreads();
            const int hd = wave & 3, ph = wave >> 2;
#pragma unroll
            for (int pp = 0; pp < 2; ++pp) { const int pt = 2 * ph + pp;
                f32x16 acc[2];
#pragma unroll
                for (int d = 0; d < 2; ++d)
#pragma unroll
                    for (int i = 0; i < 16; ++i) acc[d][i] = 0.f;
                const float* wrow = A.w_s + ((size_t)(l * 4 + hd) * 128 + 32 * pt + rho) * 128 + 8 * hh;
                f32x4 wv[16];
#pragma unroll
                for (int ks = 0; ks < 8; ++ks) { wv[2 * ks] = *(const f32x4*)(wrow + 16 * ks); wv[2 * ks + 1] = *(const f32x4*)(wrow + 16 * ks + 4); }
#pragma unroll
                for (int ks = 0; ks < 8; ++ks) { const f32x4 w0 = wv[2 * ks], w1 = wv[2 * ks + 1];
                    u32x4 w; w.x = cvt_pk_bf16(w0.x, w0.y); w.y = cvt_pk_bf16(w0.z, w0.w); w.z = cvt_pk_bf16(w1.x, w1.y); w.w = cvt_pk_bf16(w1.z, w1.w);
                    const bf16x8 af = __builtin_bit_cast(bf16x8, w);
#pragma unroll
                    for (int d = 0; d < 2; ++d) { const bf16x8 bfr = *(const LAS bf16x8*)(vnT + (hd * 64 + 32 * d + rho) * 136 + 16 * ks + 8 * hh); acc[d] = MFMA32(af, bfr, acc[d]); } }
                float bs[16]; bf16 ugv[2][16];
#pragma unroll
                for (int i = 0; i < 16; ++i) { const int p = 32 * pt + (i & 3) + 8 * (i >> 2) + 4 * hh; bs[i] = A.b_s[(l * 4 + hd) * 128 + p];
#pragma unroll
                    for (int d = 0; d < 2; ++d) ugv[d][i] = UG[((size_t)c * 128 + p) * 256 + hd * 64 + 32 * d + rho]; }
#pragma unroll
                for (int d = 0; d < 2; ++d) { const int col = hd * 64 + 32 * d + rho;
#pragma unroll
                    for (int i = 0; i < 16; ++i) { const int p = 32 * pt + (i & 3) + 8 * (i >> 2) + 4 * hh; const size_t row = (size_t)c * 128 + p;
                        const float mixed = acc[d][i] + bs[i];
                        const float ug = __uint_as_float((unsigned)ugv[d][i] << 16);
                        CC[row * 1024 + 512 + col] = (bf16)(cvt_pk_bf16(ug * mixed, 0.f) & 0xffffu); } }
            }
            __syncthreads();
        }
    }
}

__global__ void __launch_bounds__(512, 2) fwd_megakernel(Args A) {
    extern __shared__ __attribute__((aligned(16))) unsigned char smem[];
    LAS unsigned char* lds = (LAS unsigned char*)smem;
    const int wave0 = __builtin_amdgcn_readfirstlane((int)threadIdx.x >> 6);
    unsigned* const bar = (unsigned*)(A.ws + WS_BAR);
    volatile LAS unsigned* const barst = (volatile LAS unsigned*)(lds + LDS_BARST);
    const unsigned xcc = xb_xcc_id();
    if (wave0 == 0) { const int l0 = fresh_lane(); if (l0 < 2) barst[l0] = 0u; if (l0 == 0 && A.ph_hi - A.ph_lo > 1) (void)xb_add(&bar[XB_XCNT(xcc)], 1u); }
    __syncthreads();
    if (A.ph_lo < 0) cg::this_grid().sync();
    bool dup_done = false; (void)dup_done;
    for (int ph = A.ph_lo; ph < A.ph_hi; ++ph) {
        const int wave = wave0;
#define LANE fresh_lane()
#define TID (wave * 64 + fresh_lane())
        unsigned char* ws = A.ws; asm volatile("" : "+s"(ws));
        if (ph == 0) phase_prologue(A, lds, wave);
        else if (ph == 1) phase_pre(A, lds, LANE, wave);
        else {
            const int l = (ph - 2) / 9, k = (ph - 2) % 9;
            const int G = gridDim.x, bid = blockIdx.x;
            if (k == 0) {
                pg8::Gemm g{(const bf16*)(ws + WS_H), (const bf16*)(ws + WS_WIN) + (size_t)l * 2048 * 1024, NTOK, 2048, 1024}; pg8::StaticOrder S; S.init(NTOK, 2048, G, bid);
                EpiB16<0> E{(bf16*)(ws + WS_Z), INC, INC}; pg8::gemm_phase<EpiB16<0>, pg8::StaticOrder, true>(lds, g, S, E, TID);
            } else if (k == 1) phase_split(A, l, LANE, wave);
            else if (k == 2) {
                { pg8::Gemm g{(const bf16*)(ws + WS_QN), (const bf16*)(ws + WS_WUQ) + (size_t)l * 768 * 384, NTOK, 768, 384}; pg8::StaticOrder S; S.init(NTOK, 768, G, bid);
                  EpiQ E{(bf16*)(ws + WS_Q), (const float*)(ws + WS_ROPE), (const float*)(ws + WS_ROPE) + 32768}; pg8::gemm_phase<EpiQ, pg8::StaticOrder, false>(lds, g, S, E, TID); }
                                { pg8::Gemm g{(const bf16*)(ws + WS_CKVN), (const bf16*)(ws + WS_WUKV) + (size_t)l * 1024 * 256, NROWKV, 1024, 256}; pg8::StaticOrder S; S.init(NROWKV, 1024, G, (bid + G - 144 % G) % G);
                  EpiKV E{(bf16*)(ws + WS_KNOPE), (bf16*)(ws + WS_VTP), (bf16*)(ws + WS_VTS)}; pg8::gemm_phase<EpiKV, pg8::StaticOrder, false>(lds, g, S, E, TID); }
            } else if (k == 3) phase_mixer(A, l, lds, LANE, wave);
            else if (k == 4 || k == 7) {
                const bool o = (k == 4);
                pg8::Gemm g{(const bf16*)(ws + (o ? WS_CONCAT : WS_ACT)), o ? (const bf16*)(ws + WS_WOUT) + (size_t)l * 1024 * 1024 : (const bf16*)(ws + WS_WFF2) + (size_t)l * 1024 * 4096, NTOK, 1024, o ? 1024 : 4096};
                pg8::StaticOrder S; S.init(NTOK, 1024, G, bid);
                EpiB16<0> E{(bf16*)(ws + WS_MIX), 1024, 1024}; pg8::gemm_phase<EpiB16<0>, pg8::StaticOrder, true>(lds, g, S, E, TID);
                if (!o && l + 1 < DEPTH) { const int first = G > 192 ? 192 : 0;
                    if (bid >= first) convert_layer(A, lds, l + 1, (bid - first) * 8 + wave, (G - first) * 8, wave, LANE); }
            } else if (k == 5) phase_post(A, l, 0, lds, LANE, wave);
            else if (k == 6) {
                pg8::Gemm g{(const bf16*)(ws + WS_H), (const bf16*)(ws + WS_WFF1) + (size_t)l * 4096 * 1024, NTOK, 4096, 1024}; pg8::StaticOrder S; S.init(NTOK, 4096, G, bid);
                EpiB16<1> E{(bf16*)(ws + WS_ACT), 4096, 4096}; pg8::gemm_phase<EpiB16<1>, pg8::StaticOrder, true>(lds, g, S, E, TID);
            } else phase_post(A, l, 1, lds, LANE, wave);
        }
        if (ph + 1 < A.ph_hi) xcd_barrier(bar, xcc, barst, wave == 0 && fresh_lane() == 0);
#if PROBE_DUP >= 0
        {
            bool again = false;
            if (PROBE_DUP == 100) { if (ph + 1 < A.ph_hi) xcd_barrier(bar, xcc, barst, wave == 0 && fresh_lane() == 0); }
            else if (!dup_done) {
                const int kk = ph >= 2 ? (ph - 2) % 9 : -1;
                if (PROBE_DUP == 50) again = (ph == 0);
                else if (PROBE_DUP == 60) again = (kk == 0 || kk == 2 || kk == 4 || kk == 6 || kk == 7);
                else again = (kk == PROBE_DUP);
            }
            if (again) { dup_done = true; --ph; } else dup_done = false;
        }
#endif
    }
}

constexpr int N_PHASES = 2 + 9 * DEPTH;

extern "C" void kernel_launch(void* const* d_in, const int* in_sizes, int n_in, void* d_out, int out_size, void* d_ws, size_t ws_size, hipStream_t stream) {
    static int grid = 0;
    if (grid == 0) {
        if (n_in != 24 || ws_size < WS_END || in_sizes[9] != DEPTH * 1024 * INC) { fprintf(stderr, "kernel_launch: unexpected problem (n_in %d, ws %zu, w_in %d)\n", n_in, ws_size, n_in > 9 ? in_sizes[9] : -1); grid = -1; return; }
        int dev = 0, cus = 0, per_cu = 0;
        hipGetDevice(&dev); hipDeviceGetAttribute(&cus, hipDeviceAttributeMultiprocessorCount, dev);
        if (hipFuncSetAttribute((const void*)fwd_megakernel, hipFuncAttributeMaxDynamicSharedMemorySize, LDS_BYTES) != hipSuccess) { fprintf(stderr, "kernel_launch: hipFuncSetAttribute failed\n"); grid = -1; return; }
        if (hipOccupancyMaxActiveBlocksPerMultiprocessor(&per_cu, (const void*)fwd_megakernel, 512, LDS_BYTES) != hipSuccess || per_cu < 1) { fprintf(stderr, "kernel_launch: occupancy query says %d\n", per_cu); per_cu = 1; }
        (void)hipGetLastError();
        grid = cus * 1;
        fprintf(stderr, "kernel_launch: grid %d (cus %d, per_cu %d)\n", grid, cus, per_cu);
    }
    if (grid < 0) return;
    if (hipMemsetAsync((char*)d_ws + WS_BAR, 0, 16384, stream) != hipSuccess) { fprintf(stderr, "kernel_launch: memset failed\n"); return; }
    Args a{};
    const float** ap = (const float**)&a;
    for (int i = 0; i < 24; ++i) ap[i] = (const float*)d_in[i];
    a.out = (float*)d_out; a.ws = (unsigned char*)d_ws;
#if MK_PER_PHASE
    for (int ph = 0; ph < N_PHASES; ++ph) { a.ph_lo = ph; a.ph_hi = ph + 1; hipLaunchKernelGGL(fwd_megakernel, dim3(grid), dim3(512), LDS_BYTES, stream, a); }
#else
    a.ph_lo = 0; a.ph_hi = N_PHASES;
    void* args[] = {&a};
    hipError_t e = hipLaunchCooperativeKernel((const void*)fwd_megakernel, dim3(grid), dim3(512), args, LDS_BYTES, stream);
    if (e != hipSuccess) fprintf(stderr, "kernel_launch: cooperative launch failed: %s (grid %d)\n", hipGetErrorString(e), grid);
#endif
}
```

```cpp
#include <hip/hip_runtime.h>
#include <hip/hip_cooperative_groups.h>
#include <cstdio>
namespace cg = cooperative_groups;

#ifndef MK_PER_PHASE
#define MK_PER_PHASE 0
#endif

#ifndef PROBE_DUP
#define PROBE_DUP -1
#endif
#define LAS __attribute__((address_space(3)))
typedef unsigned short bf16;
typedef short bf16x8 __attribute__((ext_vector_type(8)));
typedef float f32x2 __attribute__((ext_vector_type(2)));
typedef float f32x4 __attribute__((ext_vector_type(4)));
typedef float f32x16 __attribute__((ext_vector_type(16)));
typedef unsigned u32x2 __attribute__((ext_vector_type(2)));
typedef unsigned u32x4 __attribute__((ext_vector_type(4)));

constexpr int DM = 1024, NTOK_P = 8192, NTOK_S = 4096, NTOK = 12288, NROWKV = 14336;
constexpr int DEPTH = 4, INC = 1984, DFF = 4096;
constexpr int ZQ = 0, ZCKV = 384, ZKR = 640, ZU = 704, ZV = 960, ZBG = 1216, ZCG = 1472, ZHH = 1728;
constexpr float EPS = 1e-6f;
constexpr float QSCALE = 0.07216878364870322f * 1.4426950408889634f;

constexpr size_t MiB = 1u << 20;
constexpr size_t WS_MOD = 0, WS_BAR = 512 * 1024, WS_ROPE = 1 * MiB, WS_WIN = 2 * MiB, WS_WUQ = 18 * MiB, WS_WUKV = 21 * MiB, WS_WOUT = 23 * MiB,
                 WS_WFF1 = 31 * MiB, WS_WFF2 = 63 * MiB, WS_H = 95 * MiB, WS_MIX = 119 * MiB, WS_CONCAT = 167 * MiB, WS_QN = 191 * MiB,
                 WS_CKVN = 200 * MiB, WS_KRB = 207 * MiB, WS_UG = 209 * MiB, WS_VN = 215 * MiB, WS_Q = 221 * MiB, WS_KNOPE = 239 * MiB,
                 WS_VTP = 253 * MiB, WS_VTS = 261 * MiB, WS_Z = 267 * MiB, WS_ACT = 267 * MiB, WS_END = 363 * MiB;
constexpr int LDS_BYTES = 147456, LDS_BARST = LDS_BYTES - 64;

__device__ __forceinline__ unsigned cvt_pk_bf16(float lo, float hi) { unsigned r; asm volatile("v_cvt_pk_bf16_f32 %0, %1, %2" : "=v"(r) : "v"(lo), "v"(hi)); return r; }
__device__ __forceinline__ int fresh_lane() { int l; asm volatile("v_mbcnt_lo_u32_b32 %0, -1, 0\n\tv_mbcnt_hi_u32_b32 %0, -1, %0" : "=v"(l)); return l; }
__device__ __forceinline__ float shx(float v, int mask, int lane) { return __int_as_float(__builtin_amdgcn_ds_bpermute((lane ^ mask) << 2, __float_as_int(v))); }
__device__ __forceinline__ float dpp_add(float v, const int ctrl_is) {
    return v; }
#define DPP_ADD(v, ctrl) ((v) + __int_as_float(__builtin_amdgcn_update_dpp(0, __float_as_int(v), (ctrl), 0xf, 0xf, true)))
__device__ __forceinline__ float wave_sum(float v, int lane) {
    (void)lane;
    v = DPP_ADD(v, 0xB1);
    v = DPP_ADD(v, 0x4E);
    v = DPP_ADD(v, 0x141);
    v = DPP_ADD(v, 0x140);
    const int vi = __float_as_int(v);
    return (__int_as_float(__builtin_amdgcn_readlane(vi, 0)) + __int_as_float(__builtin_amdgcn_readlane(vi, 16))) + (__int_as_float(__builtin_amdgcn_readlane(vi, 32)) + __int_as_float(__builtin_amdgcn_readlane(vi, 48)));
}
__device__ __forceinline__ float gelu_tanh(float x) { const float y = 0.7978845608028654f * (x + 0.044715f * x * x * x); return x / (1.0f + __expf(-2.0f * y)); }
__device__ __forceinline__ f32x4 gelu4(f32x4 v) { return (f32x4){gelu_tanh(v.x), gelu_tanh(v.y), gelu_tanh(v.z), gelu_tanh(v.w)}; }
__device__ __forceinline__ float sumsq4(f32x4 v) { return (v.x * v.x + v.y * v.y) + (v.z * v.z + v.w * v.w); }
__device__ __forceinline__ f32x4 ld4bf(const bf16* p) { const u32x2 w = *(const u32x2*)p; return (f32x4){__uint_as_float(w.x << 16), __uint_as_float(w.x & 0xffff0000u), __uint_as_float(w.y << 16), __uint_as_float(w.y & 0xffff0000u)}; }
__device__ __forceinline__ f32x2 ld2bf(const bf16* p) { const unsigned w = *(const unsigned*)p; return (f32x2){__uint_as_float(w << 16), __uint_as_float(w & 0xffff0000u)}; }
__device__ __forceinline__ float ld1bf(const bf16* p) { return __uint_as_float((unsigned)*p << 16); }
__device__ __forceinline__ u32x2 pk4(f32x4 v) { u32x2 w; w.x = cvt_pk_bf16(v.x, v.y); w.y = cvt_pk_bf16(v.z, v.w); return w; }


#define XB_TMO      128
#define XB_XCNT(j)  (256  + 64 * (j))
#define XB_XSUB(j)  (1280 + 64 * (j))
#define XB_XGEN(j)  (2304 + 64 * (j))
#define XB_TOP      3328
#define XB_TOPGEN   3392
#define XCD_BAR_WORDS 3456
#define XB_SPIN_CAP (1u << 18)
__device__ __forceinline__ unsigned xb_ld(unsigned* p)              { return __hip_atomic_load(p, __ATOMIC_RELAXED, __HIP_MEMORY_SCOPE_AGENT); }
__device__ __forceinline__ unsigned xb_add(unsigned* p, unsigned v) { return __hip_atomic_fetch_add(p, v, __ATOMIC_RELAXED, __HIP_MEMORY_SCOPE_AGENT); }
__device__ __forceinline__ unsigned xb_xcc_id() { return (unsigned)__builtin_amdgcn_s_getreg((3 << 11) | 20) & 0xFu; }
#define XB_SPIN(cond, bar) do { unsigned _sp = 0; while (cond) { __builtin_amdgcn_s_sleep(1); \
    if ((++_sp & 255u) == 0u) { if (xb_ld(&(bar)[XB_TMO])) break; if (_sp > XB_SPIN_CAP) { atomicAdd(&(bar)[XB_TMO], 1u); break; } } } } while (0)
__device__ __forceinline__ void xcd_barrier_complete(unsigned* bar, unsigned x, unsigned& nloc, unsigned& nx) {
    const unsigned G = gridDim.x * gridDim.y * gridDim.z;
    unsigned sum, cnt, mine, sp = 0u;
    for (;;) {
        sum = 0u; cnt = 0u; mine = 0u;
#pragma unroll
        for (unsigned j = 0; j < 16; ++j) { const unsigned c = xb_ld(&bar[XB_XCNT(j)]); sum += c; cnt += (c > 0u) ? 1u : 0u; mine = (j == x) ? c : mine; }
        if (sum == G) break;
        __builtin_amdgcn_s_sleep(1);
        if ((++sp & 255u) == 0u) { if (xb_ld(&bar[XB_TMO])) break; if (sp > XB_SPIN_CAP) { atomicAdd(&bar[XB_TMO], 1u); break; } }
    }
    nloc = mine > 0u ? mine : 1u; nx = cnt > 0u ? cnt : 1u;
}
__device__ __forceinline__ void xcd_barrier(unsigned* bar, unsigned x, volatile LAS unsigned* st, bool leader) {
    asm volatile("s_waitcnt vmcnt(0)" ::: "memory");
    __syncthreads();
    if (leader) {
        __builtin_amdgcn_s_waitcnt(0);
        unsigned nloc = st[0], nx = st[1];
        if (nloc == 0u) { xcd_barrier_complete(bar, x, nloc, nx); st[0] = nloc; st[1] = nx; }
        const unsigned old = xb_add(&bar[XB_XSUB(x)], 1u);
        const unsigned gen = old / nloc;
        if (old + 1u == (gen + 1u) * nloc) {
            __builtin_amdgcn_fence(__ATOMIC_RELEASE, "agent");
            asm volatile("s_waitcnt vmcnt(0)" ::: "memory");
            const unsigned og = xb_add(&bar[XB_TOP], 1u);
            const unsigned tg = og / nx;
            if (og + 1u == (tg + 1u) * nx) xb_add(&bar[XB_TOPGEN], 1u);
            else XB_SPIN(xb_ld(&bar[XB_TOPGEN]) == tg, bar);
            __builtin_amdgcn_fence(__ATOMIC_ACQUIRE, "agent");
            xb_add(&bar[XB_XGEN(x)], 1u);
            asm volatile("s_waitcnt vmcnt(0)" ::: "memory");
        } else {
            XB_SPIN(xb_ld(&bar[XB_XGEN(x)]) == gen, bar);
            __builtin_amdgcn_fence(__ATOMIC_ACQUIRE, "agent");
            asm volatile("s_waitcnt vmcnt(0)" ::: "memory");
        }
    }
    __syncthreads();
}

namespace pg8 {
#define PG8_LAS __attribute__((address_space(3)))
typedef unsigned short bf16_t;
constexpr int BM = 256, BK = 64, HALF = 128, HTB = HALF * BK * 2, STAGE_BYTES = 8 * HTB, NXCD = 8, WGM = 8;
__host__ __device__ __forceinline__ int lds_byte(int r, int c) { const int st = (r >> 4) * 2 + (c >> 5), rr = r & 15, cc = c & 31, ob = rr * 64 + cc * 2; return st * 1024 + (ob ^ (((ob >> 9) & 1) << 5)); }
__host__ __device__ __forceinline__ void stage_rc(int b, int& R, int& C) { const int st = b / 1024, sb = b % 1024, swz = sb ^ (((sb >> 9) & 1) << 5); R = (st >> 1) * 16 + swz / 64; C = (st & 1) * 32 + (swz % 64) / 2; }
__host__ __device__ __forceinline__ int perm32(int rho) { const int n = rho >> 4, i = rho & 15; return 8 * (i >> 2) + 4 * n + (i & 3); }
struct Unit { int pm, pn; };
struct Gemm { const bf16_t* A; const bf16_t* Bt; int M, N, K; };
struct StaticOrder {
    int nM, nN, nwg, G, c;
    __host__ __device__ void init(int M, int N, int G_, int c_) { nM = M / BM; nN = N / BM; nwg = nM * nN; G = G_; c = c_; }
    __host__ __device__ bool next(int i, Unit& u) const {
        const long L = (long)i * G + c; if (L >= nwg) return false;
        int wgid = (int)L; { const int q = nwg / NXCD, r = nwg % NXCD, xcd = wgid % NXCD, off = wgid / NXCD; wgid = (xcd < r ? xcd * (q + 1) : r * (q + 1) + (xcd - r) * q) + off; }
        const int nig = WGM * nN, gid = wgid / nig, fm = gid * WGM, gsz = (nM - fm) < WGM ? (nM - fm) : WGM;
        u.pm = fm + ((wgid % nig) % gsz); u.pn = (wgid % nig) / gsz; return true;
    }
    __device__ __forceinline__ void a_ready(const Unit&) const {}
    __device__ __forceinline__ void done(const Unit&) const {}
};

template <class Epi, class Sched, bool SP2>
__device__ __forceinline__ void gemm_phase(PG8_LAS unsigned char* lds, const Gemm g, const Sched& S, const Epi& E, const int tid) {
    const int wid = __builtin_amdgcn_readfirstlane(tid >> 6), lane = tid & 63, wr = wid >> 2, wc = wid & 3, fr = lane & 15, fq = lane >> 4;
    const int K = g.K, nt = K / BK;
    unsigned voffA[2], voffB[2];
#pragma unroll
    for (int i = 0; i < 2; ++i) { int R, C; stage_rc(tid * 16 + i * 8192, R, C); const int Rb = Epi::PERM ? ((R & ~31) + perm32(R & 31)) : R;
        voffA[i] = (unsigned)(R * K + C) * 2u; voffB[i] = (unsigned)(Rb * K + C) * 2u; }
    const size_t kstep = (size_t)(BK * 2);
    const size_t hstep = (size_t)HALF * K * 2;
    const size_t tstep = 2 * hstep;
    const unsigned ldsw = (unsigned)wid * 1024u;
    const int aoff = lds_byte(wr * 64 + fr, fq * 8), boff = lds_byte(wc * 32 + fr, fq * 8);
#define PG8_SA(b, h) (((b) * 2 + (h)) * HTB)
#define PG8_SB(b, h) ((4 + (b) * 2 + (h)) * HTB)
#define PG8_STAGE(bufoff, gbase, voff) do { _Pragma("unroll") for (int _i = 0; _i < 2; ++_i) \
        __builtin_amdgcn_global_load_lds((const unsigned*)((const char*)(gbase) + (voff)[_i]), (PG8_LAS unsigned*)(lds + (bufoff) + ldsw + _i * 8192), 16, 0, 0); } while (0)
#define PG8_LDA(dst, b, h) do { _Pragma("unroll") for (int m = 0; m < 4; ++m) _Pragma("unroll") for (int k = 0; k < 2; ++k) dst[m][k] = *(const PG8_LAS bf16x8*)(lds + PG8_SA(b, h) + aoff + m * 2048 + k * 1024); } while (0)
#define PG8_LDB(dst, b, h) do { _Pragma("unroll") for (int n = 0; n < 2; ++n) _Pragma("unroll") for (int k = 0; k < 2; ++k) dst[n][k] = *(const PG8_LAS bf16x8*)(lds + PG8_SB(b, h) + boff + n * 2048 + k * 1024); } while (0)
#define PG8_MMA(ai, bj, At, Bt) do { __builtin_amdgcn_s_setprio(1); _Pragma("unroll") for (int m = 0; m < 4; ++m) _Pragma("unroll") for (int n = 0; n < 2; ++n) _Pragma("unroll") for (int k = 0; k < 2; ++k) \
        acc[ai][bj][m][n] = __builtin_amdgcn_mfma_f32_16x16x32_bf16(Bt[n][k], At[m][k], acc[ai][bj][m][n], 0, 0, 0); __builtin_amdgcn_s_setprio(0); } while (0)
#define PG8_WAIT_V(n) asm volatile("s_waitcnt vmcnt(" #n ")" ::: "memory")
#define PG8_WAIT_L(n) asm volatile("s_waitcnt lgkmcnt(" #n ")" ::: "memory")
#define PG8_BAR __builtin_amdgcn_s_barrier()
#define PG8_SCHED __builtin_amdgcn_sched_barrier(0)
    Unit cur, nxt; int ui = 0;
    if (!S.next(0, cur)) return;
    f32x4 acc[2][2][4][2];
#pragma unroll
    for (int a = 0; a < 2; ++a)
#pragma unroll
        for (int b = 0; b < 2; ++b)
#pragma unroll
            for (int m = 0; m < 4; ++m)
#pragma unroll
                for (int n = 0; n < 2; ++n) acc[a][b][m][n] = (f32x4){0.f, 0.f, 0.f, 0.f};
    bf16x8 At[4][2], B0[2][2], B1[2][2];
    const char* cA = (const char*)g.A + (size_t)cur.pm * tstep; const char* cB = (const char*)g.Bt + (size_t)cur.pn * tstep;
    S.a_ready(cur);
    if constexpr (SP2) {
    PG8_STAGE(PG8_SB(0, 0), cB, voffB); PG8_STAGE(PG8_SB(0, 1), cB + hstep, voffB); PG8_STAGE(PG8_SA(0, 0), cA, voffA); PG8_STAGE(PG8_SA(0, 1), cA + hstep, voffA);
    if (wr == 1) PG8_BAR;
    PG8_WAIT_V(2); PG8_BAR;
    PG8_STAGE(PG8_SB(1, 0), cB + kstep, voffB); PG8_STAGE(PG8_SA(1, 0), cA + kstep, voffA); PG8_STAGE(PG8_SB(1, 1), cB + hstep + kstep, voffB);
    PG8_WAIT_V(6); PG8_BAR;
    } else {
    PG8_STAGE(PG8_SB(0, 0), cB, voffB); PG8_STAGE(PG8_SA(0, 0), cA, voffA); PG8_STAGE(PG8_SB(0, 1), cB + hstep, voffB); PG8_STAGE(PG8_SA(0, 1), cA + hstep, voffA);
    if (wr == 1) PG8_BAR;
    PG8_WAIT_V(4); PG8_BAR;
    PG8_STAGE(PG8_SB(1, 0), cB + kstep, voffB); PG8_STAGE(PG8_SA(1, 0), cA + kstep, voffA); PG8_STAGE(PG8_SB(1, 1), cB + hstep + kstep, voffB);
    PG8_WAIT_V(6); PG8_BAR;
    }
    for (;;) {
        const bool has_next = S.next(ui + 1, nxt);
        const char* nA = has_next ? (const char*)g.A + (size_t)nxt.pm * tstep : cA; const char* nB = has_next ? (const char*)g.Bt + (size_t)nxt.pn * tstep : cB;
        for (int t = 0; t < nt; t += 2) {
            const bool last = (t == nt - 2);
            const char* a1 = cA + (size_t)(t + 1) * kstep;
            const char* a2 = last ? nA : cA + (size_t)(t + 2) * kstep; const char* b2 = last ? nB : cB + (size_t)(t + 2) * kstep;
            const char* a3 = a2 + kstep; const char* b3 = b2 + kstep;
            if (last && has_next) S.a_ready(nxt);
            if constexpr (SP2) {
            PG8_LDB(B0, 0, 0); PG8_LDB(B1, 0, 1); PG8_SCHED; PG8_LDA(At, 0, 0); PG8_STAGE(PG8_SA(1, 1), a1 + hstep, voffA);
            PG8_WAIT_V(8); PG8_WAIT_L(0); PG8_BAR; PG8_MMA(0, 0, At, B0); PG8_MMA(0, 1, At, B1); PG8_BAR; PG8_SCHED;
            PG8_LDA(At, 0, 1); PG8_STAGE(PG8_SB(0, 0), b2, voffB); PG8_STAGE(PG8_SB(0, 1), b2 + hstep, voffB); PG8_STAGE(PG8_SA(0, 0), a2, voffA);
            PG8_WAIT_V(8); PG8_WAIT_L(0); PG8_BAR; PG8_MMA(1, 0, At, B0); PG8_MMA(1, 1, At, B1); PG8_BAR; PG8_SCHED;
            PG8_LDB(B0, 1, 0); PG8_LDB(B1, 1, 1); PG8_SCHED; PG8_LDA(At, 1, 0); PG8_STAGE(PG8_SA(0, 1), a2 + hstep, voffA);
            PG8_WAIT_V(8); PG8_WAIT_L(0); PG8_BAR; PG8_MMA(0, 0, At, B0); PG8_MMA(0, 1, At, B1); PG8_BAR; PG8_SCHED;
            PG8_LDA(At, 1, 1); PG8_STAGE(PG8_SB(1, 0), b3, voffB); PG8_STAGE(PG8_SB(1, 1), b3 + hstep, voffB); PG8_STAGE(PG8_SA(1, 0), a3, voffA);
            PG8_WAIT_V(8); PG8_WAIT_L(0); PG8_BAR; PG8_MMA(1, 0, At, B0); PG8_MMA(1, 1, At, B1); PG8_BAR; PG8_SCHED;
            } else {
            PG8_LDB(B0, 0, 0); PG8_SCHED; PG8_LDA(At, 0, 0); PG8_STAGE(PG8_SA(1, 1), a1 + hstep, voffA);
            PG8_WAIT_L(8); PG8_BAR; PG8_WAIT_L(0); PG8_MMA(0, 0, At, B0); PG8_BAR; PG8_SCHED;
            PG8_LDB(B1, 0, 1); PG8_STAGE(PG8_SB(0, 0), b2, voffB);
            PG8_BAR; PG8_WAIT_L(0); PG8_MMA(0, 1, At, B1); PG8_BAR;
            PG8_LDA(At, 0, 1); PG8_STAGE(PG8_SA(0, 0), a2, voffA);
            PG8_BAR; PG8_WAIT_L(0); PG8_MMA(1, 0, At, B0); PG8_BAR; PG8_SCHED;
            PG8_STAGE(PG8_SB(0, 1), b2 + hstep, voffB);
            PG8_WAIT_V(6); PG8_BAR; PG8_MMA(1, 1, At, B1); PG8_BAR;
            PG8_LDB(B0, 1, 0); PG8_SCHED; PG8_LDA(At, 1, 0); PG8_STAGE(PG8_SA(0, 1), a2 + hstep, voffA);
            PG8_WAIT_L(8); PG8_BAR; PG8_WAIT_L(0); PG8_MMA(0, 0, At, B0); PG8_BAR; PG8_SCHED;
            PG8_LDB(B1, 1, 1); PG8_STAGE(PG8_SB(1, 0), b3, voffB);
            PG8_BAR; PG8_WAIT_L(0); PG8_MMA(0, 1, At, B1); PG8_BAR;
            PG8_LDA(At, 1, 1); PG8_STAGE(PG8_SA(1, 0), a3, voffA);
            PG8_BAR; PG8_WAIT_L(0); PG8_MMA(1, 0, At, B0); PG8_BAR; PG8_SCHED;
            PG8_STAGE(PG8_SB(1, 1), b3 + hstep, voffB);
            PG8_WAIT_V(6); PG8_BAR; PG8_MMA(1, 1, At, B1); PG8_BAR;
            }
        }
        if (wr == 0) PG8_BAR;
        E(acc, cur, wr, wc, fr, fq); S.done(cur);
        if (!has_next) break;
#pragma unroll
        for (int a = 0; a < 2; ++a)
#pragma unroll
            for (int b = 0; b < 2; ++b)
#pragma unroll
                for (int m = 0; m < 4; ++m)
#pragma unroll
                    for (int n = 0; n < 2; ++n) acc[a][b][m][n] = (f32x4){0.f, 0.f, 0.f, 0.f};
        cur = nxt; cA = nA; cB = nB; ++ui;
        if (wr == 1) PG8_BAR;
    }
    PG8_WAIT_V(0);
    PG8_BAR;
#undef PG8_SA
#undef PG8_SB
#undef PG8_STAGE
#undef PG8_LDA
#undef PG8_LDB
#undef PG8_MMA
#undef PG8_WAIT_V
#undef PG8_WAIT_L
#undef PG8_BAR
#undef PG8_SCHED
}
}

struct EpiF32 {
    static constexpr bool PERM = false;
    float* C; int ldc; int ncols;
    __device__ __forceinline__ void operator()(const f32x4 (&acc)[2][2][4][2], const pg8::Unit& u, int wr, int wc, int fr, int fq) const {
        const int row0 = u.pm * 256 + wr * 64 + fr, col0 = u.pn * 256 + wc * 32 + 4 * fq;
#pragma unroll
        for (int ai = 0; ai < 2; ++ai)
#pragma unroll
            for (int m = 0; m < 4; ++m) { float* rowp = C + (size_t)(row0 + ai * 128 + m * 16) * ldc + col0;
#pragma unroll
                for (int bj = 0; bj < 2; ++bj)
#pragma unroll
                    for (int n = 0; n < 2; ++n) if (col0 + bj * 128 + n * 16 < ncols) *(f32x4*)(rowp + bj * 128 + n * 16) = acc[ai][bj][m][n]; }
    }
};
template <int ACT> struct EpiB16 {
    static constexpr bool PERM = true;
    bf16* O; int ldc; int ncols;
    __device__ __forceinline__ void operator()(const f32x4 (&acc)[2][2][4][2], const pg8::Unit& u, int wr, int wc, int fr, int fq) const {
        const int row0 = u.pm * 256 + wr * 64 + fr, col0 = u.pn * 256 + wc * 32 + 8 * fq;
#pragma unroll
        for (int ai = 0; ai < 2; ++ai)
#pragma unroll
            for (int m = 0; m < 4; ++m) { bf16* rowp = O + (size_t)(row0 + ai * 128 + m * 16) * ldc + col0;
#pragma unroll
                for (int bj = 0; bj < 2; ++bj) { f32x4 v0 = acc[ai][bj][m][0], v1 = acc[ai][bj][m][1];
                    if (col0 + bj * 128 >= ncols) continue;
                    if (ACT) {
#pragma unroll
                    for (int j = 0; j < 4; ++j) { const float a = fmaxf(v0[j], 0.f), b = fmaxf(v1[j], 0.f); v0[j] = a * a; v1[j] = b * b; } }
                    u32x4 w; w.x = cvt_pk_bf16(v0[0], v0[1]); w.y = cvt_pk_bf16(v0[2], v0[3]); w.z = cvt_pk_bf16(v1[0], v1[1]); w.w = cvt_pk_bf16(v1[2], v1[3]);
                    *(u32x4*)(rowp + bj * 128) = w; } }
    }
};
struct EpiQ {
    static constexpr bool PERM = false;
    bf16* Q; const float* ropec; const float* ropes;
    __device__ __forceinline__ void operator()(const f32x4 (&acc)[2][2][4][2], const pg8::Unit& u, int wr, int wc, int, int) const {
        const int ln = fresh_lane(), fr = ln & 15, fq = ln >> 4;
        const int row0 = u.pm * 256 + wr * 64 + fr; const bool sample = u.pm >= 32;
#pragma unroll
        for (int bj = 0; bj < 2; ++bj) {
            const int g0 = u.pn * 256 + bj * 128 + wc * 32, within0 = g0 % 192; const bool isrope = within0 >= 128; const int a = (within0 - 128) >> 5;
#pragma unroll
            for (int ai = 0; ai < 2; ++ai)
#pragma unroll
                for (int m = 0; m < 4; ++m) { const int row = row0 + ai * 128 + m * 16;
                    f32x4 x1 = acc[ai][bj][m][0], x2 = acc[ai][bj][m][1];
                    if (sample && isrope) { const int ntok = (row - NTOK_P) & 1023;
                        const f32x4 cs = *(const f32x4*)(ropec + ntok * 32 + a * 16 + 4 * fq), sn = *(const f32x4*)(ropes + ntok * 32 + a * 16 + 4 * fq);
                        const f32x4 o1 = x1 * cs - x2 * sn, o2 = x1 * sn + x2 * cs; x1 = o1; x2 = o2; }
                    x1 = x1 * QSCALE; x2 = x2 * QSCALE;
                    bf16* p = Q + (size_t)row * 768 + g0 + 4 * fq;
                    *(u32x2*)p = pk4(x1); *(u32x2*)(p + 16) = pk4(x2); asm volatile("" ::: "memory"); }
        }
    }
};
struct EpiKV {
    static constexpr bool PERM = false;
    bf16* KN; bf16* VTP; bf16* VTS;
    __device__ __forceinline__ void operator()(const f32x4 (&acc)[2][2][4][2], const pg8::Unit& u, int wr, int wc, int, int) const {
        const int ln = fresh_lane(), fr = ln & 15, fq = ln >> 4;
        const int h = u.pn, pm = u.pm;
        bf16* vt; int keys, keybase;
        if (pm < 32) { vt = VTP + (size_t)((pm * 4 + h) * 128) * 256; keys = 256; keybase = 0; }
        else if (pm < 48) { const int b = (pm - 32) >> 2; vt = VTS + (size_t)((b * 4 + h) * 128) * 1536; keys = 1536; keybase = 512 + ((pm - 32) & 3) * 256; }
        else { const int b = (pm - 48) >> 1; vt = VTS + (size_t)((b * 4 + h) * 128) * 1536; keys = 1536; keybase = ((pm - 48) & 1) * 256; }
#pragma unroll
        for (int ai = 0; ai < 2; ++ai)
#pragma unroll
            for (int m = 0; m < 4; ++m) { const int rloc = wr * 64 + fr + ai * 128 + m * 16;
                bf16* kp = KN + (size_t)(pm * 256 + rloc) * 512 + h * 128 + wc * 32 + 4 * fq;
#pragma unroll
                for (int n = 0; n < 2; ++n) *(u32x2*)(kp + 16 * n) = pk4(acc[ai][0][m][n]);
#pragma unroll
                for (int n = 0; n < 2; ++n) { const f32x4 v = acc[ai][1][m][n]; const u32x2 w = pk4(v);
                    bf16* vp = vt + (size_t)(wc * 32 + 16 * n + 4 * fq) * keys + keybase + rloc;
                    vp[0] = (bf16)(w.x & 0xffffu); vp[keys] = (bf16)(w.x >> 16); vp[2 * keys] = (bf16)(w.y & 0xffffu); vp[3 * keys] = (bf16)(w.y >> 16); }
                asm volatile("" ::: "memory");
            }
    }
};

struct Args {
    const float *x_prompt, *x_sample, *cache_ckv, *cache_krope, *c, *c_ctx, *w_ada, *b_ada, *g_pre_mix, *w_in, *g_q, *w_uq, *g_kv, *w_ukv,
                *g_v, *w_s, *b_s, *w_conv, *w_out, *g_post_mix, *g_pre_ffn, *w_ff1, *w_ff2, *g_post_ffn;
    float* out; unsigned char* ws; int ph_lo, ph_hi;
};

__device__ __forceinline__ void p0_transpose_item(const float* W, int K, int N, bf16* WT, LAS float* scr, int item, int lane) {
    const int nblk = N / 32, kb = item / nblk, nb = item % nblk, k0 = 64 * kb, n0 = 32 * nb;
#pragma unroll 8
    for (int i = 0; i < 32; ++i) { const int kk = 2 * i + (lane >> 5); scr[kk * 33 + (lane & 31)] = W[(size_t)(k0 + kk) * N + n0 + (lane & 31)]; }
    asm volatile("s_waitcnt lgkmcnt(0)" ::: "memory");
    const int c = lane & 7;
#pragma unroll
    for (int j = 0; j < 4; ++j) { const int n = (lane >> 3) + 8 * j; const LAS float* s = scr + (8 * c) * 33 + n;
        u32x4 o; o.x = cvt_pk_bf16(s[0 * 33], s[1 * 33]); o.y = cvt_pk_bf16(s[2 * 33], s[3 * 33]); o.z = cvt_pk_bf16(s[4 * 33], s[5 * 33]); o.w = cvt_pk_bf16(s[6 * 33], s[7 * 33]);
        *(u32x4*)(WT + (size_t)(n0 + n) * K + k0 + 8 * c) = o; }
    asm volatile("s_waitcnt lgkmcnt(0)" ::: "memory");
}

__device__ __forceinline__ void convert_layer(const Args& A, LAS unsigned char* lds, int l, int gwi, int nw, int wave, int lane) {
    unsigned char* ws = A.ws;
    LAS float* scr = (LAS float*)(lds + wave * 16384);
    constexpr int I_IN = 16 * 62, I_UQ = 6 * 24, I_UKV = 4 * 32, I_OUT = 16 * 32, I_F1 = 16 * 128, I_F2 = 64 * 32, I_L = I_IN + I_UQ + I_UKV + I_OUT + I_F1 + I_F2;
    for (int it = gwi; it < I_L; it += nw) {
        int r = it;
        if (r < I_IN) { p0_transpose_item(A.w_in + (size_t)l * 1024 * INC, 1024, INC, (bf16*)(ws + WS_WIN) + (size_t)l * 2048 * 1024, scr, r, lane); continue; } r -= I_IN;
        if (r < I_UQ) { p0_transpose_item(A.w_uq + (size_t)l * 384 * 768, 384, 768, (bf16*)(ws + WS_WUQ) + (size_t)l * 768 * 384, scr, r, lane); continue; } r -= I_UQ;
        if (r < I_UKV) { p0_transpose_item(A.w_ukv + (size_t)l * 256 * 1024, 256, 1024, (bf16*)(ws + WS_WUKV) + (size_t)l * 1024 * 256, scr, r, lane); continue; } r -= I_UKV;
        if (r < I_OUT) { p0_transpose_item(A.w_out + (size_t)l * 1024 * 1024, 1024, 1024, (bf16*)(ws + WS_WOUT) + (size_t)l * 1024 * 1024, scr, r, lane); continue; } r -= I_OUT;
        if (r < I_F1) { p0_transpose_item(A.w_ff1 + (size_t)l * 1024 * 4096, 1024, 4096, (bf16*)(ws + WS_WFF1) + (size_t)l * 4096 * 1024, scr, r, lane); continue; } r -= I_F1;
        p0_transpose_item(A.w_ff2 + (size_t)l * 4096 * 1024, 4096, 1024, (bf16*)(ws + WS_WFF2) + (size_t)l * 1024 * 4096, scr, r, lane);
    }
}

__device__ __forceinline__ void phase_prologue(const Args& A, LAS unsigned char* lds, int wave) {
    const int lane = fresh_lane(), tid = wave * 64 + lane;
    unsigned char* ws = A.ws;
    const int bid = blockIdx.x, G = gridDim.x;
    { const int gt = bid * 512 + tid;
      if (gt < 32768) { const int n = gt >> 5, a = (gt >> 4) & 1, f = gt & 15; const int pos = a == 0 ? (n >> 6) : (n & 63);
          double inv = 1.0; for (int i = 0; i < f; ++i) inv *= 0.5623413251903491;
          double rev = (double)pos * inv * 0.15915494309189535; rev -= floor(rev);
          const float rf = (float)rev;
          ((float*)(ws + WS_ROPE))[gt] = __builtin_amdgcn_cosf(rf); ((float*)(ws + WS_ROPE))[32768 + gt] = __builtin_amdgcn_sinf(rf); } }
    for (int it = bid; it < 192; it += G) {
        const int l = it / 48, cgp = it % 48;
        LAS float* sl = (LAS float*)lds;
        for (int i = tid; i < 5120; i += 512) { const int ci = i >> 10, k = i & 1023; const float v = ci == 0 ? A.c_ctx[k] : A.c[(ci - 1) * 1024 + k]; sl[i] = v / (1.0f + __expf(-v)); }
        __syncthreads();
        float a0[5], a1[5];
#pragma unroll
        for (int ci = 0; ci < 5; ++ci) { a0[ci] = 0.f; a1[ci] = 0.f; }
        const float* wp = A.w_ada + ((size_t)l * 1024 + wave * 128) * 6144 + cgp * 128 + 2 * lane;
#pragma unroll 8
        for (int kk = 0; kk < 128; ++kk) { const f32x2 wv = *(const f32x2*)(wp + (size_t)kk * 6144); const int k = wave * 128 + kk;
#pragma unroll
            for (int ci = 0; ci < 5; ++ci) { const float s = sl[ci * 1024 + k]; a0[ci] += s * wv.x; a1[ci] += s * wv.y; } }
        LAS float* part = (LAS float*)(lds + 32768);
#pragma unroll
        for (int ci = 0; ci < 5; ++ci) { part[(wave * 5 + ci) * 128 + 2 * lane] = a0[ci]; part[(wave * 5 + ci) * 128 + 2 * lane + 1] = a1[ci]; }
        __syncthreads();
        for (int i = tid; i < 640; i += 512) { const int ci = i >> 7, col = i & 127; float s = 0.f;
#pragma unroll
            for (int w = 0; w < 8; ++w) s += part[(w * 5 + ci) * 128 + col];
            const int gcol = cgp * 128 + col; ((float*)(ws + WS_MOD))[(l * 5 + ci) * 6144 + gcol] = s + A.b_ada[l * 6144 + gcol]; }
        __syncthreads();
    }
    convert_layer(A, lds, 0, bid * 8 + wave, G * 8, wave, lane);
}

__device__ __forceinline__ int cond_of_row(int r) { return r < NTOK_P ? 0 : 1 + ((r - NTOK_P) >> 10); }

__device__ __forceinline__ void norm_mod_store(const f32x4 (&v)[4], const LAS float* g, const LAS float* sc, const LAS float* sh, bf16* hrow, int lane) {
    float ss = 0.f;
#pragma unroll
    for (int j = 0; j < 4; ++j) ss += sumsq4(v[j]);
    const float rstd = 1.0f / sqrtf(wave_sum(ss, lane) * (1.0f / 1024.0f) + EPS);
#pragma unroll
    for (int j = 0; j < 4; ++j) { const int idx = 4 * lane + 256 * j;
        const f32x4 gg = *(const LAS f32x4*)(g + idx), s1 = *(const LAS f32x4*)(sc + idx), s0 = *(const LAS f32x4*)(sh + idx);
        const f32x4 o = v[j] * rstd * gg * (1.0f + s1) + s0;
        *(u32x2*)(hrow + idx) = pk4(o); }
}
__device__ __forceinline__ const float* x_in_row(const Args& A, int r) { return r < NTOK_P ? A.x_prompt + (size_t)r * 1024 : A.x_sample + (size_t)(r - NTOK_P) * 1024; }
__device__ __forceinline__ void fill_vec(LAS float* dst, const float* src, int tid) { if (tid < 256) *(LAS f32x4*)(dst + 4 * tid) = *(const f32x4*)(src + 4 * tid); }

__device__ __forceinline__ void phase_pre(const Args& A, LAS unsigned char* lds, int lane, int wave) {
    const int gw = blockIdx.x * 8 + wave, NGW = gridDim.x * 8;
    const float* mod = (const float*)(A.ws + WS_MOD); bf16* H = (bf16*)(A.ws + WS_H);
    LAS float* P = (LAS float*)lds;
    { const int t2 = (wave & 3) * 64 + lane, hv = wave >> 2;
      for (int v = hv; v < 11; v += 2) { const float* src = v == 0 ? A.g_pre_mix : (v <= 5 ? mod + (size_t)(v - 1) * 6144 + 1024 : mod + (size_t)(v - 6) * 6144);
          const int slot = v == 0 ? 1 : (v <= 5 ? 7 + (v - 1) : 12 + (v - 6));
          *(LAS f32x4*)(P + slot * 1024 + 4 * t2) = *(const f32x4*)(src + 4 * t2); } }
    __syncthreads();
    for (int r0 = gw; r0 < NTOK; r0 += 2 * NGW) {
        f32x4 v[2][4];
#pragma unroll
        for (int u = 0; u < 2; ++u) { const float* xr = x_in_row(A, r0 + u * NGW);
#pragma unroll
            for (int j = 0; j < 4; ++j) v[u][j] = __builtin_nontemporal_load((const f32x4*)(xr + 4 * lane + 256 * j)); }
#pragma unroll
        for (int u = 0; u < 2; ++u) { const int r = r0 + u * NGW, ci = cond_of_row(r);
            norm_mod_store(v[u], P + 1024, P + (7 + ci) * 1024, P + (12 + ci) * 1024, H + (size_t)r * 1024, lane); }
    }
    __syncthreads();
}

__device__ __forceinline__ void phase_post(const Args& A, int l, int which, LAS unsigned char* lds, int lane, int wave) {
    const int gw = blockIdx.x * 8 + wave, NGW = gridDim.x * 8;
    const float* mod = (const float*)(A.ws + WS_MOD); bf16* H = (bf16*)(A.ws + WS_H); const bf16* MIX = (const bf16*)(A.ws + WS_MIX);
    const bool first = (l == 0 && which == 0), has_h = (which == 0) || (l < DEPTH - 1);
    LAS float* P = (LAS float*)lds;
    { const int t2 = (wave & 3) * 64 + lane, hv = wave >> 2;
      const int l2 = which == 0 ? l : l + 1;
      for (int v = hv; v < 17; v += 2) { const float* src;
          if (v == 0) src = (which == 0 ? A.g_post_mix : A.g_post_ffn) + l * 1024;
          else if (v == 1) src = which == 0 ? A.g_pre_ffn + l * 1024 : A.g_pre_mix + (l2 < DEPTH ? l2 : l) * 1024;
          else if (v < 7) src = mod + (size_t)(l * 5 + (v - 2)) * 6144 + (which == 0 ? 2048 : 5120);
          else if (v < 12) src = mod + (size_t)((l2 < DEPTH ? l2 : l) * 5 + (v - 7)) * 6144 + (which == 0 ? 4096 : 1024);
          else src = mod + (size_t)((l2 < DEPTH ? l2 : l) * 5 + (v - 12)) * 6144 + (which == 0 ? 3072 : 0);
          *(LAS f32x4*)(P + v * 1024 + 4 * t2) = *(const f32x4*)(src + 4 * t2); } }
    __syncthreads();
    for (int r0 = gw; r0 < NTOK; r0 += 2 * NGW) {
        f32x4 v[2][4], t[2][4];
#pragma unroll
        for (int u = 0; u < 2; ++u) { const int r = r0 + u * NGW;
            const float* xr = first ? x_in_row(A, r) : A.out + (size_t)r * 1024; const bf16* tr = MIX + (size_t)r * 1024;
#pragma unroll
            for (int j = 0; j < 4; ++j) { v[u][j] = __builtin_nontemporal_load((const f32x4*)(xr + 4 * lane + 256 * j)); t[u][j] = ld4bf(tr + 4 * lane + 256 * j); } }
#pragma unroll
        for (int u = 0; u < 2; ++u) { const int r = r0 + u * NGW; const LAS float* ga = P + (2 + cond_of_row(r)) * 1024;
            float ss = 0.f;
#pragma unroll
            for (int j = 0; j < 4; ++j) ss += sumsq4(t[u][j]);
            const float rstd = 1.0f / sqrtf(wave_sum(ss, lane) * (1.0f / 1024.0f) + EPS);
#pragma unroll
            for (int j = 0; j < 4; ++j) { const int idx = 4 * lane + 256 * j;
                const f32x4 gg = *(const LAS f32x4*)(P + idx), gv = *(const LAS f32x4*)(ga + idx);
                v[u][j] = v[u][j] + gv * (t[u][j] * rstd * gg);
                __builtin_nontemporal_store(v[u][j], (f32x4*)(A.out + (size_t)r * 1024 + idx)); } }
        if (has_h) {
#pragma unroll
            for (int u = 0; u < 2; ++u) { const int r = r0 + u * NGW, ci = cond_of_row(r);
                norm_mod_store(v[u], P + 1024, P + (7 + ci) * 1024, P + (12 + ci) * 1024, H + (size_t)r * 1024, lane); } }
    }
    __syncthreads();
}

__device__ __forceinline__ void phase_split(const Args& A, int l, int lane, int wave) {
    const int gw = blockIdx.x * 8 + wave, NGW = gridDim.x * 8;
    unsigned char* ws = A.ws;
    const bf16* Z = (const bf16*)(ws + WS_Z);
    bf16* QN = (bf16*)(ws + WS_QN); bf16* CKVN = (bf16*)(ws + WS_CKVN); bf16* KRB = (bf16*)(ws + WS_KRB); bf16* UG = (bf16*)(ws + WS_UG); bf16* VN = (bf16*)(ws + WS_VN);
    bf16* CC = (bf16*)(ws + WS_CONCAT);
    const float* ropec = (const float*)(ws + WS_ROPE); const float* ropes = ropec + 32768;
    float* out_ckv = A.out + (size_t)NTOK * 1024; float* out_kr = out_ckv + (size_t)32 * 4 * 256 * 256;
    for (int idx = gw; idx < 2048; idx += NGW) { const int r = NTOK + idx, b = idx >> 9, j = idx & 511;
        const f32x4 cv = *(const f32x4*)(A.cache_ckv + ((size_t)(b * 4 + l) * 512 + j) * 256 + 4 * lane);
        const float kv = A.cache_krope[((size_t)(b * 4 + l) * 512 + j) * 64 + lane];
        *(u32x2*)(CKVN + (size_t)r * 256 + 4 * lane) = pk4(cv);
        KRB[(size_t)r * 64 + lane] = (bf16)(cvt_pk_bf16(kv, 0.f) & 0xffffu); }
    const f32x4 gkv = *(const f32x4*)(A.g_kv + l * 256 + 4 * lane), gvv = *(const f32x4*)(A.g_v + l * 256 + 4 * lane);
    const float* wcp = A.w_conv + (size_t)l * 3 * 256 + 4 * lane;
    const f32x4 wc0 = *(const f32x4*)(wcp), wc1 = *(const f32x4*)(wcp + 256), wc2 = *(const f32x4*)(wcp + 512);
    f32x2 gq[3];
#pragma unroll
    for (int j = 0; j < 3; ++j) gq[j] = *(const f32x2*)(A.g_q + l * 384 + 2 * lane + 128 * j);
    for (int r0 = gw; r0 < NTOK; r0 += 2 * NGW) {
        f32x2 q[2][3]; f32x4 cv[2], uu[2], vv[2], bg[2], zc[2], zm[2], zp[2]; float kr[2], cs[2], sn[2];
#pragma unroll
        for (int u = 0; u < 2; ++u) { const int r = r0 + u * NGW; const bf16* z = Z + (size_t)r * INC;
            const bool prompt = r < NTOK_P; const int n = prompt ? (r & 255) : ((r - NTOK_P) & 1023), len = prompt ? 256 : 1024;
#pragma unroll
            for (int j = 0; j < 3; ++j) q[u][j] = ld2bf(z + ZQ + 2 * lane + 128 * j);
            cv[u] = ld4bf(z + ZCKV + 4 * lane); kr[u] = ld1bf(z + ZKR + lane);
            uu[u] = ld4bf(z + ZU + 4 * lane); vv[u] = ld4bf(z + ZV + 4 * lane); bg[u] = ld4bf(z + ZBG + 4 * lane);
            zc[u] = ld4bf(z + ZCG + 4 * lane) * ld4bf(z + ZHH + 4 * lane);
            zm[u] = (f32x4){0.f, 0.f, 0.f, 0.f}; zp[u] = zm[u];
            if (n > 0) zm[u] = ld4bf(z - INC + ZCG + 4 * lane) * ld4bf(z - INC + ZHH + 4 * lane);
            if (n < len - 1) zp[u] = ld4bf(z + INC + ZCG + 4 * lane) * ld4bf(z + INC + ZHH + 4 * lane);
            cs[u] = 1.f; sn[u] = 0.f;
            if (!prompt) { const int a = lane >> 5, f = lane & 15; cs[u] = ropec[n * 32 + a * 16 + f]; sn[u] = ropes[n * 32 + a * 16 + f]; } }
#pragma unroll
        for (int u = 0; u < 2; ++u) { const int r = r0 + u * NGW; const bool prompt = r < NTOK_P; const int n = prompt ? (r & 255) : ((r - NTOK_P) & 1023);
            { float ss = 0.f;
#pragma unroll
              for (int j = 0; j < 3; ++j) ss += q[u][j].x * q[u][j].x + q[u][j].y * q[u][j].y;
              const float rstd = 1.0f / sqrtf(wave_sum(ss, lane) * (1.0f / 384.0f) + EPS);
#pragma unroll
              for (int j = 0; j < 3; ++j) *(unsigned*)(QN + (size_t)r * 384 + 2 * lane + 128 * j) = cvt_pk_bf16(q[u][j].x * rstd * gq[j].x, q[u][j].y * rstd * gq[j].y); }
            { const float rstd = 1.0f / sqrtf(wave_sum(sumsq4(cv[u]), lane) * (1.0f / 256.0f) + EPS);
              const f32x4 c2 = cv[u] * rstd * gkv;
              if (prompt) __builtin_nontemporal_store(c2, (f32x4*)(out_ckv + ((size_t)((r >> 8) * 4 + l) * 256 + n) * 256 + 4 * lane));
              *(u32x2*)(CKVN + (size_t)r * 256 + 4 * lane) = pk4(c2); }
            { float k2 = kr[u];
              if (prompt) __builtin_nontemporal_store(k2, out_kr + ((size_t)((r >> 8) * 4 + l) * 256 + n) * 64 + lane);
              else { const float partner = shx(k2, 16, lane); const int p = (lane >> 4) & 1;
                  k2 = p == 0 ? k2 * cs[u] - partner * sn[u] : partner * sn[u] + k2 * cs[u]; }
              KRB[(size_t)r * 64 + lane] = (bf16)(cvt_pk_bf16(k2, 0.f) & 0xffffu); }
            *(u32x2*)(UG + (size_t)r * 256 + 4 * lane) = pk4(gelu4(uu[u]));
            { f32x4 v = gelu4(vv[u]);
              const float rstd = 1.0f / sqrtf(wave_sum(sumsq4(v), lane) * (1.0f / 256.0f) + EPS);
              *(u32x2*)(VN + (size_t)r * 256 + 4 * lane) = pk4(v * rstd * gvv); }
            { const f32x4 y = zm[u] * wc0 + zc[u] * wc1 + zp[u] * wc2;
              *(u32x2*)(CC + (size_t)r * 1024 + 768 + 4 * lane) = pk4(bg[u] * y); }
        }
    }
}

#define MFMA32(a, b, c) __builtin_amdgcn_mfma_f32_32x32x16_bf16((a), (b), (c), 0, 0, 0)
constexpr int AT_KROW = 400, AT_VROW = 144, AT_KBYTES = 64 * AT_KROW, AT_STAGE = AT_KBYTES + 128 * AT_VROW;
__device__ __forceinline__ void attn_store_tile(const f32x16& ot, float inv, bf16* crow  , int t, int hh) {
#pragma unroll
    for (int g = 0; g < 4; ++g) { u32x2 w; w.x = cvt_pk_bf16(ot[4 * g] * inv, ot[4 * g + 1] * inv); w.y = cvt_pk_bf16(ot[4 * g + 2] * inv, ot[4 * g + 3] * inv);
        *(u32x2*)(crow + 32 * t + 8 * g + 4 * hh) = w; }
}

__device__ __forceinline__ void phase_mixer(const Args& A, int l, LAS unsigned char* lds, int lane_in, int wave) {
    unsigned char* ws = A.ws;
    const bf16* Q = (const bf16*)(ws + WS_Q); const bf16* KN = (const bf16*)(ws + WS_KNOPE); const bf16* KRB = (const bf16*)(ws + WS_KRB);
    const bf16* VTP = (const bf16*)(ws + WS_VTP); const bf16* VTS = (const bf16*)(ws + WS_VTS);
    const bf16* UG = (const bf16*)(ws + WS_UG); const bf16* VN = (const bf16*)(ws + WS_VN);
    bf16* CC = (bf16*)(ws + WS_CONCAT);
    for (int slot = 0; ; ++slot) {
        int it;
        if (gridDim.x == 256) {
            if (slot == 0) it = blockIdx.x; else if (slot == 1 && blockIdx.x >= 128 && blockIdx.x < 224) it = 256 + (int)blockIdx.x - 128; else break;
        } else { it = (int)blockIdx.x + slot * (int)gridDim.x; if (it >= 352) break; }
        int lane = lane_in; asm volatile("" : "+v"(lane));
        const int rho = lane & 31, hh = lane >> 5, tid = wave * 64 + lane;
        if (it < 256) {
            int h, q0, keys, nkeys, split, rowA, rowB; const bf16* vt;
            const bool heavy = it < 128;
            if (heavy) {
                const int xj = it >> 3, pr = 2 * (it & 7) + (xj >> 3), b = pr >> 2, qt = xj & 7; h = pr & 3;
                q0 = NTOK_P + b * 1024 + qt * 128 + (wave & 3) * 32; keys = 1536; nkeys = 1536; split = 512; rowA = NTOK + b * 512; rowB = NTOK_P + b * 1024;
                vt = VTS + (size_t)((b * 4 + h) * 128) * 1536; }
            else { const int i2 = it - 128, b = i2 >> 2; h = i2 & 3; q0 = b * 256 + wave * 32; keys = 256; nkeys = 256; split = 0; rowA = 0; rowB = b * 256;
                vt = VTP + (size_t)((b * 4 + h) * 128) * 256; }
            bf16x8 qf[12];
            { const bf16* qp = Q + (size_t)(q0 + rho) * 768 + h * 192 + 8 * hh;
#pragma unroll
              for (int ks = 0; ks < 12; ++ks) qf[ks] = *(const bf16x8*)(qp + 16 * ks); }
            f32x16 o[4];
#pragma unroll
            for (int t = 0; t < 4; ++t)
#pragma unroll
                for (int i = 0; i < 16; ++i) o[t][i] = 0.f;
            float m = -1e30f, lsum = 0.f;
            int kslot[2], kcol[2], vd[2], vc[2];
#pragma unroll
            for (int j = 0; j < 2; ++j) { const int c = tid + 512 * j, kap = c >> 4; kcol[j] = c & 15;
                kslot[j] = (kap & 32) + (kap & 3) + 4 * ((kap >> 4) & 1) + 8 * ((kap >> 2) & 3);
                vd[j] = c >> 3; vc[j] = c & 7; }
            const int rkap = tid >> 3, rc8 = tid & 7, rslot = (rkap & 32) + (rkap & 3) + 4 * ((rkap >> 4) & 1) + 8 * ((rkap >> 2) & 3);
            u32x4 sk[2], sr, sv[2];
#define AT_GLOAD(k0) do { const int rb_ = (k0) < split ? rowA + (k0) : rowB + ((k0) - split); \
                _Pragma("unroll") for (int j = 0; j < 2; ++j) sk[j] = *(const u32x4*)(KN + (size_t)(rb_ + ((tid + 512 * j) >> 4)) * 512 + h * 128 + kcol[j] * 8); \
                sr = *(const u32x4*)(KRB + (size_t)(rb_ + rkap) * 64 + rc8 * 8); \
                _Pragma("unroll") for (int j = 0; j < 2; ++j) sv[j] = *(const u32x4*)(vt + (size_t)vd[j] * keys + (k0) + vc[j] * 8); } while (0)
#define AT_SWRITE(buf) do { LAS unsigned char* sb_ = lds + (buf) * AT_STAGE; \
                _Pragma("unroll") for (int j = 0; j < 2; ++j) *(LAS u32x4*)(sb_ + kslot[j] * AT_KROW + kcol[j] * 16) = sk[j]; \
                *(LAS u32x4*)(sb_ + rslot * AT_KROW + 256 + rc8 * 16) = sr; \
                _Pragma("unroll") for (int j = 0; j < 2; ++j) *(LAS u32x4*)(sb_ + AT_KBYTES + vd[j] * AT_VROW + vc[j] * 16) = sv[j]; } while (0)
            const int ntile = nkeys >> 6;
            const int blk_lo = heavy ? (wave >> 2) : 0, blk_hi = heavy ? blk_lo + 1 : 2;
            AT_GLOAD(0); AT_SWRITE(0);
            __syncthreads();
            for (int tI = 0; tI < ntile; ++tI) {
                if (tI + 1 < ntile) AT_GLOAD((tI + 1) * 64);
                { const LAS unsigned char* sb = lds + (tI & 1) * AT_STAGE;
                for (int blk = blk_lo; blk < blk_hi; ++blk) {
                    const LAS unsigned char* kp = sb + (32 * blk + rho) * AT_KROW + hh * 16;
                    f32x16 sc, scb;
#pragma unroll
                    for (int i = 0; i < 16; ++i) { sc[i] = 0.f; scb[i] = 0.f; }
#pragma unroll
                    for (int ks = 0; ks < 12; ks += 2) { sc = MFMA32(*(const LAS bf16x8*)(kp + ks * 32), qf[ks], sc); scb = MFMA32(*(const LAS bf16x8*)(kp + ks * 32 + 32), qf[ks + 1], scb); }
                    sc = sc + scb;
                    float mx = sc[0];
#pragma unroll
                    for (int i = 1; i < 16; ++i) mx = fmaxf(mx, sc[i]);
                    mx = fmaxf(mx, shx(mx, 32, lane));
                    const float mn = fmaxf(m, mx), alpha = __builtin_amdgcn_exp2f(m - mn);
                    float ps = 0.f;
#pragma unroll
                    for (int i = 0; i < 16; ++i) { sc[i] = __builtin_amdgcn_exp2f(sc[i] - mn); ps += sc[i]; }
                    lsum = lsum * alpha + ps; m = mn;
#pragma unroll
                    for (int t = 0; t < 4; ++t) o[t] = o[t] * alpha;
                    bf16x8 pb[2];
#pragma unroll
                    for (int s2 = 0; s2 < 2; ++s2) { u32x4 w; w.x = cvt_pk_bf16(sc[8 * s2 + 0], sc[8 * s2 + 1]); w.y = cvt_pk_bf16(sc[8 * s2 + 2], sc[8 * s2 + 3]); w.z = cvt_pk_bf16(sc[8 * s2 + 4], sc[8 * s2 + 5]); w.w = cvt_pk_bf16(sc[8 * s2 + 6], sc[8 * s2 + 7]);
                        pb[s2] = __builtin_bit_cast(bf16x8, w); }
                    const LAS unsigned char* vp = sb + AT_KBYTES + rho * AT_VROW + (32 * blk + 16 * hh) * 2;
#pragma unroll
                    for (int t = 0; t < 4; ++t)
#pragma unroll
                        for (int s2 = 0; s2 < 2; ++s2) o[t] = MFMA32(*(const LAS bf16x8*)(vp + 32 * t * AT_VROW + 16 * s2), pb[s2], o[t]);
                }
                }
                if (tI + 1 < ntile) AT_SWRITE((tI + 1) & 1);
                __syncthreads();
            }
#undef AT_GLOAD
#undef AT_SWRITE
            lsum += shx(lsum, 32, lane);
            bf16* crow = CC + (size_t)(q0 + rho) * 1024 + h * 128;
            if (!heavy) { const float inv = 1.0f / lsum;
#pragma unroll
                for (int t = 0; t < 4; ++t) attn_store_tile(o[t], inv, crow, t, hh);
            } else {
                const int half = wave >> 2;
                LAS float* mine = (LAS float*)(lds + wave * 8704);
                LAS const float* theirs = (LAS const float*)(lds + (wave ^ 4) * 8704);
#pragma unroll
                for (int t2 = 0; t2 < 2; ++t2)
#pragma unroll
                    for (int i = 0; i < 16; ++i) mine[(t2 * 16 + i) * 64 + lane] = half == 0 ? o[2 + t2][i] : o[t2][i];
                if (hh == 0) { mine[2048 + rho] = m; mine[2080 + rho] = lsum; }
                __syncthreads();
                const float mp = theirs[2048 + rho], lp = theirs[2080 + rho];
                const float mg = fmaxf(m, mp), wo = __builtin_amdgcn_exp2f(m - mg), wp = __builtin_amdgcn_exp2f(mp - mg);
                const float inv = 1.0f / (wo * lsum + wp * lp);
#pragma unroll
                for (int t2 = 0; t2 < 2; ++t2) { f32x16 acc;
#pragma unroll
                    for (int i = 0; i < 16; ++i) acc[i] = wo * (half == 0 ? o[t2][i] : o[2 + t2][i]) + wp * theirs[(t2 * 16 + i) * 64 + lane];
                    attn_store_tile(acc, inv, crow, half * 2 + t2, hh); }
                __syncthreads();
            }
        } else {
            const int c = it - 256;
            LAS bf16* vnT = (LAS bf16*)lds;
#pragma unroll
            for (int pass = 0; pass < 8; ++pass) { const int u = wave + 8 * pass, qq = (u & 1) * 64 + lane, c8 = (u >> 1) * 8;
                const bf16x8 v = *(const bf16x8*)(VN + (size_t)(c * 128 + qq) * 256 + c8);
#pragma unroll
                for (int j = 0; j < 8; ++j) vnT[(c8 + j) * 136 + qq] = (bf16)v[j]; }
            __syncthreads();
            const int hd = wave & 3, ph = wave >> 2;
#pragma unroll
            for (int pp = 0; pp < 2; ++pp) { const int pt = 2 * ph + pp;
                f32x16 acc[2];
#pragma unroll
                for (int d = 0; d < 2; ++d)
#pragma unroll
                    for (int i = 0; i < 16; ++i) acc[d][i] = 0.f;
                const float* wrow = A.w_s + ((size_t)(l * 4 + hd) * 128 + 32 * pt + rho) * 128 + 8 * hh;
                f32x4 wv[16];
#pragma unroll
                for (int ks = 0; ks < 8; ++ks) { wv[2 * ks] = *(const f32x4*)(wrow + 16 * ks); wv[2 * ks + 1] = *(const f32x4*)(wrow + 16 * ks + 4); }
#pragma unroll
                for (int ks = 0; ks < 8; ++ks) { const f32x4 w0 = wv[2 * ks], w1 = wv[2 * ks + 1];
                    u32x4 w; w.x = cvt_pk_bf16(w0.x, w0.y); w.y = cvt_pk_bf16(w0.z, w0.w); w.z = cvt_pk_bf16(w1.x, w1.y); w.w = cvt_pk_bf16(w1.z, w1.w);
                    const bf16x8 af = __builtin_bit_cast(bf16x8, w);
#pragma unroll
                    for (int d = 0; d < 2; ++d) { const bf16x8 bfr = *(const LAS bf16x8*)(vnT + (hd * 64 + 32 * d + rho) * 136 + 16 * ks + 8 * hh); acc[d] = MFMA32(af, bfr, acc[d]); } }
                float bs[16]; bf16 ugv[2][16];
#pragma unroll
                for (int i = 0; i < 16; ++i) { const int p = 32 * pt + (i & 3) + 8 * (i >> 2) + 4 * hh; bs[i] = A.b_s[(l * 4 + hd) * 128 + p];
#pragma unroll
                    for (int d = 0; d < 2; ++d) ugv[d][i] = UG[((size_t)c * 128 + p) * 256 + hd * 64 + 32 * d + rho]; }
#pragma unroll
                for (int d = 0; d < 2; ++d) { const int col = hd * 64 + 32 * d + rho;
#pragma unroll
                    for (int i = 0; i < 16; ++i) { const int p = 32 * pt + (i & 3) + 8 * (i >> 2) + 4 * hh; const size_t row = (size_t)c * 128 + p;
                        const float mixed = acc[d][i] + bs[i];
                        const float ug = __uint_as_float((unsigned)ugv[d][i] << 16);
                        CC[row * 1024 + 512 + col] = (bf16)(cvt_pk_bf16(ug * mixed, 0.f) & 0xffffu); } }
            }
            __syncthreads();
        }
    }
}

__global__ void __launch_bounds__(512, 2) fwd_megakernel(Args A) {
    extern __shared__ __attribute__((aligned(16))) unsigned char smem[];
    LAS unsigned char* lds = (LAS unsigned char*)smem;
    const int wave0 = __builtin_amdgcn_readfirstlane((int)threadIdx.x >> 6);
    unsigned* const bar = (unsigned*)(A.ws + WS_BAR);
    volatile LAS unsigned* const barst = (volatile LAS unsigned*)(lds + LDS_BARST);
    const unsigned xcc = xb_xcc_id();
    if (wave0 == 0) { const int l0 = fresh_lane(); if (l0 < 2) barst[l0] = 0u; if (l0 == 0 && A.ph_hi - A.ph_lo > 1) (void)xb_add(&bar[XB_XCNT(xcc)], 1u); }
    __syncthreads();
    if (A.ph_lo < 0) cg::this_grid().sync();
    bool dup_done = false; (void)dup_done;
    for (int ph = A.ph_lo; ph < A.ph_hi; ++ph) {
        const int wave = wave0;
#define LANE fresh_lane()
#define TID (wave * 64 + fresh_lane())
        unsigned char* ws = A.ws; asm volatile("" : "+s"(ws));
        if (ph == 0) phase_prologue(A, lds, wave);
        else if (ph == 1) phase_pre(A, lds, LANE, wave);
        else {
            const int l = (ph - 2) / 9, k = (ph - 2) % 9;
            const int G = gridDim.x, bid = blockIdx.x;
            if (k == 0) {
                pg8::Gemm g{(const bf16*)(ws + WS_H), (const bf16*)(ws + WS_WIN) + (size_t)l * 2048 * 1024, NTOK, 2048, 1024}; pg8::StaticOrder S; S.init(NTOK, 2048, G, bid);
                EpiB16<0> E{(bf16*)(ws + WS_Z), INC, INC}; pg8::gemm_phase<EpiB16<0>, pg8::StaticOrder, true>(lds, g, S, E, TID);
            } else if (k == 1) phase_split(A, l, LANE, wave);
            else if (k == 2) {
                { pg8::Gemm g{(const bf16*)(ws + WS_QN), (const bf16*)(ws + WS_WUQ) + (size_t)l * 768 * 384, NTOK, 768, 384}; pg8::StaticOrder S; S.init(NTOK, 768, G, bid);
                  EpiQ E{(bf16*)(ws + WS_Q), (const float*)(ws + WS_ROPE), (const float*)(ws + WS_ROPE) + 32768}; pg8::gemm_phase<EpiQ, pg8::StaticOrder, false>(lds, g, S, E, TID); }
                                { pg8::Gemm g{(const bf16*)(ws + WS_CKVN), (const bf16*)(ws + WS_WUKV) + (size_t)l * 1024 * 256, NROWKV, 1024, 256}; pg8::StaticOrder S; S.init(NROWKV, 1024, G, (bid + G - 144 % G) % G);
                  EpiKV E{(bf16*)(ws + WS_KNOPE), (bf16*)(ws + WS_VTP), (bf16*)(ws + WS_VTS)}; pg8::gemm_phase<EpiKV, pg8::StaticOrder, false>(lds, g, S, E, TID); }
            } else if (k == 3) phase_mixer(A, l, lds, LANE, wave);
            else if (k == 4 || k == 7) {
                const bool o = (k == 4);
                pg8::Gemm g{(const bf16*)(ws + (o ? WS_CONCAT : WS_ACT)), o ? (const bf16*)(ws + WS_WOUT) + (size_t)l * 1024 * 1024 : (const bf16*)(ws + WS_WFF2) + (size_t)l * 1024 * 4096, NTOK, 1024, o ? 1024 : 4096};
                pg8::StaticOrder S; S.init(NTOK, 1024, G, bid);
                EpiB16<0> E{(bf16*)(ws + WS_MIX), 1024, 1024}; pg8::gemm_phase<EpiB16<0>, pg8::StaticOrder, true>(lds, g, S, E, TID);
                if (!o && l + 1 < DEPTH) { const int first = G > 192 ? 192 : 0;
                    if (bid >= first) convert_layer(A, lds, l + 1, (bid - first) * 8 + wave, (G - first) * 8, wave, LANE); }
            } else if (k == 5) phase_post(A, l, 0, lds, LANE, wave);
            else if (k == 6) {
                pg8::Gemm g{(const bf16*)(ws + WS_H), (const bf16*)(ws + WS_WFF1) + (size_t)l * 4096 * 1024, NTOK, 4096, 1024}; pg8::StaticOrder S; S.init(NTOK, 4096, G, bid);
                EpiB16<1> E{(bf16*)(ws + WS_ACT), 4096, 4096}; pg8::gemm_phase<EpiB16<1>, pg8::StaticOrder, true>(lds, g, S, E, TID);
            } else phase_post(A, l, 1, lds, LANE, wave);
        }
        if (ph + 1 < A.ph_hi) xcd_barrier(bar, xcc, barst, wave == 0 && fresh_lane() == 0);
#if PROBE_DUP >= 0
        {
            bool again = false;
            if (PROBE_DUP == 100) { if (ph + 1 < A.ph_hi) xcd_barrier(bar, xcc, barst, wave == 0 && fresh_lane() == 0); }
            else if (!dup_done) {
                const int kk = ph >= 2 ? (ph - 2) % 9 : -1;
                if (PROBE_DUP == 50) again = (ph == 0);
                else if (PROBE_DUP == 60) again = (kk == 0 || kk == 2 || kk == 4 || kk == 6 || kk == 7);
                else again = (kk == PROBE_DUP);
            }
            if (again) { dup_done = true; --ph; } else dup_done = false;
        }
#endif
    }
}

constexpr int N_PHASES = 2 + 9 * DEPTH;

extern "C" void kernel_launch(void* const* d_in, const int* in_sizes, int n_in, void* d_out, int out_size, void* d_ws, size_t ws_size, hipStream_t stream) {
    static int grid = 0;
    if (grid == 0) {
        if (n_in != 24 || ws_size < WS_END || in_sizes[9] != DEPTH * 1024 * INC) { fprintf(stderr, "kernel_launch: unexpected problem (n_in %d, ws %zu, w_in %d)\n", n_in, ws_size, n_in > 9 ? in_sizes[9] : -1); grid = -1; return; }
        int dev = 0, cus = 0, per_cu = 0;
        hipGetDevice(&dev); hipDeviceGetAttribute(&cus, hipDeviceAttributeMultiprocessorCount, dev);
        if (hipFuncSetAttribute((const void*)fwd_megakernel, hipFuncAttributeMaxDynamicSharedMemorySize, LDS_BYTES) != hipSuccess) { fprintf(stderr, "kernel_launch: hipFuncSetAttribute failed\n"); grid = -1; return; }
        if (hipOccupancyMaxActiveBlocksPerMultiprocessor(&per_cu, (const void*)fwd_megakernel, 512, LDS_BYTES) != hipSuccess || per_cu < 1) { fprintf(stderr, "kernel_launch: occupancy query says %d\n", per_cu); per_cu = 1; }
        (void)hipGetLastError();
        grid = cus * 1;
        fprintf(stderr, "kernel_launch: grid %d (cus %d, per_cu %d)\n", grid, cus, per_cu);
    }
    if (grid < 0) return;
    if (hipMemsetAsync((char*)d_ws + WS_BAR, 0, 16384, stream) != hipSuccess) { fprintf(stderr, "kernel_launch: memset failed\n"); return; }
    Args a{};
    const float** ap = (const float**)&a;
    for (int i = 0; i < 24; ++i) ap[i] = (const float*)d_in[i];
    a.out = (float*)d_out; a.ws = (unsigned char*)d_ws;
#if MK_PER_PHASE
    for (int ph = 0; ph < N_PHASES; ++ph) { a.ph_lo = ph; a.ph_hi = ph + 1; hipLaunchKernelGGL(fwd_megakernel, dim3(grid), dim3(512), LDS_BYTES, stream, a); }
#else
    a.ph_lo = 0; a.ph_hi = N_PHASES;
    void* args[] = {&a};
    hipError_t e = hipLaunchCooperativeKernel((const void*)fwd_megakernel, dim3(grid), dim3(512), args, LDS_BYTES, stream);
    if (e != hipSuccess) fprintf(stderr, "kernel_launch: cooperative launch failed: %s (grid %d)\n", hipGetErrorString(e), grid);
#endif
}
```

```cpp
#include <hip/hip_runtime.h>
#include <hip/hip_cooperative_groups.h>
#include <cstdio>
namespace cg = cooperative_groups;

#ifndef MK_PER_PHASE
#define MK_PER_PHASE 0
#endif

#ifndef PROBE_DUP
#define PROBE_DUP -1
#endif
#define LAS __attribute__((address_space(3)))
typedef unsigned short bf16;
typedef short bf16x8 __attribute__((ext_vector_type(8)));
typedef float f32x2 __attribute__((ext_vector_type(2)));
typedef float f32x4 __attribute__((ext_vector_type(4)));
typedef float f32x16 __attribute__((ext_vector_type(16)));
typedef unsigned u32x2 __attribute__((ext_vector_type(2)));
typedef unsigned u32x4 __attribute__((ext_vector_type(4)));

constexpr int DM = 1024, NTOK_P = 8192, NTOK_S = 4096, NTOK = 12288, NROWKV = 14336;
constexpr int DEPTH = 4, INC = 1984, DFF = 4096;
constexpr int ZQ = 0, ZCKV = 384, ZKR = 640, ZU = 704, ZV = 960, ZBG = 1216, ZCG = 1472, ZHH = 1728;
constexpr float EPS = 1e-6f;
constexpr float QSCALE = 0.07216878364870322f * 1.4426950408889634f;

constexpr size_t MiB = 1u << 20;
constexpr size_t WS_MOD = 0, WS_BAR = 512 * 1024, WS_ROPE = 1 * MiB, WS_WIN = 2 * MiB, WS_WUQ = 18 * MiB, WS_WUKV = 21 * MiB, WS_WOUT = 23 * MiB,
                 WS_WFF1 = 31 * MiB, WS_WFF2 = 63 * MiB, WS_H = 95 * MiB, WS_MIX = 119 * MiB, WS_CONCAT = 167 * MiB, WS_QN = 191 * MiB,
                 WS_CKVN = 200 * MiB, WS_KRB = 207 * MiB, WS_UG = 209 * MiB, WS_VN = 215 * MiB, WS_Q = 221 * MiB, WS_KNOPE = 239 * MiB,
                 WS_VTP = 253 * MiB, WS_VTS = 261 * MiB, WS_Z = 267 * MiB, WS_ACT = 267 * MiB, WS_END = 363 * MiB;
constexpr int LDS_BYTES = 147456, LDS_BARST = LDS_BYTES - 64;

__device__ __forceinline__ unsigned cvt_pk_bf16(float lo, float hi) { unsigned r; asm volatile("v_cvt_pk_bf16_f32 %0, %1, %2" : "=v"(r) : "v"(lo), "v"(hi)); return r; }
__device__ __forceinline__ int fresh_lane() { int l; asm volatile("v_mbcnt_lo_u32_b32 %0, -1, 0\n\tv_mbcnt_hi_u32_b32 %0, -1, %0" : "=v"(l)); return l; }
__device__ __forceinline__ float shx(float v, int mask, int lane) { return __int_as_float(__builtin_amdgcn_ds_bpermute((lane ^ mask) << 2, __float_as_int(v))); }
__device__ __forceinline__ float dpp_add(float v, const int ctrl_is) {
    return v; }
#define DPP_ADD(v, ctrl) ((v) + __int_as_float(__builtin_amdgcn_update_dpp(0, __float_as_int(v), (ctrl), 0xf, 0xf, true)))
__device__ __forceinline__ float wave_sum(float v, int lane) {
    (void)lane;
    v = DPP_ADD(v, 0xB1);
    v = DPP_ADD(v, 0x4E);
    v = DPP_ADD(v, 0x141);
    v = DPP_ADD(v, 0x140);
    const int vi = __float_as_int(v);
    return (__int_as_float(__builtin_amdgcn_readlane(vi, 0)) + __int_as_float(__builtin_amdgcn_readlane(vi, 16))) + (__int_as_float(__builtin_amdgcn_readlane(vi, 32)) + __int_as_float(__builtin_amdgcn_readlane(vi, 48)));
}
__device__ __forceinline__ float gelu_tanh(float x) { const float y = 0.7978845608028654f * (x + 0.044715f * x * x * x); return x / (1.0f + __expf(-2.0f * y)); }
__device__ __forceinline__ f32x4 gelu4(f32x4 v) { return (f32x4){gelu_tanh(v.x), gelu_tanh(v.y), gelu_tanh(v.z), gelu_tanh(v.w)}; }
__device__ __forceinline__ float sumsq4(f32x4 v) { return (v.x * v.x + v.y * v.y) + (v.z * v.z + v.w * v.w); }
__device__ __forceinline__ f32x4 ld4bf_nt(const bf16* p) { const u32x2 w = __builtin_nontemporal_load((const u32x2*)p); return (f32x4){__uint_as_float(w.x << 16), __uint_as_float(w.x & 0xffff0000u), __uint_as_float(w.y << 16), __uint_as_float(w.y & 0xffff0000u)}; }
__device__ __forceinline__ f32x4 ld4bf(const bf16* p) { const u32x2 w = *(const u32x2*)p; return (f32x4){__uint_as_float(w.x << 16), __uint_as_float(w.x & 0xffff0000u), __uint_as_float(w.y << 16), __uint_as_float(w.y & 0xffff0000u)}; }
__device__ __forceinline__ f32x2 ld2bf(const bf16* p) { const unsigned w = *(const unsigned*)p; return (f32x2){__uint_as_float(w << 16), __uint_as_float(w & 0xffff0000u)}; }
__device__ __forceinline__ float ld1bf(const bf16* p) { return __uint_as_float((unsigned)*p << 16); }
__device__ __forceinline__ u32x2 pk4(f32x4 v) { u32x2 w; w.x = cvt_pk_bf16(v.x, v.y); w.y = cvt_pk_bf16(v.z, v.w); return w; }


#define XB_TMO      128
#define XB_XCNT(j)  (256  + 64 * (j))
#define XB_XSUB(j)  (1280 + 64 * (j))
#define XB_XGEN(j)  (2304 + 64 * (j))
#define XB_TOP      3328
#define XB_TOPGEN   3392
#define XCD_BAR_WORDS 3456
#define XB_SPIN_CAP (1u << 18)
__device__ __forceinline__ unsigned xb_ld(unsigned* p)              { return __hip_atomic_load(p, __ATOMIC_RELAXED, __HIP_MEMORY_SCOPE_AGENT); }
__device__ __forceinline__ unsigned xb_add(unsigned* p, unsigned v) { return __hip_atomic_fetch_add(p, v, __ATOMIC_RELAXED, __HIP_MEMORY_SCOPE_AGENT); }
__device__ __forceinline__ unsigned xb_xcc_id() { return (unsigned)__builtin_amdgcn_s_getreg((3 << 11) | 20) & 0xFu; }
#define XB_SPIN(cond, bar) do { unsigned _sp = 0; while (cond) { __builtin_amdgcn_s_sleep(1); \
    if ((++_sp & 255u) == 0u) { if (xb_ld(&(bar)[XB_TMO])) break; if (_sp > XB_SPIN_CAP) { atomicAdd(&(bar)[XB_TMO], 1u); break; } } } } while (0)
__device__ __forceinline__ void xcd_barrier_complete(unsigned* bar, unsigned x, unsigned& nloc, unsigned& nx) {
    const unsigned G = gridDim.x * gridDim.y * gridDim.z;
    unsigned sum, cnt, mine, sp = 0u;
    for (;;) {
        sum = 0u; cnt = 0u; mine = 0u;
#pragma unroll
        for (unsigned j = 0; j < 16; ++j) { const unsigned c = xb_ld(&bar[XB_XCNT(j)]); sum += c; cnt += (c > 0u) ? 1u : 0u; mine = (j == x) ? c : mine; }
        if (sum == G) break;
        __builtin_amdgcn_s_sleep(1);
        if ((++sp & 255u) == 0u) { if (xb_ld(&bar[XB_TMO])) break; if (sp > XB_SPIN_CAP) { atomicAdd(&bar[XB_TMO], 1u); break; } }
    }
    nloc = mine > 0u ? mine : 1u; nx = cnt > 0u ? cnt : 1u;
}
__device__ __forceinline__ void xcd_barrier(unsigned* bar, unsigned x, volatile LAS unsigned* st, bool leader) {
    asm volatile("s_waitcnt vmcnt(0)" ::: "memory");
    __syncthreads();
    if (leader) {
        __builtin_amdgcn_s_waitcnt(0);
        unsigned nloc = st[0], nx = st[1];
        if (nloc == 0u) { xcd_barrier_complete(bar, x, nloc, nx); st[0] = nloc; st[1] = nx; }
        const unsigned old = xb_add(&bar[XB_XSUB(x)], 1u);
        const unsigned gen = old / nloc;
        if (old + 1u == (gen + 1u) * nloc) {
            __builtin_amdgcn_fence(__ATOMIC_RELEASE, "agent");
            asm volatile("s_waitcnt vmcnt(0)" ::: "memory");
            const unsigned og = xb_add(&bar[XB_TOP], 1u);
            const unsigned tg = og / nx;
            if (og + 1u == (tg + 1u) * nx) xb_add(&bar[XB_TOPGEN], 1u);
            else XB_SPIN(xb_ld(&bar[XB_TOPGEN]) == tg, bar);
            __builtin_amdgcn_fence(__ATOMIC_ACQUIRE, "agent");
            xb_add(&bar[XB_XGEN(x)], 1u);
            asm volatile("s_waitcnt vmcnt(0)" ::: "memory");
        } else {
            XB_SPIN(xb_ld(&bar[XB_XGEN(x)]) == gen, bar);
            __builtin_amdgcn_fence(__ATOMIC_ACQUIRE, "agent");
            asm volatile("s_waitcnt vmcnt(0)" ::: "memory");
        }
    }
    __syncthreads();
}

namespace pg8 {
#define PG8_LAS __attribute__((address_space(3)))
typedef unsigned short bf16_t;
constexpr int BM = 256, BK = 64, HALF = 128, HTB = HALF * BK * 2, STAGE_BYTES = 8 * HTB, NXCD = 8, WGM = 8;
__host__ __device__ __forceinline__ int lds_byte(int r, int c) { const int st = (r >> 4) * 2 + (c >> 5), rr = r & 15, cc = c & 31, ob = rr * 64 + cc * 2; return st * 1024 + (ob ^ (((ob >> 9) & 1) << 5)); }
__host__ __device__ __forceinline__ void stage_rc(int b, int& R, int& C) { const int st = b / 1024, sb = b % 1024, swz = sb ^ (((sb >> 9) & 1) << 5); R = (st >> 1) * 16 + swz / 64; C = (st & 1) * 32 + (swz % 64) / 2; }
__host__ __device__ __forceinline__ int perm32(int rho) { const int n = rho >> 4, i = rho & 15; return 8 * (i >> 2) + 4 * n + (i & 3); }
struct Unit { int pm, pn; };
struct Gemm { const bf16_t* A; const bf16_t* Bt; int M, N, K; };
struct StaticOrder {
    int nM, nN, nwg, G, c;
    __host__ __device__ void init(int M, int N, int G_, int c_) { nM = M / BM; nN = N / BM; nwg = nM * nN; G = G_; c = c_; }
    __host__ __device__ bool next(int i, Unit& u) const {
        const long L = (long)i * G + c; if (L >= nwg) return false;
        int wgid = (int)L; { const int q = nwg / NXCD, r = nwg % NXCD, xcd = wgid % NXCD, off = wgid / NXCD; wgid = (xcd < r ? xcd * (q + 1) : r * (q + 1) + (xcd - r) * q) + off; }
        const int nig = WGM * nN, gid = wgid / nig, fm = gid * WGM, gsz = (nM - fm) < WGM ? (nM - fm) : WGM;
        u.pm = fm + ((wgid % nig) % gsz); u.pn = (wgid % nig) / gsz; return true;
    }
    __device__ __forceinline__ void a_ready(const Unit&) const {}
    __device__ __forceinline__ void done(const Unit&) const {}
};

template <class Epi, class Sched, bool SP2>
__device__ __forceinline__ void gemm_phase(PG8_LAS unsigned char* lds, const Gemm g, const Sched& S, const Epi& E, const int tid) {
    const int wid = __builtin_amdgcn_readfirstlane(tid >> 6), lane = tid & 63, wr = wid >> 2, wc = wid & 3, fr = lane & 15, fq = lane >> 4;
    const int K = g.K, nt = K / BK;
    unsigned voffA[2], voffB[2];
#pragma unroll
    for (int i = 0; i < 2; ++i) { int R, C; stage_rc(tid * 16 + i * 8192, R, C); const int Rb = Epi::PERM ? ((R & ~31) + perm32(R & 31)) : R;
        voffA[i] = (unsigned)(R * K + C) * 2u; voffB[i] = (unsigned)(Rb * K + C) * 2u; }
    const size_t kstep = (size_t)(BK * 2);
    const size_t hstep = (size_t)HALF * K * 2;
    const size_t tstep = 2 * hstep;
    const unsigned ldsw = (unsigned)wid * 1024u;
    const int aoff = lds_byte(wr * 64 + fr, fq * 8), boff = lds_byte(wc * 32 + fr, fq * 8);
#define PG8_SA(b, h) (((b) * 2 + (h)) * HTB)
#define PG8_SB(b, h) ((4 + (b) * 2 + (h)) * HTB)
#define PG8_STAGE(bufoff, gbase, voff) do { _Pragma("unroll") for (int _i = 0; _i < 2; ++_i) \
        __builtin_amdgcn_global_load_lds((const unsigned*)((const char*)(gbase) + (voff)[_i]), (PG8_LAS unsigned*)(lds + (bufoff) + ldsw + _i * 8192), 16, 0, 0); } while (0)
#define PG8_LDA(dst, b, h) do { _Pragma("unroll") for (int m = 0; m < 4; ++m) _Pragma("unroll") for (int k = 0; k < 2; ++k) dst[m][k] = *(const PG8_LAS bf16x8*)(lds + PG8_SA(b, h) + aoff + m * 2048 + k * 1024); } while (0)
#define PG8_LDB(dst, b, h) do { _Pragma("unroll") for (int n = 0; n < 2; ++n) _Pragma("unroll") for (int k = 0; k < 2; ++k) dst[n][k] = *(const PG8_LAS bf16x8*)(lds + PG8_SB(b, h) + boff + n * 2048 + k * 1024); } while (0)
#define PG8_MMA(ai, bj, At, Bt) do { __builtin_amdgcn_s_setprio(1); _Pragma("unroll") for (int m = 0; m < 4; ++m) _Pragma("unroll") for (int n = 0; n < 2; ++n) _Pragma("unroll") for (int k = 0; k < 2; ++k) \
        acc[ai][bj][m][n] = __builtin_amdgcn_mfma_f32_16x16x32_bf16(Bt[n][k], At[m][k], acc[ai][bj][m][n], 0, 0, 0); __builtin_amdgcn_s_setprio(0); } while (0)
#define PG8_WAIT_V(n) asm volatile("s_waitcnt vmcnt(" #n ")" ::: "memory")
#define PG8_WAIT_L(n) asm volatile("s_waitcnt lgkmcnt(" #n ")" ::: "memory")
#define PG8_BAR __builtin_amdgcn_s_barrier()
#define PG8_SCHED __builtin_amdgcn_sched_barrier(0)
    Unit cur, nxt; int ui = 0;
    if (!S.next(0, cur)) return;
    f32x4 acc[2][2][4][2];
#pragma unroll
    for (int a = 0; a < 2; ++a)
#pragma unroll
        for (int b = 0; b < 2; ++b)
#pragma unroll
            for (int m = 0; m < 4; ++m)
#pragma unroll
                for (int n = 0; n < 2; ++n) acc[a][b][m][n] = (f32x4){0.f, 0.f, 0.f, 0.f};
    bf16x8 At[4][2], B0[2][2], B1[2][2];
    const char* cA = (const char*)g.A + (size_t)cur.pm * tstep; const char* cB = (const char*)g.Bt + (size_t)cur.pn * tstep;
    S.a_ready(cur);
    if constexpr (SP2) {
    PG8_STAGE(PG8_SB(0, 0), cB, voffB); PG8_STAGE(PG8_SB(0, 1), cB + hstep, voffB); PG8_STAGE(PG8_SA(0, 0), cA, voffA); PG8_STAGE(PG8_SA(0, 1), cA + hstep, voffA);
    if (wr == 1) PG8_BAR;
    PG8_WAIT_V(2); PG8_BAR;
    PG8_STAGE(PG8_SB(1, 0), cB + kstep, voffB); PG8_STAGE(PG8_SA(1, 0), cA + kstep, voffA); PG8_STAGE(PG8_SB(1, 1), cB + hstep + kstep, voffB);
    PG8_WAIT_V(6); PG8_BAR;
    } else {
    PG8_STAGE(PG8_SB(0, 0), cB, voffB); PG8_STAGE(PG8_SA(0, 0), cA, voffA); PG8_STAGE(PG8_SB(0, 1), cB + hstep, voffB); PG8_STAGE(PG8_SA(0, 1), cA + hstep, voffA);
    if (wr == 1) PG8_BAR;
    PG8_WAIT_V(4); PG8_BAR;
    PG8_STAGE(PG8_SB(1, 0), cB + kstep, voffB); PG8_STAGE(PG8_SA(1, 0), cA + kstep, voffA); PG8_STAGE(PG8_SB(1, 1), cB + hstep + kstep, voffB);
    PG8_WAIT_V(6); PG8_BAR;
    }
    for (;;) {
        const bool has_next = S.next(ui + 1, nxt);
        const char* nA = has_next ? (const char*)g.A + (size_t)nxt.pm * tstep : cA; const char* nB = has_next ? (const char*)g.Bt + (size_t)nxt.pn * tstep : cB;
        for (int t = 0; t < nt; t += 2) {
            const bool last = (t == nt - 2);
            const char* a1 = cA + (size_t)(t + 1) * kstep;
            const char* a2 = last ? nA : cA + (size_t)(t + 2) * kstep; const char* b2 = last ? nB : cB + (size_t)(t + 2) * kstep;
            const char* a3 = a2 + kstep; const char* b3 = b2 + kstep;
            if (last && has_next) S.a_ready(nxt);
            if constexpr (SP2) {
            PG8_LDB(B0, 0, 0); PG8_LDB(B1, 0, 1); PG8_SCHED; PG8_LDA(At, 0, 0); PG8_STAGE(PG8_SA(1, 1), a1 + hstep, voffA);
            PG8_WAIT_V(8); PG8_WAIT_L(0); PG8_BAR; PG8_MMA(0, 0, At, B0); PG8_MMA(0, 1, At, B1); PG8_BAR; PG8_SCHED;
            PG8_LDA(At, 0, 1); PG8_STAGE(PG8_SB(0, 0), b2, voffB); PG8_STAGE(PG8_SB(0, 1), b2 + hstep, voffB); PG8_STAGE(PG8_SA(0, 0), a2, voffA);
            PG8_WAIT_V(8); PG8_WAIT_L(0); PG8_BAR; PG8_MMA(1, 0, At, B0); PG8_MMA(1, 1, At, B1); PG8_BAR; PG8_SCHED;
            PG8_LDB(B0, 1, 0); PG8_LDB(B1, 1, 1); PG8_SCHED; PG8_LDA(At, 1, 0); PG8_STAGE(PG8_SA(0, 1), a2 + hstep, voffA);
            PG8_WAIT_V(8); PG8_WAIT_L(0); PG8_BAR; PG8_MMA(0, 0, At, B0); PG8_MMA(0, 1, At, B1); PG8_BAR; PG8_SCHED;
            PG8_LDA(At, 1, 1); PG8_STAGE(PG8_SB(1, 0), b3, voffB); PG8_STAGE(PG8_SB(1, 1), b3 + hstep, voffB); PG8_STAGE(PG8_SA(1, 0), a3, voffA);
            PG8_WAIT_V(8); PG8_WAIT_L(0); PG8_BAR; PG8_MMA(1, 0, At, B0); PG8_MMA(1, 1, At, B1); PG8_BAR; PG8_SCHED;
            } else {
            PG8_LDB(B0, 0, 0); PG8_SCHED; PG8_LDA(At, 0, 0); PG8_STAGE(PG8_SA(1, 1), a1 + hstep, voffA);
            PG8_WAIT_L(8); PG8_BAR; PG8_WAIT_L(0); PG8_MMA(0, 0, At, B0); PG8_BAR; PG8_SCHED;
            PG8_LDB(B1, 0, 1); PG8_STAGE(PG8_SB(0, 0), b2, voffB);
            PG8_BAR; PG8_WAIT_L(0); PG8_MMA(0, 1, At, B1); PG8_BAR;
            PG8_LDA(At, 0, 1); PG8_STAGE(PG8_SA(0, 0), a2, voffA);
            PG8_BAR; PG8_WAIT_L(0); PG8_MMA(1, 0, At, B0); PG8_BAR; PG8_SCHED;
            PG8_STAGE(PG8_SB(0, 1), b2 + hstep, voffB);
            PG8_WAIT_V(6); PG8_BAR; PG8_MMA(1, 1, At, B1); PG8_BAR;
            PG8_LDB(B0, 1, 0); PG8_SCHED; PG8_LDA(At, 1, 0); PG8_STAGE(PG8_SA(0, 1), a2 + hstep, voffA);
            PG8_WAIT_L(8); PG8_BAR; PG8_WAIT_L(0); PG8_MMA(0, 0, At, B0); PG8_BAR; PG8_SCHED;
            PG8_LDB(B1, 1, 1); PG8_STAGE(PG8_SB(1, 0), b3, voffB);
            PG8_BAR; PG8_WAIT_L(0); PG8_MMA(0, 1, At, B1); PG8_BAR;
            PG8_LDA(At, 1, 1); PG8_STAGE(PG8_SA(1, 0), a3, voffA);
            PG8_BAR; PG8_WAIT_L(0); PG8_MMA(1, 0, At, B0); PG8_BAR; PG8_SCHED;
            PG8_STAGE(PG8_SB(1, 1), b3 + hstep, voffB);
            PG8_WAIT_V(6); PG8_BAR; PG8_MMA(1, 1, At, B1); PG8_BAR;
            }
        }
        if (wr == 0) PG8_BAR;
        E(acc, cur, wr, wc, fr, fq); S.done(cur);
        if (!has_next) break;
#pragma unroll
        for (int a = 0; a < 2; ++a)
#pragma unroll
            for (int b = 0; b < 2; ++b)
#pragma unroll
                for (int m = 0; m < 4; ++m)
#pragma unroll
                    for (int n = 0; n < 2; ++n) acc[a][b][m][n] = (f32x4){0.f, 0.f, 0.f, 0.f};
        cur = nxt; cA = nA; cB = nB; ++ui;
        if (wr == 1) PG8_BAR;
    }
    PG8_WAIT_V(0);
    PG8_BAR;
#undef PG8_SA
#undef PG8_SB
#undef PG8_STAGE
#undef PG8_LDA
#undef PG8_LDB
#undef PG8_MMA
#undef PG8_WAIT_V
#undef PG8_WAIT_L
#undef PG8_BAR
#undef PG8_SCHED
}
}

struct EpiF32 {
    static constexpr bool PERM = false;
    float* C; int ldc; int ncols;
    __device__ __forceinline__ void operator()(const f32x4 (&acc)[2][2][4][2], const pg8::Unit& u, int wr, int wc, int fr, int fq) const {
        const int row0 = u.pm * 256 + wr * 64 + fr, col0 = u.pn * 256 + wc * 32 + 4 * fq;
#pragma unroll
        for (int ai = 0; ai < 2; ++ai)
#pragma unroll
            for (int m = 0; m < 4; ++m) { float* rowp = C + (size_t)(row0 + ai * 128 + m * 16) * ldc + col0;
#pragma unroll
                for (int bj = 0; bj < 2; ++bj)
#pragma unroll
                    for (int n = 0; n < 2; ++n) if (col0 + bj * 128 + n * 16 < ncols) *(f32x4*)(rowp + bj * 128 + n * 16) = acc[ai][bj][m][n]; }
    }
};
template <int ACT> struct EpiB16 {
    static constexpr bool PERM = true;
    bf16* O; int ldc; int ncols;
    __device__ __forceinline__ void operator()(const f32x4 (&acc)[2][2][4][2], const pg8::Unit& u, int wr, int wc, int fr, int fq) const {
        const int row0 = u.pm * 256 + wr * 64 + fr, col0 = u.pn * 256 + wc * 32 + 8 * fq;
#pragma unroll
        for (int ai = 0; ai < 2; ++ai)
#pragma unroll
            for (int m = 0; m < 4; ++m) { bf16* rowp = O + (size_t)(row0 + ai * 128 + m * 16) * ldc + col0;
#pragma unroll
                for (int bj = 0; bj < 2; ++bj) { f32x4 v0 = acc[ai][bj][m][0], v1 = acc[ai][bj][m][1];
                    if (col0 + bj * 128 >= ncols) continue;
                    if (ACT) {
#pragma unroll
                    for (int j = 0; j < 4; ++j) { const float a = fmaxf(v0[j], 0.f), b = fmaxf(v1[j], 0.f); v0[j] = a * a; v1[j] = b * b; } }
                    u32x4 w; w.x = cvt_pk_bf16(v0[0], v0[1]); w.y = cvt_pk_bf16(v0[2], v0[3]); w.z = cvt_pk_bf16(v1[0], v1[1]); w.w = cvt_pk_bf16(v1[2], v1[3]);
                    *(u32x4*)(rowp + bj * 128) = w; } }
    }
};
struct EpiQ {
    static constexpr bool PERM = false;
    bf16* Q; const float* ropec; const float* ropes;
    __device__ __forceinline__ void operator()(const f32x4 (&acc)[2][2][4][2], const pg8::Unit& u, int wr, int wc, int, int) const {
        const int ln = fresh_lane(), fr = ln & 15, fq = ln >> 4;
        const int row0 = u.pm * 256 + wr * 64 + fr; const bool sample = u.pm >= 32;
#pragma unroll
        for (int bj = 0; bj < 2; ++bj) {
            const int g0 = u.pn * 256 + bj * 128 + wc * 32, within0 = g0 % 192; const bool isrope = within0 >= 128; const int a = (within0 - 128) >> 5;
#pragma unroll
            for (int ai = 0; ai < 2; ++ai)
#pragma unroll
                for (int m = 0; m < 4; ++m) { const int row = row0 + ai * 128 + m * 16;
                    f32x4 x1 = acc[ai][bj][m][0], x2 = acc[ai][bj][m][1];
                    if (sample && isrope) { const int ntok = (row - NTOK_P) & 1023;
                        const f32x4 cs = *(const f32x4*)(ropec + ntok * 32 + a * 16 + 4 * fq), sn = *(const f32x4*)(ropes + ntok * 32 + a * 16 + 4 * fq);
                        const f32x4 o1 = x1 * cs - x2 * sn, o2 = x1 * sn + x2 * cs; x1 = o1; x2 = o2; }
                    x1 = x1 * QSCALE; x2 = x2 * QSCALE;
                    bf16* p = Q + (size_t)row * 768 + g0 + 4 * fq;
                    *(u32x2*)p = pk4(x1); *(u32x2*)(p + 16) = pk4(x2); asm volatile("" ::: "memory"); }
        }
    }
};
struct EpiKV {
    static constexpr bool PERM = false;
    bf16* KN; bf16* VTP; bf16* VTS;
    __device__ __forceinline__ void operator()(const f32x4 (&acc)[2][2][4][2], const pg8::Unit& u, int wr, int wc, int, int) const {
        const int ln = fresh_lane(), fr = ln & 15, fq = ln >> 4;
        const int h = u.pn, pm = u.pm;
        bf16* vt; int keys, keybase;
        if (pm < 32) { vt = VTP + (size_t)((pm * 4 + h) * 128) * 256; keys = 256; keybase = 0; }
        else if (pm < 48) { const int b = (pm - 32) >> 2; vt = VTS + (size_t)((b * 4 + h) * 128) * 1536; keys = 1536; keybase = 512 + ((pm - 32) & 3) * 256; }
        else { const int b = (pm - 48) >> 1; vt = VTS + (size_t)((b * 4 + h) * 128) * 1536; keys = 1536; keybase = ((pm - 48) & 1) * 256; }
#pragma unroll
        for (int ai = 0; ai < 2; ++ai)
#pragma unroll
            for (int m = 0; m < 4; ++m) { const int rloc = wr * 64 + fr + ai * 128 + m * 16;
                bf16* kp = KN + (size_t)(pm * 256 + rloc) * 512 + h * 128 + wc * 32 + 4 * fq;
#pragma unroll
                for (int n = 0; n < 2; ++n) *(u32x2*)(kp + 16 * n) = pk4(acc[ai][0][m][n]);
#pragma unroll
                for (int n = 0; n < 2; ++n) { const f32x4 v = acc[ai][1][m][n]; const u32x2 w = pk4(v);
                    bf16* vp = vt + (size_t)(wc * 32 + 16 * n + 4 * fq) * keys + keybase + rloc;
                    vp[0] = (bf16)(w.x & 0xffffu); vp[keys] = (bf16)(w.x >> 16); vp[2 * keys] = (bf16)(w.y & 0xffffu); vp[3 * keys] = (bf16)(w.y >> 16); }
                asm volatile("" ::: "memory");
            }
    }
};

struct Args {
    const float *x_prompt, *x_sample, *cache_ckv, *cache_krope, *c, *c_ctx, *w_ada, *b_ada, *g_pre_mix, *w_in, *g_q, *w_uq, *g_kv, *w_ukv,
                *g_v, *w_s, *b_s, *w_conv, *w_out, *g_post_mix, *g_pre_ffn, *w_ff1, *w_ff2, *g_post_ffn;
    float* out; unsigned char* ws; int ph_lo, ph_hi;
};

__device__ __forceinline__ void p0_transpose_item(const float* W, int K, int N, bf16* WT, LAS float* scr, int item, int lane) {
    const int nblk = N / 32, kb = item / nblk, nb = item % nblk, k0 = 64 * kb, n0 = 32 * nb;
#pragma unroll 8
    for (int i = 0; i < 32; ++i) { const int kk = 2 * i + (lane >> 5); scr[kk * 33 + (lane & 31)] = W[(size_t)(k0 + kk) * N + n0 + (lane & 31)]; }
    asm volatile("s_waitcnt lgkmcnt(0)" ::: "memory");
    const int c = lane & 7;
#pragma unroll
    for (int j = 0; j < 4; ++j) { const int n = (lane >> 3) + 8 * j; const LAS float* s = scr + (8 * c) * 33 + n;
        u32x4 o; o.x = cvt_pk_bf16(s[0 * 33], s[1 * 33]); o.y = cvt_pk_bf16(s[2 * 33], s[3 * 33]); o.z = cvt_pk_bf16(s[4 * 33], s[5 * 33]); o.w = cvt_pk_bf16(s[6 * 33], s[7 * 33]);
        *(u32x4*)(WT + (size_t)(n0 + n) * K + k0 + 8 * c) = o; }
    asm volatile("s_waitcnt lgkmcnt(0)" ::: "memory");
}

__device__ __forceinline__ void convert_layer(const Args& A, LAS unsigned char* lds, int l, int gwi, int nw, int wave, int lane) {
    unsigned char* ws = A.ws;
    LAS float* scr = (LAS float*)(lds + wave * 16384);
    constexpr int I_IN = 16 * 62, I_UQ = 6 * 24, I_UKV = 4 * 32, I_OUT = 16 * 32, I_F1 = 16 * 128, I_F2 = 64 * 32, I_L = I_IN + I_UQ + I_UKV + I_OUT + I_F1 + I_F2;
    for (int it = gwi; it < I_L; it += nw) {
        int r = it;
        if (r < I_IN) { p0_transpose_item(A.w_in + (size_t)l * 1024 * INC, 1024, INC, (bf16*)(ws + WS_WIN) + (size_t)l * 2048 * 1024, scr, r, lane); continue; } r -= I_IN;
        if (r < I_UQ) { p0_transpose_item(A.w_uq + (size_t)l * 384 * 768, 384, 768, (bf16*)(ws + WS_WUQ) + (size_t)l * 768 * 384, scr, r, lane); continue; } r -= I_UQ;
        if (r < I_UKV) { p0_transpose_item(A.w_ukv + (size_t)l * 256 * 1024, 256, 1024, (bf16*)(ws + WS_WUKV) + (size_t)l * 1024 * 256, scr, r, lane); continue; } r -= I_UKV;
        if (r < I_OUT) { p0_transpose_item(A.w_out + (size_t)l * 1024 * 1024, 1024, 1024, (bf16*)(ws + WS_WOUT) + (size_t)l * 1024 * 1024, scr, r, lane); continue; } r -= I_OUT;
        if (r < I_F1) { p0_transpose_item(A.w_ff1 + (size_t)l * 1024 * 4096, 1024, 4096, (bf16*)(ws + WS_WFF1) + (size_t)l * 4096 * 1024, scr, r, lane); continue; } r -= I_F1;
        p0_transpose_item(A.w_ff2 + (size_t)l * 4096 * 1024, 4096, 1024, (bf16*)(ws + WS_WFF2) + (size_t)l * 1024 * 4096, scr, r, lane);
    }
}

__device__ __forceinline__ void phase_prologue(const Args& A, LAS unsigned char* lds, int wave) {
    const int lane = fresh_lane(), tid = wave * 64 + lane;
    unsigned char* ws = A.ws;
    const int bid = blockIdx.x, G = gridDim.x;
    { const int gt = bid * 512 + tid;
      if (gt < 32768) { const int n = gt >> 5, a = (gt >> 4) & 1, f = gt & 15; const int pos = a == 0 ? (n >> 6) : (n & 63);
          double inv = 1.0; for (int i = 0; i < f; ++i) inv *= 0.5623413251903491;
          double rev = (double)pos * inv * 0.15915494309189535; rev -= floor(rev);
          const float rf = (float)rev;
          ((float*)(ws + WS_ROPE))[gt] = __builtin_amdgcn_cosf(rf); ((float*)(ws + WS_ROPE))[32768 + gt] = __builtin_amdgcn_sinf(rf); } }
    for (int it = bid; it < 192; it += G) {
        const int l = it / 48, cgp = it % 48;
        LAS float* sl = (LAS float*)lds;
        for (int i = tid; i < 5120; i += 512) { const int ci = i >> 10, k = i & 1023; const float v = ci == 0 ? A.c_ctx[k] : A.c[(ci - 1) * 1024 + k]; sl[i] = v / (1.0f + __expf(-v)); }
        __syncthreads();
        float a0[5], a1[5];
#pragma unroll
        for (int ci = 0; ci < 5; ++ci) { a0[ci] = 0.f; a1[ci] = 0.f; }
        const float* wp = A.w_ada + ((size_t)l * 1024 + wave * 128) * 6144 + cgp * 128 + 2 * lane;
#pragma unroll 8
        for (int kk = 0; kk < 128; ++kk) { const f32x2 wv = *(const f32x2*)(wp + (size_t)kk * 6144); const int k = wave * 128 + kk;
#pragma unroll
            for (int ci = 0; ci < 5; ++ci) { const float s = sl[ci * 1024 + k]; a0[ci] += s * wv.x; a1[ci] += s * wv.y; } }
        LAS float* part = (LAS float*)(lds + 32768);
#pragma unroll
        for (int ci = 0; ci < 5; ++ci) { part[(wave * 5 + ci) * 128 + 2 * lane] = a0[ci]; part[(wave * 5 + ci) * 128 + 2 * lane + 1] = a1[ci]; }
        __syncthreads();
        for (int i = tid; i < 640; i += 512) { const int ci = i >> 7, col = i & 127; float s = 0.f;
#pragma unroll
            for (int w = 0; w < 8; ++w) s += part[(w * 5 + ci) * 128 + col];
            const int gcol = cgp * 128 + col; ((float*)(ws + WS_MOD))[(l * 5 + ci) * 6144 + gcol] = s + A.b_ada[l * 6144 + gcol]; }
        __syncthreads();
    }
    convert_layer(A, lds, 0, bid * 8 + wave, G * 8, wave, lane);
}

__device__ __forceinline__ int cond_of_row(int r) { return r < NTOK_P ? 0 : 1 + ((r - NTOK_P) >> 10); }

__device__ __forceinline__ void norm_mod_store(const f32x4 (&v)[4], const LAS float* g, const LAS float* sc, const LAS float* sh, bf16* hrow, int lane) {
    float ss = 0.f;
#pragma unroll
    for (int j = 0; j < 4; ++j) ss += sumsq4(v[j]);
    const float rstd = 1.0f / sqrtf(wave_sum(ss, lane) * (1.0f / 1024.0f) + EPS);
#pragma unroll
    for (int j = 0; j < 4; ++j) { const int idx = 4 * lane + 256 * j;
        const f32x4 gg = *(const LAS f32x4*)(g + idx), s1 = *(const LAS f32x4*)(sc + idx), s0 = *(const LAS f32x4*)(sh + idx);
        const f32x4 o = v[j] * rstd * gg * (1.0f + s1) + s0;
        *(u32x2*)(hrow + idx) = pk4(o); }
}
__device__ __forceinline__ const float* x_in_row(const Args& A, int r) { return r < NTOK_P ? A.x_prompt + (size_t)r * 1024 : A.x_sample + (size_t)(r - NTOK_P) * 1024; }
__device__ __forceinline__ void fill_vec(LAS float* dst, const float* src, int tid) { if (tid < 256) *(LAS f32x4*)(dst + 4 * tid) = *(const f32x4*)(src + 4 * tid); }

__device__ __forceinline__ void phase_pre(const Args& A, LAS unsigned char* lds, int lane, int wave) {
    const int gw = blockIdx.x * 8 + wave, NGW = gridDim.x * 8;
    const float* mod = (const float*)(A.ws + WS_MOD); bf16* H = (bf16*)(A.ws + WS_H);
    LAS float* P = (LAS float*)lds;
    { const int t2 = (wave & 3) * 64 + lane, hv = wave >> 2;
      for (int v = hv; v < 11; v += 2) { const float* src = v == 0 ? A.g_pre_mix : (v <= 5 ? mod + (size_t)(v - 1) * 6144 + 1024 : mod + (size_t)(v - 6) * 6144);
          const int slot = v == 0 ? 1 : (v <= 5 ? 7 + (v - 1) : 12 + (v - 6));
          *(LAS f32x4*)(P + slot * 1024 + 4 * t2) = *(const f32x4*)(src + 4 * t2); } }
    __syncthreads();
    for (int r0 = gw; r0 < NTOK; r0 += 2 * NGW) {
        f32x4 v[2][4];
#pragma unroll
        for (int u = 0; u < 2; ++u) { const float* xr = x_in_row(A, r0 + u * NGW);
#pragma unroll
            for (int j = 0; j < 4; ++j) v[u][j] = __builtin_nontemporal_load((const f32x4*)(xr + 4 * lane + 256 * j)); }
#pragma unroll
        for (int u = 0; u < 2; ++u) { const int r = r0 + u * NGW, ci = cond_of_row(r);
            norm_mod_store(v[u], P + 1024, P + (7 + ci) * 1024, P + (12 + ci) * 1024, H + (size_t)r * 1024, lane); }
    }
    __syncthreads();
}

__device__ __forceinline__ void phase_post(const Args& A, int l, int which, LAS unsigned char* lds, int lane, int wave) {
    const int gw = blockIdx.x * 8 + wave, NGW = gridDim.x * 8;
    const float* mod = (const float*)(A.ws + WS_MOD); bf16* H = (bf16*)(A.ws + WS_H); const bf16* MIX = (const bf16*)(A.ws + WS_MIX);
    const bool first = (l == 0 && which == 0), has_h = (which == 0) || (l < DEPTH - 1);
    LAS float* P = (LAS float*)lds;
    { const int t2 = (wave & 3) * 64 + lane, hv = wave >> 2;
      const int l2 = which == 0 ? l : l + 1;
      for (int v = hv; v < 17; v += 2) { const float* src;
          if (v == 0) src = (which == 0 ? A.g_post_mix : A.g_post_ffn) + l * 1024;
          else if (v == 1) src = which == 0 ? A.g_pre_ffn + l * 1024 : A.g_pre_mix + (l2 < DEPTH ? l2 : l) * 1024;
          else if (v < 7) src = mod + (size_t)(l * 5 + (v - 2)) * 6144 + (which == 0 ? 2048 : 5120);
          else if (v < 12) src = mod + (size_t)((l2 < DEPTH ? l2 : l) * 5 + (v - 7)) * 6144 + (which == 0 ? 4096 : 1024);
          else src = mod + (size_t)((l2 < DEPTH ? l2 : l) * 5 + (v - 12)) * 6144 + (which == 0 ? 3072 : 0);
          *(LAS f32x4*)(P + v * 1024 + 4 * t2) = *(const f32x4*)(src + 4 * t2); } }
    __syncthreads();
    for (int r0 = gw; r0 < NTOK; r0 += 2 * NGW) {
        f32x4 v[2][4], t[2][4];
#pragma unroll
        for (int u = 0; u < 2; ++u) { const int r = r0 + u * NGW;
            const float* xr = first ? x_in_row(A, r) : A.out + (size_t)r * 1024; const bf16* tr = MIX + (size_t)r * 1024;
#pragma unroll
            for (int j = 0; j < 4; ++j) { v[u][j] = __builtin_nontemporal_load((const f32x4*)(xr + 4 * lane + 256 * j)); t[u][j] = ld4bf_nt(tr + 4 * lane + 256 * j); } }
#pragma unroll
        for (int u = 0; u < 2; ++u) { const int r = r0 + u * NGW; const LAS float* ga = P + (2 + cond_of_row(r)) * 1024;
            float ss = 0.f;
#pragma unroll
            for (int j = 0; j < 4; ++j) ss += sumsq4(t[u][j]);
            const float rstd = 1.0f / sqrtf(wave_sum(ss, lane) * (1.0f / 1024.0f) + EPS);
#pragma unroll
            for (int j = 0; j < 4; ++j) { const int idx = 4 * lane + 256 * j;
                const f32x4 gg = *(const LAS f32x4*)(P + idx), gv = *(const LAS f32x4*)(ga + idx);
                v[u][j] = v[u][j] + gv * (t[u][j] * rstd * gg);
                __builtin_nontemporal_store(v[u][j], (f32x4*)(A.out + (size_t)r * 1024 + idx)); } }
        if (has_h) {
#pragma unroll
            for (int u = 0; u < 2; ++u) { const int r = r0 + u * NGW, ci = cond_of_row(r);
                norm_mod_store(v[u], P + 1024, P + (7 + ci) * 1024, P + (12 + ci) * 1024, H + (size_t)r * 1024, lane); } }
    }
    __syncthreads();
}

__device__ __forceinline__ void phase_split(const Args& A, int l, int lane, int wave) {
    const int gw = blockIdx.x * 8 + wave, NGW = gridDim.x * 8;
    unsigned char* ws = A.ws;
    const bf16* Z = (const bf16*)(ws + WS_Z);
    bf16* QN = (bf16*)(ws + WS_QN); bf16* CKVN = (bf16*)(ws + WS_CKVN); bf16* KRB = (bf16*)(ws + WS_KRB); bf16* UG = (bf16*)(ws + WS_UG); bf16* VN = (bf16*)(ws + WS_VN);
    bf16* CC = (bf16*)(ws + WS_CONCAT);
    const float* ropec = (const float*)(ws + WS_ROPE); const float* ropes = ropec + 32768;
    float* out_ckv = A.out + (size_t)NTOK * 1024; float* out_kr = out_ckv + (size_t)32 * 4 * 256 * 256;
    for (int idx = gw; idx < 2048; idx += NGW) { const int r = NTOK + idx, b = idx >> 9, j = idx & 511;
        const f32x4 cv = *(const f32x4*)(A.cache_ckv + ((size_t)(b * 4 + l) * 512 + j) * 256 + 4 * lane);
        const float kv = A.cache_krope[((size_t)(b * 4 + l) * 512 + j) * 64 + lane];
        *(u32x2*)(CKVN + (size_t)r * 256 + 4 * lane) = pk4(cv);
        KRB[(size_t)r * 64 + lane] = (bf16)(cvt_pk_bf16(kv, 0.f) & 0xffffu); }
    const f32x4 gkv = *(const f32x4*)(A.g_kv + l * 256 + 4 * lane), gvv = *(const f32x4*)(A.g_v + l * 256 + 4 * lane);
    const float* wcp = A.w_conv + (size_t)l * 3 * 256 + 4 * lane;
    const f32x4 wc0 = *(const f32x4*)(wcp), wc1 = *(const f32x4*)(wcp + 256), wc2 = *(const f32x4*)(wcp + 512);
    f32x2 gq[3];
#pragma unroll
    for (int j = 0; j < 3; ++j) gq[j] = *(const f32x2*)(A.g_q + l * 384 + 2 * lane + 128 * j);
    for (int r0 = gw; r0 < NTOK; r0 += 2 * NGW) {
        f32x2 q[2][3]; f32x4 cv[2], uu[2], vv[2], bg[2], zc[2], zm[2], zp[2]; float kr[2], cs[2], sn[2];
#pragma unroll
        for (int u = 0; u < 2; ++u) { const int r = r0 + u * NGW; const bf16* z = Z + (size_t)r * INC;
            const bool prompt = r < NTOK_P; const int n = prompt ? (r & 255) : ((r - NTOK_P) & 1023), len = prompt ? 256 : 1024;
#pragma unroll
            for (int j = 0; j < 3; ++j) q[u][j] = ld2bf(z + ZQ + 2 * lane + 128 * j);
            cv[u] = ld4bf(z + ZCKV + 4 * lane); kr[u] = ld1bf(z + ZKR + lane);
            uu[u] = ld4bf(z + ZU + 4 * lane); vv[u] = ld4bf(z + ZV + 4 * lane); bg[u] = ld4bf(z + ZBG + 4 * lane);
            zc[u] = ld4bf(z + ZCG + 4 * lane) * ld4bf(z + ZHH + 4 * lane);
            zm[u] = (f32x4){0.f, 0.f, 0.f, 0.f}; zp[u] = zm[u];
            if (n > 0) zm[u] = ld4bf(z - INC + ZCG + 4 * lane) * ld4bf(z - INC + ZHH + 4 * lane);
            if (n < len - 1) zp[u] = ld4bf(z + INC + ZCG + 4 * lane) * ld4bf(z + INC + ZHH + 4 * lane);
            cs[u] = 1.f; sn[u] = 0.f;
            if (!prompt) { const int a = lane >> 5, f = lane & 15; cs[u] = ropec[n * 32 + a * 16 + f]; sn[u] = ropes[n * 32 + a * 16 + f]; } }
#pragma unroll
        for (int u = 0; u < 2; ++u) { const int r = r0 + u * NGW; const bool prompt = r < NTOK_P; const int n = prompt ? (r & 255) : ((r - NTOK_P) & 1023);
            { float ss = 0.f;
#pragma unroll
              for (int j = 0; j < 3; ++j) ss += q[u][j].x * q[u][j].x + q[u][j].y * q[u][j].y;
              const float rstd = 1.0f / sqrtf(wave_sum(ss, lane) * (1.0f / 384.0f) + EPS);
#pragma unroll
              for (int j = 0; j < 3; ++j) *(unsigned*)(QN + (size_t)r * 384 + 2 * lane + 128 * j) = cvt_pk_bf16(q[u][j].x * rstd * gq[j].x, q[u][j].y * rstd * gq[j].y); }
            { const float rstd = 1.0f / sqrtf(wave_sum(sumsq4(cv[u]), lane) * (1.0f / 256.0f) + EPS);
              const f32x4 c2 = cv[u] * rstd * gkv;
              if (prompt) __builtin_nontemporal_store(c2, (f32x4*)(out_ckv + ((size_t)((r >> 8) * 4 + l) * 256 + n) * 256 + 4 * lane));
              *(u32x2*)(CKVN + (size_t)r * 256 + 4 * lane) = pk4(c2); }
            { float k2 = kr[u];
              if (prompt) __builtin_nontemporal_store(k2, out_kr + ((size_t)((r >> 8) * 4 + l) * 256 + n) * 64 + lane);
              else { const float partner = shx(k2, 16, lane); const int p = (lane >> 4) & 1;
                  k2 = p == 0 ? k2 * cs[u] - partner * sn[u] : partner * sn[u] + k2 * cs[u]; }
              KRB[(size_t)r * 64 + lane] = (bf16)(cvt_pk_bf16(k2, 0.f) & 0xffffu); }
            *(u32x2*)(UG + (size_t)r * 256 + 4 * lane) = pk4(gelu4(uu[u]));
            { f32x4 v = gelu4(vv[u]);
              const float rstd = 1.0f / sqrtf(wave_sum(sumsq4(v), lane) * (1.0f / 256.0f) + EPS);
              *(u32x2*)(VN + (size_t)r * 256 + 4 * lane) = pk4(v * rstd * gvv); }
            { const f32x4 y = zm[u] * wc0 + zc[u] * wc1 + zp[u] * wc2;
              *(u32x2*)(CC + (size_t)r * 1024 + 768 + 4 * lane) = pk4(bg[u] * y); }
        }
    }
}

#define MFMA32(a, b, c) __builtin_amdgcn_mfma_f32_32x32x16_bf16((a), (b), (c), 0, 0, 0)
constexpr int AT_KROW = 400, AT_VROW = 144, AT_KBYTES = 64 * AT_KROW, AT_STAGE = AT_KBYTES + 128 * AT_VROW;
__device__ __forceinline__ void attn_store_tile(const f32x16& ot, float inv, bf16* crow  , int t, int hh) {
#pragma unroll
    for (int g = 0; g < 4; ++g) { u32x2 w; w.x = cvt_pk_bf16(ot[4 * g] * inv, ot[4 * g + 1] * inv); w.y = cvt_pk_bf16(ot[4 * g + 2] * inv, ot[4 * g + 3] * inv);
        *(u32x2*)(crow + 32 * t + 8 * g + 4 * hh) = w; }
}

__device__ __forceinline__ void phase_mixer(const Args& A, int l, LAS unsigned char* lds, int lane_in, int wave) {
    unsigned char* ws = A.ws;
    const bf16* Q = (const bf16*)(ws + WS_Q); const bf16* KN = (const bf16*)(ws + WS_KNOPE); const bf16* KRB = (const bf16*)(ws + WS_KRB);
    const bf16* VTP = (const bf16*)(ws + WS_VTP); const bf16* VTS = (const bf16*)(ws + WS_VTS);
    const bf16* UG = (const bf16*)(ws + WS_UG); const bf16* VN = (const bf16*)(ws + WS_VN);
    bf16* CC = (bf16*)(ws + WS_CONCAT);
    for (int slot = 0; ; ++slot) {
        int it;
        if (gridDim.x == 256) {
            if (slot == 0) it = blockIdx.x; else if (slot == 1 && blockIdx.x >= 128 && blockIdx.x < 224) it = 256 + (int)blockIdx.x - 128; else break;
        } else { it = (int)blockIdx.x + slot * (int)gridDim.x; if (it >= 352) break; }
        int lane = lane_in; asm volatile("" : "+v"(lane));
        const int rho = lane & 31, hh = lane >> 5, tid = wave * 64 + lane;
        if (it < 256) {
            int h, q0, keys, nkeys, split, rowA, rowB; const bf16* vt;
            const bool heavy = it < 128;
            if (heavy) {
                const int xj = it >> 3, pr = 2 * (it & 7) + (xj >> 3), b = pr >> 2, qt = xj & 7; h = pr & 3;
                q0 = NTOK_P + b * 1024 + qt * 128 + (wave & 3) * 32; keys = 1536; nkeys = 1536; split = 512; rowA = NTOK + b * 512; rowB = NTOK_P + b * 1024;
                vt = VTS + (size_t)((b * 4 + h) * 128) * 1536; }
            else { const int i2 = it - 128, b = i2 >> 2; h = i2 & 3; q0 = b * 256 + wave * 32; keys = 256; nkeys = 256; split = 0; rowA = 0; rowB = b * 256;
                vt = VTP + (size_t)((b * 4 + h) * 128) * 256; }
            bf16x8 qf[12];
            { const bf16* qp = Q + (size_t)(q0 + rho) * 768 + h * 192 + 8 * hh;
#pragma unroll
              for (int ks = 0; ks < 12; ++ks) qf[ks] = *(const bf16x8*)(qp + 16 * ks); }
            f32x16 o[4];
#pragma unroll
            for (int t = 0; t < 4; ++t)
#pragma unroll
                for (int i = 0; i < 16; ++i) o[t][i] = 0.f;
            float m = -1e30f, lsum = 0.f;
            int kslot[2], kcol[2], vd[2], vc[2];
#pragma unroll
            for (int j = 0; j < 2; ++j) { const int c = tid + 512 * j, kap = c >> 4; kcol[j] = c & 15;
                kslot[j] = (kap & 32) + (kap & 3) + 4 * ((kap >> 4) & 1) + 8 * ((kap >> 2) & 3);
                vd[j] = c >> 3; vc[j] = c & 7; }
            const int rkap = tid >> 3, rc8 = tid & 7, rslot = (rkap & 32) + (rkap & 3) + 4 * ((rkap >> 4) & 1) + 8 * ((rkap >> 2) & 3);
            u32x4 sk[2], sr, sv[2];
#define AT_GLOAD(k0) do { const int rb_ = (k0) < split ? rowA + (k0) : rowB + ((k0) - split); \
                _Pragma("unroll") for (int j = 0; j < 2; ++j) sk[j] = *(const u32x4*)(KN + (size_t)(rb_ + ((tid + 512 * j) >> 4)) * 512 + h * 128 + kcol[j] * 8); \
                sr = *(const u32x4*)(KRB + (size_t)(rb_ + rkap) * 64 + rc8 * 8); \
                _Pragma("unroll") for (int j = 0; j < 2; ++j) sv[j] = *(const u32x4*)(vt + (size_t)vd[j] * keys + (k0) + vc[j] * 8); } while (0)
#define AT_SWRITE(buf) do { LAS unsigned char* sb_ = lds + (buf) * AT_STAGE; \
                _Pragma("unroll") for (int j = 0; j < 2; ++j) *(LAS u32x4*)(sb_ + kslot[j] * AT_KROW + kcol[j] * 16) = sk[j]; \
                *(LAS u32x4*)(sb_ + rslot * AT_KROW + 256 + rc8 * 16) = sr; \
                _Pragma("unroll") for (int j = 0; j < 2; ++j) *(LAS u32x4*)(sb_ + AT_KBYTES + vd[j] * AT_VROW + vc[j] * 16) = sv[j]; } while (0)
            const int ntile = nkeys >> 6;
            const int blk_lo = heavy ? (wave >> 2) : 0, blk_hi = heavy ? blk_lo + 1 : 2;
            AT_GLOAD(0); AT_SWRITE(0);
            __syncthreads();
            for (int tI = 0; tI < ntile; ++tI) {
                if (tI + 1 < ntile) AT_GLOAD((tI + 1) * 64);
                { const LAS unsigned char* sb = lds + (tI & 1) * AT_STAGE;
                for (int blk = blk_lo; blk < blk_hi; ++blk) {
                    const LAS unsigned char* kp = sb + (32 * blk + rho) * AT_KROW + hh * 16;
                    f32x16 sc, scb;
#pragma unroll
                    for (int i = 0; i < 16; ++i) { sc[i] = 0.f; scb[i] = 0.f; }
#pragma unroll
                    for (int ks = 0; ks < 12; ks += 2) { sc = MFMA32(*(const LAS bf16x8*)(kp + ks * 32), qf[ks], sc); scb = MFMA32(*(const LAS bf16x8*)(kp + ks * 32 + 32), qf[ks + 1], scb); }
                    sc = sc + scb;
                    float mx = sc[0];
#pragma unroll
                    for (int i = 1; i < 16; ++i) mx = fmaxf(mx, sc[i]);
                    mx = fmaxf(mx, shx(mx, 32, lane));
                    const float mn = fmaxf(m, mx), alpha = __builtin_amdgcn_exp2f(m - mn);
                    float ps = 0.f;
#pragma unroll
                    for (int i = 0; i < 16; ++i) { sc[i] = __builtin_amdgcn_exp2f(sc[i] - mn); ps += sc[i]; }
                    lsum = lsum * alpha + ps; m = mn;
#pragma unroll
                    for (int t = 0; t < 4; ++t) o[t] = o[t] * alpha;
                    bf16x8 pb[2];
#pragma unroll
                    for (int s2 = 0; s2 < 2; ++s2) { u32x4 w; w.x = cvt_pk_bf16(sc[8 * s2 + 0], sc[8 * s2 + 1]); w.y = cvt_pk_bf16(sc[8 * s2 + 2], sc[8 * s2 + 3]); w.z = cvt_pk_bf16(sc[8 * s2 + 4], sc[8 * s2 + 5]); w.w = cvt_pk_bf16(sc[8 * s2 + 6], sc[8 * s2 + 7]);
                        pb[s2] = __builtin_bit_cast(bf16x8, w); }
                    const LAS unsigned char* vp = sb + AT_KBYTES + rho * AT_VROW + (32 * blk + 16 * hh) * 2;
#pragma unroll
                    for (int t = 0; t < 4; ++t)
#pragma unroll
                        for (int s2 = 0; s2 < 2; ++s2) o[t] = MFMA32(*(const LAS bf16x8*)(vp + 32 * t * AT_VROW + 16 * s2), pb[s2], o[t]);
                }
                }
                if (tI + 1 < ntile) AT_SWRITE((tI + 1) & 1);
                __syncthreads();
            }
#undef AT_GLOAD
#undef AT_SWRITE
            lsum += shx(lsum, 32, lane);
            bf16* crow = CC + (size_t)(q0 + rho) * 1024 + h * 128;
            if (!heavy) { const float inv = 1.0f / lsum;
#pragma unroll
                for (int t = 0; t < 4; ++t) attn_store_tile(o[t], inv, crow, t, hh);
            } else {
                const int half = wave >> 2;
                LAS float* mine = (LAS float*)(lds + wave * 8704);
                LAS const float* theirs = (LAS const float*)(lds + (wave ^ 4) * 8704);
#pragma unroll
                for (int t2 = 0; t2 < 2; ++t2)
#pragma unroll
                    for (int i = 0; i < 16; ++i) mine[(t2 * 16 + i) * 64 + lane] = half == 0 ? o[2 + t2][i] : o[t2][i];
                if (hh == 0) { mine[2048 + rho] = m; mine[2080 + rho] = lsum; }
                __syncthreads();
                const float mp = theirs[2048 + rho], lp = theirs[2080 + rho];
                const float mg = fmaxf(m, mp), wo = __builtin_amdgcn_exp2f(m - mg), wp = __builtin_amdgcn_exp2f(mp - mg);
                const float inv = 1.0f / (wo * lsum + wp * lp);
#pragma unroll
                for (int t2 = 0; t2 < 2; ++t2) { f32x16 acc;
#pragma unroll
                    for (int i = 0; i < 16; ++i) acc[i] = wo * (half == 0 ? o[t2][i] : o[2 + t2][i]) + wp * theirs[(t2 * 16 + i) * 64 + lane];
                    attn_store_tile(acc, inv, crow, half * 2 + t2, hh); }
                __syncthreads();
            }
        } else {
            const int c = it - 256;
            LAS bf16* vnT = (LAS bf16*)lds;
#pragma unroll
            for (int pass = 0; pass < 8; ++pass) { const int u = wave + 8 * pass, qq = (u & 1) * 64 + lane, c8 = (u >> 1) * 8;
                const bf16x8 v = *(const bf16x8*)(VN + (size_t)(c * 128 + qq) * 256 + c8);
#pragma unroll
                for (int j = 0; j < 8; ++j) vnT[(c8 + j) * 136 + qq] = (bf16)v[j]; }
            __syncthreads();
            const int hd = wave & 3, ph = wave >> 2;
#pragma unroll
            for (int pp = 0; pp < 2; ++pp) { const int pt = 2 * ph + pp;
                f32x16 acc[2];
#pragma unroll
                for (int d = 0; d < 2; ++d)
#pragma unroll
                    for (int i = 0; i < 16; ++i) acc[d][i] = 0.f;
                const float* wrow = A.w_s + ((size_t)(l * 4 + hd) * 128 + 32 * pt + rho) * 128 + 8 * hh;
                f32x4 wv[16];
#pragma unroll
                for (int ks = 0; ks < 8; ++ks) { wv[2 * ks] = *(const f32x4*)(wrow + 16 * ks); wv[2 * ks + 1] = *(const f32x4*)(wrow + 16 * ks + 4); }
#pragma unroll
                for (int ks = 0; ks < 8; ++ks) { const f32x4 w0 = wv[2 * ks], w1 = wv[2 * ks + 1];
                    u32x4 w; w.x = cvt_pk_bf16(w0.x, w0.y); w.y = cvt_pk_bf16(w0.z, w0.w); w.z = cvt_pk_bf16(w1.x, w1.y); w.w = cvt_pk_bf16(w1.z, w1.w);
                    const bf16x8 af = __builtin_bit_cast(bf16x8, w);
#pragma unroll
                    for (int d = 0; d < 2; ++d) { const bf16x8 bfr = *(const LAS bf16x8*)(vnT + (hd * 64 + 32 * d + rho) * 136 + 16 * ks + 8 * hh); acc[d] = MFMA32(af, bfr, acc[d]); } }
                float bs[16]; bf16 ugv[2][16];
#pragma unroll
                for (int i = 0; i < 16; ++i) { const int p = 32 * pt + (i & 3) + 8 * (i >> 2) + 4 * hh; bs[i] = A.b_s[(l * 4 + hd) * 128 + p];
#pragma unroll
                    for (int d = 0; d < 2; ++d) ugv[d][i] = UG[((size_t)c * 128 + p) * 256 + hd * 64 + 32 * d + rho]; }
#pragma unroll
                for (int d = 0; d < 2; ++d) { const int col = hd * 64 + 32 * d + rho;
#pragma unroll
                    for (int i = 0; i < 16; ++i) { const int p = 32 * pt + (i & 3) + 8 * (i >> 2) + 4 * hh; const size_t row = (size_t)c * 128 + p;
                        const float mixed = acc[d][i] + bs[i];
                        const float ug = __uint_as_float((unsigned)ugv[d][i] << 16);
                        CC[row * 1024 + 512 + col] = (bf16)(cvt_pk_bf16(ug * mixed, 0.f) & 0xffffu); } }
            }
            __syncthreads();
        }
    }
}

__global__ void __launch_bounds__(512, 2) fwd_megakernel(Args A) {
    extern __shared__ __attribute__((aligned(16))) unsigned char smem[];
    LAS unsigned char* lds = (LAS unsigned char*)smem;
    const int wave0 = __builtin_amdgcn_readfirstlane((int)threadIdx.x >> 6);
    unsigned* const bar = (unsigned*)(A.ws + WS_BAR);
    volatile LAS unsigned* const barst = (volatile LAS unsigned*)(lds + LDS_BARST);
    const unsigned xcc = xb_xcc_id();
    if (wave0 == 0) { const int l0 = fresh_lane(); if (l0 < 2) barst[l0] = 0u; if (l0 == 0 && A.ph_hi - A.ph_lo > 1) (void)xb_add(&bar[XB_XCNT(xcc)], 1u); }
    __syncthreads();
    if (A.ph_lo < 0) cg::this_grid().sync();
    bool dup_done = false; (void)dup_done;
    for (int ph = A.ph_lo; ph < A.ph_hi; ++ph) {
        const int wave = wave0;
#define LANE fresh_lane()
#define TID (wave * 64 + fresh_lane())
        unsigned char* ws = A.ws; asm volatile("" : "+s"(ws));
        if (ph == 0) phase_prologue(A, lds, wave);
        else if (ph == 1) phase_pre(A, lds, LANE, wave);
        else {
            const int l = (ph - 2) / 9, k = (ph - 2) % 9;
            const int G = gridDim.x, bid = blockIdx.x;
            if (k == 0) {
                pg8::Gemm g{(const bf16*)(ws + WS_H), (const bf16*)(ws + WS_WIN) + (size_t)l * 2048 * 1024, NTOK, 2048, 1024}; pg8::StaticOrder S; S.init(NTOK, 2048, G, bid);
                EpiB16<0> E{(bf16*)(ws + WS_Z), INC, INC}; pg8::gemm_phase<EpiB16<0>, pg8::StaticOrder, true>(lds, g, S, E, TID);
            } else if (k == 1) phase_split(A, l, LANE, wave);
            else if (k == 2) {
                { pg8::Gemm g{(const bf16*)(ws + WS_QN), (const bf16*)(ws + WS_WUQ) + (size_t)l * 768 * 384, NTOK, 768, 384}; pg8::StaticOrder S; S.init(NTOK, 768, G, bid);
                  EpiQ E{(bf16*)(ws + WS_Q), (const float*)(ws + WS_ROPE), (const float*)(ws + WS_ROPE) + 32768}; pg8::gemm_phase<EpiQ, pg8::StaticOrder, false>(lds, g, S, E, TID); }
                                { pg8::Gemm g{(const bf16*)(ws + WS_CKVN), (const bf16*)(ws + WS_WUKV) + (size_t)l * 1024 * 256, NROWKV, 1024, 256}; pg8::StaticOrder S; S.init(NROWKV, 1024, G, (bid + G - 144 % G) % G);
                  EpiKV E{(bf16*)(ws + WS_KNOPE), (bf16*)(ws + WS_VTP), (bf16*)(ws + WS_VTS)}; pg8::gemm_phase<EpiKV, pg8::StaticOrder, false>(lds, g, S, E, TID); }
            } else if (k == 3) phase_mixer(A, l, lds, LANE, wave);
            else if (k == 4 || k == 7) {
                const bool o = (k == 4);
                pg8::Gemm g{(const bf16*)(ws + (o ? WS_CONCAT : WS_ACT)), o ? (const bf16*)(ws + WS_WOUT) + (size_t)l * 1024 * 1024 : (const bf16*)(ws + WS_WFF2) + (size_t)l * 1024 * 4096, NTOK, 1024, o ? 1024 : 4096};
                pg8::StaticOrder S; S.init(NTOK, 1024, G, bid);
                EpiB16<0> E{(bf16*)(ws + WS_MIX), 1024, 1024}; pg8::gemm_phase<EpiB16<0>, pg8::StaticOrder, true>(lds, g, S, E, TID);
                if (!o && l + 1 < DEPTH) { const int first = G > 192 ? 192 : 0;
                    if (bid >= first) convert_layer(A, lds, l + 1, (bid - first) * 8 + wave, (G - first) * 8, wave, LANE); }
            } else if (k == 5) phase_post(A, l, 0, lds, LANE, wave);
            else if (k == 6) {
                pg8::Gemm g{(const bf16*)(ws + WS_H), (const bf16*)(ws + WS_WFF1) + (size_t)l * 4096 * 1024, NTOK, 4096, 1024}; pg8::StaticOrder S; S.init(NTOK, 4096, G, bid);
                EpiB16<1> E{(bf16*)(ws + WS_ACT), 4096, 4096}; pg8::gemm_phase<EpiB16<1>, pg8::StaticOrder, true>(lds, g, S, E, TID);
            } else phase_post(A, l, 1, lds, LANE, wave);
        }
        if (ph + 1 < A.ph_hi) xcd_barrier(bar, xcc, barst, wave == 0 && fresh_lane() == 0);
#if PROBE_DUP >= 0
        {
            bool again = false;
            if (PROBE_DUP == 100) { if (ph + 1 < A.ph_hi) xcd_barrier(bar, xcc, barst, wave == 0 && fresh_lane() == 0); }
            else if (!dup_done) {
                const int kk = ph >= 2 ? (ph - 2) % 9 : -1;
                if (PROBE_DUP == 50) again = (ph == 0);
                else if (PROBE_DUP == 60) again = (kk == 0 || kk == 2 || kk == 4 || kk == 6 || kk == 7);
                else again = (kk == PROBE_DUP);
            }
            if (again) { dup_done = true; --ph; } else dup_done = false;
        }
#endif
    }
}

constexpr int N_PHASES = 2 + 9 * DEPTH;

extern "C" void kernel_launch(void* const* d_in, const int* in_sizes, int n_in, void* d_out, int out_size, void* d_ws, size_t ws_size, hipStream_t stream) {
    static int grid = 0;
    if (grid == 0) {
        if (n_in != 24 || ws_size < WS_END || in_sizes[9] != DEPTH * 1024 * INC) { fprintf(stderr, "kernel_launch: unexpected problem (n_in %d, ws %zu, w_in %d)\n", n_in, ws_size, n_in > 9 ? in_sizes[9] : -1); grid = -1; return; }
        int dev = 0, cus = 0, per_cu = 0;
        hipGetDevice(&dev); hipDeviceGetAttribute(&cus, hipDeviceAttributeMultiprocessorCount, dev);
        if (hipFuncSetAttribute((const void*)fwd_megakernel, hipFuncAttributeMaxDynamicSharedMemorySize, LDS_BYTES) != hipSuccess) { fprintf(stderr, "kernel_launch: hipFuncSetAttribute failed\n"); grid = -1; return; }
        if (hipOccupancyMaxActiveBlocksPerMultiprocessor(&per_cu, (const void*)fwd_megakernel, 512, LDS_BYTES) != hipSuccess || per_cu < 1) { fprintf(stderr, "kernel_launch: occupancy query says %d\n", per_cu); per_cu = 1; }
        (void)hipGetLastError();
        grid = cus * 1;
        fprintf(stderr, "kernel_launch: grid %d (cus %d, per_cu %d)\n", grid, cus, per_cu);
    }
    if (grid < 0) return;
    if (hipMemsetAsync((char*)d_ws + WS_BAR, 0, 16384, stream) != hipSuccess) { fprintf(stderr, "kernel_launch: memset failed\n"); return; }
    Args a{};
    const float** ap = (const float**)&a;
    for (int i = 0; i < 24; ++i) ap[i] = (const float*)d_in[i];
    a.out = (float*)d_out; a.ws = (unsigned char*)d_ws;
#if MK_PER_PHASE
    for (int ph = 0; ph < N_PHASES; ++ph) { a.ph_lo = ph; a.ph_hi = ph + 1; hipLaunchKernelGGL(fwd_megakernel, dim3(grid), dim3(512), LDS_BYTES, stream, a); }
#else
    a.ph_lo = 0; a.ph_hi = N_PHASES;
    void* args[] = {&a};
    hipError_t e = hipLaunchCooperativeKernel((const void*)fwd_megakernel, dim3(grid), dim3(512), args, LDS_BYTES, stream);
    if (e != hipSuccess) fprintf(stderr, "kernel_launch: cooperative launch failed: %s (grid %d)\n", hipGetErrorString(e), grid);
#endif
}
```

```cpp
#include <hip/hip_runtime.h>
#include <hip/hip_cooperative_groups.h>
#include <cstdio>
namespace cg = cooperative_groups;

#ifndef MK_PER_PHASE
#define MK_PER_PHASE 0
#endif

#ifndef PROBE_DUP
#define PROBE_DUP -1
#endif
#define LAS __attribute__((address_space(3)))
typedef unsigned short bf16;
typedef short bf16x8 __attribute__((ext_vector_type(8)));
typedef float f32x2 __attribute__((ext_vector_type(2)));
typedef float f32x4 __attribute__((ext_vector_type(4)));
typedef float f32x16 __attribute__((ext_vector_type(16)));
typedef unsigned u32x2 __attribute__((ext_vector_type(2)));
typedef unsigned u32x4 __attribute__((ext_vector_type(4)));

constexpr int DM = 1024, NTOK_P = 8192, NTOK_S = 4096, NTOK = 12288, NROWKV = 14336;
constexpr int DEPTH = 4, INC = 1984, DFF = 4096;
constexpr int ZQ = 0, ZCKV = 384, ZKR = 640, ZU = 704, ZV = 960, ZBG = 1216, ZCG = 1472, ZHH = 1728;
constexpr float EPS = 1e-6f;
constexpr float QSCALE = 0.07216878364870322f * 1.4426950408889634f;

constexpr size_t MiB = 1u << 20;
constexpr size_t WS_MOD = 0, WS_BAR = 512 * 1024, WS_ROPE = 1 * MiB, WS_WIN = 2 * MiB, WS_WUQ = 18 * MiB, WS_WUKV = 21 * MiB, WS_WOUT = 23 * MiB,
                 WS_WFF1 = 31 * MiB, WS_WFF2 = 63 * MiB, WS_H = 95 * MiB, WS_MIX = 119 * MiB, WS_CONCAT = 167 * MiB, WS_QN = 191 * MiB,
                 WS_CKVN = 200 * MiB, WS_KRB = 207 * MiB, WS_UG = 209 * MiB, WS_VN = 215 * MiB, WS_Q = 221 * MiB, WS_KNOPE = 239 * MiB,
                 WS_VTP = 253 * MiB, WS_VTS = 261 * MiB, WS_Z = 267 * MiB, WS_ACT = 267 * MiB, WS_END = 363 * MiB;
constexpr int LDS_BYTES = 147456, LDS_BARST = LDS_BYTES - 64;

__device__ __forceinline__ unsigned cvt_pk_bf16(float lo, float hi) { unsigned r; asm volatile("v_cvt_pk_bf16_f32 %0, %1, %2" : "=v"(r) : "v"(lo), "v"(hi)); return r; }
__device__ __forceinline__ int fresh_lane() { int l; asm volatile("v_mbcnt_lo_u32_b32 %0, -1, 0\n\tv_mbcnt_hi_u32_b32 %0, -1, %0" : "=v"(l)); return l; }
__device__ __forceinline__ float shx(float v, int mask, int lane) { return __int_as_float(__builtin_amdgcn_ds_bpermute((lane ^ mask) << 2, __float_as_int(v))); }
__device__ __forceinline__ float dpp_add(float v, const int ctrl_is) {
    return v; }
#define DPP_ADD(v, ctrl) ((v) + __int_as_float(__builtin_amdgcn_update_dpp(0, __float_as_int(v), (ctrl), 0xf, 0xf, true)))
__device__ __forceinline__ float wave_sum(float v, int lane) {
    (void)lane;
    v = DPP_ADD(v, 0xB1);
    v = DPP_ADD(v, 0x4E);
    v = DPP_ADD(v, 0x141);
    v = DPP_ADD(v, 0x140);
    const int vi = __float_as_int(v);
    return (__int_as_float(__builtin_amdgcn_readlane(vi, 0)) + __int_as_float(__builtin_amdgcn_readlane(vi, 16))) + (__int_as_float(__builtin_amdgcn_readlane(vi, 32)) + __int_as_float(__builtin_amdgcn_readlane(vi, 48)));
}
__device__ __forceinline__ float gelu_tanh(float x) { const float y = 0.7978845608028654f * (x + 0.044715f * x * x * x); return x / (1.0f + __expf(-2.0f * y)); }
__device__ __forceinline__ f32x4 gelu4(f32x4 v) { return (f32x4){gelu_tanh(v.x), gelu_tanh(v.y), gelu_tanh(v.z), gelu_tanh(v.w)}; }
__device__ __forceinline__ float sumsq4(f32x4 v) { return (v.x * v.x + v.y * v.y) + (v.z * v.z + v.w * v.w); }
__device__ __forceinline__ f32x4 ld4bf_nt(const bf16* p) { const u32x2 w = __builtin_nontemporal_load((const u32x2*)p); return (f32x4){__uint_as_float(w.x << 16), __uint_as_float(w.x & 0xffff0000u), __uint_as_float(w.y << 16), __uint_as_float(w.y & 0xffff0000u)}; }
__device__ __forceinline__ f32x4 ld4bf(const bf16* p) { const u32x2 w = *(const u32x2*)p; return (f32x4){__uint_as_float(w.x << 16), __uint_as_float(w.x & 0xffff0000u), __uint_as_float(w.y << 16), __uint_as_float(w.y & 0xffff0000u)}; }
__device__ __forceinline__ f32x2 ld2bf(const bf16* p) { const unsigned w = *(const unsigned*)p; return (f32x2){__uint_as_float(w << 16), __uint_as_float(w & 0xffff0000u)}; }
__device__ __forceinline__ float ld1bf(const bf16* p) { return __uint_as_float((unsigned)*p << 16); }
__device__ __forceinline__ u32x2 pk4(f32x4 v) { u32x2 w; w.x = cvt_pk_bf16(v.x, v.y); w.y = cvt_pk_bf16(v.z, v.w); return w; }


#define XB_TMO      128
#define XB_XCNT(j)  (256  + 64 * (j))
#define XB_XSUB(j)  (1280 + 64 * (j))
#define XB_XGEN(j)  (2304 + 64 * (j))
#define XB_TOP      3328
#define XB_TOPGEN   3392
#define XCD_BAR_WORDS 3456
#define XB_SPIN_CAP (1u << 18)
__device__ __forceinline__ unsigned xb_ld(unsigned* p)              { return __hip_atomic_load(p, __ATOMIC_RELAXED, __HIP_MEMORY_SCOPE_AGENT); }
__device__ __forceinline__ unsigned xb_add(unsigned* p, unsigned v) { return __hip_atomic_fetch_add(p, v, __ATOMIC_RELAXED, __HIP_MEMORY_SCOPE_AGENT); }
__device__ __forceinline__ unsigned xb_xcc_id() { return (unsigned)__builtin_amdgcn_s_getreg((3 << 11) | 20) & 0xFu; }
#define XB_SPIN(cond, bar) do { unsigned _sp = 0; while (cond) { __builtin_amdgcn_s_sleep(1); \
    if ((++_sp & 255u) == 0u) { if (xb_ld(&(bar)[XB_TMO])) break; if (_sp > XB_SPIN_CAP) { atomicAdd(&(bar)[XB_TMO], 1u); break; } } } } while (0)
__device__ __forceinline__ void xcd_barrier_complete(unsigned* bar, unsigned x, unsigned& nloc, unsigned& nx) {
    const unsigned G = gridDim.x * gridDim.y * gridDim.z;
    unsigned sum, cnt, mine, sp = 0u;
    for (;;) {
        sum = 0u; cnt = 0u; mine = 0u;
#pragma unroll
        for (unsigned j = 0; j < 16; ++j) { const unsigned c = xb_ld(&bar[XB_XCNT(j)]); sum += c; cnt += (c > 0u) ? 1u : 0u; mine = (j == x) ? c : mine; }
        if (sum == G) break;
        __builtin_amdgcn_s_sleep(1);
        if ((++sp & 255u) == 0u) { if (xb_ld(&bar[XB_TMO])) break; if (sp > XB_SPIN_CAP) { atomicAdd(&bar[XB_TMO], 1u); break; } }
    }
    nloc = mine > 0u ? mine : 1u; nx = cnt > 0u ? cnt : 1u;
}
__device__ __forceinline__ void xcd_barrier(unsigned* bar, unsigned x, volatile LAS unsigned* st, bool leader) {
    asm volatile("s_waitcnt vmcnt(0)" ::: "memory");
    __syncthreads();
    if (leader) {
        __builtin_amdgcn_s_waitcnt(0);
        unsigned nloc = st[0], nx = st[1];
        if (nloc == 0u) { xcd_barrier_complete(bar, x, nloc, nx); st[0] = nloc; st[1] = nx; }
        const unsigned old = xb_add(&bar[XB_XSUB(x)], 1u);
        const unsigned gen = old / nloc;
        if (old + 1u == (gen + 1u) * nloc) {
            __builtin_amdgcn_fence(__ATOMIC_RELEASE, "agent");
            asm volatile("s_waitcnt vmcnt(0)" ::: "memory");
            const unsigned og = xb_add(&bar[XB_TOP], 1u);
            const unsigned tg = og / nx;
            if (og + 1u == (tg + 1u) * nx) xb_add(&bar[XB_TOPGEN], 1u);
            else XB_SPIN(xb_ld(&bar[XB_TOPGEN]) == tg, bar);
            __builtin_amdgcn_fence(__ATOMIC_ACQUIRE, "agent");
            xb_add(&bar[XB_XGEN(x)], 1u);
            asm volatile("s_waitcnt vmcnt(0)" ::: "memory");
        } else {
            XB_SPIN(xb_ld(&bar[XB_XGEN(x)]) == gen, bar);
            __builtin_amdgcn_fence(__ATOMIC_ACQUIRE, "agent");
            asm volatile("s_waitcnt vmcnt(0)" ::: "memory");
        }
    }
    __syncthreads();
}

namespace pg8 {
#define PG8_LAS __attribute__((address_space(3)))
typedef unsigned short bf16_t;
constexpr int BM = 256, BK = 64, HALF = 128, HTB = HALF * BK * 2, STAGE_BYTES = 8 * HTB, NXCD = 8, WGM = 8;
__host__ __device__ __forceinline__ int lds_byte(int r, int c) { const int st = (r >> 4) * 2 + (c >> 5), rr = r & 15, cc = c & 31, ob = rr * 64 + cc * 2; return st * 1024 + (ob ^ (((ob >> 9) & 1) << 5)); }
__host__ __device__ __forceinline__ void stage_rc(int b, int& R, int& C) { const int st = b / 1024, sb = b % 1024, swz = sb ^ (((sb >> 9) & 1) << 5); R = (st >> 1) * 16 + swz / 64; C = (st & 1) * 32 + (swz % 64) / 2; }
__host__ __device__ __forceinline__ int perm32(int rho) { const int n = rho >> 4, i = rho & 15; return 8 * (i >> 2) + 4 * n + (i & 3); }
struct Unit { int pm, pn; };
struct Gemm { const bf16_t* A; const bf16_t* Bt; int M, N, K; };
struct StaticOrder {
    int nM, nN, nwg, G, c;
    __host__ __device__ void init(int M, int N, int G_, int c_) { nM = M / BM; nN = N / BM; nwg = nM * nN; G = G_; c = c_; }
    __host__ __device__ bool next(int i, Unit& u) const {
        const long L = (long)i * G + c; if (L >= nwg) return false;
        int wgid = (int)L; { const int q = nwg / NXCD, r = nwg % NXCD, xcd = wgid % NXCD, off = wgid / NXCD; wgid = (xcd < r ? xcd * (q + 1) : r * (q + 1) + (xcd - r) * q) + off; }
        const int nig = WGM * nN, gid = wgid / nig, fm = gid * WGM, gsz = (nM - fm) < WGM ? (nM - fm) : WGM;
        u.pm = fm + ((wgid % nig) % gsz); u.pn = (wgid % nig) / gsz; return true;
    }
    __device__ __forceinline__ void a_ready(const Unit&) const {}
    __device__ __forceinline__ void done(const Unit&) const {}
};

template <class Epi, class Sched, bool SP2>
__device__ __forceinline__ void gemm_phase(PG8_LAS unsigned char* lds, const Gemm g, const Sched& S, const Epi& E, const int tid) {
    const int wid = __builtin_amdgcn_readfirstlane(tid >> 6), lane = tid & 63, wr = wid >> 2, wc = wid & 3, fr = lane & 15, fq = lane >> 4;
    const int K = g.K, nt = K / BK;
    unsigned voffA[2], voffB[2];
#pragma unroll
    for (int i = 0; i < 2; ++i) { int R, C; stage_rc(tid * 16 + i * 8192, R, C); const int Rb = Epi::PERM ? ((R & ~31) + perm32(R & 31)) : R;
        voffA[i] = (unsigned)(R * K + C) * 2u; voffB[i] = (unsigned)(Rb * K + C) * 2u; }
    const size_t kstep = (size_t)(BK * 2);
    const size_t hstep = (size_t)HALF * K * 2;
    const size_t tstep = 2 * hstep;
    const unsigned ldsw = (unsigned)wid * 1024u;
    const int aoff = lds_byte(wr * 64 + fr, fq * 8), boff = lds_byte(wc * 32 + fr, fq * 8);
#define PG8_SA(b, h) (((b) * 2 + (h)) * HTB)
#define PG8_SB(b, h) ((4 + (b) * 2 + (h)) * HTB)
#define PG8_STAGE(bufoff, gbase, voff) do { _Pragma("unroll") for (int _i = 0; _i < 2; ++_i) \
        __builtin_amdgcn_global_load_lds((const unsigned*)((const char*)(gbase) + (voff)[_i]), (PG8_LAS unsigned*)(lds + (bufoff) + ldsw + _i * 8192), 16, 0, 0); } while (0)
#define PG8_LDA(dst, b, h) do { _Pragma("unroll") for (int m = 0; m < 4; ++m) _Pragma("unroll") for (int k = 0; k < 2; ++k) dst[m][k] = *(const PG8_LAS bf16x8*)(lds + PG8_SA(b, h) + aoff + m * 2048 + k * 1024); } while (0)
#define PG8_LDB(dst, b, h) do { _Pragma("unroll") for (int n = 0; n < 2; ++n) _Pragma("unroll") for (int k = 0; k < 2; ++k) dst[n][k] = *(const PG8_LAS bf16x8*)(lds + PG8_SB(b, h) + boff + n * 2048 + k * 1024); } while (0)
#define PG8_MMA(ai, bj, At, Bt) do { __builtin_amdgcn_s_setprio(1); _Pragma("unroll") for (int m = 0; m < 4; ++m) _Pragma("unroll") for (int n = 0; n < 2; ++n) _Pragma("unroll") for (int k = 0; k < 2; ++k) \
        acc[ai][bj][m][n] = __builtin_amdgcn_mfma_f32_16x16x32_bf16(Bt[n][k], At[m][k], acc[ai][bj][m][n], 0, 0, 0); __builtin_amdgcn_s_setprio(0); } while (0)
#define PG8_WAIT_V(n) asm volatile("s_waitcnt vmcnt(" #n ")" ::: "memory")
#define PG8_WAIT_L(n) asm volatile("s_waitcnt lgkmcnt(" #n ")" ::: "memory")
#define PG8_BAR __builtin_amdgcn_s_barrier()
#define PG8_SCHED __builtin_amdgcn_sched_barrier(0)
    Unit cur, nxt; int ui = 0;
    if (!S.next(0, cur)) return;
    f32x4 acc[2][2][4][2];
#pragma unroll
    for (int a = 0; a < 2; ++a)
#pragma unroll
        for (int b = 0; b < 2; ++b)
#pragma unroll
            for (int m = 0; m < 4; ++m)
#pragma unroll
                for (int n = 0; n < 2; ++n) acc[a][b][m][n] = (f32x4){0.f, 0.f, 0.f, 0.f};
    bf16x8 At[4][2], B0[2][2], B1[2][2];
    const char* cA = (const char*)g.A + (size_t)cur.pm * tstep; const char* cB = (const char*)g.Bt + (size_t)cur.pn * tstep;
    S.a_ready(cur);
    if constexpr (SP2) {
    PG8_STAGE(PG8_SB(0, 0), cB, voffB); PG8_STAGE(PG8_SB(0, 1), cB + hstep, voffB); PG8_STAGE(PG8_SA(0, 0), cA, voffA); PG8_STAGE(PG8_SA(0, 1), cA + hstep, voffA);
    if (wr == 1) PG8_BAR;
    PG8_WAIT_V(2); PG8_BAR;
    PG8_STAGE(PG8_SB(1, 0), cB + kstep, voffB); PG8_STAGE(PG8_SA(1, 0), cA + kstep, voffA); PG8_STAGE(PG8_SB(1, 1), cB + hstep + kstep, voffB);
    PG8_WAIT_V(6); PG8_BAR;
    } else {
    PG8_STAGE(PG8_SB(0, 0), cB, voffB); PG8_STAGE(PG8_SA(0, 0), cA, voffA); PG8_STAGE(PG8_SB(0, 1), cB + hstep, voffB); PG8_STAGE(PG8_SA(0, 1), cA + hstep, voffA);
    if (wr == 1) PG8_BAR;
    PG8_WAIT_V(4); PG8_BAR;
    PG8_STAGE(PG8_SB(1, 0), cB + kstep, voffB); PG8_STAGE(PG8_SA(1, 0), cA + kstep, voffA); PG8_STAGE(PG8_SB(1, 1), cB + hstep + kstep, voffB);
    PG8_WAIT_V(6); PG8_BAR;
    }
    for (;;) {
        const bool has_next = S.next(ui + 1, nxt);
        const char* nA = has_next ? (const char*)g.A + (size_t)nxt.pm * tstep : cA; const char* nB = has_next ? (const char*)g.Bt + (size_t)nxt.pn * tstep : cB;
        for (int t = 0; t < nt; t += 2) {
            const bool last = (t == nt - 2);
            const char* a1 = cA + (size_t)(t + 1) * kstep;
            const char* a2 = last ? nA : cA + (size_t)(t + 2) * kstep; const char* b2 = last ? nB : cB + (size_t)(t + 2) * kstep;
            const char* a3 = a2 + kstep; const char* b3 = b2 + kstep;
            if (last && has_next) S.a_ready(nxt);
            if constexpr (SP2) {
            PG8_LDB(B0, 0, 0); PG8_LDB(B1, 0, 1); PG8_SCHED; PG8_LDA(At, 0, 0); PG8_STAGE(PG8_SA(1, 1), a1 + hstep, voffA);
            PG8_WAIT_V(8); PG8_WAIT_L(0); PG8_BAR; PG8_MMA(0, 0, At, B0); PG8_MMA(0, 1, At, B1); PG8_BAR; PG8_SCHED;
            PG8_LDA(At, 0, 1); PG8_STAGE(PG8_SB(0, 0), b2, voffB); PG8_STAGE(PG8_SB(0, 1), b2 + hstep, voffB); PG8_STAGE(PG8_SA(0, 0), a2, voffA);
            PG8_WAIT_V(8); PG8_WAIT_L(0); PG8_BAR; PG8_MMA(1, 0, At, B0); PG8_MMA(1, 1, At, B1); PG8_BAR; PG8_SCHED;
            PG8_LDB(B0, 1, 0); PG8_LDB(B1, 1, 1); PG8_SCHED; PG8_LDA(At, 1, 0); PG8_STAGE(PG8_SA(0, 1), a2 + hstep, voffA);
            PG8_WAIT_V(8); PG8_WAIT_L(0); PG8_BAR; PG8_MMA(0, 0, At, B0); PG8_MMA(0, 1, At, B1); PG8_BAR; PG8_SCHED;
            PG8_LDA(At, 1, 1); PG8_STAGE(PG8_SB(1, 0), b3, voffB); PG8_STAGE(PG8_SB(1, 1), b3 + hstep, voffB); PG8_STAGE(PG8_SA(1, 0), a3, voffA);
            PG8_WAIT_V(8); PG8_WAIT_L(0); PG8_BAR; PG8_MMA(1, 0, At, B0); PG8_MMA(1, 1, At, B1); PG8_BAR; PG8_SCHED;
            } else {
            PG8_LDB(B0, 0, 0); PG8_SCHED; PG8_LDA(At, 0, 0); PG8_STAGE(PG8_SA(1, 1), a1 + hstep, voffA);
            PG8_WAIT_L(8); PG8_BAR; PG8_WAIT_L(0); PG8_MMA(0, 0, At, B0); PG8_BAR; PG8_SCHED;
            PG8_LDB(B1, 0, 1); PG8_STAGE(PG8_SB(0, 0), b2, voffB);
            PG8_BAR; PG8_WAIT_L(0); PG8_MMA(0, 1, At, B1); PG8_BAR;
            PG8_LDA(At, 0, 1); PG8_STAGE(PG8_SA(0, 0), a2, voffA);
            PG8_BAR; PG8_WAIT_L(0); PG8_MMA(1, 0, At, B0); PG8_BAR; PG8_SCHED;
            PG8_STAGE(PG8_SB(0, 1), b2 + hstep, voffB);
            PG8_WAIT_V(6); PG8_BAR; PG8_MMA(1, 1, At, B1); PG8_BAR;
            PG8_LDB(B0, 1, 0); PG8_SCHED; PG8_LDA(At, 1, 0); PG8_STAGE(PG8_SA(0, 1), a2 + hstep, voffA);
            PG8_WAIT_L(8); PG8_BAR; PG8_WAIT_L(0); PG8_MMA(0, 0, At, B0); PG8_BAR; PG8_SCHED;
            PG8_LDB(B1, 1, 1); PG8_STAGE(PG8_SB(1, 0), b3, voffB);
            PG8_BAR; PG8_WAIT_L(0); PG8_MMA(0, 1, At, B1); PG8_BAR;
            PG8_LDA(At, 1, 1); PG8_STAGE(PG8_SA(1, 0), a3, voffA);
            PG8_BAR; PG8_WAIT_L(0); PG8_MMA(1, 0, At, B0); PG8_BAR; PG8_SCHED;
            PG8_STAGE(PG8_SB(1, 1), b3 + hstep, voffB);
            PG8_WAIT_V(6); PG8_BAR; PG8_MMA(1, 1, At, B1); PG8_BAR;
            }
        }
        if (wr == 0) PG8_BAR;
        E(acc, cur, wr, wc, fr, fq); S.done(cur);
        if (!has_next) break;
#pragma unroll
        for (int a = 0; a < 2; ++a)
#pragma unroll
            for (int b = 0; b < 2; ++b)
#pragma unroll
                for (int m = 0; m < 4; ++m)
#pragma unroll
                    for (int n = 0; n < 2; ++n) acc[a][b][m][n] = (f32x4){0.f, 0.f, 0.f, 0.f};
        cur = nxt; cA = nA; cB = nB; ++ui;
        if (wr == 1) PG8_BAR;
    }
    PG8_WAIT_V(0);
    PG8_BAR;
#undef PG8_SA
#undef PG8_SB
#undef PG8_STAGE
#undef PG8_LDA
#undef PG8_LDB
#undef PG8_MMA
#undef PG8_WAIT_V
#undef PG8_WAIT_L
#undef PG8_BAR
#undef PG8_SCHED
}
}

struct EpiF32 {
    static constexpr bool PERM = false;
    float* C; int ldc; int ncols;
    __device__ __forceinline__ void operator()(const f32x4 (&acc)[2][2][4][2], const pg8::Unit& u, int wr, int wc, int fr, int fq) const {
        const int row0 = u.pm * 256 + wr * 64 + fr, col0 = u.pn * 256 + wc * 32 + 4 * fq;
#pragma unroll
        for (int ai = 0; ai < 2; ++ai)
#pragma unroll
            for (int m = 0; m < 4; ++m) { float* rowp = C + (size_t)(row0 + ai * 128 + m * 16) * ldc + col0;
#pragma unroll
                for (int bj = 0; bj < 2; ++bj)
#pragma unroll
                    for (int n = 0; n < 2; ++n) if (col0 + bj * 128 + n * 16 < ncols) *(f32x4*)(rowp + bj * 128 + n * 16) = acc[ai][bj][m][n]; }
    }
};
template <int ACT> struct EpiB16 {
    static constexpr bool PERM = true;
    bf16* O; int ldc; int ncols;
    __device__ __forceinline__ void operator()(const f32x4 (&acc)[2][2][4][2], const pg8::Unit& u, int wr, int wc, int, int) const {
        const int ln = fresh_lane(), fr = ln & 15, fq = ln >> 4;
        const int row0 = u.pm * 256 + wr * 64 + fr, col0 = u.pn * 256 + wc * 32 + 8 * fq;
#pragma unroll
        for (int ai = 0; ai < 2; ++ai)
#pragma unroll
            for (int m = 0; m < 4; ++m) { bf16* rowp = O + (size_t)(row0 + ai * 128 + m * 16) * ldc + col0;
#pragma unroll
                for (int bj = 0; bj < 2; ++bj) { f32x4 v0 = acc[ai][bj][m][0], v1 = acc[ai][bj][m][1];
                    if (col0 + bj * 128 >= ncols) continue;
                    if (ACT) {
#pragma unroll
                    for (int j = 0; j < 4; ++j) { const float a = fmaxf(v0[j], 0.f), b = fmaxf(v1[j], 0.f); v0[j] = a * a; v1[j] = b * b; } }
                    u32x4 w; w.x = cvt_pk_bf16(v0[0], v0[1]); w.y = cvt_pk_bf16(v0[2], v0[3]); w.z = cvt_pk_bf16(v1[0], v1[1]); w.w = cvt_pk_bf16(v1[2], v1[3]);
                    *(u32x4*)(rowp + bj * 128) = w; } }
    }
};
struct EpiQ {
    static constexpr bool PERM = false;
    bf16* Q; const float* ropec; const float* ropes;
    __device__ __forceinline__ void operator()(const f32x4 (&acc)[2][2][4][2], const pg8::Unit& u, int wr, int wc, int, int) const {
        const int ln = fresh_lane(), fr = ln & 15, fq = ln >> 4;
        const int row0 = u.pm * 256 + wr * 64 + fr; const bool sample = u.pm >= 32;
#pragma unroll
        for (int bj = 0; bj < 2; ++bj) {
            const int g0 = u.pn * 256 + bj * 128 + wc * 32, within0 = g0 % 192; const bool isrope = within0 >= 128; const int a = (within0 - 128) >> 5;
#pragma unroll
            for (int ai = 0; ai < 2; ++ai)
#pragma unroll
                for (int m = 0; m < 4; ++m) { const int row = row0 + ai * 128 + m * 16;
                    f32x4 x1 = acc[ai][bj][m][0], x2 = acc[ai][bj][m][1];
                    if (sample && isrope) { const int ntok = (row - NTOK_P) & 1023;
                        const f32x4 cs = *(const f32x4*)(ropec + ntok * 32 + a * 16 + 4 * fq), sn = *(const f32x4*)(ropes + ntok * 32 + a * 16 + 4 * fq);
                        const f32x4 o1 = x1 * cs - x2 * sn, o2 = x1 * sn + x2 * cs; x1 = o1; x2 = o2; }
                    x1 = x1 * QSCALE; x2 = x2 * QSCALE;
                    bf16* p = Q + (size_t)row * 768 + g0 + 4 * fq;
                    *(u32x2*)p = pk4(x1); *(u32x2*)(p + 16) = pk4(x2); asm volatile("" ::: "memory"); }
        }
    }
};
struct EpiKV {
    static constexpr bool PERM = false;
    bf16* KN; bf16* VTP; bf16* VTS;
    __device__ __forceinline__ void operator()(const f32x4 (&acc)[2][2][4][2], const pg8::Unit& u, int wr, int wc, int, int) const {
        const int ln = fresh_lane(), fr = ln & 15, fq = ln >> 4;
        const int h = u.pn, pm = u.pm;
        bf16* vt; int keys, keybase;
        if (pm < 32) { vt = VTP + (size_t)((pm * 4 + h) * 128) * 256; keys = 256; keybase = 0; }
        else if (pm < 48) { const int b = (pm - 32) >> 2; vt = VTS + (size_t)((b * 4 + h) * 128) * 1536; keys = 1536; keybase = 512 + ((pm - 32) & 3) * 256; }
        else { const int b = (pm - 48) >> 1; vt = VTS + (size_t)((b * 4 + h) * 128) * 1536; keys = 1536; keybase = ((pm - 48) & 1) * 256; }
#pragma unroll
        for (int ai = 0; ai < 2; ++ai)
#pragma unroll
            for (int m = 0; m < 4; ++m) { const int rloc = wr * 64 + fr + ai * 128 + m * 16;
                bf16* kp = KN + (size_t)(pm * 256 + rloc) * 512 + h * 128 + wc * 32 + 4 * fq;
#pragma unroll
                for (int n = 0; n < 2; ++n) *(u32x2*)(kp + 16 * n) = pk4(acc[ai][0][m][n]);
#pragma unroll
                for (int n = 0; n < 2; ++n) { const f32x4 v = acc[ai][1][m][n]; const u32x2 w = pk4(v);
                    bf16* vp = vt + (size_t)(wc * 32 + 16 * n + 4 * fq) * keys + keybase + rloc;
                    vp[0] = (bf16)(w.x & 0xffffu); vp[keys] = (bf16)(w.x >> 16); vp[2 * keys] = (bf16)(w.y & 0xffffu); vp[3 * keys] = (bf16)(w.y >> 16); }
                asm volatile("" ::: "memory");
            }
    }
};

struct Args {
    const float *x_prompt, *x_sample, *cache_ckv, *cache_krope, *c, *c_ctx, *w_ada, *b_ada, *g_pre_mix, *w_in, *g_q, *w_uq, *g_kv, *w_ukv,
                *g_v, *w_s, *b_s, *w_conv, *w_out, *g_post_mix, *g_pre_ffn, *w_ff1, *w_ff2, *g_post_ffn;
    float* out; unsigned char* ws; int ph_lo, ph_hi;
};

__device__ __forceinline__ void p0_transpose_item(const float* W, int K, int N, bf16* WT, LAS float* scr, int item, int lane, float scale = 1.0f) {
    const int nblk = N / 32, kb = item / nblk, nb = item % nblk, k0 = 64 * kb, n0 = 32 * nb;
#pragma unroll 8
    for (int i = 0; i < 32; ++i) { const int kk = 2 * i + (lane >> 5); scr[kk * 33 + (lane & 31)] = W[(size_t)(k0 + kk) * N + n0 + (lane & 31)]; }
    asm volatile("s_waitcnt lgkmcnt(0)" ::: "memory");
    const int c = lane & 7;
#pragma unroll
    for (int j = 0; j < 4; ++j) { const int n = (lane >> 3) + 8 * j; const LAS float* s = scr + (8 * c) * 33 + n;
        u32x4 o; o.x = cvt_pk_bf16(s[0 * 33] * scale, s[1 * 33] * scale); o.y = cvt_pk_bf16(s[2 * 33] * scale, s[3 * 33] * scale); o.z = cvt_pk_bf16(s[4 * 33] * scale, s[5 * 33] * scale); o.w = cvt_pk_bf16(s[6 * 33] * scale, s[7 * 33] * scale);
        *(u32x4*)(WT + (size_t)(n0 + n) * K + k0 + 8 * c) = o; }
    asm volatile("s_waitcnt lgkmcnt(0)" ::: "memory");
}

__device__ __forceinline__ void convert_layer(const Args& A, LAS unsigned char* lds, int l, int gwi, int nw, int wave, int lane) {
    unsigned char* ws = A.ws;
    LAS float* scr = (LAS float*)(lds + wave * 16384);
    constexpr int I_IN = 16 * 62, I_UQ = 6 * 24, I_UKV = 4 * 32, I_OUT = 16 * 32, I_F1 = 16 * 128, I_F2 = 64 * 32, I_L = I_IN + I_UQ + I_UKV + I_OUT + I_F1 + I_F2;
    for (int it = gwi; it < I_L; it += nw) {
        int r = it;
        if (r < I_IN) { p0_transpose_item(A.w_in + (size_t)l * 1024 * INC, 1024, INC, (bf16*)(ws + WS_WIN) + (size_t)l * 2048 * 1024, scr, r, lane); continue; } r -= I_IN;
        if (r < I_UQ) { p0_transpose_item(A.w_uq + (size_t)l * 384 * 768, 384, 768, (bf16*)(ws + WS_WUQ) + (size_t)l * 768 * 384, scr, r, lane, QSCALE); continue; } r -= I_UQ;
        if (r < I_UKV) { p0_transpose_item(A.w_ukv + (size_t)l * 256 * 1024, 256, 1024, (bf16*)(ws + WS_WUKV) + (size_t)l * 1024 * 256, scr, r, lane); continue; } r -= I_UKV;
        if (r < I_OUT) { p0_transpose_item(A.w_out + (size_t)l * 1024 * 1024, 1024, 1024, (bf16*)(ws + WS_WOUT) + (size_t)l * 1024 * 1024, scr, r, lane); continue; } r -= I_OUT;
        if (r < I_F1) { p0_transpose_item(A.w_ff1 + (size_t)l * 1024 * 4096, 1024, 4096, (bf16*)(ws + WS_WFF1) + (size_t)l * 4096 * 1024, scr, r, lane); continue; } r -= I_F1;
        p0_transpose_item(A.w_ff2 + (size_t)l * 4096 * 1024, 4096, 1024, (bf16*)(ws + WS_WFF2) + (size_t)l * 1024 * 4096, scr, r, lane);
    }
}

__device__ __forceinline__ void phase_prologue(const Args& A, LAS unsigned char* lds, int wave) {
    const int lane = fresh_lane(), tid = wave * 64 + lane;
    unsigned char* ws = A.ws;
    const int bid = blockIdx.x, G = gridDim.x;
    { const int gt = bid * 512 + tid;
      if (gt < 32768) { const int n = gt >> 5, a = (gt >> 4) & 1, f = gt & 15; const int pos = a == 0 ? (n >> 6) : (n & 63);
          double inv = 1.0; for (int i = 0; i < f; ++i) inv *= 0.5623413251903491;
          double rev = (double)pos * inv * 0.15915494309189535; rev -= floor(rev);
          const float rf = (float)rev;
          ((float*)(ws + WS_ROPE))[gt] = __builtin_amdgcn_cosf(rf); ((float*)(ws + WS_ROPE))[32768 + gt] = __builtin_amdgcn_sinf(rf); } }
    for (int it = bid; it < 192; it += G) {
        const int l = it / 48, cgp = it % 48;
        LAS float* sl = (LAS float*)lds;
        for (int i = tid; i < 5120; i += 512) { const int ci = i >> 10, k = i & 1023; const float v = ci == 0 ? A.c_ctx[k] : A.c[(ci - 1) * 1024 + k]; sl[i] = v / (1.0f + __expf(-v)); }
        __syncthreads();
        float a0[5], a1[5];
#pragma unroll
        for (int ci = 0; ci < 5; ++ci) { a0[ci] = 0.f; a1[ci] = 0.f; }
        const float* wp = A.w_ada + ((size_t)l * 1024 + wave * 128) * 6144 + cgp * 128 + 2 * lane;
#pragma unroll 8
        for (int kk = 0; kk < 128; ++kk) { const f32x2 wv = *(const f32x2*)(wp + (size_t)kk * 6144); const int k = wave * 128 + kk;
#pragma unroll
            for (int ci = 0; ci < 5; ++ci) { const float s = sl[ci * 1024 + k]; a0[ci] += s * wv.x; a1[ci] += s * wv.y; } }
        LAS float* part = (LAS float*)(lds + 32768);
#pragma unroll
        for (int ci = 0; ci < 5; ++ci) { part[(wave * 5 + ci) * 128 + 2 * lane] = a0[ci]; part[(wave * 5 + ci) * 128 + 2 * lane + 1] = a1[ci]; }
        __syncthreads();
        for (int i = tid; i < 640; i += 512) { const int ci = i >> 7, col = i & 127; float s = 0.f;
#pragma unroll
            for (int w = 0; w < 8; ++w) s += part[(w * 5 + ci) * 128 + col];
            const int gcol = cgp * 128 + col; ((float*)(ws + WS_MOD))[(l * 5 + ci) * 6144 + gcol] = s + A.b_ada[l * 6144 + gcol]; }
        __syncthreads();
    }
    convert_layer(A, lds, 0, bid * 8 + wave, G * 8, wave, lane);
}

__device__ __forceinline__ int cond_of_row(int r) { return r < NTOK_P ? 0 : 1 + ((r - NTOK_P) >> 10); }

__device__ __forceinline__ void norm_mod_store(const f32x4 (&v)[4], const LAS float* g, const LAS float* sc, const LAS float* sh, bf16* hrow, int lane) {
    float ss = 0.f;
#pragma unroll
    for (int j = 0; j < 4; ++j) ss += sumsq4(v[j]);
    const float rstd = 1.0f / sqrtf(wave_sum(ss, lane) * (1.0f / 1024.0f) + EPS);
#pragma unroll
    for (int j = 0; j < 4; ++j) { const int idx = 4 * lane + 256 * j;
        const f32x4 gg = *(const LAS f32x4*)(g + idx), s1 = *(const LAS f32x4*)(sc + idx), s0 = *(const LAS f32x4*)(sh + idx);
        const f32x4 o = v[j] * rstd * gg * (1.0f + s1) + s0;
        *(u32x2*)(hrow + idx) = pk4(o); }
}
__device__ __forceinline__ const float* x_in_row(const Args& A, int r) { return r < NTOK_P ? A.x_prompt + (size_t)r * 1024 : A.x_sample + (size_t)(r - NTOK_P) * 1024; }
__device__ __forceinline__ void fill_vec(LAS float* dst, const float* src, int tid) { if (tid < 256) *(LAS f32x4*)(dst + 4 * tid) = *(const f32x4*)(src + 4 * tid); }

__device__ __forceinline__ void phase_pre(const Args& A, LAS unsigned char* lds, int lane, int wave) {
    const int gw = blockIdx.x * 8 + wave, NGW = gridDim.x * 8;
    const float* mod = (const float*)(A.ws + WS_MOD); bf16* H = (bf16*)(A.ws + WS_H);
    LAS float* P = (LAS float*)lds;
    { const int t2 = (wave & 3) * 64 + lane, hv = wave >> 2;
      for (int v = hv; v < 11; v += 2) { const float* src = v == 0 ? A.g_pre_mix : (v <= 5 ? mod + (size_t)(v - 1) * 6144 + 1024 : mod + (size_t)(v - 6) * 6144);
          const int slot = v == 0 ? 1 : (v <= 5 ? 7 + (v - 1) : 12 + (v - 6));
          *(LAS f32x4*)(P + slot * 1024 + 4 * t2) = *(const f32x4*)(src + 4 * t2); } }
    __syncthreads();
    for (int r0 = gw; r0 < NTOK; r0 += 2 * NGW) {
        f32x4 v[2][4];
#pragma unroll
        for (int u = 0; u < 2; ++u) { const float* xr = x_in_row(A, r0 + u * NGW);
#pragma unroll
            for (int j = 0; j < 4; ++j) v[u][j] = __builtin_nontemporal_load((const f32x4*)(xr + 4 * lane + 256 * j)); }
#pragma unroll
        for (int u = 0; u < 2; ++u) { const int r = r0 + u * NGW, ci = cond_of_row(r);
            norm_mod_store(v[u], P + 1024, P + (7 + ci) * 1024, P + (12 + ci) * 1024, H + (size_t)r * 1024, lane); }
    }
    __syncthreads();
}

__device__ __forceinline__ void phase_post(const Args& A, int l, int which, LAS unsigned char* lds, int lane, int wave) {
    const int gw = blockIdx.x * 8 + wave, NGW = gridDim.x * 8;
    const float* mod = (const float*)(A.ws + WS_MOD); bf16* H = (bf16*)(A.ws + WS_H); const bf16* MIX = (const bf16*)(A.ws + WS_MIX);
    const bool first = (l == 0 && which == 0), has_h = (which == 0) || (l < DEPTH - 1);
    LAS float* P = (LAS float*)lds;
    { const int t2 = (wave & 3) * 64 + lane, hv = wave >> 2;
      const int l2 = which == 0 ? l : l + 1;
      for (int v = hv; v < 17; v += 2) { const float* src;
          if (v == 0) src = (which == 0 ? A.g_post_mix : A.g_post_ffn) + l * 1024;
          else if (v == 1) src = which == 0 ? A.g_pre_ffn + l * 1024 : A.g_pre_mix + (l2 < DEPTH ? l2 : l) * 1024;
          else if (v < 7) src = mod + (size_t)(l * 5 + (v - 2)) * 6144 + (which == 0 ? 2048 : 5120);
          else if (v < 12) src = mod + (size_t)((l2 < DEPTH ? l2 : l) * 5 + (v - 7)) * 6144 + (which == 0 ? 4096 : 1024);
          else src = mod + (size_t)((l2 < DEPTH ? l2 : l) * 5 + (v - 12)) * 6144 + (which == 0 ? 3072 : 0);
          *(LAS f32x4*)(P + v * 1024 + 4 * t2) = *(const f32x4*)(src + 4 * t2); } }
    __syncthreads();
    for (int r0 = gw; r0 < NTOK; r0 += 2 * NGW) {
        f32x4 v[2][4], t[2][4];
#pragma unroll
        for (int u = 0; u < 2; ++u) { const int r = r0 + u * NGW;
            const float* xr = first ? x_in_row(A, r) : A.out + (size_t)r * 1024; const bf16* tr = MIX + (size_t)r * 1024;
#pragma unroll
            for (int j = 0; j < 4; ++j) { v[u][j] = __builtin_nontemporal_load((const f32x4*)(xr + 4 * lane + 256 * j)); t[u][j] = ld4bf_nt(tr + 4 * lane + 256 * j); } }
#pragma unroll
        for (int u = 0; u < 2; ++u) { const int r = r0 + u * NGW; const LAS float* ga = P + (2 + cond_of_row(r)) * 1024;
            float ss = 0.f;
#pragma unroll
            for (int j = 0; j < 4; ++j) ss += sumsq4(t[u][j]);
            const float rstd = 1.0f / sqrtf(wave_sum(ss, lane) * (1.0f / 1024.0f) + EPS);
#pragma unroll
            for (int j = 0; j < 4; ++j) { const int idx = 4 * lane + 256 * j;
                const f32x4 gg = *(const LAS f32x4*)(P + idx), gv = *(const LAS f32x4*)(ga + idx);
                v[u][j] = v[u][j] + gv * (t[u][j] * rstd * gg);
                __builtin_nontemporal_store(v[u][j], (f32x4*)(A.out + (size_t)r * 1024 + idx)); } }
        if (has_h) {
#pragma unroll
            for (int u = 0; u < 2; ++u) { const int r = r0 + u * NGW, ci = cond_of_row(r);
                norm_mod_store(v[u], P + 1024, P + (7 + ci) * 1024, P + (12 + ci) * 1024, H + (size_t)r * 1024, lane); } }
    }
    __syncthreads();
}

__device__ __forceinline__ void phase_split(const Args& A, int l, int lane, int wave) {
    const int gw = blockIdx.x * 8 + wave, NGW = gridDim.x * 8;
    unsigned char* ws = A.ws;
    const bf16* Z = (const bf16*)(ws + WS_Z);
    bf16* QN = (bf16*)(ws + WS_QN); bf16* CKVN = (bf16*)(ws + WS_CKVN); bf16* KRB = (bf16*)(ws + WS_KRB); bf16* UG = (bf16*)(ws + WS_UG); bf16* VN = (bf16*)(ws + WS_VN);
    bf16* CC = (bf16*)(ws + WS_CONCAT);
    const float* ropec = (const float*)(ws + WS_ROPE); const float* ropes = ropec + 32768;
    float* out_ckv = A.out + (size_t)NTOK * 1024; float* out_kr = out_ckv + (size_t)32 * 4 * 256 * 256;
    for (int idx = gw; idx < 2048; idx += NGW) { const int r = NTOK + idx, b = idx >> 9, j = idx & 511;
        const f32x4 cv = *(const f32x4*)(A.cache_ckv + ((size_t)(b * 4 + l) * 512 + j) * 256 + 4 * lane);
        const float kv = A.cache_krope[((size_t)(b * 4 + l) * 512 + j) * 64 + lane];
        *(u32x2*)(CKVN + (size_t)r * 256 + 4 * lane) = pk4(cv);
        KRB[(size_t)r * 64 + lane] = (bf16)(cvt_pk_bf16(kv, 0.f) & 0xffffu); }
    const f32x4 gkv = *(const f32x4*)(A.g_kv + l * 256 + 4 * lane), gvv = *(const f32x4*)(A.g_v + l * 256 + 4 * lane);
    const float* wcp = A.w_conv + (size_t)l * 3 * 256 + 4 * lane;
    const f32x4 wc0 = *(const f32x4*)(wcp), wc1 = *(const f32x4*)(wcp + 256), wc2 = *(const f32x4*)(wcp + 512);
    f32x2 gq[3];
#pragma unroll
    for (int j = 0; j < 3; ++j) gq[j] = *(const f32x2*)(A.g_q + l * 384 + 2 * lane + 128 * j);
    for (int r0 = gw; r0 < NTOK; r0 += 2 * NGW) {
        f32x2 q[2][3]; f32x4 cv[2], uu[2], vv[2], bg[2], zc[2], zm[2], zp[2]; float kr[2], cs[2], sn[2];
#pragma unroll
        for (int u = 0; u < 2; ++u) { const int r = r0 + u * NGW; const bf16* z = Z + (size_t)r * INC;
            const bool prompt = r < NTOK_P; const int n = prompt ? (r & 255) : ((r - NTOK_P) & 1023), len = prompt ? 256 : 1024;
#pragma unroll
            for (int j = 0; j < 3; ++j) q[u][j] = ld2bf(z + ZQ + 2 * lane + 128 * j);
            cv[u] = ld4bf(z + ZCKV + 4 * lane); kr[u] = ld1bf(z + ZKR + lane);
            uu[u] = ld4bf(z + ZU + 4 * lane); vv[u] = ld4bf(z + ZV + 4 * lane); bg[u] = ld4bf(z + ZBG + 4 * lane);
            zc[u] = ld4bf(z + ZCG + 4 * lane) * ld4bf(z + ZHH + 4 * lane);
            zm[u] = (f32x4){0.f, 0.f, 0.f, 0.f}; zp[u] = zm[u];
            if (n > 0) zm[u] = ld4bf(z - INC + ZCG + 4 * lane) * ld4bf(z - INC + ZHH + 4 * lane);
            if (n < len - 1) zp[u] = ld4bf(z + INC + ZCG + 4 * lane) * ld4bf(z + INC + ZHH + 4 * lane);
            cs[u] = 1.f; sn[u] = 0.f;
            if (!prompt) { const int a = lane >> 5, f = lane & 15; cs[u] = ropec[n * 32 + a * 16 + f]; sn[u] = ropes[n * 32 + a * 16 + f]; } }
#pragma unroll
        for (int u = 0; u < 2; ++u) { const int r = r0 + u * NGW; const bool prompt = r < NTOK_P; const int n = prompt ? (r & 255) : ((r - NTOK_P) & 1023);
            { float ss = 0.f;
#pragma unroll
              for (int j = 0; j < 3; ++j) ss += q[u][j].x * q[u][j].x + q[u][j].y * q[u][j].y;
              const float rstd = 1.0f / sqrtf(wave_sum(ss, lane) * (1.0f / 384.0f) + EPS);
#pragma unroll
              for (int j = 0; j < 3; ++j) *(unsigned*)(QN + (size_t)r * 384 + 2 * lane + 128 * j) = cvt_pk_bf16(q[u][j].x * rstd * gq[j].x, q[u][j].y * rstd * gq[j].y); }
            { const float rstd = 1.0f / sqrtf(wave_sum(sumsq4(cv[u]), lane) * (1.0f / 256.0f) + EPS);
              const f32x4 c2 = cv[u] * rstd * gkv;
              if (prompt) __builtin_nontemporal_store(c2, (f32x4*)(out_ckv + ((size_t)((r >> 8) * 4 + l) * 256 + n) * 256 + 4 * lane));
              *(u32x2*)(CKVN + (size_t)r * 256 + 4 * lane) = pk4(c2); }
            { float k2 = kr[u];
              if (prompt) __builtin_nontemporal_store(k2, out_kr + ((size_t)((r >> 8) * 4 + l) * 256 + n) * 64 + lane);
              else { const float partner = shx(k2, 16, lane); const int p = (lane >> 4) & 1;
                  k2 = p == 0 ? k2 * cs[u] - partner * sn[u] : partner * sn[u] + k2 * cs[u]; }
              KRB[(size_t)r * 64 + lane] = (bf16)(cvt_pk_bf16(k2, 0.f) & 0xffffu); }
            *(u32x2*)(UG + (size_t)r * 256 + 4 * lane) = pk4(gelu4(uu[u]));
            { f32x4 v = gelu4(vv[u]);
              const float rstd = 1.0f / sqrtf(wave_sum(sumsq4(v), lane) * (1.0f / 256.0f) + EPS);
              *(u32x2*)(VN + (size_t)r * 256 + 4 * lane) = pk4(v * rstd * gvv); }
            { const f32x4 y = zm[u] * wc0 + zc[u] * wc1 + zp[u] * wc2;
              *(u32x2*)(CC + (size_t)r * 1024 + 768 + 4 * lane) = pk4(bg[u] * y); }
        }
    }
}

#define MFMA32(a, b, c) __builtin_amdgcn_mfma_f32_32x32x16_bf16((a), (b), (c), 0, 0, 0)
constexpr int AT_KROW = 400, AT_VROW = 144, AT_KBYTES = 64 * AT_KROW, AT_STAGE = AT_KBYTES + 128 * AT_VROW;
__device__ __forceinline__ void attn_store_tile(const f32x16& ot, float inv, bf16* crow  , int t, int hh) {
#pragma unroll
    for (int g = 0; g < 4; ++g) { u32x2 w; w.x = cvt_pk_bf16(ot[4 * g] * inv, ot[4 * g + 1] * inv); w.y = cvt_pk_bf16(ot[4 * g + 2] * inv, ot[4 * g + 3] * inv);
        *(u32x2*)(crow + 32 * t + 8 * g + 4 * hh) = w; }
}

__device__ __forceinline__ void phase_mixer(const Args& A, int l, LAS unsigned char* lds, int lane_in, int wave) {
    unsigned char* ws = A.ws;
    const bf16* Q = (const bf16*)(ws + WS_Q); const bf16* KN = (const bf16*)(ws + WS_KNOPE); const bf16* KRB = (const bf16*)(ws + WS_KRB);
    const bf16* VTP = (const bf16*)(ws + WS_VTP); const bf16* VTS = (const bf16*)(ws + WS_VTS);
    const bf16* UG = (const bf16*)(ws + WS_UG); const bf16* VN = (const bf16*)(ws + WS_VN);
    bf16* CC = (bf16*)(ws + WS_CONCAT);
    for (int slot = 0; ; ++slot) {
        int it;
        if (gridDim.x == 256) {
            if (slot == 0) it = blockIdx.x; else if (slot == 1 && blockIdx.x >= 128 && blockIdx.x < 224) it = 256 + (int)blockIdx.x - 128; else break;
        } else { it = (int)blockIdx.x + slot * (int)gridDim.x; if (it >= 352) break; }
        int lane = lane_in; asm volatile("" : "+v"(lane));
        const int rho = lane & 31, hh = lane >> 5, tid = wave * 64 + lane;
        if (it < 256) {
            int h, q0, keys, nkeys, split, rowA, rowB; const bf16* vt;
            const bool heavy = it < 128;
            if (heavy) {
                const int xj = it >> 3, pr = 2 * (it & 7) + (xj >> 3), b = pr >> 2, qt = xj & 7; h = pr & 3;
                q0 = NTOK_P + b * 1024 + qt * 128 + (wave & 3) * 32; keys = 1536; nkeys = 1536; split = 512; rowA = NTOK + b * 512; rowB = NTOK_P + b * 1024;
                vt = VTS + (size_t)((b * 4 + h) * 128) * 1536; }
            else { const int i2 = it - 128, b = i2 >> 2; h = i2 & 3; q0 = b * 256 + wave * 32; keys = 256; nkeys = 256; split = 0; rowA = 0; rowB = b * 256;
                vt = VTP + (size_t)((b * 4 + h) * 128) * 256; }
            bf16x8 qf[12];
            { const bf16* qp = Q + (size_t)(q0 + rho) * 768 + h * 192 + 8 * hh;
#pragma unroll
              for (int ks = 0; ks < 12; ++ks) qf[ks] = *(const bf16x8*)(qp + 16 * ks); }
            if (heavy) {
                const float* ropec = (const float*)(ws + WS_ROPE); const int ntok = (q0 + rho - NTOK_P) & 1023;
#pragma unroll
                for (int a = 0; a < 2; ++a) { const float* cp = ropec + ntok * 32 + a * 16 + 8 * hh;
                    const f32x4 c0 = *(const f32x4*)cp, c1 = *(const f32x4*)(cp + 4), s0 = *(const f32x4*)(cp + 32768), s1 = *(const f32x4*)(cp + 32768 + 4);
                    const u32x4 w1 = __builtin_bit_cast(u32x4, qf[8 + 2 * a]), w2 = __builtin_bit_cast(u32x4, qf[9 + 2 * a]); u32x4 r1, r2;
#pragma unroll
                    for (int j = 0; j < 4; ++j) { const float x1l = __uint_as_float(w1[j] << 16), x1h = __uint_as_float(w1[j] & 0xffff0000u), x2l = __uint_as_float(w2[j] << 16), x2h = __uint_as_float(w2[j] & 0xffff0000u);
                        const float cl = j < 2 ? c0[2 * j] : c1[2 * j - 4], ch = j < 2 ? c0[2 * j + 1] : c1[2 * j - 3], sl = j < 2 ? s0[2 * j] : s1[2 * j - 4], sh = j < 2 ? s0[2 * j + 1] : s1[2 * j - 3];
                        r1[j] = cvt_pk_bf16(x1l * cl - x2l * sl, x1h * ch - x2h * sh); r2[j] = cvt_pk_bf16(x1l * sl + x2l * cl, x1h * sh + x2h * ch); }
                    qf[8 + 2 * a] = __builtin_bit_cast(bf16x8, r1); qf[9 + 2 * a] = __builtin_bit_cast(bf16x8, r2); }
            }
            f32x16 o[4];
#pragma unroll
            for (int t = 0; t < 4; ++t)
#pragma unroll
                for (int i = 0; i < 16; ++i) o[t][i] = 0.f;
            float m = -1e30f, lsum = 0.f;
            int kslot[2], kcol[2], vd[2], vc[2];
#pragma unroll
            for (int j = 0; j < 2; ++j) { const int c = tid + 512 * j, kap = c >> 4; kcol[j] = c & 15;
                kslot[j] = (kap & 32) + (kap & 3) + 4 * ((kap >> 4) & 1) + 8 * ((kap >> 2) & 3);
                vd[j] = c >> 3; vc[j] = c & 7; }
            const int rkap = tid >> 3, rc8 = tid & 7, rslot = (rkap & 32) + (rkap & 3) + 4 * ((rkap >> 4) & 1) + 8 * ((rkap >> 2) & 3);
            u32x4 sk[2], sr, sv[2];
#define AT_GLOAD(k0) do { const int rb_ = (k0) < split ? rowA + (k0) : rowB + ((k0) - split); \
                _Pragma("unroll") for (int j = 0; j < 2; ++j) sk[j] = *(const u32x4*)(KN + (size_t)(rb_ + ((tid + 512 * j) >> 4)) * 512 + h * 128 + kcol[j] * 8); \
                sr = *(const u32x4*)(KRB + (size_t)(rb_ + rkap) * 64 + rc8 * 8); \
                _Pragma("unroll") for (int j = 0; j < 2; ++j) sv[j] = *(const u32x4*)(vt + (size_t)vd[j] * keys + (k0) + vc[j] * 8); } while (0)
#define AT_SWRITE(buf) do { LAS unsigned char* sb_ = lds + (buf) * AT_STAGE; \
                _Pragma("unroll") for (int j = 0; j < 2; ++j) *(LAS u32x4*)(sb_ + kslot[j] * AT_KROW + kcol[j] * 16) = sk[j]; \
                *(LAS u32x4*)(sb_ + rslot * AT_KROW + 256 + rc8 * 16) = sr; \
                _Pragma("unroll") for (int j = 0; j < 2; ++j) *(LAS u32x4*)(sb_ + AT_KBYTES + vd[j] * AT_VROW + vc[j] * 16) = sv[j]; } while (0)
            const int ntile = nkeys >> 6;
            const int blk_lo = heavy ? (wave >> 2) : 0, blk_hi = heavy ? blk_lo + 1 : 2;
            AT_GLOAD(0); AT_SWRITE(0);
            __syncthreads();
            for (int tI = 0; tI < ntile; ++tI) {
                if (tI + 1 < ntile) AT_GLOAD((tI + 1) * 64);
                { const LAS unsigned char* sb = lds + (tI & 1) * AT_STAGE;
                for (int blk = blk_lo; blk < blk_hi; ++blk) {
                    const LAS unsigned char* kp = sb + (32 * blk + rho) * AT_KROW + hh * 16;
                    f32x16 sc, scb;
#pragma unroll
                    for (int i = 0; i < 16; ++i) { sc[i] = 0.f; scb[i] = 0.f; }
#pragma unroll
                    for (int ks = 0; ks < 12; ks += 2) { sc = MFMA32(*(const LAS bf16x8*)(kp + ks * 32), qf[ks], sc); scb = MFMA32(*(const LAS bf16x8*)(kp + ks * 32 + 32), qf[ks + 1], scb); }
                    sc = sc + scb;
                    float mx = sc[0];
#pragma unroll
                    for (int i = 1; i < 16; ++i) mx = fmaxf(mx, sc[i]);
                    mx = fmaxf(mx, shx(mx, 32, lane));
                    const float mn = fmaxf(m, mx), alpha = __builtin_amdgcn_exp2f(m - mn);
                    float ps = 0.f;
#pragma unroll
                    for (int i = 0; i < 16; ++i) { sc[i] = __builtin_amdgcn_exp2f(sc[i] - mn); ps += sc[i]; }
                    lsum = lsum * alpha + ps; m = mn;
#pragma unroll
                    for (int t = 0; t < 4; ++t) o[t] = o[t] * alpha;
                    bf16x8 pb[2];
#pragma unroll
                    for (int s2 = 0; s2 < 2; ++s2) { u32x4 w; w.x = cvt_pk_bf16(sc[8 * s2 + 0], sc[8 * s2 + 1]); w.y = cvt_pk_bf16(sc[8 * s2 + 2], sc[8 * s2 + 3]); w.z = cvt_pk_bf16(sc[8 * s2 + 4], sc[8 * s2 + 5]); w.w = cvt_pk_bf16(sc[8 * s2 + 6], sc[8 * s2 + 7]);
                        pb[s2] = __builtin_bit_cast(bf16x8, w); }
                    const LAS unsigned char* vp = sb + AT_KBYTES + rho * AT_VROW + (32 * blk + 16 * hh) * 2;
#pragma unroll
                    for (int t = 0; t < 4; ++t)
#pragma unroll
                        for (int s2 = 0; s2 < 2; ++s2) o[t] = MFMA32(*(const LAS bf16x8*)(vp + 32 * t * AT_VROW + 16 * s2), pb[s2], o[t]);
                }
                }
                if (tI + 1 < ntile) AT_SWRITE((tI + 1) & 1);
                __syncthreads();
            }
#undef AT_GLOAD
#undef AT_SWRITE
            lsum += shx(lsum, 32, lane);
            bf16* crow = CC + (size_t)(q0 + rho) * 1024 + h * 128;
            if (!heavy) { const float inv = 1.0f / lsum;
#pragma unroll
                for (int t = 0; t < 4; ++t) attn_store_tile(o[t], inv, crow, t, hh);
            } else {
                const int half = wave >> 2;
                LAS float* mine = (LAS float*)(lds + wave * 8704);
                LAS const float* theirs = (LAS const float*)(lds + (wave ^ 4) * 8704);
#pragma unroll
                for (int t2 = 0; t2 < 2; ++t2)
#pragma unroll
                    for (int i = 0; i < 16; ++i) mine[(t2 * 16 + i) * 64 + lane] = half == 0 ? o[2 + t2][i] : o[t2][i];
                if (hh == 0) { mine[2048 + rho] = m; mine[2080 + rho] = lsum; }
                __syncthreads();
                const float mp = theirs[2048 + rho], lp = theirs[2080 + rho];
                const float mg = fmaxf(m, mp), wo = __builtin_amdgcn_exp2f(m - mg), wp = __builtin_amdgcn_exp2f(mp - mg);
                const float inv = 1.0f / (wo * lsum + wp * lp);
#pragma unroll
                for (int t2 = 0; t2 < 2; ++t2) { f32x16 acc;
#pragma unroll
                    for (int i = 0; i < 16; ++i) acc[i] = wo * (half == 0 ? o[t2][i] : o[2 + t2][i]) + wp * theirs[(t2 * 16 + i) * 64 + lane];
                    attn_store_tile(acc, inv, crow, half * 2 + t2, hh); }
                __syncthreads();
            }
        } else {
            const int c = it - 256;
            LAS bf16* vnT = (LAS bf16*)lds;
#pragma unroll
            for (int pass = 0; pass < 8; ++pass) { const int u = wave + 8 * pass, qq = (u & 1) * 64 + lane, c8 = (u >> 1) * 8;
                const bf16x8 v = *(const bf16x8*)(VN + (size_t)(c * 128 + qq) * 256 + c8);
#pragma unroll
                for (int j = 0; j < 8; ++j) vnT[(c8 + j) * 136 + qq] = (bf16)v[j]; }
            __syncthreads();
            const int hd = wave & 3, ph = wave >> 2;
#pragma unroll
            for (int pp = 0; pp < 2; ++pp) { const int pt = 2 * ph + pp;
                f32x16 acc[2];
#pragma unroll
                for (int d = 0; d < 2; ++d)
#pragma unroll
                    for (int i = 0; i < 16; ++i) acc[d][i] = 0.f;
                const float* wrow = A.w_s + ((size_t)(l * 4 + hd) * 128 + 32 * pt + rho) * 128 + 8 * hh;
                f32x4 wv[16];
#pragma unroll
                for (int ks = 0; ks < 8; ++ks) { wv[2 * ks] = *(const f32x4*)(wrow + 16 * ks); wv[2 * ks + 1] = *(const f32x4*)(wrow + 16 * ks + 4); }
#pragma unroll
                for (int ks = 0; ks < 8; ++ks) { const f32x4 w0 = wv[2 * ks], w1 = wv[2 * ks + 1];
                    u32x4 w; w.x = cvt_pk_bf16(w0.x, w0.y); w.y = cvt_pk_bf16(w0.z, w0.w); w.z = cvt_pk_bf16(w1.x, w1.y); w.w = cvt_pk_bf16(w1.z, w1.w);
                    const bf16x8 af = __builtin_bit_cast(bf16x8, w);
#pragma unroll
                    for (int d = 0; d < 2; ++d) { const bf16x8 bfr = *(const LAS bf16x8*)(vnT + (hd * 64 + 32 * d + rho) * 136 + 16 * ks + 8 * hh); acc[d] = MFMA32(af, bfr, acc[d]); } }
                float bs[16]; bf16 ugv[2][16];
#pragma unroll
                for (int i = 0; i < 16; ++i) { const int p = 32 * pt + (i & 3) + 8 * (i >> 2) + 4 * hh; bs[i] = A.b_s[(l * 4 + hd) * 128 + p];
#pragma unroll
                    for (int d = 0; d < 2; ++d) ugv[d][i] = UG[((size_t)c * 128 + p) * 256 + hd * 64 + 32 * d + rho]; }
#pragma unroll
                for (int d = 0; d < 2; ++d) { const int col = hd * 64 + 32 * d + rho;
#pragma unroll
                    for (int i = 0; i < 16; ++i) { const int p = 32 * pt + (i & 3) + 8 * (i >> 2) + 4 * hh; const size_t row = (size_t)c * 128 + p;
                        const float mixed = acc[d][i] + bs[i];
                        const float ug = __uint_as_float((unsigned)ugv[d][i] << 16);
                        CC[row * 1024 + 512 + col] = (bf16)(cvt_pk_bf16(ug * mixed, 0.f) & 0xffffu); } }
            }
            __syncthreads();
        }
    }
}

__global__ void __launch_bounds__(512, 2) fwd_megakernel(Args A) {
    extern __shared__ __attribute__((aligned(16))) unsigned char smem[];
    LAS unsigned char* lds = (LAS unsigned char*)smem;
    const int wave0 = __builtin_amdgcn_readfirstlane((int)threadIdx.x >> 6);
    unsigned* const bar = (unsigned*)(A.ws + WS_BAR);
    volatile LAS unsigned* const barst = (volatile LAS unsigned*)(lds + LDS_BARST);
    const unsigned xcc = xb_xcc_id();
    if (wave0 == 0) { const int l0 = fresh_lane(); if (l0 < 2) barst[l0] = 0u; if (l0 == 0 && A.ph_hi - A.ph_lo > 1) (void)xb_add(&bar[XB_XCNT(xcc)], 1u); }
    __syncthreads();
    if (A.ph_lo < 0) cg::this_grid().sync();
    bool dup_done = false; (void)dup_done;
    for (int ph = A.ph_lo; ph < A.ph_hi; ++ph) {
        const int wave = wave0;
#define LANE fresh_lane()
#define TID (wave * 64 + fresh_lane())
        unsigned char* ws = A.ws; asm volatile("" : "+s"(ws));
        if (ph == 0) phase_prologue(A, lds, wave);
        else if (ph == 1) phase_pre(A, lds, LANE, wave);
        else {
            const int l = (ph - 2) / 9, k = (ph - 2) % 9;
            const int G = gridDim.x, bid = blockIdx.x;
            if (k == 0) {
                pg8::Gemm g{(const bf16*)(ws + WS_H), (const bf16*)(ws + WS_WIN) + (size_t)l * 2048 * 1024, NTOK, 2048, 1024}; pg8::StaticOrder S; S.init(NTOK, 2048, G, bid);
                EpiB16<0> E{(bf16*)(ws + WS_Z), INC, INC}; pg8::gemm_phase<EpiB16<0>, pg8::StaticOrder, true>(lds, g, S, E, TID);
            } else if (k == 1) phase_split(A, l, LANE, wave);
            else if (k == 2) {
                { pg8::Gemm g{(const bf16*)(ws + WS_QN), (const bf16*)(ws + WS_WUQ) + (size_t)l * 768 * 384, NTOK, 768, 384}; pg8::StaticOrder S; S.init(NTOK, 768, G, bid);
                  EpiB16<0> E{(bf16*)(ws + WS_Q), 768, 768}; pg8::gemm_phase<EpiB16<0>, pg8::StaticOrder, false>(lds, g, S, E, TID); }
                { pg8::Gemm g{(const bf16*)(ws + WS_CKVN), (const bf16*)(ws + WS_WUKV) + (size_t)l * 1024 * 256, NROWKV, 1024, 256}; pg8::StaticOrder S; S.init(NROWKV, 1024, G, (bid + G - 144 % G) % G);
                  EpiKV E{(bf16*)(ws + WS_KNOPE), (bf16*)(ws + WS_VTP), (bf16*)(ws + WS_VTS)}; pg8::gemm_phase<EpiKV, pg8::StaticOrder, false>(lds, g, S, E, TID); }
            } else if (k == 3) phase_mixer(A, l, lds, LANE, wave);
            else if (k == 4 || k == 7) {
                const bool o = (k == 4);
                pg8::Gemm g{(const bf16*)(ws + (o ? WS_CONCAT : WS_ACT)), o ? (const bf16*)(ws + WS_WOUT) + (size_t)l * 1024 * 1024 : (const bf16*)(ws + WS_WFF2) + (size_t)l * 1024 * 4096, NTOK, 1024, o ? 1024 : 4096};
                pg8::StaticOrder S; S.init(NTOK, 1024, G, bid);
                EpiB16<0> E{(bf16*)(ws + WS_MIX), 1024, 1024}; pg8::gemm_phase<EpiB16<0>, pg8::StaticOrder, true>(lds, g, S, E, TID);
                if (!o && l + 1 < DEPTH) { const int first = G > 192 ? 192 : 0;
                    if (bid >= first) convert_layer(A, lds, l + 1, (bid - first) * 8 + wave, (G - first) * 8, wave, LANE); }
            } else if (k == 5) phase_post(A, l, 0, lds, LANE, wave);
            else if (k == 6) {
                pg8::Gemm g{(const bf16*)(ws + WS_H), (const bf16*)(ws + WS_WFF1) + (size_t)l * 4096 * 1024, NTOK, 4096, 1024}; pg8::StaticOrder S; S.init(NTOK, 4096, G, bid);
                EpiB16<1> E{(bf16*)(ws + WS_ACT), 4096, 4096}; pg8::gemm_phase<EpiB16<1>, pg8::StaticOrder, true>(lds, g, S, E, TID);
            } else phase_post(A, l, 1, lds, LANE, wave);
        }
        if (ph + 1 < A.ph_hi) xcd_barrier(bar, xcc, barst, wave == 0 && fresh_lane() == 0);
#if PROBE_DUP >= 0
        {
            bool again = false;
            if (PROBE_DUP == 100) { if (ph + 1 < A.ph_hi) xcd_barrier(bar, xcc, barst, wave == 0 && fresh_lane() == 0); }
            else if (!dup_done) {
                const int kk = ph >= 2 ? (ph - 2) % 9 : -1;
                if (PROBE_DUP == 50) again = (ph == 0);
                else if (PROBE_DUP == 60) again = (kk == 0 || kk == 2 || kk == 4 || kk == 6 || kk == 7);
                else again = (kk == PROBE_DUP);
            }
            if (again) { dup_done = true; --ph; } else dup_done = false;
        }
#endif
    }
}

constexpr int N_PHASES = 2 + 9 * DEPTH;

extern "C" void kernel_launch(void* const* d_in, const int* in_sizes, int n_in, void* d_out, int out_size, void* d_ws, size_t ws_size, hipStream_t stream) {
    static int grid = 0;
    if (grid == 0) {
        if (n_in != 24 || ws_size < WS_END || in_sizes[9] != DEPTH * 1024 * INC) { fprintf(stderr, "kernel_launch: unexpected problem (n_in %d, ws %zu, w_in %d)\n", n_in, ws_size, n_in > 9 ? in_sizes[9] : -1); grid = -1; return; }
        int dev = 0, cus = 0, per_cu = 0;
        hipGetDevice(&dev); hipDeviceGetAttribute(&cus, hipDeviceAttributeMultiprocessorCount, dev);
        if (hipFuncSetAttribute((const void*)fwd_megakernel, hipFuncAttributeMaxDynamicSharedMemorySize, LDS_BYTES) != hipSuccess) { fprintf(stderr, "kernel_launch: hipFuncSetAttribute failed\n"); grid = -1; return; }
        if (hipOccupancyMaxActiveBlocksPerMultiprocessor(&per_cu, (const void*)fwd_megakernel, 512, LDS_BYTES) != hipSuccess || per_cu < 1) { fprintf(stderr, "kernel_launch: occupancy query says %d\n", per_cu); per_cu = 1; }
        (void)hipGetLastError();
        grid = cus * 1;
        fprintf(stderr, "kernel_launch: grid %d (cus %d, per_cu %d)\n", grid, cus, per_cu);
    }
    if (grid < 0) return;
    if (hipMemsetAsync((char*)d_ws + WS_BAR, 0, 16384, stream) != hipSuccess) { fprintf(stderr, "kernel_launch: memset failed\n"); return; }
    Args a{};
    const float** ap = (const float**)&a;
    for (int i = 0; i < 24; ++i) ap[i] = (const float*)d_in[i];
    a.out = (float*)d_out; a.ws = (unsigned char*)d_ws;
#if MK_PER_PHASE
    for (int ph = 0; ph < N_PHASES; ++ph) { a.ph_lo = ph; a.ph_hi = ph + 1; hipLaunchKernelGGL(fwd_megakernel, dim3(grid), dim3(512), LDS_BYTES, stream, a); }
#else
    a.ph_lo = 0; a.ph_hi = N_PHASES;
    void* args[] = {&a};
    hipError_t e = hipLaunchCooperativeKernel((const void*)fwd_megakernel, dim3(grid), dim3(512), args, LDS_BYTES, stream);
    if (e != hipSuccess) fprintf(stderr, "kernel_launch: cooperative launch failed: %s (grid %d)\n", hipGetErrorString(e), grid);
#endif
}
```

```cpp
#include <hip/hip_runtime.h>
#include <hip/hip_cooperative_groups.h>
#include <cstdio>
namespace cg = cooperative_groups;

#ifndef MK_PER_PHASE
#define MK_PER_PHASE 0
#endif

#ifndef PROBE_DUP
#define PROBE_DUP -1
#endif
#define LAS __attribute__((address_space(3)))
typedef unsigned short bf16;
typedef short bf16x8 __attribute__((ext_vector_type(8)));
typedef float f32x2 __attribute__((ext_vector_type(2)));
typedef float f32x4 __attribute__((ext_vector_type(4)));
typedef float f32x16 __attribute__((ext_vector_type(16)));
typedef unsigned u32x2 __attribute__((ext_vector_type(2)));
typedef unsigned u32x4 __attribute__((ext_vector_type(4)));

constexpr int DM = 1024, NTOK_P = 8192, NTOK_S = 4096, NTOK = 12288, NROWKV = 14336;
constexpr int DEPTH = 4, INC = 1984, DFF = 4096;
constexpr int ZQ = 0, ZCKV = 384, ZKR = 640, ZU = 704, ZV = 960, ZBG = 1216, ZCG = 1472, ZHH = 1728;
constexpr float EPS = 1e-6f;
constexpr float QSCALE = 0.07216878364870322f * 1.4426950408889634f;

constexpr size_t MiB = 1u << 20;
constexpr size_t WS_MOD = 0, WS_BAR = 512 * 1024, WS_ROPE = 1 * MiB, WS_WIN = 2 * MiB, WS_WUQ = 18 * MiB, WS_WUKV = 21 * MiB, WS_WOUT = 23 * MiB,
                 WS_WFF1 = 31 * MiB, WS_WFF2 = 63 * MiB, WS_H = 95 * MiB, WS_MIX = 119 * MiB, WS_CONCAT = 167 * MiB, WS_QN = 191 * MiB,
                 WS_CKVN = 200 * MiB, WS_KRB = 207 * MiB, WS_UG = 209 * MiB, WS_VN = 215 * MiB, WS_Q = 221 * MiB, WS_KNOPE = 239 * MiB,
                 WS_VTP = 253 * MiB, WS_VTS = 261 * MiB, WS_Z = 267 * MiB, WS_ACT = 267 * MiB, WS_END = 363 * MiB;
constexpr int LDS_BYTES = 147456, LDS_BARST = LDS_BYTES - 64;

__device__ __forceinline__ unsigned cvt_pk_bf16(float lo, float hi) { unsigned r; asm volatile("v_cvt_pk_bf16_f32 %0, %1, %2" : "=v"(r) : "v"(lo), "v"(hi)); return r; }
__device__ __forceinline__ int fresh_lane() { int l; asm volatile("v_mbcnt_lo_u32_b32 %0, -1, 0\n\tv_mbcnt_hi_u32_b32 %0, -1, %0" : "=v"(l)); return l; }
__device__ __forceinline__ float shx(float v, int mask, int lane) { return __int_as_float(__builtin_amdgcn_ds_bpermute((lane ^ mask) << 2, __float_as_int(v))); }
__device__ __forceinline__ float dpp_add(float v, const int ctrl_is) {
    return v; }
#define DPP_ADD(v, ctrl) ((v) + __int_as_float(__builtin_amdgcn_update_dpp(0, __float_as_int(v), (ctrl), 0xf, 0xf, true)))
__device__ __forceinline__ float wave_sum(float v, int lane) {
    (void)lane;
    v = DPP_ADD(v, 0xB1);
    v = DPP_ADD(v, 0x4E);
    v = DPP_ADD(v, 0x141);
    v = DPP_ADD(v, 0x140);
    const int vi = __float_as_int(v);
    return (__int_as_float(__builtin_amdgcn_readlane(vi, 0)) + __int_as_float(__builtin_amdgcn_readlane(vi, 16))) + (__int_as_float(__builtin_amdgcn_readlane(vi, 32)) + __int_as_float(__builtin_amdgcn_readlane(vi, 48)));
}
__device__ __forceinline__ float gelu_tanh(float x) { const float y = 0.7978845608028654f * (x + 0.044715f * x * x * x); return x / (1.0f + __expf(-2.0f * y)); }
__device__ __forceinline__ f32x4 gelu4(f32x4 v) { return (f32x4){gelu_tanh(v.x), gelu_tanh(v.y), gelu_tanh(v.z), gelu_tanh(v.w)}; }
__device__ __forceinline__ float sumsq4(f32x4 v) { return (v.x * v.x + v.y * v.y) + (v.z * v.z + v.w * v.w); }
__device__ __forceinline__ f32x4 ld4bf_nt(const bf16* p) { const u32x2 w = __builtin_nontemporal_load((const u32x2*)p); return (f32x4){__uint_as_float(w.x << 16), __uint_as_float(w.x & 0xffff0000u), __uint_as_float(w.y << 16), __uint_as_float(w.y & 0xffff0000u)}; }
__device__ __forceinline__ f32x4 ld4bf(const bf16* p) { const u32x2 w = *(const u32x2*)p; return (f32x4){__uint_as_float(w.x << 16), __uint_as_float(w.x & 0xffff0000u), __uint_as_float(w.y << 16), __uint_as_float(w.y & 0xffff0000u)}; }
__device__ __forceinline__ f32x2 ld2bf(const bf16* p) { const unsigned w = *(const unsigned*)p; return (f32x2){__uint_as_float(w << 16), __uint_as_float(w & 0xffff0000u)}; }
__device__ __forceinline__ float ld1bf(const bf16* p) { return __uint_as_float((unsigned)*p << 16); }
__device__ __forceinline__ u32x2 pk4(f32x4 v) { u32x2 w; w.x = cvt_pk_bf16(v.x, v.y); w.y = cvt_pk_bf16(v.z, v.w); return w; }


#define XB_TMO      128
#define XB_XCNT(j)  (256  + 64 * (j))
#define XB_XSUB(j)  (1280 + 64 * (j))
#define XB_XGEN(j)  (2304 + 64 * (j))
#define XB_TOP      3328
#define XB_TOPGEN   3392
#define XCD_BAR_WORDS 3456
#define XB_SPIN_CAP (1u << 18)
__device__ __forceinline__ unsigned xb_ld(unsigned* p)              { return __hip_atomic_load(p, __ATOMIC_RELAXED, __HIP_MEMORY_SCOPE_AGENT); }
__device__ __forceinline__ unsigned xb_add(unsigned* p, unsigned v) { return __hip_atomic_fetch_add(p, v, __ATOMIC_RELAXED, __HIP_MEMORY_SCOPE_AGENT); }
__device__ __forceinline__ unsigned xb_xcc_id() { return (unsigned)__builtin_amdgcn_s_getreg((3 << 11) | 20) & 0xFu; }
#define XB_SPIN(cond, bar) do { unsigned _sp = 0; while (cond) { __builtin_amdgcn_s_sleep(1); \
    if ((++_sp & 255u) == 0u) { if (xb_ld(&(bar)[XB_TMO])) break; if (_sp > XB_SPIN_CAP) { atomicAdd(&(bar)[XB_TMO], 1u); break; } } } } while (0)
__device__ __forceinline__ void xcd_barrier_complete(unsigned* bar, unsigned x, unsigned& nloc, unsigned& nx) {
    const unsigned G = gridDim.x * gridDim.y * gridDim.z;
    unsigned sum, cnt, mine, sp = 0u;
    for (;;) {
        sum = 0u; cnt = 0u; mine = 0u;
#pragma unroll
        for (unsigned j = 0; j < 16; ++j) { const unsigned c = xb_ld(&bar[XB_XCNT(j)]); sum += c; cnt += (c > 0u) ? 1u : 0u; mine = (j == x) ? c : mine; }
        if (sum == G) break;
        __builtin_amdgcn_s_sleep(1);
        if ((++sp & 255u) == 0u) { if (xb_ld(&bar[XB_TMO])) break; if (sp > XB_SPIN_CAP) { atomicAdd(&bar[XB_TMO], 1u); break; } }
    }
    nloc = mine > 0u ? mine : 1u; nx = cnt > 0u ? cnt : 1u;
}
__device__ __forceinline__ void xcd_barrier(unsigned* bar, unsigned x, volatile LAS unsigned* st, bool leader) {
    asm volatile("s_waitcnt vmcnt(0)" ::: "memory");
    __syncthreads();
    if (leader) {
        __builtin_amdgcn_s_waitcnt(0);
        unsigned nloc = st[0], nx = st[1];
        if (nloc == 0u) { xcd_barrier_complete(bar, x, nloc, nx); st[0] = nloc; st[1] = nx; }
        const unsigned old = xb_add(&bar[XB_XSUB(x)], 1u);
        const unsigned gen = old / nloc;
        if (old + 1u == (gen + 1u) * nloc) {
            __builtin_amdgcn_fence(__ATOMIC_RELEASE, "agent");
            asm volatile("s_waitcnt vmcnt(0)" ::: "memory");
            const unsigned og = xb_add(&bar[XB_TOP], 1u);
            const unsigned tg = og / nx;
            if (og + 1u == (tg + 1u) * nx) xb_add(&bar[XB_TOPGEN], 1u);
            else XB_SPIN(xb_ld(&bar[XB_TOPGEN]) == tg, bar);
            __builtin_amdgcn_fence(__ATOMIC_ACQUIRE, "agent");
            xb_add(&bar[XB_XGEN(x)], 1u);
            asm volatile("s_waitcnt vmcnt(0)" ::: "memory");
        } else {
            XB_SPIN(xb_ld(&bar[XB_XGEN(x)]) == gen, bar);
            __builtin_amdgcn_fence(__ATOMIC_ACQUIRE, "agent");
            asm volatile("s_waitcnt vmcnt(0)" ::: "memory");
        }
    }
    __syncthreads();
}

namespace pg8 {
#define PG8_LAS __attribute__((address_space(3)))
typedef unsigned short bf16_t;
constexpr int BM = 256, BK = 64, HALF = 128, HTB = HALF * BK * 2, STAGE_BYTES = 8 * HTB, NXCD = 8, WGM = 8;
__host__ __device__ __forceinline__ int lds_byte(int r, int c) { const int st = (r >> 4) * 2 + (c >> 5), rr = r & 15, cc = c & 31, ob = rr * 64 + cc * 2; return st * 1024 + (ob ^ (((ob >> 9) & 1) << 5)); }
__host__ __device__ __forceinline__ void stage_rc(int b, int& R, int& C) { const int st = b / 1024, sb = b % 1024, swz = sb ^ (((sb >> 9) & 1) << 5); R = (st >> 1) * 16 + swz / 64; C = (st & 1) * 32 + (swz % 64) / 2; }
__host__ __device__ __forceinline__ int perm32(int rho) { const int n = rho >> 4, i = rho & 15; return 8 * (i >> 2) + 4 * n + (i & 3); }
struct Unit { int pm, pn; };
struct Gemm { const bf16_t* A; const bf16_t* Bt; int M, N, K; };
struct StaticOrder {
    int nM, nN, nwg, G, c;
    __host__ __device__ void init(int M, int N, int G_, int c_) { nM = M / BM; nN = N / BM; nwg = nM * nN; G = G_; c = c_; }
    __host__ __device__ bool next(int i, Unit& u) const {
        const long L = (long)i * G + c; if (L >= nwg) return false;
        int wgid = (int)L; { const int q = nwg / NXCD, r = nwg % NXCD, xcd = wgid % NXCD, off = wgid / NXCD; wgid = (xcd < r ? xcd * (q + 1) : r * (q + 1) + (xcd - r) * q) + off; }
        const int nig = WGM * nN, gid = wgid / nig, fm = gid * WGM, gsz = (nM - fm) < WGM ? (nM - fm) : WGM;
        u.pm = fm + ((wgid % nig) % gsz); u.pn = (wgid % nig) / gsz; return true;
    }
    __device__ __forceinline__ void a_ready(const Unit&) const {}
    __device__ __forceinline__ void done(const Unit&) const {}
};

template <class Epi, class Sched, bool SP2>
__device__ __forceinline__ void gemm_phase(PG8_LAS unsigned char* lds, const Gemm g, const Sched& S, const Epi& E, const int tid) {
    const int wid = __builtin_amdgcn_readfirstlane(tid >> 6), lane = tid & 63, wr = wid >> 2, wc = wid & 3, fr = lane & 15, fq = lane >> 4;
    const int K = g.K, nt = K / BK;
    unsigned voffA[2], voffB[2];
#pragma unroll
    for (int i = 0; i < 2; ++i) { int R, C; stage_rc(tid * 16 + i * 8192, R, C); const int Rb = Epi::PERM ? ((R & ~31) + perm32(R & 31)) : R;
        voffA[i] = (unsigned)(R * K + C) * 2u; voffB[i] = (unsigned)(Rb * K + C) * 2u; }
    const size_t kstep = (size_t)(BK * 2);
    const size_t hstep = (size_t)HALF * K * 2;
    const size_t tstep = 2 * hstep;
    const unsigned ldsw = (unsigned)wid * 1024u;
    const int aoff = lds_byte(wr * 64 + fr, fq * 8), boff = lds_byte(wc * 32 + fr, fq * 8);
#define PG8_SA(b, h) (((b) * 2 + (h)) * HTB)
#define PG8_SB(b, h) ((4 + (b) * 2 + (h)) * HTB)
#define PG8_STAGE(bufoff, gbase, voff) do { _Pragma("unroll") for (int _i = 0; _i < 2; ++_i) \
        __builtin_amdgcn_global_load_lds((const unsigned*)((const char*)(gbase) + (voff)[_i]), (PG8_LAS unsigned*)(lds + (bufoff) + ldsw + _i * 8192), 16, 0, 0); } while (0)
#define PG8_LDA(dst, b, h) do { _Pragma("unroll") for (int m = 0; m < 4; ++m) _Pragma("unroll") for (int k = 0; k < 2; ++k) dst[m][k] = *(const PG8_LAS bf16x8*)(lds + PG8_SA(b, h) + aoff + m * 2048 + k * 1024); } while (0)
#define PG8_LDB(dst, b, h) do { _Pragma("unroll") for (int n = 0; n < 2; ++n) _Pragma("unroll") for (int k = 0; k < 2; ++k) dst[n][k] = *(const PG8_LAS bf16x8*)(lds + PG8_SB(b, h) + boff + n * 2048 + k * 1024); } while (0)
#define PG8_MMA(ai, bj, At, Bt) do { __builtin_amdgcn_s_setprio(1); _Pragma("unroll") for (int m = 0; m < 4; ++m) _Pragma("unroll") for (int n = 0; n < 2; ++n) _Pragma("unroll") for (int k = 0; k < 2; ++k) \
        acc[ai][bj][m][n] = __builtin_amdgcn_mfma_f32_16x16x32_bf16(Bt[n][k], At[m][k], acc[ai][bj][m][n], 0, 0, 0); __builtin_amdgcn_s_setprio(0); } while (0)
#define PG8_WAIT_V(n) asm volatile("s_waitcnt vmcnt(" #n ")" ::: "memory")
#define PG8_WAIT_L(n) asm volatile("s_waitcnt lgkmcnt(" #n ")" ::: "memory")
#define PG8_BAR __builtin_amdgcn_s_barrier()
#define PG8_SCHED __builtin_amdgcn_sched_barrier(0)
    Unit cur, nxt; int ui = 0;
    if (!S.next(0, cur)) return;
    f32x4 acc[2][2][4][2];
#pragma unroll
    for (int a = 0; a < 2; ++a)
#pragma unroll
        for (int b = 0; b < 2; ++b)
#pragma unroll
            for (int m = 0; m < 4; ++m)
#pragma unroll
                for (int n = 0; n < 2; ++n) acc[a][b][m][n] = (f32x4){0.f, 0.f, 0.f, 0.f};
    bf16x8 At[4][2], B0[2][2], B1[2][2];
    const char* cA = (const char*)g.A + (size_t)cur.pm * tstep; const char* cB = (const char*)g.Bt + (size_t)cur.pn * tstep;
    S.a_ready(cur);
    if constexpr (SP2) {
    PG8_STAGE(PG8_SB(0, 0), cB, voffB); PG8_STAGE(PG8_SB(0, 1), cB + hstep, voffB); PG8_STAGE(PG8_SA(0, 0), cA, voffA); PG8_STAGE(PG8_SA(0, 1), cA + hstep, voffA);
    if (wr == 1) PG8_BAR;
    PG8_WAIT_V(2); PG8_BAR;
    PG8_STAGE(PG8_SB(1, 0), cB + kstep, voffB); PG8_STAGE(PG8_SA(1, 0), cA + kstep, voffA); PG8_STAGE(PG8_SB(1, 1), cB + hstep + kstep, voffB);
    PG8_WAIT_V(6); PG8_BAR;
    } else {
    PG8_STAGE(PG8_SB(0, 0), cB, voffB); PG8_STAGE(PG8_SA(0, 0), cA, voffA); PG8_STAGE(PG8_SB(0, 1), cB + hstep, voffB); PG8_STAGE(PG8_SA(0, 1), cA + hstep, voffA);
    if (wr == 1) PG8_BAR;
    PG8_WAIT_V(4); PG8_BAR;
    PG8_STAGE(PG8_SB(1, 0), cB + kstep, voffB); PG8_STAGE(PG8_SA(1, 0), cA + kstep, voffA); PG8_STAGE(PG8_SB(1, 1), cB + hstep + kstep, voffB);
    PG8_WAIT_V(6); PG8_BAR;
    }
    for (;;) {
        const bool has_next = S.next(ui + 1, nxt);
        const char* nA = has_next ? (const char*)g.A + (size_t)nxt.pm * tstep : cA; const char* nB = has_next ? (const char*)g.Bt + (size_t)nxt.pn * tstep : cB;
        for (int t = 0; t < nt; t += 2) {
            const bool last = (t == nt - 2);
            const char* a1 = cA + (size_t)(t + 1) * kstep;
            const char* a2 = last ? nA : cA + (size_t)(t + 2) * kstep; const char* b2 = last ? nB : cB + (size_t)(t + 2) * kstep;
            const char* a3 = a2 + kstep; const char* b3 = b2 + kstep;
            if (last && has_next) S.a_ready(nxt);
            if constexpr (SP2) {
            PG8_LDB(B0, 0, 0); PG8_LDB(B1, 0, 1); PG8_SCHED; PG8_LDA(At, 0, 0); PG8_STAGE(PG8_SA(1, 1), a1 + hstep, voffA);
            PG8_WAIT_V(8); PG8_WAIT_L(0); PG8_BAR; PG8_MMA(0, 0, At, B0); PG8_MMA(0, 1, At, B1); PG8_BAR; PG8_SCHED;
            PG8_LDA(At, 0, 1); PG8_STAGE(PG8_SB(0, 0), b2, voffB); PG8_STAGE(PG8_SB(0, 1), b2 + hstep, voffB); PG8_STAGE(PG8_SA(0, 0), a2, voffA);
            PG8_WAIT_V(8); PG8_WAIT_L(0); PG8_BAR; PG8_MMA(1, 0, At, B0); PG8_MMA(1, 1, At, B1); PG8_BAR; PG8_SCHED;
            PG8_LDB(B0, 1, 0); PG8_LDB(B1, 1, 1); PG8_SCHED; PG8_LDA(At, 1, 0); PG8_STAGE(PG8_SA(0, 1), a2 + hstep, voffA);
            PG8_WAIT_V(8); PG8_WAIT_L(0); PG8_BAR; PG8_MMA(0, 0, At, B0); PG8_MMA(0, 1, At, B1); PG8_BAR; PG8_SCHED;
            PG8_LDA(At, 1, 1); PG8_STAGE(PG8_SB(1, 0), b3, voffB); PG8_STAGE(PG8_SB(1, 1), b3 + hstep, voffB); PG8_STAGE(PG8_SA(1, 0), a3, voffA);
            PG8_WAIT_V(8); PG8_WAIT_L(0); PG8_BAR; PG8_MMA(1, 0, At, B0); PG8_MMA(1, 1, At, B1); PG8_BAR; PG8_SCHED;
            } else {
            PG8_LDB(B0, 0, 0); PG8_SCHED; PG8_LDA(At, 0, 0); PG8_STAGE(PG8_SA(1, 1), a1 + hstep, voffA);
            PG8_WAIT_L(8); PG8_BAR; PG8_WAIT_L(0); PG8_MMA(0, 0, At, B0); PG8_BAR; PG8_SCHED;
            PG8_LDB(B1, 0, 1); PG8_STAGE(PG8_SB(0, 0), b2, voffB);
            PG8_BAR; PG8_WAIT_L(0); PG8_MMA(0, 1, At, B1); PG8_BAR;
            PG8_LDA(At, 0, 1); PG8_STAGE(PG8_SA(0, 0), a2, voffA);
            PG8_BAR; PG8_WAIT_L(0); PG8_MMA(1, 0, At, B0); PG8_BAR; PG8_SCHED;
            PG8_STAGE(PG8_SB(0, 1), b2 + hstep, voffB);
            PG8_WAIT_V(6); PG8_BAR; PG8_MMA(1, 1, At, B1); PG8_BAR;
            PG8_LDB(B0, 1, 0); PG8_SCHED; PG8_LDA(At, 1, 0); PG8_STAGE(PG8_SA(0, 1), a2 + hstep, voffA);
            PG8_WAIT_L(8); PG8_BAR; PG8_WAIT_L(0); PG8_MMA(0, 0, At, B0); PG8_BAR; PG8_SCHED;
            PG8_LDB(B1, 1, 1); PG8_STAGE(PG8_SB(1, 0), b3, voffB);
            PG8_BAR; PG8_WAIT_L(0); PG8_MMA(0, 1, At, B1); PG8_BAR;
            PG8_LDA(At, 1, 1); PG8_STAGE(PG8_SA(1, 0), a3, voffA);
            PG8_BAR; PG8_WAIT_L(0); PG8_MMA(1, 0, At, B0); PG8_BAR; PG8_SCHED;
            PG8_STAGE(PG8_SB(1, 1), b3 + hstep, voffB);
            PG8_WAIT_V(6); PG8_BAR; PG8_MMA(1, 1, At, B1); PG8_BAR;
            }
        }
        if (wr == 0) PG8_BAR;
        E(acc, cur, wr, wc, fr, fq); S.done(cur);
        if (!has_next) break;
#pragma unroll
        for (int a = 0; a < 2; ++a)
#pragma unroll
            for (int b = 0; b < 2; ++b)
#pragma unroll
                for (int m = 0; m < 4; ++m)
#pragma unroll
                    for (int n = 0; n < 2; ++n) acc[a][b][m][n] = (f32x4){0.f, 0.f, 0.f, 0.f};
        cur = nxt; cA = nA; cB = nB; ++ui;
        if (wr == 1) PG8_BAR;
    }
    PG8_WAIT_V(0);
    PG8_BAR;
#undef PG8_SA
#undef PG8_SB
#undef PG8_STAGE
#undef PG8_LDA
#undef PG8_LDB
#undef PG8_MMA
#undef PG8_WAIT_V
#undef PG8_WAIT_L
#undef PG8_BAR
#undef PG8_SCHED
}
}

struct EpiF32 {
    static constexpr bool PERM = false;
    float* C; int ldc; int ncols;
    __device__ __forceinline__ void operator()(const f32x4 (&acc)[2][2][4][2], const pg8::Unit& u, int wr, int wc, int fr, int fq) const {
        const int row0 = u.pm * 256 + wr * 64 + fr, col0 = u.pn * 256 + wc * 32 + 4 * fq;
#pragma unroll
        for (int ai = 0; ai < 2; ++ai)
#pragma unroll
            for (int m = 0; m < 4; ++m) { float* rowp = C + (size_t)(row0 + ai * 128 + m * 16) * ldc + col0;
#pragma unroll
                for (int bj = 0; bj < 2; ++bj)
#pragma unroll
                    for (int n = 0; n < 2; ++n) if (col0 + bj * 128 + n * 16 < ncols) *(f32x4*)(rowp + bj * 128 + n * 16) = acc[ai][bj][m][n]; }
    }
};
template <int ACT> struct EpiB16 {
    static constexpr bool PERM = true;
    bf16* O; int ldc; int ncols;
    __device__ __forceinline__ void operator()(const f32x4 (&acc)[2][2][4][2], const pg8::Unit& u, int wr, int wc, int, int) const {
        const int ln = fresh_lane(), fr = ln & 15, fq = ln >> 4;
        const int row0 = u.pm * 256 + wr * 64 + fr, col0 = u.pn * 256 + wc * 32 + 8 * fq;
#pragma unroll
        for (int ai = 0; ai < 2; ++ai)
#pragma unroll
            for (int m = 0; m < 4; ++m) { bf16* rowp = O + (size_t)(row0 + ai * 128 + m * 16) * ldc + col0;
#pragma unroll
                for (int bj = 0; bj < 2; ++bj) { f32x4 v0 = acc[ai][bj][m][0], v1 = acc[ai][bj][m][1];
                    if (col0 + bj * 128 >= ncols) continue;
                    if (ACT) {
#pragma unroll
                    for (int j = 0; j < 4; ++j) { const float a = fmaxf(v0[j], 0.f), b = fmaxf(v1[j], 0.f); v0[j] = a * a; v1[j] = b * b; } }
                    u32x4 w; w.x = cvt_pk_bf16(v0[0], v0[1]); w.y = cvt_pk_bf16(v0[2], v0[3]); w.z = cvt_pk_bf16(v1[0], v1[1]); w.w = cvt_pk_bf16(v1[2], v1[3]);
                    *(u32x4*)(rowp + bj * 128) = w; } }
    }
};
struct EpiQ {
    static constexpr bool PERM = false;
    bf16* Q; const float* ropec; const float* ropes;
    __device__ __forceinline__ void operator()(const f32x4 (&acc)[2][2][4][2], const pg8::Unit& u, int wr, int wc, int, int) const {
        const int ln = fresh_lane(), fr = ln & 15, fq = ln >> 4;
        const int row0 = u.pm * 256 + wr * 64 + fr; const bool sample = u.pm >= 32;
#pragma unroll
        for (int bj = 0; bj < 2; ++bj) {
            const int g0 = u.pn * 256 + bj * 128 + wc * 32, within0 = g0 % 192; const bool isrope = within0 >= 128; const int a = (within0 - 128) >> 5;
#pragma unroll
            for (int ai = 0; ai < 2; ++ai)
#pragma unroll
                for (int m = 0; m < 4; ++m) { const int row = row0 + ai * 128 + m * 16;
                    f32x4 x1 = acc[ai][bj][m][0], x2 = acc[ai][bj][m][1];
                    if (sample && isrope) { const int ntok = (row - NTOK_P) & 1023;
                        const f32x4 cs = *(const f32x4*)(ropec + ntok * 32 + a * 16 + 4 * fq), sn = *(const f32x4*)(ropes + ntok * 32 + a * 16 + 4 * fq);
                        const f32x4 o1 = x1 * cs - x2 * sn, o2 = x1 * sn + x2 * cs; x1 = o1; x2 = o2; }
                    x1 = x1 * QSCALE; x2 = x2 * QSCALE;
                    bf16* p = Q + (size_t)row * 768 + g0 + 4 * fq;
                    *(u32x2*)p = pk4(x1); *(u32x2*)(p + 16) = pk4(x2); asm volatile("" ::: "memory"); }
        }
    }
};
struct EpiKV {
    static constexpr bool PERM = false;
    bf16* KN; bf16* VTP; bf16* VTS;
    __device__ __forceinline__ void operator()(const f32x4 (&acc)[2][2][4][2], const pg8::Unit& u, int wr, int wc, int, int) const {
        const int ln = fresh_lane(), fr = ln & 15, fq = ln >> 4;
        const int h = u.pn, pm = u.pm;
        bf16* vt; int keys, keybase;
        if (pm < 32) { vt = VTP + (size_t)((pm * 4 + h) * 128) * 256; keys = 256; keybase = 0; }
        else if (pm < 48) { const int b = (pm - 32) >> 2; vt = VTS + (size_t)((b * 4 + h) * 128) * 1536; keys = 1536; keybase = 512 + ((pm - 32) & 3) * 256; }
        else { const int b = (pm - 48) >> 1; vt = VTS + (size_t)((b * 4 + h) * 128) * 1536; keys = 1536; keybase = ((pm - 48) & 1) * 256; }
#pragma unroll
        for (int ai = 0; ai < 2; ++ai)
#pragma unroll
            for (int m = 0; m < 4; ++m) { const int rloc = wr * 64 + fr + ai * 128 + m * 16;
                bf16* kp = KN + (size_t)(pm * 256 + rloc) * 512 + h * 128 + wc * 32 + 4 * fq;
#pragma unroll
                for (int n = 0; n < 2; ++n) *(u32x2*)(kp + 16 * n) = pk4(acc[ai][0][m][n]);
#pragma unroll
                for (int n = 0; n < 2; ++n) { const f32x4 v = acc[ai][1][m][n]; const u32x2 w = pk4(v);
                    bf16* vp = vt + (size_t)(wc * 32 + 16 * n + 4 * fq) * keys + keybase + rloc;
                    vp[0] = (bf16)(w.x & 0xffffu); vp[keys] = (bf16)(w.x >> 16); vp[2 * keys] = (bf16)(w.y & 0xffffu); vp[3 * keys] = (bf16)(w.y >> 16); }
                asm volatile("" ::: "memory");
            }
    }
};

struct Args {
    const float *x_prompt, *x_sample, *cache_ckv, *cache_krope, *c, *c_ctx, *w_ada, *b_ada, *g_pre_mix, *w_in, *g_q, *w_uq, *g_kv, *w_ukv,
                *g_v, *w_s, *b_s, *w_conv, *w_out, *g_post_mix, *g_pre_ffn, *w_ff1, *w_ff2, *g_post_ffn;
    float* out; unsigned char* ws; int ph_lo, ph_hi;
};

__device__ __forceinline__ void p0_transpose_item(const float* W, int K, int N, bf16* WT, LAS float* scr, int item, int lane, float scale = 1.0f) {
    const int nblk = N / 32, kb = item / nblk, nb = item % nblk, k0 = 64 * kb, n0 = 32 * nb;
#pragma unroll 8
    for (int i = 0; i < 32; ++i) { const int kk = 2 * i + (lane >> 5); scr[kk * 33 + (lane & 31)] = W[(size_t)(k0 + kk) * N + n0 + (lane & 31)]; }
    asm volatile("s_waitcnt lgkmcnt(0)" ::: "memory");
    const int c = lane & 7;
#pragma unroll
    for (int j = 0; j < 4; ++j) { const int n = (lane >> 3) + 8 * j; const LAS float* s = scr + (8 * c) * 33 + n;
        u32x4 o; o.x = cvt_pk_bf16(s[0 * 33] * scale, s[1 * 33] * scale); o.y = cvt_pk_bf16(s[2 * 33] * scale, s[3 * 33] * scale); o.z = cvt_pk_bf16(s[4 * 33] * scale, s[5 * 33] * scale); o.w = cvt_pk_bf16(s[6 * 33] * scale, s[7 * 33] * scale);
        *(u32x4*)(WT + (size_t)(n0 + n) * K + k0 + 8 * c) = o; }
    asm volatile("s_waitcnt lgkmcnt(0)" ::: "memory");
}

__device__ __forceinline__ void convert_layer(const Args& A, LAS unsigned char* lds, int l, int gwi, int nw, int wave, int lane) {
    unsigned char* ws = A.ws;
    LAS float* scr = (LAS float*)(lds + wave * 16384);
    constexpr int I_IN = 16 * 62, I_UQ = 6 * 24, I_UKV = 4 * 32, I_OUT = 16 * 32, I_F1 = 16 * 128, I_F2 = 64 * 32, I_L = I_IN + I_UQ + I_UKV + I_OUT + I_F1 + I_F2;
    for (int it = gwi; it < I_L; it += nw) {
        int r = it;
        if (r < I_IN) { p0_transpose_item(A.w_in + (size_t)l * 1024 * INC, 1024, INC, (bf16*)(ws + WS_WIN) + (size_t)l * 2048 * 1024, scr, r, lane); continue; } r -= I_IN;
        if (r < I_UQ) { p0_transpose_item(A.w_uq + (size_t)l * 384 * 768, 384, 768, (bf16*)(ws + WS_WUQ) + (size_t)l * 768 * 384, scr, r, lane, QSCALE); continue; } r -= I_UQ;
        if (r < I_UKV) { p0_transpose_item(A.w_ukv + (size_t)l * 256 * 1024, 256, 1024, (bf16*)(ws + WS_WUKV) + (size_t)l * 1024 * 256, scr, r, lane); continue; } r -= I_UKV;
        if (r < I_OUT) { p0_transpose_item(A.w_out + (size_t)l * 1024 * 1024, 1024, 1024, (bf16*)(ws + WS_WOUT) + (size_t)l * 1024 * 1024, scr, r, lane); continue; } r -= I_OUT;
        if (r < I_F1) { p0_transpose_item(A.w_ff1 + (size_t)l * 1024 * 4096, 1024, 4096, (bf16*)(ws + WS_WFF1) + (size_t)l * 4096 * 1024, scr, r, lane); continue; } r -= I_F1;
        p0_transpose_item(A.w_ff2 + (size_t)l * 4096 * 1024, 4096, 1024, (bf16*)(ws + WS_WFF2) + (size_t)l * 1024 * 4096, scr, r, lane);
    }
}

__device__ __forceinline__ void phase_prologue(const Args& A, LAS unsigned char* lds, int wave) {
    const int lane = fresh_lane(), tid = wave * 64 + lane;
    unsigned char* ws = A.ws;
    const int bid = blockIdx.x, G = gridDim.x;
    { const int gt = bid * 512 + tid;
      if (gt < 32768) { const int n = gt >> 5, a = (gt >> 4) & 1, f = gt & 15; const int pos = a == 0 ? (n >> 6) : (n & 63);
          double inv = 1.0; for (int i = 0; i < f; ++i) inv *= 0.5623413251903491;
          double rev = (double)pos * inv * 0.15915494309189535; rev -= floor(rev);
          const float rf = (float)rev;
          ((float*)(ws + WS_ROPE))[gt] = __builtin_amdgcn_cosf(rf); ((float*)(ws + WS_ROPE))[32768 + gt] = __builtin_amdgcn_sinf(rf); } }
    for (int it = bid; it < 192; it += G) {
        const int l = it / 48, cgp = it % 48;
        LAS float* sl = (LAS float*)lds;
        for (int i = tid; i < 5120; i += 512) { const int ci = i >> 10, k = i & 1023; const float v = ci == 0 ? A.c_ctx[k] : A.c[(ci - 1) * 1024 + k]; sl[i] = v / (1.0f + __expf(-v)); }
        __syncthreads();
        float a0[5], a1[5];
#pragma unroll
        for (int ci = 0; ci < 5; ++ci) { a0[ci] = 0.f; a1[ci] = 0.f; }
        const float* wp = A.w_ada + ((size_t)l * 1024 + wave * 128) * 6144 + cgp * 128 + 2 * lane;
#pragma unroll 8
        for (int kk = 0; kk < 128; ++kk) { const f32x2 wv = *(const f32x2*)(wp + (size_t)kk * 6144); const int k = wave * 128 + kk;
#pragma unroll
            for (int ci = 0; ci < 5; ++ci) { const float s = sl[ci * 1024 + k]; a0[ci] += s * wv.x; a1[ci] += s * wv.y; } }
        LAS float* part = (LAS float*)(lds + 32768);
#pragma unroll
        for (int ci = 0; ci < 5; ++ci) { part[(wave * 5 + ci) * 128 + 2 * lane] = a0[ci]; part[(wave * 5 + ci) * 128 + 2 * lane + 1] = a1[ci]; }
        __syncthreads();
        for (int i = tid; i < 640; i += 512) { const int ci = i >> 7, col = i & 127; float s = 0.f;
#pragma unroll
            for (int w = 0; w < 8; ++w) s += part[(w * 5 + ci) * 128 + col];
            const int gcol = cgp * 128 + col; ((float*)(ws + WS_MOD))[(l * 5 + ci) * 6144 + gcol] = s + A.b_ada[l * 6144 + gcol]; }
        __syncthreads();
    }
    convert_layer(A, lds, 0, bid * 8 + wave, G * 8, wave, lane);
}

__device__ __forceinline__ int cond_of_row(int r) { return r < NTOK_P ? 0 : 1 + ((r - NTOK_P) >> 10); }

__device__ __forceinline__ void norm_mod_store(const f32x4 (&v)[4], const LAS float* g, const LAS float* sc, const LAS float* sh, bf16* hrow, int lane) {
    float ss = 0.f;
#pragma unroll
    for (int j = 0; j < 4; ++j) ss += sumsq4(v[j]);
    const float rstd = 1.0f / sqrtf(wave_sum(ss, lane) * (1.0f / 1024.0f) + EPS);
#pragma unroll
    for (int j = 0; j < 4; ++j) { const int idx = 4 * lane + 256 * j;
        const f32x4 gg = *(const LAS f32x4*)(g + idx), s1 = *(const LAS f32x4*)(sc + idx), s0 = *(const LAS f32x4*)(sh + idx);
        const f32x4 o = v[j] * rstd * gg * (1.0f + s1) + s0;
        *(u32x2*)(hrow + idx) = pk4(o); }
}
__device__ __forceinline__ const float* x_in_row(const Args& A, int r) { return r < NTOK_P ? A.x_prompt + (size_t)r * 1024 : A.x_sample + (size_t)(r - NTOK_P) * 1024; }
__device__ __forceinline__ void fill_vec(LAS float* dst, const float* src, int tid) { if (tid < 256) *(LAS f32x4*)(dst + 4 * tid) = *(const f32x4*)(src + 4 * tid); }

__device__ __forceinline__ void phase_pre(const Args& A, LAS unsigned char* lds, int lane, int wave) {
    const int gw = blockIdx.x * 8 + wave, NGW = gridDim.x * 8;
    const float* mod = (const float*)(A.ws + WS_MOD); bf16* H = (bf16*)(A.ws + WS_H);
    LAS float* P = (LAS float*)lds;
    { const int t2 = (wave & 3) * 64 + lane, hv = wave >> 2;
      for (int v = hv; v < 11; v += 2) { const float* src = v == 0 ? A.g_pre_mix : (v <= 5 ? mod + (size_t)(v - 1) * 6144 + 1024 : mod + (size_t)(v - 6) * 6144);
          const int slot = v == 0 ? 1 : (v <= 5 ? 7 + (v - 1) : 12 + (v - 6));
          *(LAS f32x4*)(P + slot * 1024 + 4 * t2) = *(const f32x4*)(src + 4 * t2); } }
    __syncthreads();
    for (int r0 = gw; r0 < NTOK; r0 += 2 * NGW) {
        f32x4 v[2][4];
#pragma unroll
        for (int u = 0; u < 2; ++u) { const float* xr = x_in_row(A, r0 + u * NGW);
#pragma unroll
            for (int j = 0; j < 4; ++j) v[u][j] = __builtin_nontemporal_load((const f32x4*)(xr + 4 * lane + 256 * j)); }
#pragma unroll
        for (int u = 0; u < 2; ++u) { const int r = r0 + u * NGW, ci = cond_of_row(r);
            norm_mod_store(v[u], P + 1024, P + (7 + ci) * 1024, P + (12 + ci) * 1024, H + (size_t)r * 1024, lane); }
    }
    __syncthreads();
}

__device__ __forceinline__ void phase_post(const Args& A, int l, int which, LAS unsigned char* lds, int lane, int wave) {
    const int gw = blockIdx.x * 8 + wave, NGW = gridDim.x * 8;
    const float* mod = (const float*)(A.ws + WS_MOD); bf16* H = (bf16*)(A.ws + WS_H); const bf16* MIX = (const bf16*)(A.ws + WS_MIX);
    const bool first = (l == 0 && which == 0), has_h = (which == 0) || (l < DEPTH - 1);
    LAS float* P = (LAS float*)lds;
    { const int t2 = (wave & 3) * 64 + lane, hv = wave >> 2;
      const int l2 = which == 0 ? l : l + 1;
      for (int v = hv; v < 17; v += 2) { const float* src;
          if (v == 0) src = (which == 0 ? A.g_post_mix : A.g_post_ffn) + l * 1024;
          else if (v == 1) src = which == 0 ? A.g_pre_ffn + l * 1024 : A.g_pre_mix + (l2 < DEPTH ? l2 : l) * 1024;
          else if (v < 7) src = mod + (size_t)(l * 5 + (v - 2)) * 6144 + (which == 0 ? 2048 : 5120);
          else if (v < 12) src = mod + (size_t)((l2 < DEPTH ? l2 : l) * 5 + (v - 7)) * 6144 + (which == 0 ? 4096 : 1024);
          else src = mod + (size_t)((l2 < DEPTH ? l2 : l) * 5 + (v - 12)) * 6144 + (which == 0 ? 3072 : 0);
          *(LAS f32x4*)(P + v * 1024 + 4 * t2) = *(const f32x4*)(src + 4 * t2); } }
    __syncthreads();
    for (int r0 = gw; r0 < NTOK; r0 += 2 * NGW) {
        f32x4 v[2][4], t[2][4];
#pragma unroll
        for (int u = 0; u < 2; ++u) { const int r = r0 + u * NGW;
            const float* xr = first ? x_in_row(A, r) : A.out + (size_t)r * 1024; const bf16* tr = MIX + (size_t)r * 1024;
#pragma unroll
            for (int j = 0; j < 4; ++j) { v[u][j] = __builtin_nontemporal_load((const f32x4*)(xr + 4 * lane + 256 * j)); t[u][j] = ld4bf_nt(tr + 4 * lane + 256 * j); } }
#pragma unroll
        for (int u = 0; u < 2; ++u) { const int r = r0 + u * NGW; const LAS float* ga = P + (2 + cond_of_row(r)) * 1024;
            float ss = 0.f;
#pragma unroll
            for (int j = 0; j < 4; ++j) ss += sumsq4(t[u][j]);
            const float rstd = 1.0f / sqrtf(wave_sum(ss, lane) * (1.0f / 1024.0f) + EPS);
#pragma unroll
            for (int j = 0; j < 4; ++j) { const int idx = 4 * lane + 256 * j;
                const f32x4 gg = *(const LAS f32x4*)(P + idx), gv = *(const LAS f32x4*)(ga + idx);
                v[u][j] = v[u][j] + gv * (t[u][j] * rstd * gg);
                __builtin_nontemporal_store(v[u][j], (f32x4*)(A.out + (size_t)r * 1024 + idx)); } }
        if (has_h) {
#pragma unroll
            for (int u = 0; u < 2; ++u) { const int r = r0 + u * NGW, ci = cond_of_row(r);
                norm_mod_store(v[u], P + 1024, P + (7 + ci) * 1024, P + (12 + ci) * 1024, H + (size_t)r * 1024, lane); } }
    }
    __syncthreads();
}

__device__ __forceinline__ void phase_split(const Args& A, int l, int lane, int wave) {
    const int gw = blockIdx.x * 8 + wave, NGW = gridDim.x * 8;
    unsigned char* ws = A.ws;
    const bf16* Z = (const bf16*)(ws + WS_Z);
    bf16* QN = (bf16*)(ws + WS_QN); bf16* CKVN = (bf16*)(ws + WS_CKVN); bf16* KRB = (bf16*)(ws + WS_KRB); bf16* UG = (bf16*)(ws + WS_UG); bf16* VN = (bf16*)(ws + WS_VN);
    bf16* CC = (bf16*)(ws + WS_CONCAT);
    const float* ropec = (const float*)(ws + WS_ROPE); const float* ropes = ropec + 32768;
    float* out_ckv = A.out + (size_t)NTOK * 1024; float* out_kr = out_ckv + (size_t)32 * 4 * 256 * 256;
    for (int idx = gw; idx < 2048; idx += NGW) { const int r = NTOK + idx, b = idx >> 9, j = idx & 511;
        const f32x4 cv = *(const f32x4*)(A.cache_ckv + ((size_t)(b * 4 + l) * 512 + j) * 256 + 4 * lane);
        const float kv = A.cache_krope[((size_t)(b * 4 + l) * 512 + j) * 64 + lane];
        *(u32x2*)(CKVN + (size_t)r * 256 + 4 * lane) = pk4(cv);
        KRB[(size_t)r * 64 + lane] = (bf16)(cvt_pk_bf16(kv, 0.f) & 0xffffu); }
    const f32x4 gkv = *(const f32x4*)(A.g_kv + l * 256 + 4 * lane), gvv = *(const f32x4*)(A.g_v + l * 256 + 4 * lane);
    const float* wcp = A.w_conv + (size_t)l * 3 * 256 + 4 * lane;
    const f32x4 wc0 = *(const f32x4*)(wcp), wc1 = *(const f32x4*)(wcp + 256), wc2 = *(const f32x4*)(wcp + 512);
    f32x2 gq[3];
#pragma unroll
    for (int j = 0; j < 3; ++j) gq[j] = *(const f32x2*)(A.g_q + l * 384 + 2 * lane + 128 * j);
    for (int r0 = gw; r0 < NTOK; r0 += 2 * NGW) {
        f32x2 q[2][3]; f32x4 cv[2], uu[2], vv[2], bg[2], zc[2], zm[2], zp[2]; float kr[2], cs[2], sn[2];
#pragma unroll
        for (int u = 0; u < 2; ++u) { const int r = r0 + u * NGW; const bf16* z = Z + (size_t)r * INC;
            const bool prompt = r < NTOK_P; const int n = prompt ? (r & 255) : ((r - NTOK_P) & 1023), len = prompt ? 256 : 1024;
#pragma unroll
            for (int j = 0; j < 3; ++j) q[u][j] = ld2bf(z + ZQ + 2 * lane + 128 * j);
            cv[u] = ld4bf(z + ZCKV + 4 * lane); kr[u] = ld1bf(z + ZKR + lane);
            uu[u] = ld4bf(z + ZU + 4 * lane); vv[u] = ld4bf(z + ZV + 4 * lane); bg[u] = ld4bf(z + ZBG + 4 * lane);
            zc[u] = ld4bf(z + ZCG + 4 * lane) * ld4bf(z + ZHH + 4 * lane);
            zm[u] = (f32x4){0.f, 0.f, 0.f, 0.f}; zp[u] = zm[u];
            if (n > 0) zm[u] = ld4bf(z - INC + ZCG + 4 * lane) * ld4bf(z - INC + ZHH + 4 * lane);
            if (n < len - 1) zp[u] = ld4bf(z + INC + ZCG + 4 * lane) * ld4bf(z + INC + ZHH + 4 * lane);
            cs[u] = 1.f; sn[u] = 0.f;
            if (!prompt) { const int a = lane >> 5, f = lane & 15; cs[u] = ropec[n * 32 + a * 16 + f]; sn[u] = ropes[n * 32 + a * 16 + f]; } }
#pragma unroll
        for (int u = 0; u < 2; ++u) { const int r = r0 + u * NGW; const bool prompt = r < NTOK_P; const int n = prompt ? (r & 255) : ((r - NTOK_P) & 1023);
            { float ss = 0.f;
#pragma unroll
              for (int j = 0; j < 3; ++j) ss += q[u][j].x * q[u][j].x + q[u][j].y * q[u][j].y;
              const float rstd = 1.0f / sqrtf(wave_sum(ss, lane) * (1.0f / 384.0f) + EPS);
#pragma unroll
              for (int j = 0; j < 3; ++j) *(unsigned*)(QN + (size_t)r * 384 + 2 * lane + 128 * j) = cvt_pk_bf16(q[u][j].x * rstd * gq[j].x, q[u][j].y * rstd * gq[j].y); }
            { const float rstd = 1.0f / sqrtf(wave_sum(sumsq4(cv[u]), lane) * (1.0f / 256.0f) + EPS);
              const f32x4 c2 = cv[u] * rstd * gkv;
              if (prompt) __builtin_nontemporal_store(c2, (f32x4*)(out_ckv + ((size_t)((r >> 8) * 4 + l) * 256 + n) * 256 + 4 * lane));
              *(u32x2*)(CKVN + (size_t)r * 256 + 4 * lane) = pk4(c2); }
            { float k2 = kr[u];
              if (prompt) __builtin_nontemporal_store(k2, out_kr + ((size_t)((r >> 8) * 4 + l) * 256 + n) * 64 + lane);
              else { const float partner = shx(k2, 16, lane); const int p = (lane >> 4) & 1;
                  k2 = p == 0 ? k2 * cs[u] - partner * sn[u] : partner * sn[u] + k2 * cs[u]; }
              KRB[(size_t)r * 64 + lane] = (bf16)(cvt_pk_bf16(k2, 0.f) & 0xffffu); }
            *(u32x2*)(UG + (size_t)r * 256 + 4 * lane) = pk4(gelu4(uu[u]));
            { f32x4 v = gelu4(vv[u]);
              const float rstd = 1.0f / sqrtf(wave_sum(sumsq4(v), lane) * (1.0f / 256.0f) + EPS);
              *(u32x2*)(VN + (size_t)r * 256 + 4 * lane) = pk4(v * rstd * gvv); }
            { const f32x4 y = zm[u] * wc0 + zc[u] * wc1 + zp[u] * wc2;
              *(u32x2*)(CC + (size_t)r * 1024 + 768 + 4 * lane) = pk4(bg[u] * y); }
        }
    }
}

#define MFMA32(a, b, c) __builtin_amdgcn_mfma_f32_32x32x16_bf16((a), (b), (c), 0, 0, 0)
constexpr int AT_KROW = 400, AT_VROW = 144, AT_KBYTES = 64 * AT_KROW, AT_STAGE = AT_KBYTES + 128 * AT_VROW;
__device__ __forceinline__ void attn_store_tile(const f32x16& ot, float inv, bf16* crow  , int t, int hh) {
#pragma unroll
    for (int g = 0; g < 4; ++g) { u32x2 w; w.x = cvt_pk_bf16(ot[4 * g] * inv, ot[4 * g + 1] * inv); w.y = cvt_pk_bf16(ot[4 * g + 2] * inv, ot[4 * g + 3] * inv);
        *(u32x2*)(crow + 32 * t + 8 * g + 4 * hh) = w; }
}

__device__ __forceinline__ void phase_mixer(const Args& A, int l, LAS unsigned char* lds, int lane_in, int wave) {
    unsigned char* ws = A.ws;
    const bf16* Q = (const bf16*)(ws + WS_Q); const bf16* KN = (const bf16*)(ws + WS_KNOPE); const bf16* KRB = (const bf16*)(ws + WS_KRB);
    const bf16* VTP = (const bf16*)(ws + WS_VTP); const bf16* VTS = (const bf16*)(ws + WS_VTS);
    const bf16* UG = (const bf16*)(ws + WS_UG); const bf16* VN = (const bf16*)(ws + WS_VN);
    bf16* CC = (bf16*)(ws + WS_CONCAT);
    for (int slot = 0; ; ++slot) {
        int it;
        if (gridDim.x == 256) {
            if (slot == 0) it = blockIdx.x; else if (slot == 1 && blockIdx.x >= 128 && blockIdx.x < 224) it = 256 + (int)blockIdx.x - 128; else break;
        } else { it = (int)blockIdx.x + slot * (int)gridDim.x; if (it >= 352) break; }
        int lane = lane_in; asm volatile("" : "+v"(lane));
        const int rho = lane & 31, hh = lane >> 5, tid = wave * 64 + lane;
        if (it < 256) {
            int h, q0, keys, nkeys, split, rowA, rowB; const bf16* vt;
            const bool heavy = it < 128;
            if (heavy) {
                const int xj = it >> 3, pr = 2 * (it & 7) + (xj >> 3), b = pr >> 2, qt = xj & 7; h = pr & 3;
                q0 = NTOK_P + b * 1024 + qt * 128 + (wave & 3) * 32; keys = 1536; nkeys = 1536; split = 512; rowA = NTOK + b * 512; rowB = NTOK_P + b * 1024;
                vt = VTS + (size_t)((b * 4 + h) * 128) * 1536; }
            else { const int i2 = it - 128, b = i2 >> 2; h = i2 & 3; q0 = b * 256 + wave * 32; keys = 256; nkeys = 256; split = 0; rowA = 0; rowB = b * 256;
                vt = VTP + (size_t)((b * 4 + h) * 128) * 256; }
            bf16x8 qf[12];
            { const bf16* qp = Q + (size_t)(q0 + rho) * 768 + h * 192 + 8 * hh;
#pragma unroll
              for (int ks = 0; ks < 12; ++ks) qf[ks] = *(const bf16x8*)(qp + 16 * ks); }
            if (heavy) {
                const float* ropec = (const float*)(ws + WS_ROPE); const int ntok = (q0 + rho - NTOK_P) & 1023;
#pragma unroll
                for (int a = 0; a < 2; ++a) { const float* cp = ropec + ntok * 32 + a * 16 + 8 * hh;
                    const f32x4 c0 = *(const f32x4*)cp, c1 = *(const f32x4*)(cp + 4), s0 = *(const f32x4*)(cp + 32768), s1 = *(const f32x4*)(cp + 32768 + 4);
                    const u32x4 w1 = __builtin_bit_cast(u32x4, qf[8 + 2 * a]), w2 = __builtin_bit_cast(u32x4, qf[9 + 2 * a]); u32x4 r1, r2;
#pragma unroll
                    for (int j = 0; j < 4; ++j) { const float x1l = __uint_as_float(w1[j] << 16), x1h = __uint_as_float(w1[j] & 0xffff0000u), x2l = __uint_as_float(w2[j] << 16), x2h = __uint_as_float(w2[j] & 0xffff0000u);
                        const float cl = j < 2 ? c0[2 * j] : c1[2 * j - 4], ch = j < 2 ? c0[2 * j + 1] : c1[2 * j - 3], sl = j < 2 ? s0[2 * j] : s1[2 * j - 4], sh = j < 2 ? s0[2 * j + 1] : s1[2 * j - 3];
                        r1[j] = cvt_pk_bf16(x1l * cl - x2l * sl, x1h * ch - x2h * sh); r2[j] = cvt_pk_bf16(x1l * sl + x2l * cl, x1h * sh + x2h * ch); }
                    qf[8 + 2 * a] = __builtin_bit_cast(bf16x8, r1); qf[9 + 2 * a] = __builtin_bit_cast(bf16x8, r2); }
            }
            f32x16 o[4];
#pragma unroll
            for (int t = 0; t < 4; ++t)
#pragma unroll
                for (int i = 0; i < 16; ++i) o[t][i] = 0.f;
            float m = 0.f, lsum = 0.f; bool fresh = true;
            int kslot[2], kcol[2], vd[2], vc[2];
#pragma unroll
            for (int j = 0; j < 2; ++j) { const int c = tid + 512 * j, kap = c >> 4; kcol[j] = c & 15;
                kslot[j] = (kap & 32) + (kap & 3) + 4 * ((kap >> 4) & 1) + 8 * ((kap >> 2) & 3);
                vd[j] = c >> 3; vc[j] = c & 7; }
            const int rkap = tid >> 3, rc8 = tid & 7, rslot = (rkap & 32) + (rkap & 3) + 4 * ((rkap >> 4) & 1) + 8 * ((rkap >> 2) & 3);
            u32x4 sk[2], sr, sv[2];
#define AT_GLOAD(k0) do { const int rb_ = (k0) < split ? rowA + (k0) : rowB + ((k0) - split); \
                _Pragma("unroll") for (int j = 0; j < 2; ++j) sk[j] = *(const u32x4*)(KN + (size_t)(rb_ + ((tid + 512 * j) >> 4)) * 512 + h * 128 + kcol[j] * 8); \
                sr = *(const u32x4*)(KRB + (size_t)(rb_ + rkap) * 64 + rc8 * 8); \
                _Pragma("unroll") for (int j = 0; j < 2; ++j) sv[j] = *(const u32x4*)(vt + (size_t)vd[j] * keys + (k0) + vc[j] * 8); } while (0)
#define AT_SWRITE(buf) do { LAS unsigned char* sb_ = lds + (buf) * AT_STAGE; \
                _Pragma("unroll") for (int j = 0; j < 2; ++j) *(LAS u32x4*)(sb_ + kslot[j] * AT_KROW + kcol[j] * 16) = sk[j]; \
                *(LAS u32x4*)(sb_ + rslot * AT_KROW + 256 + rc8 * 16) = sr; \
                _Pragma("unroll") for (int j = 0; j < 2; ++j) *(LAS u32x4*)(sb_ + AT_KBYTES + vd[j] * AT_VROW + vc[j] * 16) = sv[j]; } while (0)
            const int ntile = nkeys >> 6;
            const int blk_lo = heavy ? (wave >> 2) : 0, blk_hi = heavy ? blk_lo + 1 : 2;
            AT_GLOAD(0); AT_SWRITE(0);
            __syncthreads();
            for (int tI = 0; tI < ntile; ++tI) {
                if (tI + 1 < ntile) AT_GLOAD((tI + 1) * 64);
                { const LAS unsigned char* sb = lds + (tI & 1) * AT_STAGE;
                for (int blk = blk_lo; blk < blk_hi; ++blk) {
                    const LAS unsigned char* kp = sb + (32 * blk + rho) * AT_KROW + hh * 16;
                    f32x16 sc;
#pragma unroll
                    for (int i = 0; i < 16; ++i) sc[i] = -m;
                    bf16x8 kf[12];
#pragma unroll
                    for (int ks = 0; ks < 12; ++ks) kf[ks] = *(const LAS bf16x8*)(kp + ks * 32);
                    __builtin_amdgcn_sched_barrier(0);
#pragma unroll
                    for (int ks = 0; ks < 12; ++ks) sc = MFMA32(kf[ks], qf[ks], sc);
                    const LAS unsigned char* vp = sb + AT_KBYTES + rho * AT_VROW + (32 * blk + 16 * hh) * 2;
                    bf16x8 vf[8];
#pragma unroll
                    for (int t = 0; t < 4; ++t)
#pragma unroll
                        for (int s2 = 0; s2 < 2; ++s2) vf[t * 2 + s2] = *(const LAS bf16x8*)(vp + 32 * t * AT_VROW + 16 * s2);
                    __builtin_amdgcn_sched_barrier(0);
                    float mx = sc[0];
#pragma unroll
                    for (int i = 1; i < 16; ++i) mx = fmaxf(mx, sc[i]);
                    { const auto rr = __builtin_amdgcn_permlane32_swap(__float_as_uint(mx), __float_as_uint(mx), false, false); mx = fmaxf(__uint_as_float(rr[0]), __uint_as_float(rr[1])); }
                    if (fresh || __builtin_amdgcn_ballot_w64(mx > 8.0f) != 0ull) { const float delta = fresh ? mx : fmaxf(mx, 0.f), alpha = fresh ? 0.f : __builtin_amdgcn_exp2f(-delta); m += delta; lsum *= alpha; fresh = false;
#pragma unroll
                        for (int i = 0; i < 16; ++i) sc[i] -= delta;
#pragma unroll
                        for (int t = 0; t < 4; ++t) o[t] = o[t] * alpha; }
                    float ps = 0.f;
#pragma unroll
                    for (int i = 0; i < 16; ++i) { sc[i] = __builtin_amdgcn_exp2f(sc[i]); ps += sc[i]; }
                    lsum += ps;
                    bf16x8 pb[2];
#pragma unroll
                    for (int s2 = 0; s2 < 2; ++s2) { u32x4 w; w.x = cvt_pk_bf16(sc[8 * s2 + 0], sc[8 * s2 + 1]); w.y = cvt_pk_bf16(sc[8 * s2 + 2], sc[8 * s2 + 3]); w.z = cvt_pk_bf16(sc[8 * s2 + 4], sc[8 * s2 + 5]); w.w = cvt_pk_bf16(sc[8 * s2 + 6], sc[8 * s2 + 7]);
                        pb[s2] = __builtin_bit_cast(bf16x8, w); }
#pragma unroll
                    for (int s2 = 0; s2 < 2; ++s2)
#pragma unroll
                        for (int t = 0; t < 4; ++t) o[t] = MFMA32(vf[t * 2 + s2], pb[s2], o[t]);
                }
                }
                if (tI + 1 < ntile) AT_SWRITE((tI + 1) & 1);
                __syncthreads();
            }
#undef AT_GLOAD
#undef AT_SWRITE
            lsum += shx(lsum, 32, lane);
            bf16* crow = CC + (size_t)(q0 + rho) * 1024 + h * 128;
            if (!heavy) { const float inv = 1.0f / lsum;
#pragma unroll
                for (int t = 0; t < 4; ++t) attn_store_tile(o[t], inv, crow, t, hh);
            } else {
                const int half = wave >> 2;
                LAS float* mine = (LAS float*)(lds + wave * 8704);
                LAS const float* theirs = (LAS const float*)(lds + (wave ^ 4) * 8704);
#pragma unroll
                for (int t2 = 0; t2 < 2; ++t2)
#pragma unroll
                    for (int i = 0; i < 16; ++i) mine[(t2 * 16 + i) * 64 + lane] = half == 0 ? o[2 + t2][i] : o[t2][i];
                if (hh == 0) { mine[2048 + rho] = m; mine[2080 + rho] = lsum; }
                __syncthreads();
                const float mp = theirs[2048 + rho], lp = theirs[2080 + rho];
                const float mg = fmaxf(m, mp), wo = __builtin_amdgcn_exp2f(m - mg), wp = __builtin_amdgcn_exp2f(mp - mg);
                const float inv = 1.0f / (wo * lsum + wp * lp);
#pragma unroll
                for (int t2 = 0; t2 < 2; ++t2) { f32x16 acc;
#pragma unroll
                    for (int i = 0; i < 16; ++i) acc[i] = wo * (half == 0 ? o[t2][i] : o[2 + t2][i]) + wp * theirs[(t2 * 16 + i) * 64 + lane];
                    attn_store_tile(acc, inv, crow, half * 2 + t2, hh); }
                __syncthreads();
            }
        } else {
            const int c = it - 256;
            const int hd = wave & 3, ph = wave >> 2;
            const float* wbase = A.w_s + ((size_t)(l * 4 + hd) * 128 + 64 * ph + rho) * 128 + 8 * hh;
            f32x4 wva[16], wvb[16];
#pragma unroll
            for (int ks = 0; ks < 8; ++ks) { wva[2 * ks] = *(const f32x4*)(wbase + 16 * ks); wva[2 * ks + 1] = *(const f32x4*)(wbase + 16 * ks + 4); }
            LAS bf16* vnT = (LAS bf16*)lds;
            { bf16x8 vv[8];
#pragma unroll
              for (int pass = 0; pass < 8; ++pass) { const int u = wave + 8 * pass, qq = (u & 1) * 64 + lane, c8 = (u >> 1) * 8; vv[pass] = *(const bf16x8*)(VN + (size_t)(c * 128 + qq) * 256 + c8); }
#pragma unroll
              for (int pass = 0; pass < 8; ++pass) { const int u = wave + 8 * pass, qq = (u & 1) * 64 + lane, c8 = (u >> 1) * 8;
#pragma unroll
                for (int j = 0; j < 8; ++j) vnT[(c8 + j) * 136 + qq] = (bf16)vv[pass][j]; } }
            __syncthreads();
#pragma unroll
            for (int pp = 0; pp < 2; ++pp) { const int pt = 2 * ph + pp;
                bf16x8 af[8];
#pragma unroll
                for (int ks = 0; ks < 8; ++ks) { const f32x4 w0 = pp == 0 ? wva[2 * ks] : wvb[2 * ks], w1 = pp == 0 ? wva[2 * ks + 1] : wvb[2 * ks + 1];
                    u32x4 w; w.x = cvt_pk_bf16(w0.x, w0.y); w.y = cvt_pk_bf16(w0.z, w0.w); w.z = cvt_pk_bf16(w1.x, w1.y); w.w = cvt_pk_bf16(w1.z, w1.w); af[ks] = __builtin_bit_cast(bf16x8, w); }
                if (pp == 0) {
#pragma unroll
                    for (int ks = 0; ks < 8; ++ks) { wvb[2 * ks] = *(const f32x4*)(wbase + 32 * 128 + 16 * ks); wvb[2 * ks + 1] = *(const f32x4*)(wbase + 32 * 128 + 16 * ks + 4); } }
                float bs[16]; bf16 ugv[2][16];
#pragma unroll
                for (int i = 0; i < 16; ++i) { const int p = 32 * pt + (i & 3) + 8 * (i >> 2) + 4 * hh; bs[i] = A.b_s[(l * 4 + hd) * 128 + p];
#pragma unroll
                    for (int d = 0; d < 2; ++d) ugv[d][i] = UG[((size_t)c * 128 + p) * 256 + hd * 64 + 32 * d + rho]; }
                f32x16 acc[2];
#pragma unroll
                for (int d = 0; d < 2; ++d)
#pragma unroll
                    for (int i = 0; i < 16; ++i) acc[d][i] = 0.f;
#pragma unroll
                for (int ks = 0; ks < 8; ++ks)
#pragma unroll
                    for (int d = 0; d < 2; ++d) { const bf16x8 bfr = *(const LAS bf16x8*)(vnT + (hd * 64 + 32 * d + rho) * 136 + 16 * ks + 8 * hh); acc[d] = MFMA32(af[ks], bfr, acc[d]); }
#pragma unroll
                for (int d = 0; d < 2; ++d) { const int col = hd * 64 + 32 * d + rho;
#pragma unroll
                    for (int i = 0; i < 16; ++i) { const int p = 32 * pt + (i & 3) + 8 * (i >> 2) + 4 * hh; const size_t row = (size_t)c * 128 + p;
                        const float mixed = acc[d][i] + bs[i];
                        const float ug = __uint_as_float((unsigned)ugv[d][i] << 16);
                        CC[row * 1024 + 512 + col] = (bf16)(cvt_pk_bf16(ug * mixed, 0.f) & 0xffffu); } }
            }
            __syncthreads();
        }
    }
}

__global__ void __launch_bounds__(512, 2) fwd_megakernel(Args A) {
    extern __shared__ __attribute__((aligned(16))) unsigned char smem[];
    LAS unsigned char* lds = (LAS unsigned char*)smem;
    const int wave0 = __builtin_amdgcn_readfirstlane((int)threadIdx.x >> 6);
    unsigned* const bar = (unsigned*)(A.ws + WS_BAR);
    volatile LAS unsigned* const barst = (volatile LAS unsigned*)(lds + LDS_BARST);
    const unsigned xcc = xb_xcc_id();
    if (wave0 == 0) { const int l0 = fresh_lane(); if (l0 < 2) barst[l0] = 0u; if (l0 == 0 && A.ph_hi - A.ph_lo > 1) (void)xb_add(&bar[XB_XCNT(xcc)], 1u); }
    __syncthreads();
    if (A.ph_lo < 0) cg::this_grid().sync();
    bool dup_done = false; (void)dup_done;
    for (int ph = A.ph_lo; ph < A.ph_hi; ++ph) {
        const int wave = wave0;
#define LANE fresh_lane()
#define TID (wave * 64 + fresh_lane())
        unsigned char* ws = A.ws; asm volatile("" : "+s"(ws));
        if (ph == 0) phase_prologue(A, lds, wave);
        else if (ph == 1) phase_pre(A, lds, LANE, wave);
        else {
            const int l = (ph - 2) / 9, k = (ph - 2) % 9;
            const int G = gridDim.x, bid = blockIdx.x;
            if (k == 0) {
                pg8::Gemm g{(const bf16*)(ws + WS_H), (const bf16*)(ws + WS_WIN) + (size_t)l * 2048 * 1024, NTOK, 2048, 1024}; pg8::StaticOrder S; S.init(NTOK, 2048, G, bid);
                EpiB16<0> E{(bf16*)(ws + WS_Z), INC, INC}; pg8::gemm_phase<EpiB16<0>, pg8::StaticOrder, true>(lds, g, S, E, TID);
            } else if (k == 1) phase_split(A, l, LANE, wave);
            else if (k == 2) {
                { pg8::Gemm g{(const bf16*)(ws + WS_QN), (const bf16*)(ws + WS_WUQ) + (size_t)l * 768 * 384, NTOK, 768, 384}; pg8::StaticOrder S; S.init(NTOK, 768, G, bid);
                  EpiB16<0> E{(bf16*)(ws + WS_Q), 768, 768}; pg8::gemm_phase<EpiB16<0>, pg8::StaticOrder, false>(lds, g, S, E, TID); }
                { pg8::Gemm g{(const bf16*)(ws + WS_CKVN), (const bf16*)(ws + WS_WUKV) + (size_t)l * 1024 * 256, NROWKV, 1024, 256}; pg8::StaticOrder S; S.init(NROWKV, 1024, G, (bid + G - 144 % G) % G);
                  EpiKV E{(bf16*)(ws + WS_KNOPE), (bf16*)(ws + WS_VTP), (bf16*)(ws + WS_VTS)}; pg8::gemm_phase<EpiKV, pg8::StaticOrder, false>(lds, g, S, E, TID); }
            } else if (k == 3) phase_mixer(A, l, lds, LANE, wave);
            else if (k == 4 || k == 7) {
                const bool o = (k == 4);
                pg8::Gemm g{(const bf16*)(ws + (o ? WS_CONCAT : WS_ACT)), o ? (const bf16*)(ws + WS_WOUT) + (size_t)l * 1024 * 1024 : (const bf16*)(ws + WS_WFF2) + (size_t)l * 1024 * 4096, NTOK, 1024, o ? 1024 : 4096};
                pg8::StaticOrder S; S.init(NTOK, 1024, G, bid);
                EpiB16<0> E{(bf16*)(ws + WS_MIX), 1024, 1024}; pg8::gemm_phase<EpiB16<0>, pg8::StaticOrder, true>(lds, g, S, E, TID);
                if (!o && l + 1 < DEPTH) { const int first = G > 192 ? 192 : 0;
                    if (bid >= first) convert_layer(A, lds, l + 1, (bid - first) * 8 + wave, (G - first) * 8, wave, LANE); }
            } else if (k == 5) phase_post(A, l, 0, lds, LANE, wave);
            else if (k == 6) {
                pg8::Gemm g{(const bf16*)(ws + WS_H), (const bf16*)(ws + WS_WFF1) + (size_t)l * 4096 * 1024, NTOK, 4096, 1024}; pg8::StaticOrder S; S.init(NTOK, 4096, G, bid);
                EpiB16<1> E{(bf16*)(ws + WS_ACT), 4096, 4096}; pg8::gemm_phase<EpiB16<1>, pg8::StaticOrder, true>(lds, g, S, E, TID);
            } else phase_post(A, l, 1, lds, LANE, wave);
        }
        if (ph + 1 < A.ph_hi) xcd_barrier(bar, xcc, barst, wave == 0 && fresh_lane() == 0);
#if PROBE_DUP >= 0
        {
            bool again = false;
            if (PROBE_DUP == 100) { if (ph + 1 < A.ph_hi) xcd_barrier(bar, xcc, barst, wave == 0 && fresh_lane() == 0); }
            else if (!dup_done) {
                const int kk = ph >= 2 ? (ph - 2) % 9 : -1;
                if (PROBE_DUP == 50) again = (ph == 0);
                else if (PROBE_DUP == 60) again = (kk == 0 || kk == 2 || kk == 4 || kk == 6 || kk == 7);
                else again = (kk == PROBE_DUP);
            }
            if (again) { dup_done = true; --ph; } else dup_done = false;
        }
#endif
    }
}

constexpr int N_PHASES = 2 + 9 * DEPTH;

extern "C" void kernel_launch(void* const* d_in, const int* in_sizes, int n_in, void* d_out, int out_size, void* d_ws, size_t ws_size, hipStream_t stream) {
    static int grid = 0;
    if (grid == 0) {
        if (n_in != 24 || ws_size < WS_END || in_sizes[9] != DEPTH * 1024 * INC) { fprintf(stderr, "kernel_launch: unexpected problem (n_in %d, ws %zu, w_in %d)\n", n_in, ws_size, n_in > 9 ? in_sizes[9] : -1); grid = -1; return; }
        int dev = 0, cus = 0, per_cu = 0;
        hipGetDevice(&dev); hipDeviceGetAttribute(&cus, hipDeviceAttributeMultiprocessorCount, dev);
        if (hipFuncSetAttribute((const void*)fwd_megakernel, hipFuncAttributeMaxDynamicSharedMemorySize, LDS_BYTES) != hipSuccess) { fprintf(stderr, "kernel_launch: hipFuncSetAttribute failed\n"); grid = -1; return; }
        if (hipOccupancyMaxActiveBlocksPerMultiprocessor(&per_cu, (const void*)fwd_megakernel, 512, LDS_BYTES) != hipSuccess || per_cu < 1) { fprintf(stderr, "kernel_launch: occupancy query says %d\n", per_cu); per_cu = 1; }
        (void)hipGetLastError();
        grid = cus * 1;
        fprintf(stderr, "kernel_launch: grid %d (cus %d, per_cu %d)\n", grid, cus, per_cu);
    }
    if (grid < 0) return;
    if (hipMemsetAsync((char*)d_ws + WS_BAR, 0, 16384, stream) != hipSuccess) { fprintf(stderr, "kernel_launch: memset failed\n"); return; }
    Args a{};
    const float** ap = (const float**)&a;
    for (int i = 0; i < 24; ++i) ap[i] = (const float*)d_in[i];
    a.out = (float*)d_out; a.ws = (unsigned char*)d_ws;
#if MK_PER_PHASE
    for (int ph = 0; ph < N_PHASES; ++ph) { a.ph_lo = ph; a.ph_hi = ph + 1; hipLaunchKernelGGL(fwd_megakernel, dim3(grid), dim3(512), LDS_BYTES, stream, a); }
#else
    a.ph_lo = 0; a.ph_hi = N_PHASES;
    void* args[] = {&a};
    hipError_t e = hipLaunchCooperativeKernel((const void*)fwd_megakernel, dim3(grid), dim3(512), args, LDS_BYTES, stream);
    if (e != hipSuccess) fprintf(stderr, "kernel_launch: cooperative launch failed: %s (grid %d)\n", hipGetErrorString(e), grid);
#endif
}
```

```cpp
#include <hip/hip_runtime.h>
#include <hip/hip_cooperative_groups.h>
#include <cstdio>
namespace cg = cooperative_groups;

#ifndef MK_PER_PHASE
#define MK_PER_PHASE 0
#endif

#ifndef PROBE_DUP
#define PROBE_DUP -1
#endif
#define LAS __attribute__((address_space(3)))
typedef unsigned short bf16;
typedef short bf16x8 __attribute__((ext_vector_type(8)));
typedef float f32x2 __attribute__((ext_vector_type(2)));
typedef float f32x4 __attribute__((ext_vector_type(4)));
typedef float f32x16 __attribute__((ext_vector_type(16)));
typedef unsigned u32x2 __attribute__((ext_vector_type(2)));
typedef unsigned u32x4 __attribute__((ext_vector_type(4)));

constexpr int DM = 1024, NTOK_P = 8192, NTOK_S = 4096, NTOK = 12288, NROWKV = 14336;
constexpr int DEPTH = 4, INC = 1984, DFF = 4096;
constexpr int ZQ = 0, ZCKV = 384, ZKR = 640, ZU = 704, ZV = 960, ZBG = 1216, ZCG = 1472, ZHH = 1728;
constexpr float EPS = 1e-6f;
constexpr float QSCALE = 0.07216878364870322f * 1.4426950408889634f;

constexpr size_t MiB = 1u << 20;
constexpr size_t WS_MOD = 0, WS_BAR = 512 * 1024, WS_ROPE = 1 * MiB, WS_WIN = 2 * MiB, WS_WUQ = 18 * MiB, WS_WUKV = 21 * MiB, WS_WOUT = 23 * MiB,
                 WS_WFF1 = 31 * MiB, WS_WFF2 = 63 * MiB, WS_H = 95 * MiB, WS_MIX = 119 * MiB, WS_XB = 143 * MiB, WS_CONCAT = 167 * MiB, WS_QN = 191 * MiB,
                 WS_CKVN = 200 * MiB, WS_KRB = 207 * MiB, WS_UG = 209 * MiB, WS_VN = 215 * MiB, WS_Q = 221 * MiB, WS_KNOPE = 239 * MiB,
                 WS_VTP = 253 * MiB, WS_VTS = 261 * MiB, WS_Z = 267 * MiB, WS_ACT = 267 * MiB, WS_END = 363 * MiB;
constexpr int LDS_BYTES = 147456, LDS_BARST = LDS_BYTES - 64;

__device__ __forceinline__ unsigned cvt_pk_bf16(float lo, float hi) { unsigned r; asm volatile("v_cvt_pk_bf16_f32 %0, %1, %2" : "=v"(r) : "v"(lo), "v"(hi)); return r; }
__device__ __forceinline__ int fresh_lane() { int l; asm volatile("v_mbcnt_lo_u32_b32 %0, -1, 0\n\tv_mbcnt_hi_u32_b32 %0, -1, %0" : "=v"(l)); return l; }
__device__ __forceinline__ float shx(float v, int mask, int lane) { return __int_as_float(__builtin_amdgcn_ds_bpermute((lane ^ mask) << 2, __float_as_int(v))); }
__device__ __forceinline__ float dpp_add(float v, const int ctrl_is) {
    return v; }
#define DPP_ADD(v, ctrl) ((v) + __int_as_float(__builtin_amdgcn_update_dpp(0, __float_as_int(v), (ctrl), 0xf, 0xf, true)))
__device__ __forceinline__ float wave_sum(float v, int lane) {
    (void)lane;
    v = DPP_ADD(v, 0xB1);
    v = DPP_ADD(v, 0x4E);
    v = DPP_ADD(v, 0x141);
    v = DPP_ADD(v, 0x140);
    const int vi = __float_as_int(v);
    return (__int_as_float(__builtin_amdgcn_readlane(vi, 0)) + __int_as_float(__builtin_amdgcn_readlane(vi, 16))) + (__int_as_float(__builtin_amdgcn_readlane(vi, 32)) + __int_as_float(__builtin_amdgcn_readlane(vi, 48)));
}
__device__ __forceinline__ float gelu_tanh(float x) { const float y = 0.7978845608028654f * (x + 0.044715f * x * x * x); return x / (1.0f + __expf(-2.0f * y)); }
__device__ __forceinline__ f32x4 gelu4(f32x4 v) { return (f32x4){gelu_tanh(v.x), gelu_tanh(v.y), gelu_tanh(v.z), gelu_tanh(v.w)}; }
__device__ __forceinline__ float sumsq4(f32x4 v) { return (v.x * v.x + v.y * v.y) + (v.z * v.z + v.w * v.w); }
__device__ __forceinline__ f32x4 ld4bf_nt(const bf16* p) { const u32x2 w = __builtin_nontemporal_load((const u32x2*)p); return (f32x4){__uint_as_float(w.x << 16), __uint_as_float(w.x & 0xffff0000u), __uint_as_float(w.y << 16), __uint_as_float(w.y & 0xffff0000u)}; }
__device__ __forceinline__ f32x4 ld4bf(const bf16* p) { const u32x2 w = *(const u32x2*)p; return (f32x4){__uint_as_float(w.x << 16), __uint_as_float(w.x & 0xffff0000u), __uint_as_float(w.y << 16), __uint_as_float(w.y & 0xffff0000u)}; }
__device__ __forceinline__ f32x2 ld2bf(const bf16* p) { const unsigned w = *(const unsigned*)p; return (f32x2){__uint_as_float(w << 16), __uint_as_float(w & 0xffff0000u)}; }
__device__ __forceinline__ float ld1bf(const bf16* p) { return __uint_as_float((unsigned)*p << 16); }
__device__ __forceinline__ u32x2 pk4(f32x4 v) { u32x2 w; w.x = cvt_pk_bf16(v.x, v.y); w.y = cvt_pk_bf16(v.z, v.w); return w; }


#define XB_TMO      128
#define XB_XCNT(j)  (256  + 64 * (j))
#define XB_XSUB(j)  (1280 + 64 * (j))
#define XB_XGEN(j)  (2304 + 64 * (j))
#define XB_TOP      3328
#define XB_TOPGEN   3392
#define XCD_BAR_WORDS 3456
#define XB_SPIN_CAP (1u << 18)
__device__ __forceinline__ unsigned xb_ld(unsigned* p)              { return __hip_atomic_load(p, __ATOMIC_RELAXED, __HIP_MEMORY_SCOPE_AGENT); }
__device__ __forceinline__ unsigned xb_add(unsigned* p, unsigned v) { return __hip_atomic_fetch_add(p, v, __ATOMIC_RELAXED, __HIP_MEMORY_SCOPE_AGENT); }
__device__ __forceinline__ unsigned xb_xcc_id() { return (unsigned)__builtin_amdgcn_s_getreg((3 << 11) | 20) & 0xFu; }
#define XB_SPIN(cond, bar) do { unsigned _sp = 0; while (cond) { __builtin_amdgcn_s_sleep(1); \
    if ((++_sp & 255u) == 0u) { if (xb_ld(&(bar)[XB_TMO])) break; if (_sp > XB_SPIN_CAP) { atomicAdd(&(bar)[XB_TMO], 1u); break; } } } } while (0)
__device__ __forceinline__ void xcd_barrier_complete(unsigned* bar, unsigned x, unsigned& nloc, unsigned& nx) {
    const unsigned G = gridDim.x * gridDim.y * gridDim.z;
    unsigned sum, cnt, mine, sp = 0u;
    for (;;) {
        sum = 0u; cnt = 0u; mine = 0u;
#pragma unroll
        for (unsigned j = 0; j < 16; ++j) { const unsigned c = xb_ld(&bar[XB_XCNT(j)]); sum += c; cnt += (c > 0u) ? 1u : 0u; mine = (j == x) ? c : mine; }
        if (sum == G) break;
        __builtin_amdgcn_s_sleep(1);
        if ((++sp & 255u) == 0u) { if (xb_ld(&bar[XB_TMO])) break; if (sp > XB_SPIN_CAP) { atomicAdd(&bar[XB_TMO], 1u); break; } }
    }
    nloc = mine > 0u ? mine : 1u; nx = cnt > 0u ? cnt : 1u;
}
__device__ __forceinline__ void xcd_barrier(unsigned* bar, unsigned x, volatile LAS unsigned* st, bool leader) {
    asm volatile("s_waitcnt vmcnt(0)" ::: "memory");
    __syncthreads();
    if (leader) {
        __builtin_amdgcn_s_waitcnt(0);
        unsigned nloc = st[0], nx = st[1];
        if (nloc == 0u) { xcd_barrier_complete(bar, x, nloc, nx); st[0] = nloc; st[1] = nx; }
        const unsigned old = xb_add(&bar[XB_XSUB(x)], 1u);
        const unsigned gen = old / nloc;
        if (old + 1u == (gen + 1u) * nloc) {
            __builtin_amdgcn_fence(__ATOMIC_RELEASE, "agent");
            asm volatile("s_waitcnt vmcnt(0)" ::: "memory");
            const unsigned og = xb_add(&bar[XB_TOP], 1u);
            const unsigned tg = og / nx;
            if (og + 1u == (tg + 1u) * nx) xb_add(&bar[XB_TOPGEN], 1u);
            else XB_SPIN(xb_ld(&bar[XB_TOPGEN]) == tg, bar);
            __builtin_amdgcn_fence(__ATOMIC_ACQUIRE, "agent");
            xb_add(&bar[XB_XGEN(x)], 1u);
            asm volatile("s_waitcnt vmcnt(0)" ::: "memory");
        } else {
            XB_SPIN(xb_ld(&bar[XB_XGEN(x)]) == gen, bar);
            __builtin_amdgcn_fence(__ATOMIC_ACQUIRE, "agent");
            asm volatile("s_waitcnt vmcnt(0)" ::: "memory");
        }
    }
    __syncthreads();
}

namespace pg8 {
#define PG8_LAS __attribute__((address_space(3)))
typedef unsigned short bf16_t;
constexpr int BM = 256, BK = 64, HALF = 128, HTB = HALF * BK * 2, STAGE_BYTES = 8 * HTB, NXCD = 8, WGM = 8;
__host__ __device__ __forceinline__ int lds_byte(int r, int c) { const int st = (r >> 4) * 2 + (c >> 5), rr = r & 15, cc = c & 31, ob = rr * 64 + cc * 2; return st * 1024 + (ob ^ (((ob >> 9) & 1) << 5)); }
__host__ __device__ __forceinline__ void stage_rc(int b, int& R, int& C) { const int st = b / 1024, sb = b % 1024, swz = sb ^ (((sb >> 9) & 1) << 5); R = (st >> 1) * 16 + swz / 64; C = (st & 1) * 32 + (swz % 64) / 2; }
__host__ __device__ __forceinline__ int perm32(int rho) { const int n = rho >> 4, i = rho & 15; return 8 * (i >> 2) + 4 * n + (i & 3); }
struct Unit { int pm, pn; };
struct Gemm { const bf16_t* A; const bf16_t* Bt; int M, N, K; };
struct StaticOrder {
    int nM, nN, nwg, G, c;
    __host__ __device__ void init(int M, int N, int G_, int c_) { nM = M / BM; nN = N / BM; nwg = nM * nN; G = G_; c = c_; }
    __host__ __device__ bool next(int i, Unit& u) const {
        const long L = (long)i * G + c; if (L >= nwg) return false;
        int wgid = (int)L; { const int q = nwg / NXCD, r = nwg % NXCD, xcd = wgid % NXCD, off = wgid / NXCD; wgid = (xcd < r ? xcd * (q + 1) : r * (q + 1) + (xcd - r) * q) + off; }
        const int nig = WGM * nN, gid = wgid / nig, fm = gid * WGM, gsz = (nM - fm) < WGM ? (nM - fm) : WGM;
        u.pm = fm + ((wgid % nig) % gsz); u.pn = (wgid % nig) / gsz; return true;
    }
    __device__ __forceinline__ void a_ready(const Unit&) const {}
    __device__ __forceinline__ void done(const Unit&) const {}
};

template <class Epi, class Sched, bool SP2>
__device__ __forceinline__ void gemm_phase(PG8_LAS unsigned char* lds, const Gemm g, const Sched& S, const Epi& E, const int tid) {
    const int wid = __builtin_amdgcn_readfirstlane(tid >> 6), lane = tid & 63, wr = wid >> 2, wc = wid & 3, fr = lane & 15, fq = lane >> 4;
    const int K = g.K, nt = K / BK;
    unsigned voffA[2], voffB[2];
#pragma unroll
    for (int i = 0; i < 2; ++i) { int R, C; stage_rc(tid * 16 + i * 8192, R, C); const int Rb = Epi::PERM ? ((R & ~31) + perm32(R & 31)) : R;
        voffA[i] = (unsigned)(R * K + C) * 2u; voffB[i] = (unsigned)(Rb * K + C) * 2u; }
    const size_t kstep = (size_t)(BK * 2);
    const size_t hstep = (size_t)HALF * K * 2;
    const size_t tstep = 2 * hstep;
    const unsigned ldsw = (unsigned)wid * 1024u;
    const int aoff = lds_byte(wr * 64 + fr, fq * 8), boff = lds_byte(wc * 32 + fr, fq * 8);
#define PG8_SA(b, h) (((b) * 2 + (h)) * HTB)
#define PG8_SB(b, h) ((4 + (b) * 2 + (h)) * HTB)
#define PG8_STAGE(bufoff, gbase, voff) do { _Pragma("unroll") for (int _i = 0; _i < 2; ++_i) \
        __builtin_amdgcn_global_load_lds((const unsigned*)((const char*)(gbase) + (voff)[_i]), (PG8_LAS unsigned*)(lds + (bufoff) + ldsw + _i * 8192), 16, 0, 0); } while (0)
#define PG8_LDA(dst, b, h) do { _Pragma("unroll") for (int m = 0; m < 4; ++m) _Pragma("unroll") for (int k = 0; k < 2; ++k) dst[m][k] = *(const PG8_LAS bf16x8*)(lds + PG8_SA(b, h) + aoff + m * 2048 + k * 1024); } while (0)
#define PG8_LDB(dst, b, h) do { _Pragma("unroll") for (int n = 0; n < 2; ++n) _Pragma("unroll") for (int k = 0; k < 2; ++k) dst[n][k] = *(const PG8_LAS bf16x8*)(lds + PG8_SB(b, h) + boff + n * 2048 + k * 1024); } while (0)
#define PG8_MMA(ai, bj, At, Bt) do { __builtin_amdgcn_s_setprio(1); _Pragma("unroll") for (int m = 0; m < 4; ++m) _Pragma("unroll") for (int n = 0; n < 2; ++n) _Pragma("unroll") for (int k = 0; k < 2; ++k) \
        acc[ai][bj][m][n] = __builtin_amdgcn_mfma_f32_16x16x32_bf16(Bt[n][k], At[m][k], acc[ai][bj][m][n], 0, 0, 0); __builtin_amdgcn_s_setprio(0); } while (0)
#define PG8_WAIT_V(n) asm volatile("s_waitcnt vmcnt(" #n ")" ::: "memory")
#define PG8_WAIT_L(n) asm volatile("s_waitcnt lgkmcnt(" #n ")" ::: "memory")
#define PG8_BAR __builtin_amdgcn_s_barrier()
#define PG8_SCHED __builtin_amdgcn_sched_barrier(0)
    Unit cur, nxt; int ui = 0;
    if (!S.next(0, cur)) return;
    f32x4 acc[2][2][4][2];
#pragma unroll
    for (int a = 0; a < 2; ++a)
#pragma unroll
        for (int b = 0; b < 2; ++b)
#pragma unroll
            for (int m = 0; m < 4; ++m)
#pragma unroll
                for (int n = 0; n < 2; ++n) acc[a][b][m][n] = (f32x4){0.f, 0.f, 0.f, 0.f};
    bf16x8 At[4][2], B0[2][2], B1[2][2];
    const char* cA = (const char*)g.A + (size_t)cur.pm * tstep; const char* cB = (const char*)g.Bt + (size_t)cur.pn * tstep;
    S.a_ready(cur);
    if constexpr (SP2) {
    PG8_STAGE(PG8_SB(0, 0), cB, voffB); PG8_STAGE(PG8_SB(0, 1), cB + hstep, voffB); PG8_STAGE(PG8_SA(0, 0), cA, voffA); PG8_STAGE(PG8_SA(0, 1), cA + hstep, voffA);
    if (wr == 1) PG8_BAR;
    PG8_WAIT_V(2); PG8_BAR;
    PG8_STAGE(PG8_SB(1, 0), cB + kstep, voffB); PG8_STAGE(PG8_SA(1, 0), cA + kstep, voffA); PG8_STAGE(PG8_SB(1, 1), cB + hstep + kstep, voffB);
    PG8_WAIT_V(6); PG8_BAR;
    } else {
    PG8_STAGE(PG8_SB(0, 0), cB, voffB); PG8_STAGE(PG8_SA(0, 0), cA, voffA); PG8_STAGE(PG8_SB(0, 1), cB + hstep, voffB); PG8_STAGE(PG8_SA(0, 1), cA + hstep, voffA);
    if (wr == 1) PG8_BAR;
    PG8_WAIT_V(4); PG8_BAR;
    PG8_STAGE(PG8_SB(1, 0), cB + kstep, voffB); PG8_STAGE(PG8_SA(1, 0), cA + kstep, voffA); PG8_STAGE(PG8_SB(1, 1), cB + hstep + kstep, voffB);
    PG8_WAIT_V(6); PG8_BAR;
    }
    for (;;) {
        const bool has_next = S.next(ui + 1, nxt);
        const char* nA = has_next ? (const char*)g.A + (size_t)nxt.pm * tstep : cA; const char* nB = has_next ? (const char*)g.Bt + (size_t)nxt.pn * tstep : cB;
        for (int t = 0; t < nt; t += 2) {
            const bool last = (t == nt - 2);
            const char* a1 = cA + (size_t)(t + 1) * kstep;
            const char* a2 = last ? nA : cA + (size_t)(t + 2) * kstep; const char* b2 = last ? nB : cB + (size_t)(t + 2) * kstep;
            const char* a3 = a2 + kstep; const char* b3 = b2 + kstep;
            if (last && has_next) S.a_ready(nxt);
            if constexpr (SP2) {
            PG8_LDB(B0, 0, 0); PG8_LDB(B1, 0, 1); PG8_SCHED; PG8_LDA(At, 0, 0); PG8_STAGE(PG8_SA(1, 1), a1 + hstep, voffA);
            PG8_WAIT_V(8); PG8_WAIT_L(0); PG8_BAR; PG8_MMA(0, 0, At, B0); PG8_MMA(0, 1, At, B1); PG8_BAR; PG8_SCHED;
            PG8_LDA(At, 0, 1); PG8_STAGE(PG8_SB(0, 0), b2, voffB); PG8_STAGE(PG8_SB(0, 1), b2 + hstep, voffB); PG8_STAGE(PG8_SA(0, 0), a2, voffA);
            PG8_WAIT_V(8); PG8_WAIT_L(0); PG8_BAR; PG8_MMA(1, 0, At, B0); PG8_MMA(1, 1, At, B1); PG8_BAR; PG8_SCHED;
            PG8_LDB(B0, 1, 0); PG8_LDB(B1, 1, 1); PG8_SCHED; PG8_LDA(At, 1, 0); PG8_STAGE(PG8_SA(0, 1), a2 + hstep, voffA);
            PG8_WAIT_V(8); PG8_WAIT_L(0); PG8_BAR; PG8_MMA(0, 0, At, B0); PG8_MMA(0, 1, At, B1); PG8_BAR; PG8_SCHED;
            PG8_LDA(At, 1, 1); PG8_STAGE(PG8_SB(1, 0), b3, voffB); PG8_STAGE(PG8_SB(1, 1), b3 + hstep, voffB); PG8_STAGE(PG8_SA(1, 0), a3, voffA);
            PG8_WAIT_V(8); PG8_WAIT_L(0); PG8_BAR; PG8_MMA(1, 0, At, B0); PG8_MMA(1, 1, At, B1); PG8_BAR; PG8_SCHED;
            } else {
            PG8_LDB(B0, 0, 0); PG8_SCHED; PG8_LDA(At, 0, 0); PG8_STAGE(PG8_SA(1, 1), a1 + hstep, voffA);
            PG8_WAIT_L(8); PG8_BAR; PG8_WAIT_L(0); PG8_MMA(0, 0, At, B0); PG8_BAR; PG8_SCHED;
            PG8_LDB(B1, 0, 1); PG8_STAGE(PG8_SB(0, 0), b2, voffB);
            PG8_BAR; PG8_WAIT_L(0); PG8_MMA(0, 1, At, B1); PG8_BAR;
            PG8_LDA(At, 0, 1); PG8_STAGE(PG8_SA(0, 0), a2, voffA);
            PG8_BAR; PG8_WAIT_L(0); PG8_MMA(1, 0, At, B0); PG8_BAR; PG8_SCHED;
            PG8_STAGE(PG8_SB(0, 1), b2 + hstep, voffB);
            PG8_WAIT_V(6); PG8_BAR; PG8_MMA(1, 1, At, B1); PG8_BAR;
            PG8_LDB(B0, 1, 0); PG8_SCHED; PG8_LDA(At, 1, 0); PG8_STAGE(PG8_SA(0, 1), a2 + hstep, voffA);
            PG8_WAIT_L(8); PG8_BAR; PG8_WAIT_L(0); PG8_MMA(0, 0, At, B0); PG8_BAR; PG8_SCHED;
            PG8_LDB(B1, 1, 1); PG8_STAGE(PG8_SB(1, 0), b3, voffB);
            PG8_BAR; PG8_WAIT_L(0); PG8_MMA(0, 1, At, B1); PG8_BAR;
            PG8_LDA(At, 1, 1); PG8_STAGE(PG8_SA(1, 0), a3, voffA);
            PG8_BAR; PG8_WAIT_L(0); PG8_MMA(1, 0, At, B0); PG8_BAR; PG8_SCHED;
            PG8_STAGE(PG8_SB(1, 1), b3 + hstep, voffB);
            PG8_WAIT_V(6); PG8_BAR; PG8_MMA(1, 1, At, B1); PG8_BAR;
            }
        }
        if (wr == 0) PG8_BAR;
        E(acc, cur, wr, wc, fr, fq); S.done(cur);
        if (!has_next) break;
#pragma unroll
        for (int a = 0; a < 2; ++a)
#pragma unroll
            for (int b = 0; b < 2; ++b)
#pragma unroll
                for (int m = 0; m < 4; ++m)
#pragma unroll
                    for (int n = 0; n < 2; ++n) acc[a][b][m][n] = (f32x4){0.f, 0.f, 0.f, 0.f};
        cur = nxt; cA = nA; cB = nB; ++ui;
        if (wr == 1) PG8_BAR;
    }
    PG8_WAIT_V(0);
    PG8_BAR;
#undef PG8_SA
#undef PG8_SB
#undef PG8_STAGE
#undef PG8_LDA
#undef PG8_LDB
#undef PG8_MMA
#undef PG8_WAIT_V
#undef PG8_WAIT_L
#undef PG8_BAR
#undef PG8_SCHED
}
}

struct EpiF32 {
    static constexpr bool PERM = false;
    float* C; int ldc; int ncols;
    __device__ __forceinline__ void operator()(const f32x4 (&acc)[2][2][4][2], const pg8::Unit& u, int wr, int wc, int fr, int fq) const {
        const int row0 = u.pm * 256 + wr * 64 + fr, col0 = u.pn * 256 + wc * 32 + 4 * fq;
#pragma unroll
        for (int ai = 0; ai < 2; ++ai)
#pragma unroll
            for (int m = 0; m < 4; ++m) { float* rowp = C + (size_t)(row0 + ai * 128 + m * 16) * ldc + col0;
#pragma unroll
                for (int bj = 0; bj < 2; ++bj)
#pragma unroll
                    for (int n = 0; n < 2; ++n) if (col0 + bj * 128 + n * 16 < ncols) *(f32x4*)(rowp + bj * 128 + n * 16) = acc[ai][bj][m][n]; }
    }
};
template <int ACT> struct EpiB16 {
    static constexpr bool PERM = true;
    bf16* O; int ldc; int ncols;
    __device__ __forceinline__ void operator()(const f32x4 (&acc)[2][2][4][2], const pg8::Unit& u, int wr, int wc, int, int) const {
        const int ln = fresh_lane(), fr = ln & 15, fq = ln >> 4;
        const int row0 = u.pm * 256 + wr * 64 + fr, col0 = u.pn * 256 + wc * 32 + 8 * fq;
#pragma unroll
        for (int ai = 0; ai < 2; ++ai)
#pragma unroll
            for (int m = 0; m < 4; ++m) { bf16* rowp = O + (size_t)(row0 + ai * 128 + m * 16) * ldc + col0;
#pragma unroll
                for (int bj = 0; bj < 2; ++bj) { f32x4 v0 = acc[ai][bj][m][0], v1 = acc[ai][bj][m][1];
                    if (col0 + bj * 128 >= ncols) continue;
                    if (ACT) {
#pragma unroll
                    for (int j = 0; j < 4; ++j) { const float a = fmaxf(v0[j], 0.f), b = fmaxf(v1[j], 0.f); v0[j] = a * a; v1[j] = b * b; } }
                    u32x4 w; w.x = cvt_pk_bf16(v0[0], v0[1]); w.y = cvt_pk_bf16(v0[2], v0[3]); w.z = cvt_pk_bf16(v1[0], v1[1]); w.w = cvt_pk_bf16(v1[2], v1[3]);
                    *(u32x4*)(rowp + bj * 128) = w; } }
    }
};
struct EpiQ {
    static constexpr bool PERM = false;
    bf16* Q; const float* ropec; const float* ropes;
    __device__ __forceinline__ void operator()(const f32x4 (&acc)[2][2][4][2], const pg8::Unit& u, int wr, int wc, int, int) const {
        const int ln = fresh_lane(), fr = ln & 15, fq = ln >> 4;
        const int row0 = u.pm * 256 + wr * 64 + fr; const bool sample = u.pm >= 32;
#pragma unroll
        for (int bj = 0; bj < 2; ++bj) {
            const int g0 = u.pn * 256 + bj * 128 + wc * 32, within0 = g0 % 192; const bool isrope = within0 >= 128; const int a = (within0 - 128) >> 5;
#pragma unroll
            for (int ai = 0; ai < 2; ++ai)
#pragma unroll
                for (int m = 0; m < 4; ++m) { const int row = row0 + ai * 128 + m * 16;
                    f32x4 x1 = acc[ai][bj][m][0], x2 = acc[ai][bj][m][1];
                    if (sample && isrope) { const int ntok = (row - NTOK_P) & 1023;
                        const f32x4 cs = *(const f32x4*)(ropec + ntok * 32 + a * 16 + 4 * fq), sn = *(const f32x4*)(ropes + ntok * 32 + a * 16 + 4 * fq);
                        const f32x4 o1 = x1 * cs - x2 * sn, o2 = x1 * sn + x2 * cs; x1 = o1; x2 = o2; }
                    x1 = x1 * QSCALE; x2 = x2 * QSCALE;
                    bf16* p = Q + (size_t)row * 768 + g0 + 4 * fq;
                    *(u32x2*)p = pk4(x1); *(u32x2*)(p + 16) = pk4(x2); asm volatile("" ::: "memory"); }
        }
    }
};
struct EpiKV {
    static constexpr bool PERM = false;
    bf16* KN; bf16* VTP; bf16* VTS;
    __device__ __forceinline__ void operator()(const f32x4 (&acc)[2][2][4][2], const pg8::Unit& u, int wr, int wc, int, int) const {
        const int ln = fresh_lane(), fr = ln & 15, fq = ln >> 4;
        const int h = u.pn, pm = u.pm;
        bf16* vt; int keys, keybase;
        if (pm < 32) { vt = VTP + (size_t)((pm * 4 + h) * 128) * 256; keys = 256; keybase = 0; }
        else if (pm < 48) { const int b = (pm - 32) >> 2; vt = VTS + (size_t)((b * 4 + h) * 128) * 1536; keys = 1536; keybase = 512 + ((pm - 32) & 3) * 256; }
        else { const int b = (pm - 48) >> 1; vt = VTS + (size_t)((b * 4 + h) * 128) * 1536; keys = 1536; keybase = ((pm - 48) & 1) * 256; }
#pragma unroll
        for (int ai = 0; ai < 2; ++ai)
#pragma unroll
            for (int m = 0; m < 4; ++m) { const int rloc = wr * 64 + fr + ai * 128 + m * 16;
                bf16* kp = KN + (size_t)(pm * 256 + rloc) * 512 + h * 128 + wc * 32 + 4 * fq;
#pragma unroll
                for (int n = 0; n < 2; ++n) *(u32x2*)(kp + 16 * n) = pk4(acc[ai][0][m][n]);
#pragma unroll
                for (int n = 0; n < 2; ++n) { const f32x4 v = acc[ai][1][m][n]; const u32x2 w = pk4(v);
                    bf16* vp = vt + (size_t)(wc * 32 + 16 * n + 4 * fq) * keys + keybase + rloc;
                    vp[0] = (bf16)(w.x & 0xffffu); vp[keys] = (bf16)(w.x >> 16); vp[2 * keys] = (bf16)(w.y & 0xffffu); vp[3 * keys] = (bf16)(w.y >> 16); }
                asm volatile("" ::: "memory");
            }
    }
};

struct Args {
    const float *x_prompt, *x_sample, *cache_ckv, *cache_krope, *c, *c_ctx, *w_ada, *b_ada, *g_pre_mix, *w_in, *g_q, *w_uq, *g_kv, *w_ukv,
                *g_v, *w_s, *b_s, *w_conv, *w_out, *g_post_mix, *g_pre_ffn, *w_ff1, *w_ff2, *g_post_ffn;
    float* out; unsigned char* ws; int ph_lo, ph_hi;
};

__device__ __forceinline__ void p0_transpose_item(const float* W, int K, int N, bf16* WT, LAS float* scr, int item, int lane, float scale = 1.0f) {
    const int nblk = N / 32, kb = item / nblk, nb = item % nblk, k0 = 64 * kb, n0 = 32 * nb;
#pragma unroll 8
    for (int i = 0; i < 32; ++i) { const int kk = 2 * i + (lane >> 5); scr[kk * 33 + (lane & 31)] = W[(size_t)(k0 + kk) * N + n0 + (lane & 31)]; }
    asm volatile("s_waitcnt lgkmcnt(0)" ::: "memory");
    const int c = lane & 7;
#pragma unroll
    for (int j = 0; j < 4; ++j) { const int n = (lane >> 3) + 8 * j; const LAS float* s = scr + (8 * c) * 33 + n;
        u32x4 o; o.x = cvt_pk_bf16(s[0 * 33] * scale, s[1 * 33] * scale); o.y = cvt_pk_bf16(s[2 * 33] * scale, s[3 * 33] * scale); o.z = cvt_pk_bf16(s[4 * 33] * scale, s[5 * 33] * scale); o.w = cvt_pk_bf16(s[6 * 33] * scale, s[7 * 33] * scale);
        *(u32x4*)(WT + (size_t)(n0 + n) * K + k0 + 8 * c) = o; }
    asm volatile("s_waitcnt lgkmcnt(0)" ::: "memory");
}

__device__ __forceinline__ void convert_layer(const Args& A, LAS unsigned char* lds, int l, int gwi, int nw, int wave, int lane) {
    unsigned char* ws = A.ws;
    LAS float* scr = (LAS float*)(lds + wave * 16384);
    constexpr int I_IN = 16 * 62, I_UQ = 6 * 24, I_UKV = 4 * 32, I_OUT = 16 * 32, I_F1 = 16 * 128, I_F2 = 64 * 32, I_L = I_IN + I_UQ + I_UKV + I_OUT + I_F1 + I_F2;
    for (int it = gwi; it < I_L; it += nw) {
        int r = it;
        if (r < I_IN) { p0_transpose_item(A.w_in + (size_t)l * 1024 * INC, 1024, INC, (bf16*)(ws + WS_WIN) + (size_t)l * 2048 * 1024, scr, r, lane); continue; } r -= I_IN;
        if (r < I_UQ) { p0_transpose_item(A.w_uq + (size_t)l * 384 * 768, 384, 768, (bf16*)(ws + WS_WUQ) + (size_t)l * 768 * 384, scr, r, lane, QSCALE); continue; } r -= I_UQ;
        if (r < I_UKV) { p0_transpose_item(A.w_ukv + (size_t)l * 256 * 1024, 256, 1024, (bf16*)(ws + WS_WUKV) + (size_t)l * 1024 * 256, scr, r, lane); continue; } r -= I_UKV;
        if (r < I_OUT) { p0_transpose_item(A.w_out + (size_t)l * 1024 * 1024, 1024, 1024, (bf16*)(ws + WS_WOUT) + (size_t)l * 1024 * 1024, scr, r, lane); continue; } r -= I_OUT;
        if (r < I_F1) { p0_transpose_item(A.w_ff1 + (size_t)l * 1024 * 4096, 1024, 4096, (bf16*)(ws + WS_WFF1) + (size_t)l * 4096 * 1024, scr, r, lane); continue; } r -= I_F1;
        p0_transpose_item(A.w_ff2 + (size_t)l * 4096 * 1024, 4096, 1024, (bf16*)(ws + WS_WFF2) + (size_t)l * 1024 * 4096, scr, r, lane);
    }
}

__device__ __forceinline__ void phase_prologue(const Args& A, LAS unsigned char* lds, int wave) {
    const int lane = fresh_lane(), tid = wave * 64 + lane;
    unsigned char* ws = A.ws;
    const int bid = blockIdx.x, G = gridDim.x;
    { const int gt = bid * 512 + tid;
      if (gt < 32768) { const int n = gt >> 5, a = (gt >> 4) & 1, f = gt & 15; const int pos = a == 0 ? (n >> 6) : (n & 63);
          double inv = 1.0; for (int i = 0; i < f; ++i) inv *= 0.5623413251903491;
          double rev = (double)pos * inv * 0.15915494309189535; rev -= floor(rev);
          const float rf = (float)rev;
          ((float*)(ws + WS_ROPE))[gt] = __builtin_amdgcn_cosf(rf); ((float*)(ws + WS_ROPE))[32768 + gt] = __builtin_amdgcn_sinf(rf); } }
    for (int it = bid; it < 192; it += G) {
        const int l = it / 48, cgp = it % 48;
        LAS float* sl = (LAS float*)lds;
        for (int i = tid; i < 5120; i += 512) { const int ci = i >> 10, k = i & 1023; const float v = ci == 0 ? A.c_ctx[k] : A.c[(ci - 1) * 1024 + k]; sl[i] = v / (1.0f + __expf(-v)); }
        __syncthreads();
        float a0[5], a1[5];
#pragma unroll
        for (int ci = 0; ci < 5; ++ci) { a0[ci] = 0.f; a1[ci] = 0.f; }
        const float* wp = A.w_ada + ((size_t)l * 1024 + wave * 128) * 6144 + cgp * 128 + 2 * lane;
#pragma unroll 8
        for (int kk = 0; kk < 128; ++kk) { const f32x2 wv = *(const f32x2*)(wp + (size_t)kk * 6144); const int k = wave * 128 + kk;
#pragma unroll
            for (int ci = 0; ci < 5; ++ci) { const float s = sl[ci * 1024 + k]; a0[ci] += s * wv.x; a1[ci] += s * wv.y; } }
        LAS float* part = (LAS float*)(lds + 32768);
#pragma unroll
        for (int ci = 0; ci < 5; ++ci) { part[(wave * 5 + ci) * 128 + 2 * lane] = a0[ci]; part[(wave * 5 + ci) * 128 + 2 * lane + 1] = a1[ci]; }
        __syncthreads();
        for (int i = tid; i < 640; i += 512) { const int ci = i >> 7, col = i & 127; float s = 0.f;
#pragma unroll
            for (int w = 0; w < 8; ++w) s += part[(w * 5 + ci) * 128 + col];
            const int gcol = cgp * 128 + col; ((float*)(ws + WS_MOD))[(l * 5 + ci) * 6144 + gcol] = s + A.b_ada[l * 6144 + gcol]; }
        __syncthreads();
    }
    convert_layer(A, lds, 0, bid * 8 + wave, G * 8, wave, lane);
}

__device__ __forceinline__ int cond_of_row(int r) { return r < NTOK_P ? 0 : 1 + ((r - NTOK_P) >> 10); }

__device__ __forceinline__ void norm_mod_store(const f32x4 (&v)[4], const LAS float* g, const LAS float* sc, const LAS float* sh, bf16* hrow, int lane) {
    float ss = 0.f;
#pragma unroll
    for (int j = 0; j < 4; ++j) ss += sumsq4(v[j]);
    const float rstd = 1.0f / sqrtf(wave_sum(ss, lane) * (1.0f / 1024.0f) + EPS);
#pragma unroll
    for (int j = 0; j < 4; ++j) { const int idx = 4 * lane + 256 * j;
        const f32x4 gg = *(const LAS f32x4*)(g + idx), s1 = *(const LAS f32x4*)(sc + idx), s0 = *(const LAS f32x4*)(sh + idx);
        const f32x4 o = v[j] * rstd * gg * (1.0f + s1) + s0;
        *(u32x2*)(hrow + idx) = pk4(o); }
}
__device__ __forceinline__ const float* x_in_row(const Args& A, int r) { return r < NTOK_P ? A.x_prompt + (size_t)r * 1024 : A.x_sample + (size_t)(r - NTOK_P) * 1024; }
__device__ __forceinline__ void fill_vec(LAS float* dst, const float* src, int tid) { if (tid < 256) *(LAS f32x4*)(dst + 4 * tid) = *(const f32x4*)(src + 4 * tid); }

__device__ __forceinline__ void phase_pre(const Args& A, LAS unsigned char* lds, int lane, int wave) {
    const int gw = blockIdx.x * 8 + wave, NGW = gridDim.x * 8;
    const float* mod = (const float*)(A.ws + WS_MOD); bf16* H = (bf16*)(A.ws + WS_H);
    LAS float* P = (LAS float*)lds;
    { const int t2 = (wave & 3) * 64 + lane, hv = wave >> 2;
      for (int v = hv; v < 11; v += 2) { const float* src = v == 0 ? A.g_pre_mix : (v <= 5 ? mod + (size_t)(v - 1) * 6144 + 1024 : mod + (size_t)(v - 6) * 6144);
          const int slot = v == 0 ? 1 : (v <= 5 ? 7 + (v - 1) : 12 + (v - 6));
          *(LAS f32x4*)(P + slot * 1024 + 4 * t2) = *(const f32x4*)(src + 4 * t2); } }
    __syncthreads();
    for (int r0 = gw; r0 < NTOK; r0 += 2 * NGW) {
        f32x4 v[2][4];
#pragma unroll
        for (int u = 0; u < 2; ++u) { const float* xr = x_in_row(A, r0 + u * NGW);
#pragma unroll
            for (int j = 0; j < 4; ++j) v[u][j] = __builtin_nontemporal_load((const f32x4*)(xr + 4 * lane + 256 * j)); }
#pragma unroll
        for (int u = 0; u < 2; ++u) { const int r = r0 + u * NGW, ci = cond_of_row(r);
            norm_mod_store(v[u], P + 1024, P + (7 + ci) * 1024, P + (12 + ci) * 1024, H + (size_t)r * 1024, lane); }
    }
    __syncthreads();
}

__device__ __forceinline__ void phase_post(const Args& A, int l, int which, LAS unsigned char* lds, int lane, int wave) {
    const int gw = blockIdx.x * 8 + wave, NGW = gridDim.x * 8;
    const float* mod = (const float*)(A.ws + WS_MOD); bf16* H = (bf16*)(A.ws + WS_H); const bf16* MIX = (const bf16*)(A.ws + WS_MIX);
    const bool first = (l == 0 && which == 0), has_h = (which == 0) || (l < DEPTH - 1), last = (l == DEPTH - 1 && which == 1);
    bf16* XB = (bf16*)(A.ws + WS_XB);
    LAS float* P = (LAS float*)lds;
    { const int t2 = (wave & 3) * 64 + lane, hv = wave >> 2;
      const int l2 = which == 0 ? l : l + 1;
      for (int v = hv; v < 17; v += 2) { const float* src;
          if (v == 0) src = (which == 0 ? A.g_post_mix : A.g_post_ffn) + l * 1024;
          else if (v == 1) src = which == 0 ? A.g_pre_ffn + l * 1024 : A.g_pre_mix + (l2 < DEPTH ? l2 : l) * 1024;
          else if (v < 7) src = mod + (size_t)(l * 5 + (v - 2)) * 6144 + (which == 0 ? 2048 : 5120);
          else if (v < 12) src = mod + (size_t)((l2 < DEPTH ? l2 : l) * 5 + (v - 7)) * 6144 + (which == 0 ? 4096 : 1024);
          else src = mod + (size_t)((l2 < DEPTH ? l2 : l) * 5 + (v - 12)) * 6144 + (which == 0 ? 3072 : 0);
          *(LAS f32x4*)(P + v * 1024 + 4 * t2) = *(const f32x4*)(src + 4 * t2); } }
    __syncthreads();
    for (int r0 = gw; r0 < NTOK; r0 += 2 * NGW) {
        f32x4 v[2][4], t[2][4];
#pragma unroll
        for (int u = 0; u < 2; ++u) { const int r = r0 + u * NGW;
            const bf16* tr = MIX + (size_t)r * 1024;
            if (first) { const float* xr = x_in_row(A, r);
#pragma unroll
                for (int j = 0; j < 4; ++j) v[u][j] = __builtin_nontemporal_load((const f32x4*)(xr + 4 * lane + 256 * j)); }
            else { const bf16* xr = XB + (size_t)r * 1024;
#pragma unroll
                for (int j = 0; j < 4; ++j) v[u][j] = ld4bf_nt(xr + 4 * lane + 256 * j); }
#pragma unroll
            for (int j = 0; j < 4; ++j) t[u][j] = ld4bf_nt(tr + 4 * lane + 256 * j); }
#pragma unroll
        for (int u = 0; u < 2; ++u) { const int r = r0 + u * NGW; const LAS float* ga = P + (2 + cond_of_row(r)) * 1024;
            float ss = 0.f;
#pragma unroll
            for (int j = 0; j < 4; ++j) ss += sumsq4(t[u][j]);
            const float rstd = 1.0f / sqrtf(wave_sum(ss, lane) * (1.0f / 1024.0f) + EPS);
#pragma unroll
            for (int j = 0; j < 4; ++j) { const int idx = 4 * lane + 256 * j;
                const f32x4 gg = *(const LAS f32x4*)(P + idx), gv = *(const LAS f32x4*)(ga + idx);
                v[u][j] = v[u][j] + gv * (t[u][j] * rstd * gg);
                if (last) __builtin_nontemporal_store(v[u][j], (f32x4*)(A.out + (size_t)r * 1024 + idx));
                else __builtin_nontemporal_store(pk4(v[u][j]), (u32x2*)(XB + (size_t)r * 1024 + idx)); } }
        if (has_h) {
#pragma unroll
            for (int u = 0; u < 2; ++u) { const int r = r0 + u * NGW, ci = cond_of_row(r);
                norm_mod_store(v[u], P + 1024, P + (7 + ci) * 1024, P + (12 + ci) * 1024, H + (size_t)r * 1024, lane); } }
    }
    __syncthreads();
}

__device__ __forceinline__ void phase_split(const Args& A, int l, int lane, int wave) {
    const int gw = blockIdx.x * 8 + wave, NGW = gridDim.x * 8;
    unsigned char* ws = A.ws;
    const bf16* Z = (const bf16*)(ws + WS_Z);
    bf16* QN = (bf16*)(ws + WS_QN); bf16* CKVN = (bf16*)(ws + WS_CKVN); bf16* KRB = (bf16*)(ws + WS_KRB); bf16* UG = (bf16*)(ws + WS_UG); bf16* VN = (bf16*)(ws + WS_VN);
    bf16* CC = (bf16*)(ws + WS_CONCAT);
    const float* ropec = (const float*)(ws + WS_ROPE); const float* ropes = ropec + 32768;
    float* out_ckv = A.out + (size_t)NTOK * 1024; float* out_kr = out_ckv + (size_t)32 * 4 * 256 * 256;
    for (int idx = gw; idx < 2048; idx += NGW) { const int r = NTOK + idx, b = idx >> 9, j = idx & 511;
        const f32x4 cv = *(const f32x4*)(A.cache_ckv + ((size_t)(b * 4 + l) * 512 + j) * 256 + 4 * lane);
        const float kv = A.cache_krope[((size_t)(b * 4 + l) * 512 + j) * 64 + lane];
        *(u32x2*)(CKVN + (size_t)r * 256 + 4 * lane) = pk4(cv);
        KRB[(size_t)r * 64 + lane] = (bf16)(cvt_pk_bf16(kv, 0.f) & 0xffffu); }
    const f32x4 gkv = *(const f32x4*)(A.g_kv + l * 256 + 4 * lane), gvv = *(const f32x4*)(A.g_v + l * 256 + 4 * lane);
    const float* wcp = A.w_conv + (size_t)l * 3 * 256 + 4 * lane;
    const f32x4 wc0 = *(const f32x4*)(wcp), wc1 = *(const f32x4*)(wcp + 256), wc2 = *(const f32x4*)(wcp + 512);
    f32x2 gq[3];
#pragma unroll
    for (int j = 0; j < 3; ++j) gq[j] = *(const f32x2*)(A.g_q + l * 384 + 2 * lane + 128 * j);
    for (int r0 = gw; r0 < NTOK; r0 += 2 * NGW) {
        f32x2 q[2][3]; f32x4 cv[2], uu[2], vv[2], bg[2], zc[2], zm[2], zp[2]; float kr[2], cs[2], sn[2];
#pragma unroll
        for (int u = 0; u < 2; ++u) { const int r = r0 + u * NGW; const bf16* z = Z + (size_t)r * INC;
            const bool prompt = r < NTOK_P; const int n = prompt ? (r & 255) : ((r - NTOK_P) & 1023), len = prompt ? 256 : 1024;
#pragma unroll
            for (int j = 0; j < 3; ++j) q[u][j] = ld2bf(z + ZQ + 2 * lane + 128 * j);
            cv[u] = ld4bf(z + ZCKV + 4 * lane); kr[u] = ld1bf(z + ZKR + lane);
            uu[u] = ld4bf(z + ZU + 4 * lane); vv[u] = ld4bf(z + ZV + 4 * lane); bg[u] = ld4bf(z + ZBG + 4 * lane);
            zc[u] = ld4bf(z + ZCG + 4 * lane) * ld4bf(z + ZHH + 4 * lane);
            zm[u] = (f32x4){0.f, 0.f, 0.f, 0.f}; zp[u] = zm[u];
            if (n > 0) zm[u] = ld4bf(z - INC + ZCG + 4 * lane) * ld4bf(z - INC + ZHH + 4 * lane);
            if (n < len - 1) zp[u] = ld4bf(z + INC + ZCG + 4 * lane) * ld4bf(z + INC + ZHH + 4 * lane);
            cs[u] = 1.f; sn[u] = 0.f;
            if (!prompt) { const int a = lane >> 5, f = lane & 15; cs[u] = ropec[n * 32 + a * 16 + f]; sn[u] = ropes[n * 32 + a * 16 + f]; } }
#pragma unroll
        for (int u = 0; u < 2; ++u) { const int r = r0 + u * NGW; const bool prompt = r < NTOK_P; const int n = prompt ? (r & 255) : ((r - NTOK_P) & 1023);
            { float ss = 0.f;
#pragma unroll
              for (int j = 0; j < 3; ++j) ss += q[u][j].x * q[u][j].x + q[u][j].y * q[u][j].y;
              const float rstd = 1.0f / sqrtf(wave_sum(ss, lane) * (1.0f / 384.0f) + EPS);
#pragma unroll
              for (int j = 0; j < 3; ++j) *(unsigned*)(QN + (size_t)r * 384 + 2 * lane + 128 * j) = cvt_pk_bf16(q[u][j].x * rstd * gq[j].x, q[u][j].y * rstd * gq[j].y); }
            { const float rstd = 1.0f / sqrtf(wave_sum(sumsq4(cv[u]), lane) * (1.0f / 256.0f) + EPS);
              const f32x4 c2 = cv[u] * rstd * gkv;
              if (prompt) __builtin_nontemporal_store(c2, (f32x4*)(out_ckv + ((size_t)((r >> 8) * 4 + l) * 256 + n) * 256 + 4 * lane));
              *(u32x2*)(CKVN + (size_t)r * 256 + 4 * lane) = pk4(c2); }
            { float k2 = kr[u];
              if (prompt) __builtin_nontemporal_store(k2, out_kr + ((size_t)((r >> 8) * 4 + l) * 256 + n) * 64 + lane);
              else { const float partner = shx(k2, 16, lane); const int p = (lane >> 4) & 1;
                  k2 = p == 0 ? k2 * cs[u] - partner * sn[u] : partner * sn[u] + k2 * cs[u]; }
              KRB[(size_t)r * 64 + lane] = (bf16)(cvt_pk_bf16(k2, 0.f) & 0xffffu); }
            *(u32x2*)(UG + (size_t)r * 256 + 4 * lane) = pk4(gelu4(uu[u]));
            { f32x4 v = gelu4(vv[u]);
              const float rstd = 1.0f / sqrtf(wave_sum(sumsq4(v), lane) * (1.0f / 256.0f) + EPS);
              *(u32x2*)(VN + (size_t)r * 256 + 4 * lane) = pk4(v * rstd * gvv); }
            { const f32x4 y = zm[u] * wc0 + zc[u] * wc1 + zp[u] * wc2;
              *(u32x2*)(CC + (size_t)r * 1024 + 768 + 4 * lane) = pk4(bg[u] * y); }
        }
    }
}

#define MFMA32(a, b, c) __builtin_amdgcn_mfma_f32_32x32x16_bf16((a), (b), (c), 0, 0, 0)
constexpr int AT_KROW = 400, AT_VROW = 144, AT_KBYTES = 64 * AT_KROW, AT_STAGE = AT_KBYTES + 128 * AT_VROW;
__device__ __forceinline__ void attn_store_tile(const f32x16& ot, float inv, bf16* crow  , int t, int hh) {
#pragma unroll
    for (int g = 0; g < 4; ++g) { u32x2 w; w.x = cvt_pk_bf16(ot[4 * g] * inv, ot[4 * g + 1] * inv); w.y = cvt_pk_bf16(ot[4 * g + 2] * inv, ot[4 * g + 3] * inv);
        *(u32x2*)(crow + 32 * t + 8 * g + 4 * hh) = w; }
}

__device__ __forceinline__ void phase_mixer(const Args& A, int l, LAS unsigned char* lds, int lane_in, int wave) {
    unsigned char* ws = A.ws;
    const bf16* Q = (const bf16*)(ws + WS_Q); const bf16* KN = (const bf16*)(ws + WS_KNOPE); const bf16* KRB = (const bf16*)(ws + WS_KRB);
    const bf16* VTP = (const bf16*)(ws + WS_VTP); const bf16* VTS = (const bf16*)(ws + WS_VTS);
    const bf16* UG = (const bf16*)(ws + WS_UG); const bf16* VN = (const bf16*)(ws + WS_VN);
    bf16* CC = (bf16*)(ws + WS_CONCAT);
    for (int slot = 0; ; ++slot) {
        int it;
        if (gridDim.x == 256) {
            if (slot == 0) it = blockIdx.x; else if (slot == 1 && blockIdx.x >= 128 && blockIdx.x < 224) it = 256 + (int)blockIdx.x - 128; else break;
        } else { it = (int)blockIdx.x + slot * (int)gridDim.x; if (it >= 352) break; }
        int lane = lane_in; asm volatile("" : "+v"(lane));
        const int rho = lane & 31, hh = lane >> 5, tid = wave * 64 + lane;
        if (it < 256) {
            int h, q0, keys, nkeys, split, rowA, rowB; const bf16* vt;
            const bool heavy = it < 128;
            if (heavy) {
                const int xj = it >> 3, pr = 2 * (it & 7) + (xj >> 3), b = pr >> 2, qt = xj & 7; h = pr & 3;
                q0 = NTOK_P + b * 1024 + qt * 128 + (wave & 3) * 32; keys = 1536; nkeys = 1536; split = 512; rowA = NTOK + b * 512; rowB = NTOK_P + b * 1024;
                vt = VTS + (size_t)((b * 4 + h) * 128) * 1536; }
            else { const int i2 = it - 128, b = i2 >> 2; h = i2 & 3; q0 = b * 256 + wave * 32; keys = 256; nkeys = 256; split = 0; rowA = 0; rowB = b * 256;
                vt = VTP + (size_t)((b * 4 + h) * 128) * 256; }
            bf16x8 qf[12];
            { const bf16* qp = Q + (size_t)(q0 + rho) * 768 + h * 192 + 8 * hh;
#pragma unroll
              for (int ks = 0; ks < 12; ++ks) qf[ks] = *(const bf16x8*)(qp + 16 * ks); }
            if (heavy) {
                const float* ropec = (const float*)(ws + WS_ROPE); const int ntok = (q0 + rho - NTOK_P) & 1023;
#pragma unroll
                for (int a = 0; a < 2; ++a) { const float* cp = ropec + ntok * 32 + a * 16 + 8 * hh;
                    const f32x4 c0 = *(const f32x4*)cp, c1 = *(const f32x4*)(cp + 4), s0 = *(const f32x4*)(cp + 32768), s1 = *(const f32x4*)(cp + 32768 + 4);
                    const u32x4 w1 = __builtin_bit_cast(u32x4, qf[8 + 2 * a]), w2 = __builtin_bit_cast(u32x4, qf[9 + 2 * a]); u32x4 r1, r2;
#pragma unroll
                    for (int j = 0; j < 4; ++j) { const float x1l = __uint_as_float(w1[j] << 16), x1h = __uint_as_float(w1[j] & 0xffff0000u), x2l = __uint_as_float(w2[j] << 16), x2h = __uint_as_float(w2[j] & 0xffff0000u);
                        const float cl = j < 2 ? c0[2 * j] : c1[2 * j - 4], ch = j < 2 ? c0[2 * j + 1] : c1[2 * j - 3], sl = j < 2 ? s0[2 * j] : s1[2 * j - 4], sh = j < 2 ? s0[2 * j + 1] : s1[2 * j - 3];
                        r1[j] = cvt_pk_bf16(x1l * cl - x2l * sl, x1h * ch - x2h * sh); r2[j] = cvt_pk_bf16(x1l * sl + x2l * cl, x1h * sh + x2h * ch); }
                    qf[8 + 2 * a] = __builtin_bit_cast(bf16x8, r1); qf[9 + 2 * a] = __builtin_bit_cast(bf16x8, r2); }
            }
            f32x16 o[4];
#pragma unroll
            for (int t = 0; t < 4; ++t)
#pragma unroll
                for (int i = 0; i < 16; ++i) o[t][i] = 0.f;
            float m = 0.f, lsum = 0.f; bool fresh = true;
            int kslot[2], kcol[2], vd[2], vc[2];
#pragma unroll
            for (int j = 0; j < 2; ++j) { const int c = tid + 512 * j, kap = c >> 4; kcol[j] = c & 15;
                kslot[j] = (kap & 32) + (kap & 3) + 4 * ((kap >> 4) & 1) + 8 * ((kap >> 2) & 3);
                vd[j] = c >> 3; vc[j] = c & 7; }
            const int rkap = tid >> 3, rc8 = tid & 7, rslot = (rkap & 32) + (rkap & 3) + 4 * ((rkap >> 4) & 1) + 8 * ((rkap >> 2) & 3);
            u32x4 sk[2], sr, sv[2];
#define AT_GLOAD(k0) do { const int rb_ = (k0) < split ? rowA + (k0) : rowB + ((k0) - split); \
                _Pragma("unroll") for (int j = 0; j < 2; ++j) sk[j] = *(const u32x4*)(KN + (size_t)(rb_ + ((tid + 512 * j) >> 4)) * 512 + h * 128 + kcol[j] * 8); \
                sr = *(const u32x4*)(KRB + (size_t)(rb_ + rkap) * 64 + rc8 * 8); \
                _Pragma("unroll") for (int j = 0; j < 2; ++j) sv[j] = *(const u32x4*)(vt + (size_t)vd[j] * keys + (k0) + vc[j] * 8); } while (0)
#define AT_SWRITE(buf) do { LAS unsigned char* sb_ = lds + (buf) * AT_STAGE; \
                _Pragma("unroll") for (int j = 0; j < 2; ++j) *(LAS u32x4*)(sb_ + kslot[j] * AT_KROW + kcol[j] * 16) = sk[j]; \
                *(LAS u32x4*)(sb_ + rslot * AT_KROW + 256 + rc8 * 16) = sr; \
                _Pragma("unroll") for (int j = 0; j < 2; ++j) *(LAS u32x4*)(sb_ + AT_KBYTES + vd[j] * AT_VROW + vc[j] * 16) = sv[j]; } while (0)
            const int ntile = nkeys >> 6;
            const int blk_lo = heavy ? (wave >> 2) : 0, blk_hi = heavy ? blk_lo + 1 : 2;
            AT_GLOAD(0); AT_SWRITE(0);
            __syncthreads();
            for (int tI = 0; tI < ntile; ++tI) {
                if (tI + 1 < ntile) AT_GLOAD((tI + 1) * 64);
                { const LAS unsigned char* sb = lds + (tI & 1) * AT_STAGE;
                for (int blk = blk_lo; blk < blk_hi; ++blk) {
                    const LAS unsigned char* kp = sb + (32 * blk + rho) * AT_KROW + hh * 16;
                    f32x16 sc;
#pragma unroll
                    for (int i = 0; i < 16; ++i) sc[i] = -m;
                    bf16x8 kf[12];
#pragma unroll
                    for (int ks = 0; ks < 12; ++ks) kf[ks] = *(const LAS bf16x8*)(kp + ks * 32);
                    __builtin_amdgcn_sched_barrier(0);
#pragma unroll
                    for (int ks = 0; ks < 12; ++ks) sc = MFMA32(kf[ks], qf[ks], sc);
                    const LAS unsigned char* vp = sb + AT_KBYTES + rho * AT_VROW + (32 * blk + 16 * hh) * 2;
                    bf16x8 vf[8];
#pragma unroll
                    for (int t = 0; t < 4; ++t)
#pragma unroll
                        for (int s2 = 0; s2 < 2; ++s2) vf[t * 2 + s2] = *(const LAS bf16x8*)(vp + 32 * t * AT_VROW + 16 * s2);
                    __builtin_amdgcn_sched_barrier(0);
                    float mx = sc[0];
#pragma unroll
                    for (int i = 1; i < 16; ++i) mx = fmaxf(mx, sc[i]);
                    { const auto rr = __builtin_amdgcn_permlane32_swap(__float_as_uint(mx), __float_as_uint(mx), false, false); mx = fmaxf(__uint_as_float(rr[0]), __uint_as_float(rr[1])); }
                    if (fresh || __builtin_amdgcn_ballot_w64(mx > 8.0f) != 0ull) { const float delta = fresh ? mx : fmaxf(mx, 0.f), alpha = fresh ? 0.f : __builtin_amdgcn_exp2f(-delta); m += delta; lsum *= alpha; fresh = false;
#pragma unroll
                        for (int i = 0; i < 16; ++i) sc[i] -= delta;
#pragma unroll
                        for (int t = 0; t < 4; ++t) o[t] = o[t] * alpha; }
                    float ps = 0.f;
#pragma unroll
                    for (int i = 0; i < 16; ++i) { sc[i] = __builtin_amdgcn_exp2f(sc[i]); ps += sc[i]; }
                    lsum += ps;
                    bf16x8 pb[2];
#pragma unroll
                    for (int s2 = 0; s2 < 2; ++s2) { u32x4 w; w.x = cvt_pk_bf16(sc[8 * s2 + 0], sc[8 * s2 + 1]); w.y = cvt_pk_bf16(sc[8 * s2 + 2], sc[8 * s2 + 3]); w.z = cvt_pk_bf16(sc[8 * s2 + 4], sc[8 * s2 + 5]); w.w = cvt_pk_bf16(sc[8 * s2 + 6], sc[8 * s2 + 7]);
                        pb[s2] = __builtin_bit_cast(bf16x8, w); }
#pragma unroll
                    for (int s2 = 0; s2 < 2; ++s2)
#pragma unroll
                        for (int t = 0; t < 4; ++t) o[t] = MFMA32(vf[t * 2 + s2], pb[s2], o[t]);
                }
                }
                if (tI + 1 < ntile) AT_SWRITE((tI + 1) & 1);
                __syncthreads();
            }
#undef AT_GLOAD
#undef AT_SWRITE
            lsum += shx(lsum, 32, lane);
            bf16* crow = CC + (size_t)(q0 + rho) * 1024 + h * 128;
            if (!heavy) { const float inv = 1.0f / lsum;
#pragma unroll
                for (int t = 0; t < 4; ++t) attn_store_tile(o[t], inv, crow, t, hh);
            } else {
                const int half = wave >> 2;
                LAS float* mine = (LAS float*)(lds + wave * 8704);
                LAS const float* theirs = (LAS const float*)(lds + (wave ^ 4) * 8704);
#pragma unroll
                for (int t2 = 0; t2 < 2; ++t2)
#pragma unroll
                    for (int i = 0; i < 16; ++i) mine[(t2 * 16 + i) * 64 + lane] = half == 0 ? o[2 + t2][i] : o[t2][i];
                if (hh == 0) { mine[2048 + rho] = m; mine[2080 + rho] = lsum; }
                __syncthreads();
                const float mp = theirs[2048 + rho], lp = theirs[2080 + rho];
                const float mg = fmaxf(m, mp), wo = __builtin_amdgcn_exp2f(m - mg), wp = __builtin_amdgcn_exp2f(mp - mg);
                const float inv = 1.0f / (wo * lsum + wp * lp);
#pragma unroll
                for (int t2 = 0; t2 < 2; ++t2) { f32x16 acc;
#pragma unroll
                    for (int i = 0; i < 16; ++i) acc[i] = wo * (half == 0 ? o[t2][i] : o[2 + t2][i]) + wp * theirs[(t2 * 16 + i) * 64 + lane];
                    attn_store_tile(acc, inv, crow, half * 2 + t2, hh); }
                __syncthreads();
            }
        } else {
            const int c = it - 256;
            const int hd = wave & 3, ph = wave >> 2;
            const float* wbase = A.w_s + ((size_t)(l * 4 + hd) * 128 + 64 * ph + rho) * 128 + 8 * hh;
            f32x4 wva[16], wvb[16];
#pragma unroll
            for (int ks = 0; ks < 8; ++ks) { wva[2 * ks] = *(const f32x4*)(wbase + 16 * ks); wva[2 * ks + 1] = *(const f32x4*)(wbase + 16 * ks + 4); }
            LAS bf16* vnT = (LAS bf16*)lds;
            { bf16x8 vv[8];
#pragma unroll
              for (int pass = 0; pass < 8; ++pass) { const int u = wave + 8 * pass, qq = (u & 1) * 64 + lane, c8 = (u >> 1) * 8; vv[pass] = *(const bf16x8*)(VN + (size_t)(c * 128 + qq) * 256 + c8); }
#pragma unroll
              for (int pass = 0; pass < 8; ++pass) { const int u = wave + 8 * pass, qq = (u & 1) * 64 + lane, c8 = (u >> 1) * 8;
#pragma unroll
                for (int j = 0; j < 8; ++j) vnT[(c8 + j) * 136 + qq] = (bf16)vv[pass][j]; } }
            __syncthreads();
#pragma unroll
            for (int pp = 0; pp < 2; ++pp) { const int pt = 2 * ph + pp;
                bf16x8 af[8];
#pragma unroll
                for (int ks = 0; ks < 8; ++ks) { const f32x4 w0 = pp == 0 ? wva[2 * ks] : wvb[2 * ks], w1 = pp == 0 ? wva[2 * ks + 1] : wvb[2 * ks + 1];
                    u32x4 w; w.x = cvt_pk_bf16(w0.x, w0.y); w.y = cvt_pk_bf16(w0.z, w0.w); w.z = cvt_pk_bf16(w1.x, w1.y); w.w = cvt_pk_bf16(w1.z, w1.w); af[ks] = __builtin_bit_cast(bf16x8, w); }
                if (pp == 0) {
#pragma unroll
                    for (int ks = 0; ks < 8; ++ks) { wvb[2 * ks] = *(const f32x4*)(wbase + 32 * 128 + 16 * ks); wvb[2 * ks + 1] = *(const f32x4*)(wbase + 32 * 128 + 16 * ks + 4); } }
                float bs[16]; bf16 ugv[2][16];
#pragma unroll
                for (int i = 0; i < 16; ++i) { const int p = 32 * pt + (i & 3) + 8 * (i >> 2) + 4 * hh; bs[i] = A.b_s[(l * 4 + hd) * 128 + p];
#pragma unroll
                    for (int d = 0; d < 2; ++d) ugv[d][i] = UG[((size_t)c * 128 + p) * 256 + hd * 64 + 32 * d + rho]; }
                f32x16 acc[2];
#pragma unroll
                for (int d = 0; d < 2; ++d)
#pragma unroll
                    for (int i = 0; i < 16; ++i) acc[d][i] = 0.f;
#pragma unroll
                for (int ks = 0; ks < 8; ++ks)
#pragma unroll
                    for (int d = 0; d < 2; ++d) { const bf16x8 bfr = *(const LAS bf16x8*)(vnT + (hd * 64 + 32 * d + rho) * 136 + 16 * ks + 8 * hh); acc[d] = MFMA32(af[ks], bfr, acc[d]); }
#pragma unroll
                for (int d = 0; d < 2; ++d) { const int col = hd * 64 + 32 * d + rho;
#pragma unroll
                    for (int i = 0; i < 16; ++i) { const int p = 32 * pt + (i & 3) + 8 * (i >> 2) + 4 * hh; const size_t row = (size_t)c * 128 + p;
                        const float mixed = acc[d][i] + bs[i];
                        const float ug = __uint_as_float((unsigned)ugv[d][i] << 16);
                        CC[row * 1024 + 512 + col] = (bf16)(cvt_pk_bf16(ug * mixed, 0.f) & 0xffffu); } }
            }
            __syncthreads();
        }
    }
}

__global__ void __launch_bounds__(512, 2) fwd_megakernel(Args A) {
    extern __shared__ __attribute__((aligned(16))) unsigned char smem[];
    LAS unsigned char* lds = (LAS unsigned char*)smem;
    const int wave0 = __builtin_amdgcn_readfirstlane((int)threadIdx.x >> 6);
    unsigned* const bar = (unsigned*)(A.ws + WS_BAR);
    volatile LAS unsigned* const barst = (volatile LAS unsigned*)(lds + LDS_BARST);
    const unsigned xcc = xb_xcc_id();
    if (wave0 == 0) { const int l0 = fresh_lane(); if (l0 < 2) barst[l0] = 0u; if (l0 == 0 && A.ph_hi - A.ph_lo > 1) (void)xb_add(&bar[XB_XCNT(xcc)], 1u); }
    __syncthreads();
    if (A.ph_lo < 0) cg::this_grid().sync();
    bool dup_done = false; (void)dup_done;
    for (int ph = A.ph_lo; ph < A.ph_hi; ++ph) {
        const int wave = wave0;
#define LANE fresh_lane()
#define TID (wave * 64 + fresh_lane())
        unsigned char* ws = A.ws; asm volatile("" : "+s"(ws));
        if (ph == 0) phase_prologue(A, lds, wave);
        else if (ph == 1) phase_pre(A, lds, LANE, wave);
        else {
            const int l = (ph - 2) / 9, k = (ph - 2) % 9;
            const int G = gridDim.x, bid = blockIdx.x;
            if (k == 0) {
                pg8::Gemm g{(const bf16*)(ws + WS_H), (const bf16*)(ws + WS_WIN) + (size_t)l * 2048 * 1024, NTOK, 2048, 1024}; pg8::StaticOrder S; S.init(NTOK, 2048, G, bid);
                EpiB16<0> E{(bf16*)(ws + WS_Z), INC, INC}; pg8::gemm_phase<EpiB16<0>, pg8::StaticOrder, true>(lds, g, S, E, TID);
            } else if (k == 1) phase_split(A, l, LANE, wave);
            else if (k == 2) {
                { pg8::Gemm g{(const bf16*)(ws + WS_QN), (const bf16*)(ws + WS_WUQ) + (size_t)l * 768 * 384, NTOK, 768, 384}; pg8::StaticOrder S; S.init(NTOK, 768, G, bid);
                  EpiB16<0> E{(bf16*)(ws + WS_Q), 768, 768}; pg8::gemm_phase<EpiB16<0>, pg8::StaticOrder, false>(lds, g, S, E, TID); }
                { pg8::Gemm g{(const bf16*)(ws + WS_CKVN), (const bf16*)(ws + WS_WUKV) + (size_t)l * 1024 * 256, NROWKV, 1024, 256}; pg8::StaticOrder S; S.init(NROWKV, 1024, G, (bid + G - 144 % G) % G);
                  EpiKV E{(bf16*)(ws + WS_KNOPE), (bf16*)(ws + WS_VTP), (bf16*)(ws + WS_VTS)}; pg8::gemm_phase<EpiKV, pg8::StaticOrder, false>(lds, g, S, E, TID); }
            } else if (k == 3) phase_mixer(A, l, lds, LANE, wave);
            else if (k == 4 || k == 7) {
                const bool o = (k == 4);
                pg8::Gemm g{(const bf16*)(ws + (o ? WS_CONCAT : WS_ACT)), o ? (const bf16*)(ws + WS_WOUT) + (size_t)l * 1024 * 1024 : (const bf16*)(ws + WS_WFF2) + (size_t)l * 1024 * 4096, NTOK, 1024, o ? 1024 : 4096};
                pg8::StaticOrder S; S.init(NTOK, 1024, G, bid);
                EpiB16<0> E{(bf16*)(ws + WS_MIX), 1024, 1024}; pg8::gemm_phase<EpiB16<0>, pg8::StaticOrder, true>(lds, g, S, E, TID);
                if (!o && l + 1 < DEPTH) { const int first = G > 192 ? 192 : 0;
                    if (bid >= first) convert_layer(A, lds, l + 1, (bid - first) * 8 + wave, (G - first) * 8, wave, LANE); }
            } else if (k == 5) phase_post(A, l, 0, lds, LANE, wave);
            else if (k == 6) {
                pg8::Gemm g{(const bf16*)(ws + WS_H), (const bf16*)(ws + WS_WFF1) + (size_t)l * 4096 * 1024, NTOK, 4096, 1024}; pg8::StaticOrder S; S.init(NTOK, 4096, G, bid);
                EpiB16<1> E{(bf16*)(ws + WS_ACT), 4096, 4096}; pg8::gemm_phase<EpiB16<1>, pg8::StaticOrder, true>(lds, g, S, E, TID);
            } else phase_post(A, l, 1, lds, LANE, wave);
        }
        if (ph + 1 < A.ph_hi) xcd_barrier(bar, xcc, barst, wave == 0 && fresh_lane() == 0);
#if PROBE_DUP >= 0
        {
            bool again = false;
            if (PROBE_DUP == 100) { if (ph + 1 < A.ph_hi) xcd_barrier(bar, xcc, barst, wave == 0 && fresh_lane() == 0); }
            else if (!dup_done) {
                const int kk = ph >= 2 ? (ph - 2) % 9 : -1;
                if (PROBE_DUP == 50) again = (ph == 0);
                else if (PROBE_DUP == 60) again = (kk == 0 || kk == 2 || kk == 4 || kk == 6 || kk == 7);
                else again = (kk == PROBE_DUP);
            }
            if (again) { dup_done = true; --ph; } else dup_done = false;
        }
#endif
    }
}

constexpr int N_PHASES = 2 + 9 * DEPTH;

extern "C" void kernel_launch(void* const* d_in, const int* in_sizes, int n_in, void* d_out, int out_size, void* d_ws, size_t ws_size, hipStream_t stream) {
    static int grid = 0;
    if (grid == 0) {
        if (n_in != 24 || ws_size < WS_END || in_sizes[9] != DEPTH * 1024 * INC) { fprintf(stderr, "kernel_launch: unexpected problem (n_in %d, ws %zu, w_in %d)\n", n_in, ws_size, n_in > 9 ? in_sizes[9] : -1); grid = -1; return; }
        int dev = 0, cus = 0, per_cu = 0;
        hipGetDevice(&dev); hipDeviceGetAttribute(&cus, hipDeviceAttributeMultiprocessorCount, dev);
        if (hipFuncSetAttribute((const void*)fwd_megakernel, hipFuncAttributeMaxDynamicSharedMemorySize, LDS_BYTES) != hipSuccess) { fprintf(stderr, "kernel_launch: hipFuncSetAttribute failed\n"); grid = -1; return; }
        if (hipOccupancyMaxActiveBlocksPerMultiprocessor(&per_cu, (const void*)fwd_megakernel, 512, LDS_BYTES) != hipSuccess || per_cu < 1) { fprintf(stderr, "kernel_launch: occupancy query says %d\n", per_cu); per_cu = 1; }
        (void)hipGetLastError();
        grid = cus * 1;
        fprintf(stderr, "kernel_launch: grid %d (cus %d, per_cu %d)\n", grid, cus, per_cu);
    }
    if (grid < 0) return;
    if (hipMemsetAsync((char*)d_ws + WS_BAR, 0, 16384, stream) != hipSuccess) { fprintf(stderr, "kernel_launch: memset failed\n"); return; }
    Args a{};
    const float** ap = (const float**)&a;
    for (int i = 0; i < 24; ++i) ap[i] = (const float*)d_in[i];
    a.out = (float*)d_out; a.ws = (unsigned char*)d_ws;
#if MK_PER_PHASE
    for (int ph = 0; ph < N_PHASES; ++ph) { a.ph_lo = ph; a.ph_hi = ph + 1; hipLaunchKernelGGL(fwd_megakernel, dim3(grid), dim3(512), LDS_BYTES, stream, a); }
#else
    a.ph_lo = 0; a.ph_hi = N_PHASES;
    void* args[] = {&a};
    hipError_t e = hipLaunchCooperativeKernel((const void*)fwd_megakernel, dim3(grid), dim3(512), args, LDS_BYTES, stream);
    if (e != hipSuccess) fprintf(stderr, "kernel_launch: cooperative launch failed: %s (grid %d)\n", hipGetErrorString(e), grid);
#endif
}
```

```cpp
#include <hip/hip_runtime.h>
#include <hip/hip_cooperative_groups.h>
#include <cstdio>
namespace cg = cooperative_groups;

#ifndef MK_PER_PHASE
#define MK_PER_PHASE 0
#endif

#ifndef PROBE_DUP
#define PROBE_DUP -1
#endif
#define LAS __attribute__((address_space(3)))
typedef unsigned short bf16;
typedef short bf16x8 __attribute__((ext_vector_type(8)));
typedef float f32x2 __attribute__((ext_vector_type(2)));
typedef float f32x4 __attribute__((ext_vector_type(4)));
typedef float f32x16 __attribute__((ext_vector_type(16)));
typedef unsigned u32x2 __attribute__((ext_vector_type(2)));
typedef unsigned u32x4 __attribute__((ext_vector_type(4)));

constexpr int DM = 1024, NTOK_P = 8192, NTOK_S = 4096, NTOK = 12288, NROWKV = 14336;
constexpr int DEPTH = 4, INC = 1984, DFF = 4096;
constexpr int ZQ = 0, ZCKV = 384, ZKR = 640, ZU = 704, ZV = 960, ZBG = 1216, ZCG = 1472, ZHH = 1728;
constexpr float EPS = 1e-6f;
constexpr float QSCALE = 0.07216878364870322f * 1.4426950408889634f;

constexpr size_t MiB = 1u << 20;
constexpr size_t WS_MOD = 0, WS_BAR = 512 * 1024, WS_ROPE = 1 * MiB, WS_WIN = 2 * MiB, WS_WUQ = 18 * MiB, WS_WUKV = 21 * MiB, WS_WOUT = 23 * MiB,
                 WS_WFF1 = 31 * MiB, WS_WFF2 = 63 * MiB, WS_H = 95 * MiB, WS_MIX = 119 * MiB, WS_XB = 143 * MiB, WS_CONCAT = 167 * MiB, WS_QN = 191 * MiB,
                 WS_CKVN = 200 * MiB, WS_KRB = 207 * MiB, WS_UG = 209 * MiB, WS_VN = 215 * MiB, WS_Q = 221 * MiB, WS_KNOPE = 239 * MiB,
                 WS_VTP = 253 * MiB, WS_VTS = 261 * MiB, WS_Z = 267 * MiB, WS_ACT = 267 * MiB, WS_END = 363 * MiB;
constexpr int LDS_BYTES = 147456, LDS_BARST = LDS_BYTES - 64;

__device__ __forceinline__ unsigned cvt_pk_bf16(float lo, float hi) { unsigned r; asm volatile("v_cvt_pk_bf16_f32 %0, %1, %2" : "=v"(r) : "v"(lo), "v"(hi)); return r; }
__device__ __forceinline__ int fresh_lane() { int l; asm volatile("v_mbcnt_lo_u32_b32 %0, -1, 0\n\tv_mbcnt_hi_u32_b32 %0, -1, %0" : "=v"(l)); return l; }
__device__ __forceinline__ float shx(float v, int mask, int lane) { return __int_as_float(__builtin_amdgcn_ds_bpermute((lane ^ mask) << 2, __float_as_int(v))); }
__device__ __forceinline__ float dpp_add(float v, const int ctrl_is) {
    return v; }
#define DPP_ADD(v, ctrl) ((v) + __int_as_float(__builtin_amdgcn_update_dpp(0, __float_as_int(v), (ctrl), 0xf, 0xf, true)))
__device__ __forceinline__ float wave_sum(float v, int lane) {
    (void)lane;
    v = DPP_ADD(v, 0xB1);
    v = DPP_ADD(v, 0x4E);
    v = DPP_ADD(v, 0x141);
    v = DPP_ADD(v, 0x140);
    const int vi = __float_as_int(v);
    return (__int_as_float(__builtin_amdgcn_readlane(vi, 0)) + __int_as_float(__builtin_amdgcn_readlane(vi, 16))) + (__int_as_float(__builtin_amdgcn_readlane(vi, 32)) + __int_as_float(__builtin_amdgcn_readlane(vi, 48)));
}
__device__ __forceinline__ float gelu_tanh(float x) { const float y = 0.7978845608028654f * (x + 0.044715f * x * x * x); return x / (1.0f + __expf(-2.0f * y)); }
__device__ __forceinline__ f32x4 gelu4(f32x4 v) { return (f32x4){gelu_tanh(v.x), gelu_tanh(v.y), gelu_tanh(v.z), gelu_tanh(v.w)}; }
__device__ __forceinline__ float sumsq4(f32x4 v) { return (v.x * v.x + v.y * v.y) + (v.z * v.z + v.w * v.w); }
__device__ __forceinline__ f32x4 bf4(u32x2 w) { return (f32x4){__uint_as_float(w.x << 16), __uint_as_float(w.x & 0xffff0000u), __uint_as_float(w.y << 16), __uint_as_float(w.y & 0xffff0000u)}; }
__device__ __forceinline__ f32x4 ld4bf_nt(const bf16* p) { const u32x2 w = __builtin_nontemporal_load((const u32x2*)p); return (f32x4){__uint_as_float(w.x << 16), __uint_as_float(w.x & 0xffff0000u), __uint_as_float(w.y << 16), __uint_as_float(w.y & 0xffff0000u)}; }
__device__ __forceinline__ f32x4 ld4bf(const bf16* p) { const u32x2 w = *(const u32x2*)p; return (f32x4){__uint_as_float(w.x << 16), __uint_as_float(w.x & 0xffff0000u), __uint_as_float(w.y << 16), __uint_as_float(w.y & 0xffff0000u)}; }
__device__ __forceinline__ f32x2 ld2bf(const bf16* p) { const unsigned w = *(const unsigned*)p; return (f32x2){__uint_as_float(w << 16), __uint_as_float(w & 0xffff0000u)}; }
__device__ __forceinline__ float ld1bf(const bf16* p) { return __uint_as_float((unsigned)*p << 16); }
__device__ __forceinline__ u32x2 pk4(f32x4 v) { u32x2 w; w.x = cvt_pk_bf16(v.x, v.y); w.y = cvt_pk_bf16(v.z, v.w); return w; }


#define XB_TMO      128
#define XB_XCNT(j)  (256  + 64 * (j))
#define XB_XSUB(j)  (1280 + 64 * (j))
#define XB_XGEN(j)  (2304 + 64 * (j))
#define XB_TOP      3328
#define XB_TOPGEN   3392
#define XCD_BAR_WORDS 3456
#define XB_SPIN_CAP (1u << 18)
__device__ __forceinline__ unsigned xb_ld(unsigned* p)              { return __hip_atomic_load(p, __ATOMIC_RELAXED, __HIP_MEMORY_SCOPE_AGENT); }
__device__ __forceinline__ unsigned xb_add(unsigned* p, unsigned v) { return __hip_atomic_fetch_add(p, v, __ATOMIC_RELAXED, __HIP_MEMORY_SCOPE_AGENT); }
__device__ __forceinline__ unsigned xb_xcc_id() { return (unsigned)__builtin_amdgcn_s_getreg((3 << 11) | 20) & 0xFu; }
#define XB_SPIN(cond, bar) do { unsigned _sp = 0; while (cond) { __builtin_amdgcn_s_sleep(1); \
    if ((++_sp & 255u) == 0u) { if (xb_ld(&(bar)[XB_TMO])) break; if (_sp > XB_SPIN_CAP) { atomicAdd(&(bar)[XB_TMO], 1u); break; } } } } while (0)
__device__ __forceinline__ void xcd_barrier_complete(unsigned* bar, unsigned x, unsigned& nloc, unsigned& nx) {
    const unsigned G = gridDim.x * gridDim.y * gridDim.z;
    unsigned sum, cnt, mine, sp = 0u;
    for (;;) {
        sum = 0u; cnt = 0u; mine = 0u;
#pragma unroll
        for (unsigned j = 0; j < 16; ++j) { const unsigned c = xb_ld(&bar[XB_XCNT(j)]); sum += c; cnt += (c > 0u) ? 1u : 0u; mine = (j == x) ? c : mine; }
        if (sum == G) break;
        __builtin_amdgcn_s_sleep(1);
        if ((++sp & 255u) == 0u) { if (xb_ld(&bar[XB_TMO])) break; if (sp > XB_SPIN_CAP) { atomicAdd(&bar[XB_TMO], 1u); break; } }
    }
    nloc = mine > 0u ? mine : 1u; nx = cnt > 0u ? cnt : 1u;
}
__device__ __forceinline__ void xcd_barrier(unsigned* bar, unsigned x, volatile LAS unsigned* st, bool leader) {
    asm volatile("s_waitcnt vmcnt(0)" ::: "memory");
    __syncthreads();
    if (leader) {
        __builtin_amdgcn_s_waitcnt(0);
        unsigned nloc = st[0], nx = st[1];
        if (nloc == 0u) { xcd_barrier_complete(bar, x, nloc, nx); st[0] = nloc; st[1] = nx; }
        const unsigned old = xb_add(&bar[XB_XSUB(x)], 1u);
        const unsigned gen = old / nloc;
        if (old + 1u == (gen + 1u) * nloc) {
            __builtin_amdgcn_fence(__ATOMIC_RELEASE, "agent");
            asm volatile("s_waitcnt vmcnt(0)" ::: "memory");
            const unsigned og = xb_add(&bar[XB_TOP], 1u);
            const unsigned tg = og / nx;
            if (og + 1u == (tg + 1u) * nx) xb_add(&bar[XB_TOPGEN], 1u);
            else XB_SPIN(xb_ld(&bar[XB_TOPGEN]) == tg, bar);
            __builtin_amdgcn_fence(__ATOMIC_ACQUIRE, "agent");
            xb_add(&bar[XB_XGEN(x)], 1u);
            asm volatile("s_waitcnt vmcnt(0)" ::: "memory");
        } else {
            XB_SPIN(xb_ld(&bar[XB_XGEN(x)]) == gen, bar);
            __builtin_amdgcn_fence(__ATOMIC_ACQUIRE, "agent");
            asm volatile("s_waitcnt vmcnt(0)" ::: "memory");
        }
    }
    __syncthreads();
}

namespace pg8 {
#define PG8_LAS __attribute__((address_space(3)))
typedef unsigned short bf16_t;
constexpr int BM = 256, BK = 64, HALF = 128, HTB = HALF * BK * 2, STAGE_BYTES = 8 * HTB, NXCD = 8, WGM = 8;
__host__ __device__ __forceinline__ int lds_byte(int r, int c) { const int st = (r >> 4) * 2 + (c >> 5), rr = r & 15, cc = c & 31, ob = rr * 64 + cc * 2; return st * 1024 + (ob ^ (((ob >> 9) & 1) << 5)); }
__host__ __device__ __forceinline__ void stage_rc(int b, int& R, int& C) { const int st = b / 1024, sb = b % 1024, swz = sb ^ (((sb >> 9) & 1) << 5); R = (st >> 1) * 16 + swz / 64; C = (st & 1) * 32 + (swz % 64) / 2; }
__host__ __device__ __forceinline__ int perm32(int rho) { const int n = rho >> 4, i = rho & 15; return 8 * (i >> 2) + 4 * n + (i & 3); }
struct Unit { int pm, pn; };
struct Gemm { const bf16_t* A; const bf16_t* Bt; int M, N, K; };
struct StaticOrder {
    int nM, nN, nwg, G, c;
    __host__ __device__ void init(int M, int N, int G_, int c_) { nM = M / BM; nN = N / BM; nwg = nM * nN; G = G_; c = c_; }
    __host__ __device__ bool next(int i, Unit& u) const {
        const long L = (long)i * G + c; if (L >= nwg) return false;
        int wgid = (int)L; { const int q = nwg / NXCD, r = nwg % NXCD, xcd = wgid % NXCD, off = wgid / NXCD; wgid = (xcd < r ? xcd * (q + 1) : r * (q + 1) + (xcd - r) * q) + off; }
        const int nig = WGM * nN, gid = wgid / nig, fm = gid * WGM, gsz = (nM - fm) < WGM ? (nM - fm) : WGM;
        u.pm = fm + ((wgid % nig) % gsz); u.pn = (wgid % nig) / gsz; return true;
    }
    __device__ __forceinline__ void a_ready(const Unit&) const {}
    __device__ __forceinline__ void done(const Unit&) const {}
};

template <class Epi, class Sched, bool SP2>
__device__ __forceinline__ void gemm_phase(PG8_LAS unsigned char* lds, const Gemm g, const Sched& S, const Epi& E, const int tid) {
    const int wid = __builtin_amdgcn_readfirstlane(tid >> 6), lane = tid & 63, wr = wid >> 2, wc = wid & 3, fr = lane & 15, fq = lane >> 4;
    const int K = g.K, nt = K / BK;
    unsigned voffA[2], voffB[2];
#pragma unroll
    for (int i = 0; i < 2; ++i) { int R, C; stage_rc(tid * 16 + i * 8192, R, C); const int Rb = Epi::PERM ? ((R & ~31) + perm32(R & 31)) : R;
        voffA[i] = (unsigned)(R * K + C) * 2u; voffB[i] = (unsigned)(Rb * K + C) * 2u; }
    const size_t kstep = (size_t)(BK * 2);
    const size_t hstep = (size_t)HALF * K * 2;
    const size_t tstep = 2 * hstep;
    const unsigned ldsw = (unsigned)wid * 1024u;
    const int aoff = lds_byte(wr * 64 + fr, fq * 8), boff = lds_byte(wc * 32 + fr, fq * 8);
#define PG8_SA(b, h) (((b) * 2 + (h)) * HTB)
#define PG8_SB(b, h) ((4 + (b) * 2 + (h)) * HTB)
#define PG8_STAGE(bufoff, gbase, voff) do { _Pragma("unroll") for (int _i = 0; _i < 2; ++_i) \
        __builtin_amdgcn_global_load_lds((const unsigned*)((const char*)(gbase) + (voff)[_i]), (PG8_LAS unsigned*)(lds + (bufoff) + ldsw + _i * 8192), 16, 0, 0); } while (0)
#define PG8_LDA(dst, b, h) do { _Pragma("unroll") for (int m = 0; m < 4; ++m) _Pragma("unroll") for (int k = 0; k < 2; ++k) dst[m][k] = *(const PG8_LAS bf16x8*)(lds + PG8_SA(b, h) + aoff + m * 2048 + k * 1024); } while (0)
#define PG8_LDB(dst, b, h) do { _Pragma("unroll") for (int n = 0; n < 2; ++n) _Pragma("unroll") for (int k = 0; k < 2; ++k) dst[n][k] = *(const PG8_LAS bf16x8*)(lds + PG8_SB(b, h) + boff + n * 2048 + k * 1024); } while (0)
#define PG8_MMA(ai, bj, At, Bt) do { __builtin_amdgcn_s_setprio(1); _Pragma("unroll") for (int m = 0; m < 4; ++m) _Pragma("unroll") for (int n = 0; n < 2; ++n) _Pragma("unroll") for (int k = 0; k < 2; ++k) \
        acc[ai][bj][m][n] = __builtin_amdgcn_mfma_f32_16x16x32_bf16(Bt[n][k], At[m][k], acc[ai][bj][m][n], 0, 0, 0); __builtin_amdgcn_s_setprio(0); } while (0)
#define PG8_WAIT_V(n) asm volatile("s_waitcnt vmcnt(" #n ")" ::: "memory")
#define PG8_WAIT_L(n) asm volatile("s_waitcnt lgkmcnt(" #n ")" ::: "memory")
#define PG8_BAR __builtin_amdgcn_s_barrier()
#define PG8_SCHED __builtin_amdgcn_sched_barrier(0)
    Unit cur, nxt; int ui = 0;
    if (!S.next(0, cur)) return;
    f32x4 acc[2][2][4][2];
#pragma unroll
    for (int a = 0; a < 2; ++a)
#pragma unroll
        for (int b = 0; b < 2; ++b)
#pragma unroll
            for (int m = 0; m < 4; ++m)
#pragma unroll
                for (int n = 0; n < 2; ++n) acc[a][b][m][n] = (f32x4){0.f, 0.f, 0.f, 0.f};
    bf16x8 At[4][2], B0[2][2], B1[2][2];
    const char* cA = (const char*)g.A + (size_t)cur.pm * tstep; const char* cB = (const char*)g.Bt + (size_t)cur.pn * tstep;
    S.a_ready(cur);
    if constexpr (SP2) {
    PG8_STAGE(PG8_SB(0, 0), cB, voffB); PG8_STAGE(PG8_SB(0, 1), cB + hstep, voffB); PG8_STAGE(PG8_SA(0, 0), cA, voffA); PG8_STAGE(PG8_SA(0, 1), cA + hstep, voffA);
    if (wr == 1) PG8_BAR;
    PG8_WAIT_V(2); PG8_BAR;
    PG8_STAGE(PG8_SB(1, 0), cB + kstep, voffB); PG8_STAGE(PG8_SA(1, 0), cA + kstep, voffA); PG8_STAGE(PG8_SB(1, 1), cB + hstep + kstep, voffB);
    PG8_WAIT_V(6); PG8_BAR;
    } else {
    PG8_STAGE(PG8_SB(0, 0), cB, voffB); PG8_STAGE(PG8_SA(0, 0), cA, voffA); PG8_STAGE(PG8_SB(0, 1), cB + hstep, voffB); PG8_STAGE(PG8_SA(0, 1), cA + hstep, voffA);
    if (wr == 1) PG8_BAR;
    PG8_WAIT_V(4); PG8_BAR;
    PG8_STAGE(PG8_SB(1, 0), cB + kstep, voffB); PG8_STAGE(PG8_SA(1, 0), cA + kstep, voffA); PG8_STAGE(PG8_SB(1, 1), cB + hstep + kstep, voffB);
    PG8_WAIT_V(6); PG8_BAR;
    }
    for (;;) {
        const bool has_next = S.next(ui + 1, nxt);
        const char* nA = has_next ? (const char*)g.A + (size_t)nxt.pm * tstep : cA; const char* nB = has_next ? (const char*)g.Bt + (size_t)nxt.pn * tstep : cB;
        for (int t = 0; t < nt; t += 2) {
            const bool last = (t == nt - 2);
            const char* a1 = cA + (size_t)(t + 1) * kstep;
            const char* a2 = last ? nA : cA + (size_t)(t + 2) * kstep; const char* b2 = last ? nB : cB + (size_t)(t + 2) * kstep;
            const char* a3 = a2 + kstep; const char* b3 = b2 + kstep;
            if (last && has_next) S.a_ready(nxt);
            if constexpr (SP2) {
            PG8_LDB(B0, 0, 0); PG8_LDB(B1, 0, 1); PG8_SCHED; PG8_LDA(At, 0, 0); PG8_STAGE(PG8_SA(1, 1), a1 + hstep, voffA);
            PG8_WAIT_V(8); PG8_WAIT_L(0); PG8_BAR; PG8_MMA(0, 0, At, B0); PG8_MMA(0, 1, At, B1); PG8_BAR; PG8_SCHED;
            PG8_LDA(At, 0, 1); PG8_STAGE(PG8_SB(0, 0), b2, voffB); PG8_STAGE(PG8_SB(0, 1), b2 + hstep, voffB); PG8_STAGE(PG8_SA(0, 0), a2, voffA);
            PG8_WAIT_V(8); PG8_WAIT_L(0); PG8_BAR; PG8_MMA(1, 0, At, B0); PG8_MMA(1, 1, At, B1); PG8_BAR; PG8_SCHED;
            PG8_LDB(B0, 1, 0); PG8_LDB(B1, 1, 1); PG8_SCHED; PG8_LDA(At, 1, 0); PG8_STAGE(PG8_SA(0, 1), a2 + hstep, voffA);
            PG8_WAIT_V(8); PG8_WAIT_L(0); PG8_BAR; PG8_MMA(0, 0, At, B0); PG8_MMA(0, 1, At, B1); PG8_BAR; PG8_SCHED;
            PG8_LDA(At, 1, 1); PG8_STAGE(PG8_SB(1, 0), b3, voffB); PG8_STAGE(PG8_SB(1, 1), b3 + hstep, voffB); PG8_STAGE(PG8_SA(1, 0), a3, voffA);
            PG8_WAIT_V(8); PG8_WAIT_L(0); PG8_BAR; PG8_MMA(1, 0, At, B0); PG8_MMA(1, 1, At, B1); PG8_BAR; PG8_SCHED;
            } else {
            PG8_LDB(B0, 0, 0); PG8_SCHED; PG8_LDA(At, 0, 0); PG8_STAGE(PG8_SA(1, 1), a1 + hstep, voffA);
            PG8_WAIT_L(8); PG8_BAR; PG8_WAIT_L(0); PG8_MMA(0, 0, At, B0); PG8_BAR; PG8_SCHED;
            PG8_LDB(B1, 0, 1); PG8_STAGE(PG8_SB(0, 0), b2, voffB);
            PG8_BAR; PG8_WAIT_L(0); PG8_MMA(0, 1, At, B1); PG8_BAR;
            PG8_LDA(At, 0, 1); PG8_STAGE(PG8_SA(0, 0), a2, voffA);
            PG8_BAR; PG8_WAIT_L(0); PG8_MMA(1, 0, At, B0); PG8_BAR; PG8_SCHED;
            PG8_STAGE(PG8_SB(0, 1), b2 + hstep, voffB);
            PG8_WAIT_V(6); PG8_BAR; PG8_MMA(1, 1, At, B1); PG8_BAR;
            PG8_LDB(B0, 1, 0); PG8_SCHED; PG8_LDA(At, 1, 0); PG8_STAGE(PG8_SA(0, 1), a2 + hstep, voffA);
            PG8_WAIT_L(8); PG8_BAR; PG8_WAIT_L(0); PG8_MMA(0, 0, At, B0); PG8_BAR; PG8_SCHED;
            PG8_LDB(B1, 1, 1); PG8_STAGE(PG8_SB(1, 0), b3, voffB);
            PG8_BAR; PG8_WAIT_L(0); PG8_MMA(0, 1, At, B1); PG8_BAR;
            PG8_LDA(At, 1, 1); PG8_STAGE(PG8_SA(1, 0), a3, voffA);
            PG8_BAR; PG8_WAIT_L(0); PG8_MMA(1, 0, At, B0); PG8_BAR; PG8_SCHED;
            PG8_STAGE(PG8_SB(1, 1), b3 + hstep, voffB);
            PG8_WAIT_V(6); PG8_BAR; PG8_MMA(1, 1, At, B1); PG8_BAR;
            }
        }
        if (wr == 0) PG8_BAR;
        E(acc, cur, wr, wc, fr, fq); S.done(cur);
        if (!has_next) break;
#pragma unroll
        for (int a = 0; a < 2; ++a)
#pragma unroll
            for (int b = 0; b < 2; ++b)
#pragma unroll
                for (int m = 0; m < 4; ++m)
#pragma unroll
                    for (int n = 0; n < 2; ++n) acc[a][b][m][n] = (f32x4){0.f, 0.f, 0.f, 0.f};
        cur = nxt; cA = nA; cB = nB; ++ui;
        if (wr == 1) PG8_BAR;
    }
    PG8_WAIT_V(0);
    PG8_BAR;
#undef PG8_SA
#undef PG8_SB
#undef PG8_STAGE
#undef PG8_LDA
#undef PG8_LDB
#undef PG8_MMA
#undef PG8_WAIT_V
#undef PG8_WAIT_L
#undef PG8_BAR
#undef PG8_SCHED
}
}

struct EpiF32 {
    static constexpr bool PERM = false;
    float* C; int ldc; int ncols;
    __device__ __forceinline__ void operator()(const f32x4 (&acc)[2][2][4][2], const pg8::Unit& u, int wr, int wc, int fr, int fq) const {
        const int row0 = u.pm * 256 + wr * 64 + fr, col0 = u.pn * 256 + wc * 32 + 4 * fq;
#pragma unroll
        for (int ai = 0; ai < 2; ++ai)
#pragma unroll
            for (int m = 0; m < 4; ++m) { float* rowp = C + (size_t)(row0 + ai * 128 + m * 16) * ldc + col0;
#pragma unroll
                for (int bj = 0; bj < 2; ++bj)
#pragma unroll
                    for (int n = 0; n < 2; ++n) if (col0 + bj * 128 + n * 16 < ncols) *(f32x4*)(rowp + bj * 128 + n * 16) = acc[ai][bj][m][n]; }
    }
};
template <int ACT> struct EpiB16 {
    static constexpr bool PERM = true;
    bf16* O; int ldc; int ncols;
    __device__ __forceinline__ void operator()(const f32x4 (&acc)[2][2][4][2], const pg8::Unit& u, int wr, int wc, int, int) const {
        const int ln = fresh_lane(), fr = ln & 15, fq = ln >> 4;
        const int row0 = u.pm * 256 + wr * 64 + fr, col0 = u.pn * 256 + wc * 32 + 8 * fq;
#pragma unroll
        for (int ai = 0; ai < 2; ++ai)
#pragma unroll
            for (int m = 0; m < 4; ++m) { bf16* rowp = O + (size_t)(row0 + ai * 128 + m * 16) * ldc + col0;
#pragma unroll
                for (int bj = 0; bj < 2; ++bj) { f32x4 v0 = acc[ai][bj][m][0], v1 = acc[ai][bj][m][1];
                    if (col0 + bj * 128 >= ncols) continue;
                    if (ACT) {
#pragma unroll
                    for (int j = 0; j < 4; ++j) { const float a = fmaxf(v0[j], 0.f), b = fmaxf(v1[j], 0.f); v0[j] = a * a; v1[j] = b * b; } }
                    u32x4 w; w.x = cvt_pk_bf16(v0[0], v0[1]); w.y = cvt_pk_bf16(v0[2], v0[3]); w.z = cvt_pk_bf16(v1[0], v1[1]); w.w = cvt_pk_bf16(v1[2], v1[3]);
                    *(u32x4*)(rowp + bj * 128) = w; } }
    }
};
struct EpiQ {
    static constexpr bool PERM = false;
    bf16* Q; const float* ropec; const float* ropes;
    __device__ __forceinline__ void operator()(const f32x4 (&acc)[2][2][4][2], const pg8::Unit& u, int wr, int wc, int, int) const {
        const int ln = fresh_lane(), fr = ln & 15, fq = ln >> 4;
        const int row0 = u.pm * 256 + wr * 64 + fr; const bool sample = u.pm >= 32;
#pragma unroll
        for (int bj = 0; bj < 2; ++bj) {
            const int g0 = u.pn * 256 + bj * 128 + wc * 32, within0 = g0 % 192; const bool isrope = within0 >= 128; const int a = (within0 - 128) >> 5;
#pragma unroll
            for (int ai = 0; ai < 2; ++ai)
#pragma unroll
                for (int m = 0; m < 4; ++m) { const int row = row0 + ai * 128 + m * 16;
                    f32x4 x1 = acc[ai][bj][m][0], x2 = acc[ai][bj][m][1];
                    if (sample && isrope) { const int ntok = (row - NTOK_P) & 1023;
                        const f32x4 cs = *(const f32x4*)(ropec + ntok * 32 + a * 16 + 4 * fq), sn = *(const f32x4*)(ropes + ntok * 32 + a * 16 + 4 * fq);
                        const f32x4 o1 = x1 * cs - x2 * sn, o2 = x1 * sn + x2 * cs; x1 = o1; x2 = o2; }
                    x1 = x1 * QSCALE; x2 = x2 * QSCALE;
                    bf16* p = Q + (size_t)row * 768 + g0 + 4 * fq;
                    *(u32x2*)p = pk4(x1); *(u32x2*)(p + 16) = pk4(x2); asm volatile("" ::: "memory"); }
        }
    }
};
struct EpiKV {
    static constexpr bool PERM = false;
    bf16* KN; bf16* VTP; bf16* VTS;
    __device__ __forceinline__ void operator()(const f32x4 (&acc)[2][2][4][2], const pg8::Unit& u, int wr, int wc, int, int) const {
        const int ln = fresh_lane(), fr = ln & 15, fq = ln >> 4;
        const int h = u.pn, pm = u.pm;
        bf16* vt; int keys, keybase;
        if (pm < 32) { vt = VTP + (size_t)((pm * 4 + h) * 128) * 256; keys = 256; keybase = 0; }
        else if (pm < 48) { const int b = (pm - 32) >> 2; vt = VTS + (size_t)((b * 4 + h) * 128) * 1536; keys = 1536; keybase = 512 + ((pm - 32) & 3) * 256; }
        else { const int b = (pm - 48) >> 1; vt = VTS + (size_t)((b * 4 + h) * 128) * 1536; keys = 1536; keybase = ((pm - 48) & 1) * 256; }
#pragma unroll
        for (int ai = 0; ai < 2; ++ai)
#pragma unroll
            for (int m = 0; m < 4; ++m) { const int rloc = wr * 64 + fr + ai * 128 + m * 16;
                bf16* kp = KN + (size_t)(pm * 256 + rloc) * 512 + h * 128 + wc * 32 + 4 * fq;
#pragma unroll
                for (int n = 0; n < 2; ++n) *(u32x2*)(kp + 16 * n) = pk4(acc[ai][0][m][n]);
#pragma unroll
                for (int n = 0; n < 2; ++n) { const f32x4 v = acc[ai][1][m][n]; const u32x2 w = pk4(v);
                    bf16* vp = vt + (size_t)(wc * 32 + 16 * n + 4 * fq) * keys + keybase + rloc;
                    vp[0] = (bf16)(w.x & 0xffffu); vp[keys] = (bf16)(w.x >> 16); vp[2 * keys] = (bf16)(w.y & 0xffffu); vp[3 * keys] = (bf16)(w.y >> 16); }
                asm volatile("" ::: "memory");
            }
    }
};

struct Args {
    const float *x_prompt, *x_sample, *cache_ckv, *cache_krope, *c, *c_ctx, *w_ada, *b_ada, *g_pre_mix, *w_in, *g_q, *w_uq, *g_kv, *w_ukv,
                *g_v, *w_s, *b_s, *w_conv, *w_out, *g_post_mix, *g_pre_ffn, *w_ff1, *w_ff2, *g_post_ffn;
    float* out; unsigned char* ws; int ph_lo, ph_hi;
};

__device__ __forceinline__ void p0_transpose_item(const float* W, int K, int N, bf16* WT, LAS float* scr, int item, int lane, float scale = 1.0f) {
    const int nblk = N / 32, kb = item / nblk, nb = item % nblk, k0 = 64 * kb, n0 = 32 * nb;
#pragma unroll 8
    for (int i = 0; i < 32; ++i) { const int kk = 2 * i + (lane >> 5); scr[kk * 33 + (lane & 31)] = W[(size_t)(k0 + kk) * N + n0 + (lane & 31)]; }
    asm volatile("s_waitcnt lgkmcnt(0)" ::: "memory");
    const int c = lane & 7;
#pragma unroll
    for (int j = 0; j < 4; ++j) { const int n = (lane >> 3) + 8 * j; const LAS float* s = scr + (8 * c) * 33 + n;
        u32x4 o; o.x = cvt_pk_bf16(s[0 * 33] * scale, s[1 * 33] * scale); o.y = cvt_pk_bf16(s[2 * 33] * scale, s[3 * 33] * scale); o.z = cvt_pk_bf16(s[4 * 33] * scale, s[5 * 33] * scale); o.w = cvt_pk_bf16(s[6 * 33] * scale, s[7 * 33] * scale);
        *(u32x4*)(WT + (size_t)(n0 + n) * K + k0 + 8 * c) = o; }
    asm volatile("s_waitcnt lgkmcnt(0)" ::: "memory");
}

__device__ __forceinline__ void convert_layer(const Args& A, LAS unsigned char* lds, int l, int gwi, int nw, int wave, int lane) {
    unsigned char* ws = A.ws;
    LAS float* scr = (LAS float*)(lds + wave * 16384);
    constexpr int I_IN = 16 * 62, I_UQ = 6 * 24, I_UKV = 4 * 32, I_OUT = 16 * 32, I_F1 = 16 * 128, I_F2 = 64 * 32, I_L = I_IN + I_UQ + I_UKV + I_OUT + I_F1 + I_F2;
    for (int it = gwi; it < I_L; it += nw) {
        int r = it;
        if (r < I_IN) { p0_transpose_item(A.w_in + (size_t)l * 1024 * INC, 1024, INC, (bf16*)(ws + WS_WIN) + (size_t)l * 2048 * 1024, scr, r, lane); continue; } r -= I_IN;
        if (r < I_UQ) { p0_transpose_item(A.w_uq + (size_t)l * 384 * 768, 384, 768, (bf16*)(ws + WS_WUQ) + (size_t)l * 768 * 384, scr, r, lane, QSCALE); continue; } r -= I_UQ;
        if (r < I_UKV) { p0_transpose_item(A.w_ukv + (size_t)l * 256 * 1024, 256, 1024, (bf16*)(ws + WS_WUKV) + (size_t)l * 1024 * 256, scr, r, lane); continue; } r -= I_UKV;
        if (r < I_OUT) { p0_transpose_item(A.w_out + (size_t)l * 1024 * 1024, 1024, 1024, (bf16*)(ws + WS_WOUT) + (size_t)l * 1024 * 1024, scr, r, lane); continue; } r -= I_OUT;
        if (r < I_F1) { p0_transpose_item(A.w_ff1 + (size_t)l * 1024 * 4096, 1024, 4096, (bf16*)(ws + WS_WFF1) + (size_t)l * 4096 * 1024, scr, r, lane); continue; } r -= I_F1;
        p0_transpose_item(A.w_ff2 + (size_t)l * 4096 * 1024, 4096, 1024, (bf16*)(ws + WS_WFF2) + (size_t)l * 1024 * 4096, scr, r, lane);
    }
}

__device__ __forceinline__ void phase_prologue(const Args& A, LAS unsigned char* lds, int wave) {
    const int lane = fresh_lane(), tid = wave * 64 + lane;
    unsigned char* ws = A.ws;
    const int bid = blockIdx.x, G = gridDim.x;
    { const int gt = bid * 512 + tid;
      if (gt < 32768) { const int n = gt >> 5, a = (gt >> 4) & 1, f = gt & 15; const int pos = a == 0 ? (n >> 6) : (n & 63);
          double inv = 1.0; for (int i = 0; i < f; ++i) inv *= 0.5623413251903491;
          double rev = (double)pos * inv * 0.15915494309189535; rev -= floor(rev);
          const float rf = (float)rev;
          ((float*)(ws + WS_ROPE))[gt] = __builtin_amdgcn_cosf(rf); ((float*)(ws + WS_ROPE))[32768 + gt] = __builtin_amdgcn_sinf(rf); } }
    for (int it = bid; it < 192; it += G) {
        const int l = it / 48, cgp = it % 48;
        LAS float* sl = (LAS float*)lds;
        for (int i = tid; i < 5120; i += 512) { const int ci = i >> 10, k = i & 1023; const float v = ci == 0 ? A.c_ctx[k] : A.c[(ci - 1) * 1024 + k]; sl[i] = v / (1.0f + __expf(-v)); }
        __syncthreads();
        float a0[5], a1[5];
#pragma unroll
        for (int ci = 0; ci < 5; ++ci) { a0[ci] = 0.f; a1[ci] = 0.f; }
        const float* wp = A.w_ada + ((size_t)l * 1024 + wave * 128) * 6144 + cgp * 128 + 2 * lane;
#pragma unroll 8
        for (int kk = 0; kk < 128; ++kk) { const f32x2 wv = *(const f32x2*)(wp + (size_t)kk * 6144); const int k = wave * 128 + kk;
#pragma unroll
            for (int ci = 0; ci < 5; ++ci) { const float s = sl[ci * 1024 + k]; a0[ci] += s * wv.x; a1[ci] += s * wv.y; } }
        LAS float* part = (LAS float*)(lds + 32768);
#pragma unroll
        for (int ci = 0; ci < 5; ++ci) { part[(wave * 5 + ci) * 128 + 2 * lane] = a0[ci]; part[(wave * 5 + ci) * 128 + 2 * lane + 1] = a1[ci]; }
        __syncthreads();
        for (int i = tid; i < 640; i += 512) { const int ci = i >> 7, col = i & 127; float s = 0.f;
#pragma unroll
            for (int w = 0; w < 8; ++w) s += part[(w * 5 + ci) * 128 + col];
            const int gcol = cgp * 128 + col; ((float*)(ws + WS_MOD))[(l * 5 + ci) * 6144 + gcol] = s + A.b_ada[l * 6144 + gcol]; }
        __syncthreads();
    }
    convert_layer(A, lds, 0, bid * 8 + wave, G * 8, wave, lane);
}

__device__ __forceinline__ int cond_of_row(int r) { return r < NTOK_P ? 0 : 1 + ((r - NTOK_P) >> 10); }

__device__ __forceinline__ void norm_mod_store(const f32x4 (&v)[4], const LAS float* g, const LAS float* sc, const LAS float* sh, bf16* hrow, int lane) {
    float ss = 0.f;
#pragma unroll
    for (int j = 0; j < 4; ++j) ss += sumsq4(v[j]);
    const float rstd = 1.0f / sqrtf(wave_sum(ss, lane) * (1.0f / 1024.0f) + EPS);
#pragma unroll
    for (int j = 0; j < 4; ++j) { const int idx = 4 * lane + 256 * j;
        const f32x4 gg = *(const LAS f32x4*)(g + idx), s1 = *(const LAS f32x4*)(sc + idx), s0 = *(const LAS f32x4*)(sh + idx);
        const f32x4 o = v[j] * rstd * gg * (1.0f + s1) + s0;
        *(u32x2*)(hrow + idx) = pk4(o); }
}
__device__ __forceinline__ const float* x_in_row(const Args& A, int r) { return r < NTOK_P ? A.x_prompt + (size_t)r * 1024 : A.x_sample + (size_t)(r - NTOK_P) * 1024; }
__device__ __forceinline__ void fill_vec(LAS float* dst, const float* src, int tid) { if (tid < 256) *(LAS f32x4*)(dst + 4 * tid) = *(const f32x4*)(src + 4 * tid); }

__device__ __forceinline__ void phase_pre(const Args& A, LAS unsigned char* lds, int lane, int wave) {
    const int gw = blockIdx.x * 8 + wave, NGW = gridDim.x * 8;
    const float* mod = (const float*)(A.ws + WS_MOD); bf16* H = (bf16*)(A.ws + WS_H);
    LAS float* P = (LAS float*)lds;
    { const int t2 = (wave & 3) * 64 + lane, hv = wave >> 2;
      for (int v = hv; v < 11; v += 2) { const float* src = v == 0 ? A.g_pre_mix : (v <= 5 ? mod + (size_t)(v - 1) * 6144 + 1024 : mod + (size_t)(v - 6) * 6144);
          const int slot = v == 0 ? 1 : (v <= 5 ? 7 + (v - 1) : 12 + (v - 6));
          *(LAS f32x4*)(P + slot * 1024 + 4 * t2) = *(const f32x4*)(src + 4 * t2); } }
    __syncthreads();
    for (int r0 = gw; r0 < NTOK; r0 += 2 * NGW) {
        f32x4 v[2][4];
#pragma unroll
        for (int u = 0; u < 2; ++u) { const float* xr = x_in_row(A, r0 + u * NGW);
#pragma unroll
            for (int j = 0; j < 4; ++j) v[u][j] = __builtin_nontemporal_load((const f32x4*)(xr + 4 * lane + 256 * j)); }
#pragma unroll
        for (int u = 0; u < 2; ++u) { const int r = r0 + u * NGW, ci = cond_of_row(r);
            norm_mod_store(v[u], P + 1024, P + (7 + ci) * 1024, P + (12 + ci) * 1024, H + (size_t)r * 1024, lane); }
    }
    __syncthreads();
}

__device__ __forceinline__ void phase_post(const Args& A, int l, int which, LAS unsigned char* lds, int lane, int wave) {
    const int gw = blockIdx.x * 8 + wave, NGW = gridDim.x * 8;
    const float* mod = (const float*)(A.ws + WS_MOD); bf16* H = (bf16*)(A.ws + WS_H); const bf16* MIX = (const bf16*)(A.ws + WS_MIX);
    const bool first = (l == 0 && which == 0), has_h = (which == 0) || (l < DEPTH - 1), last = (l == DEPTH - 1 && which == 1);
    bf16* XB = (bf16*)(A.ws + WS_XB);
    LAS float* P = (LAS float*)lds;
    f32x4 rxf[2][4]; u32x2 rxb[2][4], rt[2][4];
#define POST_LOAD(r0_) do { _Pragma("unroll") for (int u = 0; u < 2; ++u) { const int r_ = (r0_) + u * NGW; \
        if (first) { const float* xr_ = x_in_row(A, r_); _Pragma("unroll") for (int j = 0; j < 4; ++j) rxf[u][j] = __builtin_nontemporal_load((const f32x4*)(xr_ + 4 * lane + 256 * j)); } \
        else { const bf16* xr_ = XB + (size_t)r_ * 1024; _Pragma("unroll") for (int j = 0; j < 4; ++j) rxb[u][j] = __builtin_nontemporal_load((const u32x2*)(xr_ + 4 * lane + 256 * j)); } \
        const bf16* tr_ = MIX + (size_t)r_ * 1024; _Pragma("unroll") for (int j = 0; j < 4; ++j) rt[u][j] = __builtin_nontemporal_load((const u32x2*)(tr_ + 4 * lane + 256 * j)); } } while (0)
#pragma unroll
    for (int u = 0; u < 2; ++u)
#pragma unroll
        for (int j = 0; j < 4; ++j) { rxf[u][j] = (f32x4){0.f, 0.f, 0.f, 0.f}; rxb[u][j] = (u32x2){0u, 0u}; }
    POST_LOAD(gw);
    { const int t2 = (wave & 3) * 64 + lane, hv = wave >> 2;
      const int l2 = which == 0 ? l : l + 1;
      for (int v = hv; v < 17; v += 2) { const float* src;
          if (v == 0) src = (which == 0 ? A.g_post_mix : A.g_post_ffn) + l * 1024;
          else if (v == 1) src = which == 0 ? A.g_pre_ffn + l * 1024 : A.g_pre_mix + (l2 < DEPTH ? l2 : l) * 1024;
          else if (v < 7) src = mod + (size_t)(l * 5 + (v - 2)) * 6144 + (which == 0 ? 2048 : 5120);
          else if (v < 12) src = mod + (size_t)((l2 < DEPTH ? l2 : l) * 5 + (v - 7)) * 6144 + (which == 0 ? 4096 : 1024);
          else src = mod + (size_t)((l2 < DEPTH ? l2 : l) * 5 + (v - 12)) * 6144 + (which == 0 ? 3072 : 0);
          *(LAS f32x4*)(P + v * 1024 + 4 * t2) = *(const f32x4*)(src + 4 * t2); } }
    __syncthreads();
    for (int r0 = gw; r0 < NTOK; r0 += 2 * NGW) {
        f32x4 v[2][4], t[2][4];
#pragma unroll
        for (int u = 0; u < 2; ++u)
#pragma unroll
            for (int j = 0; j < 4; ++j) { v[u][j] = first ? rxf[u][j] : bf4(rxb[u][j]); t[u][j] = bf4(rt[u][j]); }
        if (r0 + 2 * NGW < NTOK) POST_LOAD(r0 + 2 * NGW);
#pragma unroll
        for (int u = 0; u < 2; ++u) { const int r = r0 + u * NGW; const LAS float* ga = P + (2 + cond_of_row(r)) * 1024;
            float ss = 0.f;
#pragma unroll
            for (int j = 0; j < 4; ++j) ss += sumsq4(t[u][j]);
            const float rstd = 1.0f / sqrtf(wave_sum(ss, lane) * (1.0f / 1024.0f) + EPS);
#pragma unroll
            for (int j = 0; j < 4; ++j) { const int idx = 4 * lane + 256 * j;
                const f32x4 gg = *(const LAS f32x4*)(P + idx), gv = *(const LAS f32x4*)(ga + idx);
                v[u][j] = v[u][j] + gv * (t[u][j] * rstd * gg);
                if (last) __builtin_nontemporal_store(v[u][j], (f32x4*)(A.out + (size_t)r * 1024 + idx));
                else __builtin_nontemporal_store(pk4(v[u][j]), (u32x2*)(XB + (size_t)r * 1024 + idx)); } }
        if (has_h) {
#pragma unroll
            for (int u = 0; u < 2; ++u) { const int r = r0 + u * NGW, ci = cond_of_row(r);
                norm_mod_store(v[u], P + 1024, P + (7 + ci) * 1024, P + (12 + ci) * 1024, H + (size_t)r * 1024, lane); } }
    }
    __syncthreads();
}

#undef POST_LOAD
__device__ __forceinline__ void phase_split(const Args& A, int l, int lane, int wave) {
    const int gw = blockIdx.x * 8 + wave, NGW = gridDim.x * 8;
    unsigned char* ws = A.ws;
    const bf16* Z = (const bf16*)(ws + WS_Z);
    bf16* QN = (bf16*)(ws + WS_QN); bf16* CKVN = (bf16*)(ws + WS_CKVN); bf16* KRB = (bf16*)(ws + WS_KRB); bf16* UG = (bf16*)(ws + WS_UG); bf16* VN = (bf16*)(ws + WS_VN);
    bf16* CC = (bf16*)(ws + WS_CONCAT);
    const float* ropec = (const float*)(ws + WS_ROPE); const float* ropes = ropec + 32768;
    float* out_ckv = A.out + (size_t)NTOK * 1024; float* out_kr = out_ckv + (size_t)32 * 4 * 256 * 256;
    for (int idx = gw; idx < 2048; idx += NGW) { const int r = NTOK + idx, b = idx >> 9, j = idx & 511;
        const f32x4 cv = *(const f32x4*)(A.cache_ckv + ((size_t)(b * 4 + l) * 512 + j) * 256 + 4 * lane);
        const float kv = A.cache_krope[((size_t)(b * 4 + l) * 512 + j) * 64 + lane];
        *(u32x2*)(CKVN + (size_t)r * 256 + 4 * lane) = pk4(cv);
        KRB[(size_t)r * 64 + lane] = (bf16)(cvt_pk_bf16(kv, 0.f) & 0xffffu); }
    const f32x4 gkv = *(const f32x4*)(A.g_kv + l * 256 + 4 * lane), gvv = *(const f32x4*)(A.g_v + l * 256 + 4 * lane);
    const float* wcp = A.w_conv + (size_t)l * 3 * 256 + 4 * lane;
    const f32x4 wc0 = *(const f32x4*)(wcp), wc1 = *(const f32x4*)(wcp + 256), wc2 = *(const f32x4*)(wcp + 512);
    f32x2 gq[3];
#pragma unroll
    for (int j = 0; j < 3; ++j) gq[j] = *(const f32x2*)(A.g_q + l * 384 + 2 * lane + 128 * j);
    for (int r0 = gw; r0 < NTOK; r0 += 2 * NGW) {
        f32x2 q[2][3]; f32x4 cv[2], uu[2], vv[2], bg[2], zc[2], zm[2], zp[2]; float kr[2], cs[2], sn[2];
#pragma unroll
        for (int u = 0; u < 2; ++u) { const int r = r0 + u * NGW; const bf16* z = Z + (size_t)r * INC;
            const bool prompt = r < NTOK_P; const int n = prompt ? (r & 255) : ((r - NTOK_P) & 1023), len = prompt ? 256 : 1024;
#pragma unroll
            for (int j = 0; j < 3; ++j) q[u][j] = ld2bf(z + ZQ + 2 * lane + 128 * j);
            cv[u] = ld4bf(z + ZCKV + 4 * lane); kr[u] = ld1bf(z + ZKR + lane);
            uu[u] = ld4bf(z + ZU + 4 * lane); vv[u] = ld4bf(z + ZV + 4 * lane); bg[u] = ld4bf(z + ZBG + 4 * lane);
            zc[u] = ld4bf(z + ZCG + 4 * lane) * ld4bf(z + ZHH + 4 * lane);
            zm[u] = (f32x4){0.f, 0.f, 0.f, 0.f}; zp[u] = zm[u];
            if (n > 0) zm[u] = ld4bf(z - INC + ZCG + 4 * lane) * ld4bf(z - INC + ZHH + 4 * lane);
            if (n < len - 1) zp[u] = ld4bf(z + INC + ZCG + 4 * lane) * ld4bf(z + INC + ZHH + 4 * lane);
            cs[u] = 1.f; sn[u] = 0.f;
            if (!prompt) { const int a = lane >> 5, f = lane & 15; cs[u] = ropec[n * 32 + a * 16 + f]; sn[u] = ropes[n * 32 + a * 16 + f]; } }
#pragma unroll
        for (int u = 0; u < 2; ++u) { const int r = r0 + u * NGW; const bool prompt = r < NTOK_P; const int n = prompt ? (r & 255) : ((r - NTOK_P) & 1023);
            { float ss = 0.f;
#pragma unroll
              for (int j = 0; j < 3; ++j) ss += q[u][j].x * q[u][j].x + q[u][j].y * q[u][j].y;
              const float rstd = 1.0f / sqrtf(wave_sum(ss, lane) * (1.0f / 384.0f) + EPS);
#pragma unroll
              for (int j = 0; j < 3; ++j) *(unsigned*)(QN + (size_t)r * 384 + 2 * lane + 128 * j) = cvt_pk_bf16(q[u][j].x * rstd * gq[j].x, q[u][j].y * rstd * gq[j].y); }
            { const float rstd = 1.0f / sqrtf(wave_sum(sumsq4(cv[u]), lane) * (1.0f / 256.0f) + EPS);
              const f32x4 c2 = cv[u] * rstd * gkv;
              if (prompt) __builtin_nontemporal_store(c2, (f32x4*)(out_ckv + ((size_t)((r >> 8) * 4 + l) * 256 + n) * 256 + 4 * lane));
              *(u32x2*)(CKVN + (size_t)r * 256 + 4 * lane) = pk4(c2); }
            { float k2 = kr[u];
              if (prompt) __builtin_nontemporal_store(k2, out_kr + ((size_t)((r >> 8) * 4 + l) * 256 + n) * 64 + lane);
              else { const float partner = shx(k2, 16, lane); const int p = (lane >> 4) & 1;
                  k2 = p == 0 ? k2 * cs[u] - partner * sn[u] : partner * sn[u] + k2 * cs[u]; }
              KRB[(size_t)r * 64 + lane] = (bf16)(cvt_pk_bf16(k2, 0.f) & 0xffffu); }
            *(u32x2*)(UG + (size_t)r * 256 + 4 * lane) = pk4(gelu4(uu[u]));
            { f32x4 v = gelu4(vv[u]);
              const float rstd = 1.0f / sqrtf(wave_sum(sumsq4(v), lane) * (1.0f / 256.0f) + EPS);
              *(u32x2*)(VN + (size_t)r * 256 + 4 * lane) = pk4(v * rstd * gvv); }
            { const f32x4 y = zm[u] * wc0 + zc[u] * wc1 + zp[u] * wc2;
              *(u32x2*)(CC + (size_t)r * 1024 + 768 + 4 * lane) = pk4(bg[u] * y); }
        }
    }
}

#define MFMA32(a, b, c) __builtin_amdgcn_mfma_f32_32x32x16_bf16((a), (b), (c), 0, 0, 0)
constexpr int AT_KROW = 400, AT_VROW = 144, AT_KBYTES = 64 * AT_KROW, AT_STAGE = AT_KBYTES + 128 * AT_VROW;
__device__ __forceinline__ void attn_store_tile(const f32x16& ot, float inv, bf16* crow  , int t, int hh) {
#pragma unroll
    for (int g = 0; g < 4; ++g) { u32x2 w; w.x = cvt_pk_bf16(ot[4 * g] * inv, ot[4 * g + 1] * inv); w.y = cvt_pk_bf16(ot[4 * g + 2] * inv, ot[4 * g + 3] * inv);
        *(u32x2*)(crow + 32 * t + 8 * g + 4 * hh) = w; }
}

__device__ __forceinline__ void phase_mixer(const Args& A, int l, LAS unsigned char* lds, int lane_in, int wave) {
    unsigned char* ws = A.ws;
    const bf16* Q = (const bf16*)(ws + WS_Q); const bf16* KN = (const bf16*)(ws + WS_KNOPE); const bf16* KRB = (const bf16*)(ws + WS_KRB);
    const bf16* VTP = (const bf16*)(ws + WS_VTP); const bf16* VTS = (const bf16*)(ws + WS_VTS);
    const bf16* UG = (const bf16*)(ws + WS_UG); const bf16* VN = (const bf16*)(ws + WS_VN);
    bf16* CC = (bf16*)(ws + WS_CONCAT);
    for (int slot = 0; ; ++slot) {
        int it;
        if (gridDim.x == 256) {
            if (slot == 0) it = blockIdx.x; else if (slot == 1 && blockIdx.x >= 128 && blockIdx.x < 224) it = 256 + (int)blockIdx.x - 128; else break;
        } else { it = (int)blockIdx.x + slot * (int)gridDim.x; if (it >= 352) break; }
        int lane = lane_in; asm volatile("" : "+v"(lane));
        const int rho = lane & 31, hh = lane >> 5, tid = wave * 64 + lane;
        if (it < 256) {
            int h, q0, keys, nkeys, split, rowA, rowB; const bf16* vt;
            const bool heavy = it < 128;
            if (heavy) {
                const int xj = it >> 3, pr = 2 * (it & 7) + (xj >> 3), b = pr >> 2, qt = xj & 7; h = pr & 3;
                q0 = NTOK_P + b * 1024 + qt * 128 + (wave & 3) * 32; keys = 1536; nkeys = 1536; split = 512; rowA = NTOK + b * 512; rowB = NTOK_P + b * 1024;
                vt = VTS + (size_t)((b * 4 + h) * 128) * 1536; }
            else { const int i2 = it - 128, b = i2 >> 2; h = i2 & 3; q0 = b * 256 + wave * 32; keys = 256; nkeys = 256; split = 0; rowA = 0; rowB = b * 256;
                vt = VTP + (size_t)((b * 4 + h) * 128) * 256; }
            bf16x8 qf[12];
            { const bf16* qp = Q + (size_t)(q0 + rho) * 768 + h * 192 + 8 * hh;
#pragma unroll
              for (int ks = 0; ks < 12; ++ks) qf[ks] = *(const bf16x8*)(qp + 16 * ks); }
            if (heavy) {
                const float* ropec = (const float*)(ws + WS_ROPE); const int ntok = (q0 + rho - NTOK_P) & 1023;
#pragma unroll
                for (int a = 0; a < 2; ++a) { const float* cp = ropec + ntok * 32 + a * 16 + 8 * hh;
                    const f32x4 c0 = *(const f32x4*)cp, c1 = *(const f32x4*)(cp + 4), s0 = *(const f32x4*)(cp + 32768), s1 = *(const f32x4*)(cp + 32768 + 4);
                    const u32x4 w1 = __builtin_bit_cast(u32x4, qf[8 + 2 * a]), w2 = __builtin_bit_cast(u32x4, qf[9 + 2 * a]); u32x4 r1, r2;
#pragma unroll
                    for (int j = 0; j < 4; ++j) { const float x1l = __uint_as_float(w1[j] << 16), x1h = __uint_as_float(w1[j] & 0xffff0000u), x2l = __uint_as_float(w2[j] << 16), x2h = __uint_as_float(w2[j] & 0xffff0000u);
                        const float cl = j < 2 ? c0[2 * j] : c1[2 * j - 4], ch = j < 2 ? c0[2 * j + 1] : c1[2 * j - 3], sl = j < 2 ? s0[2 * j] : s1[2 * j - 4], sh = j < 2 ? s0[2 * j + 1] : s1[2 * j - 3];
                        r1[j] = cvt_pk_bf16(x1l * cl - x2l * sl, x1h * ch - x2h * sh); r2[j] = cvt_pk_bf16(x1l * sl + x2l * cl, x1h * sh + x2h * ch); }
                    qf[8 + 2 * a] = __builtin_bit_cast(bf16x8, r1); qf[9 + 2 * a] = __builtin_bit_cast(bf16x8, r2); }
            }
            f32x16 o[4];
#pragma unroll
            for (int t = 0; t < 4; ++t)
#pragma unroll
                for (int i = 0; i < 16; ++i) o[t][i] = 0.f;
            float m = 0.f, lsum = 0.f; bool fresh = true;
            int kslot[2], kcol[2], vd[2], vc[2];
#pragma unroll
            for (int j = 0; j < 2; ++j) { const int c = tid + 512 * j, kap = c >> 4; kcol[j] = c & 15;
                kslot[j] = (kap & 32) + (kap & 3) + 4 * ((kap >> 4) & 1) + 8 * ((kap >> 2) & 3);
                vd[j] = c >> 3; vc[j] = c & 7; }
            const int rkap = tid >> 3, rc8 = tid & 7, rslot = (rkap & 32) + (rkap & 3) + 4 * ((rkap >> 4) & 1) + 8 * ((rkap >> 2) & 3);
            u32x4 sk[2], sr, sv[2];
#define AT_GLOAD(k0) do { const int rb_ = (k0) < split ? rowA + (k0) : rowB + ((k0) - split); \
                _Pragma("unroll") for (int j = 0; j < 2; ++j) sk[j] = *(const u32x4*)(KN + (size_t)(rb_ + ((tid + 512 * j) >> 4)) * 512 + h * 128 + kcol[j] * 8); \
                sr = *(const u32x4*)(KRB + (size_t)(rb_ + rkap) * 64 + rc8 * 8); \
                _Pragma("unroll") for (int j = 0; j < 2; ++j) sv[j] = *(const u32x4*)(vt + (size_t)vd[j] * keys + (k0) + vc[j] * 8); } while (0)
#define AT_SWRITE(buf) do { LAS unsigned char* sb_ = lds + (buf) * AT_STAGE; \
                _Pragma("unroll") for (int j = 0; j < 2; ++j) *(LAS u32x4*)(sb_ + kslot[j] * AT_KROW + kcol[j] * 16) = sk[j]; \
                *(LAS u32x4*)(sb_ + rslot * AT_KROW + 256 + rc8 * 16) = sr; \
                _Pragma("unroll") for (int j = 0; j < 2; ++j) *(LAS u32x4*)(sb_ + AT_KBYTES + vd[j] * AT_VROW + vc[j] * 16) = sv[j]; } while (0)
            const int ntile = nkeys >> 6;
            const int blk_lo = heavy ? (wave >> 2) : 0, blk_hi = heavy ? blk_lo + 1 : 2;
            AT_GLOAD(0); AT_SWRITE(0);
            __syncthreads();
            for (int tI = 0; tI < ntile; ++tI) {
                if (tI + 1 < ntile) AT_GLOAD((tI + 1) * 64);
                { const LAS unsigned char* sb = lds + (tI & 1) * AT_STAGE;
                for (int blk = blk_lo; blk < blk_hi; ++blk) {
                    const LAS unsigned char* kp = sb + (32 * blk + rho) * AT_KROW + hh * 16;
                    f32x16 sc;
#pragma unroll
                    for (int i = 0; i < 16; ++i) sc[i] = -m;
                    bf16x8 kf[12];
#pragma unroll
                    for (int ks = 0; ks < 12; ++ks) kf[ks] = *(const LAS bf16x8*)(kp + ks * 32);
                    __builtin_amdgcn_sched_barrier(0);
#pragma unroll
                    for (int ks = 0; ks < 12; ++ks) sc = MFMA32(kf[ks], qf[ks], sc);
                    const LAS unsigned char* vp = sb + AT_KBYTES + rho * AT_VROW + (32 * blk + 16 * hh) * 2;
                    bf16x8 vf[8];
#pragma unroll
                    for (int t = 0; t < 4; ++t)
#pragma unroll
                        for (int s2 = 0; s2 < 2; ++s2) vf[t * 2 + s2] = *(const LAS bf16x8*)(vp + 32 * t * AT_VROW + 16 * s2);
                    __builtin_amdgcn_sched_barrier(0);
                    float mx = sc[0];
#pragma unroll
                    for (int i = 1; i < 16; ++i) mx = fmaxf(mx, sc[i]);
                    { const auto rr = __builtin_amdgcn_permlane32_swap(__float_as_uint(mx), __float_as_uint(mx), false, false); mx = fmaxf(__uint_as_float(rr[0]), __uint_as_float(rr[1])); }
                    if (fresh || __builtin_amdgcn_ballot_w64(mx > 8.0f) != 0ull) { const float delta = fresh ? mx : fmaxf(mx, 0.f), alpha = fresh ? 0.f : __builtin_amdgcn_exp2f(-delta); m += delta; lsum *= alpha; fresh = false;
#pragma unroll
                        for (int i = 0; i < 16; ++i) sc[i] -= delta;
#pragma unroll
                        for (int t = 0; t < 4; ++t) o[t] = o[t] * alpha; }
                    float ps = 0.f;
#pragma unroll
                    for (int i = 0; i < 16; ++i) { sc[i] = __builtin_amdgcn_exp2f(sc[i]); ps += sc[i]; }
                    lsum += ps;
                    bf16x8 pb[2];
#pragma unroll
                    for (int s2 = 0; s2 < 2; ++s2) { u32x4 w; w.x = cvt_pk_bf16(sc[8 * s2 + 0], sc[8 * s2 + 1]); w.y = cvt_pk_bf16(sc[8 * s2 + 2], sc[8 * s2 + 3]); w.z = cvt_pk_bf16(sc[8 * s2 + 4], sc[8 * s2 + 5]); w.w = cvt_pk_bf16(sc[8 * s2 + 6], sc[8 * s2 + 7]);
                        pb[s2] = __builtin_bit_cast(bf16x8, w); }
#pragma unroll
                    for (int s2 = 0; s2 < 2; ++s2)
#pragma unroll
                        for (int t = 0; t < 4; ++t) o[t] = MFMA32(vf[t * 2 + s2], pb[s2], o[t]);
                }
                }
                if (tI + 1 < ntile) AT_SWRITE((tI + 1) & 1);
                __syncthreads();
            }
#undef AT_GLOAD
#undef AT_SWRITE
            lsum += shx(lsum, 32, lane);
            bf16* crow = CC + (size_t)(q0 + rho) * 1024 + h * 128;
            if (!heavy) { const float inv = 1.0f / lsum;
#pragma unroll
                for (int t = 0; t < 4; ++t) attn_store_tile(o[t], inv, crow, t, hh);
            } else {
                const int half = wave >> 2;
                LAS float* mine = (LAS float*)(lds + wave * 8704);
                LAS const float* theirs = (LAS const float*)(lds + (wave ^ 4) * 8704);
#pragma unroll
                for (int t2 = 0; t2 < 2; ++t2)
#pragma unroll
                    for (int i = 0; i < 16; ++i) mine[(t2 * 16 + i) * 64 + lane] = half == 0 ? o[2 + t2][i] : o[t2][i];
                if (hh == 0) { mine[2048 + rho] = m; mine[2080 + rho] = lsum; }
                __syncthreads();
                const float mp = theirs[2048 + rho], lp = theirs[2080 + rho];
                const float mg = fmaxf(m, mp), wo = __builtin_amdgcn_exp2f(m - mg), wp = __builtin_amdgcn_exp2f(mp - mg);
                const float inv = 1.0f / (wo * lsum + wp * lp);
#pragma unroll
                for (int t2 = 0; t2 < 2; ++t2) { f32x16 acc;
#pragma unroll
                    for (int i = 0; i < 16; ++i) acc[i] = wo * (half == 0 ? o[t2][i] : o[2 + t2][i]) + wp * theirs[(t2 * 16 + i) * 64 + lane];
                    attn_store_tile(acc, inv, crow, half * 2 + t2, hh); }
                __syncthreads();
            }
        } else {
            const int c = it - 256;
            const int hd = wave & 3, ph = wave >> 2;
            const float* wbase = A.w_s + ((size_t)(l * 4 + hd) * 128 + 64 * ph + rho) * 128 + 8 * hh;
            f32x4 wva[16], wvb[16];
#pragma unroll
            for (int ks = 0; ks < 8; ++ks) { wva[2 * ks] = *(const f32x4*)(wbase + 16 * ks); wva[2 * ks + 1] = *(const f32x4*)(wbase + 16 * ks + 4); }
            LAS bf16* vnT = (LAS bf16*)lds;
            { bf16x8 vv[8];
#pragma unroll
              for (int pass = 0; pass < 8; ++pass) { const int u = wave + 8 * pass, qq = (u & 1) * 64 + lane, c8 = (u >> 1) * 8; vv[pass] = *(const bf16x8*)(VN + (size_t)(c * 128 + qq) * 256 + c8); }
#pragma unroll
              for (int pass = 0; pass < 8; ++pass) { const int u = wave + 8 * pass, qq = (u & 1) * 64 + lane, c8 = (u >> 1) * 8;
#pragma unroll
                for (int j = 0; j < 8; ++j) vnT[(c8 + j) * 136 + qq] = (bf16)vv[pass][j]; } }
            __syncthreads();
#pragma unroll
            for (int pp = 0; pp < 2; ++pp) { const int pt = 2 * ph + pp;
                bf16x8 af[8];
#pragma unroll
                for (int ks = 0; ks < 8; ++ks) { const f32x4 w0 = pp == 0 ? wva[2 * ks] : wvb[2 * ks], w1 = pp == 0 ? wva[2 * ks + 1] : wvb[2 * ks + 1];
                    u32x4 w; w.x = cvt_pk_bf16(w0.x, w0.y); w.y = cvt_pk_bf16(w0.z, w0.w); w.z = cvt_pk_bf16(w1.x, w1.y); w.w = cvt_pk_bf16(w1.z, w1.w); af[ks] = __builtin_bit_cast(bf16x8, w); }
                if (pp == 0) {
#pragma unroll
                    for (int ks = 0; ks < 8; ++ks) { wvb[2 * ks] = *(const f32x4*)(wbase + 32 * 128 + 16 * ks); wvb[2 * ks + 1] = *(const f32x4*)(wbase + 32 * 128 + 16 * ks + 4); } }
                float bs[16]; bf16 ugv[2][16];
#pragma unroll
                for (int i = 0; i < 16; ++i) { const int p = 32 * pt + (i & 3) + 8 * (i >> 2) + 4 * hh; bs[i] = A.b_s[(l * 4 + hd) * 128 + p];
#pragma unroll
                    for (int d = 0; d < 2; ++d) ugv[d][i] = UG[((size_t)c * 128 + p) * 256 + hd * 64 + 32 * d + rho]; }
                f32x16 acc[2];
#pragma unroll
                for (int d = 0; d < 2; ++d)
#pragma unroll
                    for (int i = 0; i < 16; ++i) acc[d][i] = 0.f;
#pragma unroll
                for (int ks = 0; ks < 8; ++ks)
#pragma unroll
                    for (int d = 0; d < 2; ++d) { const bf16x8 bfr = *(const LAS bf16x8*)(vnT + (hd * 64 + 32 * d + rho) * 136 + 16 * ks + 8 * hh); acc[d] = MFMA32(af[ks], bfr, acc[d]); }
#pragma unroll
                for (int d = 0; d < 2; ++d) { const int col = hd * 64 + 32 * d + rho;
#pragma unroll
                    for (int i = 0; i < 16; ++i) { const int p = 32 * pt + (i & 3) + 8 * (i >> 2) + 4 * hh; const size_t row = (size_t)c * 128 + p;
                        const float mixed = acc[d][i] + bs[i];
                        const float ug = __uint_as_float((unsigned)ugv[d][i] << 16);
                        CC[row * 1024 + 512 + col] = (bf16)(cvt_pk_bf16(ug * mixed, 0.f) & 0xffffu); } }
            }
            __syncthreads();
        }
    }
}

__global__ void __launch_bounds__(512, 2) fwd_megakernel(Args A) {
    extern __shared__ __attribute__((aligned(16))) unsigned char smem[];
    LAS unsigned char* lds = (LAS unsigned char*)smem;
    const int wave0 = __builtin_amdgcn_readfirstlane((int)threadIdx.x >> 6);
    unsigned* const bar = (unsigned*)(A.ws + WS_BAR);
    volatile LAS unsigned* const barst = (volatile LAS unsigned*)(lds + LDS_BARST);
    const unsigned xcc = xb_xcc_id();
    if (wave0 == 0) { const int l0 = fresh_lane(); if (l0 < 2) barst[l0] = 0u; if (l0 == 0 && A.ph_hi - A.ph_lo > 1) (void)xb_add(&bar[XB_XCNT(xcc)], 1u); }
    __syncthreads();
    if (A.ph_lo < 0) cg::this_grid().sync();
    bool dup_done = false; (void)dup_done;
    for (int ph = A.ph_lo; ph < A.ph_hi; ++ph) {
        const int wave = wave0;
#define LANE fresh_lane()
#define TID (wave * 64 + fresh_lane())
        unsigned char* ws = A.ws; asm volatile("" : "+s"(ws));
        if (ph == 0) phase_prologue(A, lds, wave);
        else if (ph == 1) phase_pre(A, lds, LANE, wave);
        else {
            const int l = (ph - 2) / 9, k = (ph - 2) % 9;
            const int G = gridDim.x, bid = blockIdx.x;
            if (k == 0) {
                pg8::Gemm g{(const bf16*)(ws + WS_H), (const bf16*)(ws + WS_WIN) + (size_t)l * 2048 * 1024, NTOK, 2048, 1024}; pg8::StaticOrder S; S.init(NTOK, 2048, G, bid);
                EpiB16<0> E{(bf16*)(ws + WS_Z), INC, INC}; pg8::gemm_phase<EpiB16<0>, pg8::StaticOrder, true>(lds, g, S, E, TID);
            } else if (k == 1) phase_split(A, l, LANE, wave);
            else if (k == 2) {
                { pg8::Gemm g{(const bf16*)(ws + WS_QN), (const bf16*)(ws + WS_WUQ) + (size_t)l * 768 * 384, NTOK, 768, 384}; pg8::StaticOrder S; S.init(NTOK, 768, G, bid);
                  EpiB16<0> E{(bf16*)(ws + WS_Q), 768, 768}; pg8::gemm_phase<EpiB16<0>, pg8::StaticOrder, false>(lds, g, S, E, TID); }
                { pg8::Gemm g{(const bf16*)(ws + WS_CKVN), (const bf16*)(ws + WS_WUKV) + (size_t)l * 1024 * 256, NROWKV, 1024, 256}; pg8::StaticOrder S; S.init(NROWKV, 1024, G, (bid + G - 144 % G) % G);
                  EpiKV E{(bf16*)(ws + WS_KNOPE), (bf16*)(ws + WS_VTP), (bf16*)(ws + WS_VTS)}; pg8::gemm_phase<EpiKV, pg8::StaticOrder, false>(lds, g, S, E, TID); }
            } else if (k == 3) phase_mixer(A, l, lds, LANE, wave);
            else if (k == 4 || k == 7) {
                const bool o = (k == 4);
                pg8::Gemm g{(const bf16*)(ws + (o ? WS_CONCAT : WS_ACT)), o ? (const bf16*)(ws + WS_WOUT) + (size_t)l * 1024 * 1024 : (const bf16*)(ws + WS_WFF2) + (size_t)l * 1024 * 4096, NTOK, 1024, o ? 1024 : 4096};
                pg8::StaticOrder S; S.init(NTOK, 1024, G, bid);
                EpiB16<0> E{(bf16*)(ws + WS_MIX), 1024, 1024}; pg8::gemm_phase<EpiB16<0>, pg8::StaticOrder, true>(lds, g, S, E, TID);
                if (!o && l + 1 < DEPTH) { const int first = G > 192 ? 192 : 0;
                    if (bid >= first) convert_layer(A, lds, l + 1, (bid - first) * 8 + wave, (G - first) * 8, wave, LANE); }
            } else if (k == 5) phase_post(A, l, 0, lds, LANE, wave);
            else if (k == 6) {
                pg8::Gemm g{(const bf16*)(ws + WS_H), (const bf16*)(ws + WS_WFF1) + (size_t)l * 4096 * 1024, NTOK, 4096, 1024}; pg8::StaticOrder S; S.init(NTOK, 4096, G, bid);
                EpiB16<1> E{(bf16*)(ws + WS_ACT), 4096, 4096}; pg8::gemm_phase<EpiB16<1>, pg8::StaticOrder, true>(lds, g, S, E, TID);
            } else phase_post(A, l, 1, lds, LANE, wave);
        }
        if (ph + 1 < A.ph_hi) xcd_barrier(bar, xcc, barst, wave == 0 && fresh_lane() == 0);
#if PROBE_DUP >= 0
        {
            bool again = false;
            if (PROBE_DUP == 100) { if (ph + 1 < A.ph_hi) xcd_barrier(bar, xcc, barst, wave == 0 && fresh_lane() == 0); }
            else if (!dup_done) {
                const int kk = ph >= 2 ? (ph - 2) % 9 : -1;
                if (PROBE_DUP == 50) again = (ph == 0);
                else if (PROBE_DUP == 60) again = (kk == 0 || kk == 2 || kk == 4 || kk == 6 || kk == 7);
                else again = (kk == PROBE_DUP);
            }
            if (again) { dup_done = true; --ph; } else dup_done = false;
        }
#endif
    }
}

constexpr int N_PHASES = 2 + 9 * DEPTH;

extern "C" void kernel_launch(void* const* d_in, const int* in_sizes, int n_in, void* d_out, int out_size, void* d_ws, size_t ws_size, hipStream_t stream) {
    static int grid = 0;
    if (grid == 0) {
        if (n_in != 24 || ws_size < WS_END || in_sizes[9] != DEPTH * 1024 * INC) { fprintf(stderr, "kernel_launch: unexpected problem (n_in %d, ws %zu, w_in %d)\n", n_in, ws_size, n_in > 9 ? in_sizes[9] : -1); grid = -1; return; }
        int dev = 0, cus = 0, per_cu = 0;
        hipGetDevice(&dev); hipDeviceGetAttribute(&cus, hipDeviceAttributeMultiprocessorCount, dev);
        if (hipFuncSetAttribute((const void*)fwd_megakernel, hipFuncAttributeMaxDynamicSharedMemorySize, LDS_BYTES) != hipSuccess) { fprintf(stderr, "kernel_launch: hipFuncSetAttribute failed\n"); grid = -1; return; }
        if (hipOccupancyMaxActiveBlocksPerMultiprocessor(&per_cu, (const void*)fwd_megakernel, 512, LDS_BYTES) != hipSuccess || per_cu < 1) { fprintf(stderr, "kernel_launch: occupancy query says %d\n", per_cu); per_cu = 1; }
        (void)hipGetLastError();
        grid = cus * 1;
        fprintf(stderr, "kernel_launch: grid %d (cus %d, per_cu %d)\n", grid, cus, per_cu);
    }
    if (grid < 0) return;
    if (hipMemsetAsync((char*)d_ws + WS_BAR, 0, 16384, stream) != hipSuccess) { fprintf(stderr, "kernel_launch: memset failed\n"); return; }
    Args a{};
    const float** ap = (const float**)&a;
    for (int i = 0; i < 24; ++i) ap[i] = (const float*)d_in[i];
    a.out = (float*)d_out; a.ws = (unsigned char*)d_ws;
#if MK_PER_PHASE
    for (int ph = 0; ph < N_PHASES; ++ph) { a.ph_lo = ph; a.ph_hi = ph + 1; hipLaunchKernelGGL(fwd_megakernel, dim3(grid), dim3(512), LDS_BYTES, stream, a); }
#else
    a.ph_lo = 0; a.ph_hi = N_PHASES;
    void* args[] = {&a};
    hipError_t e = hipLaunchCooperativeKernel((const void*)fwd_megakernel, dim3(grid), dim3(512), args, LDS_BYTES, stream);
    if (e != hipSuccess) fprintf(stderr, "kernel_launch: cooperative launch failed: %s (grid %d)\n", hipGetErrorString(e), grid);
#endif
}
```

```cpp
#include <hip/hip_runtime.h>
#include <hip/hip_cooperative_groups.h>
#include <cstdio>
namespace cg = cooperative_groups;

#ifndef MK_PER_PHASE
#define MK_PER_PHASE 0
#endif

#ifndef PROBE_DUP
#define PROBE_DUP -1
#endif
#define LAS __attribute__((address_space(3)))
typedef unsigned short bf16;
typedef short bf16x8 __attribute__((ext_vector_type(8)));
typedef float f32x2 __attribute__((ext_vector_type(2)));
typedef float f32x4 __attribute__((ext_vector_type(4)));
typedef float f32x16 __attribute__((ext_vector_type(16)));
typedef unsigned u32x2 __attribute__((ext_vector_type(2)));
typedef unsigned u32x4 __attribute__((ext_vector_type(4)));

constexpr int DM = 1024, NTOK_P = 8192, NTOK_S = 4096, NTOK = 12288, NROWKV = 14336;
constexpr int DEPTH = 4, INC = 1984, DFF = 4096;
constexpr int ZQ = 0, ZCKV = 384, ZKR = 640, ZU = 704, ZV = 960, ZBG = 1216, ZCG = 1472, ZHH = 1728;
constexpr float EPS = 1e-6f;
constexpr float QSCALE = 0.07216878364870322f * 1.4426950408889634f;

constexpr size_t MiB = 1u << 20;
constexpr size_t WS_MOD = 0, WS_BAR = 512 * 1024, WS_ROPE = 1 * MiB, WS_WIN = 2 * MiB, WS_WUQ = 18 * MiB, WS_WUKV = 21 * MiB, WS_WOUT = 23 * MiB,
                 WS_WFF1 = 31 * MiB, WS_WFF2 = 63 * MiB, WS_H = 95 * MiB, WS_MIX = 119 * MiB, WS_XB = 143 * MiB, WS_CONCAT = 167 * MiB, WS_QN = 191 * MiB,
                 WS_CKVN = 200 * MiB, WS_KRB = 207 * MiB, WS_UG = 209 * MiB, WS_VN = 215 * MiB, WS_Q = 221 * MiB, WS_KNOPE = 239 * MiB,
                 WS_VTP = 253 * MiB, WS_VTS = 261 * MiB, WS_Z = 267 * MiB, WS_ACT = 267 * MiB, WS_END = 363 * MiB;
constexpr int LDS_BYTES = 147456, LDS_BARST = LDS_BYTES - 64;

__device__ __forceinline__ unsigned cvt_pk_bf16(float lo, float hi) { unsigned r; asm volatile("v_cvt_pk_bf16_f32 %0, %1, %2" : "=v"(r) : "v"(lo), "v"(hi)); return r; }
__device__ __forceinline__ int fresh_lane() { int l; asm volatile("v_mbcnt_lo_u32_b32 %0, -1, 0\n\tv_mbcnt_hi_u32_b32 %0, -1, %0" : "=v"(l)); return l; }
__device__ __forceinline__ float shx(float v, int mask, int lane) { return __int_as_float(__builtin_amdgcn_ds_bpermute((lane ^ mask) << 2, __float_as_int(v))); }
__device__ __forceinline__ float dpp_add(float v, const int ctrl_is) {
    return v; }
#define DPP_ADD(v, ctrl) ((v) + __int_as_float(__builtin_amdgcn_update_dpp(0, __float_as_int(v), (ctrl), 0xf, 0xf, true)))
__device__ __forceinline__ float wave_sum(float v, int lane) {
    (void)lane;
    v = DPP_ADD(v, 0xB1);
    v = DPP_ADD(v, 0x4E);
    v = DPP_ADD(v, 0x141);
    v = DPP_ADD(v, 0x140);
    const int vi = __float_as_int(v);
    return (__int_as_float(__builtin_amdgcn_readlane(vi, 0)) + __int_as_float(__builtin_amdgcn_readlane(vi, 16))) + (__int_as_float(__builtin_amdgcn_readlane(vi, 32)) + __int_as_float(__builtin_amdgcn_readlane(vi, 48)));
}
__device__ __forceinline__ float gelu_tanh(float x) { const float y = 0.7978845608028654f * (x + 0.044715f * x * x * x); return x / (1.0f + __expf(-2.0f * y)); }
__device__ __forceinline__ f32x4 gelu4(f32x4 v) { return (f32x4){gelu_tanh(v.x), gelu_tanh(v.y), gelu_tanh(v.z), gelu_tanh(v.w)}; }
__device__ __forceinline__ float sumsq4(f32x4 v) { return (v.x * v.x + v.y * v.y) + (v.z * v.z + v.w * v.w); }
__device__ __forceinline__ f32x4 bf4(u32x2 w) { return (f32x4){__uint_as_float(w.x << 16), __uint_as_float(w.x & 0xffff0000u), __uint_as_float(w.y << 16), __uint_as_float(w.y & 0xffff0000u)}; }
__device__ __forceinline__ f32x4 ld4bf_nt(const bf16* p) { const u32x2 w = __builtin_nontemporal_load((const u32x2*)p); return (f32x4){__uint_as_float(w.x << 16), __uint_as_float(w.x & 0xffff0000u), __uint_as_float(w.y << 16), __uint_as_float(w.y & 0xffff0000u)}; }
__device__ __forceinline__ f32x4 ld4bf(const bf16* p) { const u32x2 w = *(const u32x2*)p; return (f32x4){__uint_as_float(w.x << 16), __uint_as_float(w.x & 0xffff0000u), __uint_as_float(w.y << 16), __uint_as_float(w.y & 0xffff0000u)}; }
__device__ __forceinline__ f32x2 ld2bf(const bf16* p) { const unsigned w = *(const unsigned*)p; return (f32x2){__uint_as_float(w << 16), __uint_as_float(w & 0xffff0000u)}; }
__device__ __forceinline__ float ld1bf(const bf16* p) { return __uint_as_float((unsigned)*p << 16); }
__device__ __forceinline__ u32x2 pk4(f32x4 v) { u32x2 w; w.x = cvt_pk_bf16(v.x, v.y); w.y = cvt_pk_bf16(v.z, v.w); return w; }


#define XB_TMO      128
#define XB_XCNT(j)  (256  + 64 * (j))
#define XB_XSUB(j)  (1280 + 64 * (j))
#define XB_XGEN(j)  (2304 + 64 * (j))
#define XB_TOP      3328
#define XB_TOPGEN   3392
#define XCD_BAR_WORDS 3456
#define XB_SPIN_CAP (1u << 18)
__device__ __forceinline__ unsigned xb_ld(unsigned* p)              { return __hip_atomic_load(p, __ATOMIC_RELAXED, __HIP_MEMORY_SCOPE_AGENT); }
__device__ __forceinline__ unsigned xb_add(unsigned* p, unsigned v) { return __hip_atomic_fetch_add(p, v, __ATOMIC_RELAXED, __HIP_MEMORY_SCOPE_AGENT); }
__device__ __forceinline__ unsigned xb_xcc_id() { return (unsigned)__builtin_amdgcn_s_getreg((3 << 11) | 20) & 0xFu; }
#define XB_SPIN(cond, bar) do { unsigned _sp = 0; while (cond) { __builtin_amdgcn_s_sleep(1); \
    if ((++_sp & 255u) == 0u) { if (xb_ld(&(bar)[XB_TMO])) break; if (_sp > XB_SPIN_CAP) { atomicAdd(&(bar)[XB_TMO], 1u); break; } } } } while (0)
__device__ __forceinline__ void xcd_barrier_complete(unsigned* bar, unsigned x, unsigned& nloc, unsigned& nx) {
    const unsigned G = gridDim.x * gridDim.y * gridDim.z;
    unsigned sum, cnt, mine, sp = 0u;
    for (;;) {
        sum = 0u; cnt = 0u; mine = 0u;
#pragma unroll
        for (unsigned j = 0; j < 16; ++j) { const unsigned c = xb_ld(&bar[XB_XCNT(j)]); sum += c; cnt += (c > 0u) ? 1u : 0u; mine = (j == x) ? c : mine; }
        if (sum == G) break;
        __builtin_amdgcn_s_sleep(1);
        if ((++sp & 255u) == 0u) { if (xb_ld(&bar[XB_TMO])) break; if (sp > XB_SPIN_CAP) { atomicAdd(&bar[XB_TMO], 1u); break; } }
    }
    nloc = mine > 0u ? mine : 1u; nx = cnt > 0u ? cnt : 1u;
}
__device__ __forceinline__ void xcd_barrier(unsigned* bar, unsigned x, volatile LAS unsigned* st, bool leader) {
    asm volatile("s_waitcnt vmcnt(0)" ::: "memory");
    __syncthreads();
    if (leader) {
        __builtin_amdgcn_s_waitcnt(0);
        unsigned nloc = st[0], nx = st[1];
        if (nloc == 0u) { xcd_barrier_complete(bar, x, nloc, nx); st[0] = nloc; st[1] = nx; }
        const unsigned old = xb_add(&bar[XB_XSUB(x)], 1u);
        const unsigned gen = old / nloc;
        if (old + 1u == (gen + 1u) * nloc) {
            __builtin_amdgcn_fence(__ATOMIC_RELEASE, "agent");
            asm volatile("s_waitcnt vmcnt(0)" ::: "memory");
            const unsigned og = xb_add(&bar[XB_TOP], 1u);
            const unsigned tg = og / nx;
            if (og + 1u == (tg + 1u) * nx) xb_add(&bar[XB_TOPGEN], 1u);
            else XB_SPIN(xb_ld(&bar[XB_TOPGEN]) == tg, bar);
            __builtin_amdgcn_fence(__ATOMIC_ACQUIRE, "agent");
            xb_add(&bar[XB_XGEN(x)], 1u);
            asm volatile("s_waitcnt vmcnt(0)" ::: "memory");
        } else {
            XB_SPIN(xb_ld(&bar[XB_XGEN(x)]) == gen, bar);
            __builtin_amdgcn_fence(__ATOMIC_ACQUIRE, "agent");
            asm volatile("s_waitcnt vmcnt(0)" ::: "memory");
        }
    }
    __syncthreads();
}

namespace pg8 {
#define PG8_LAS __attribute__((address_space(3)))
typedef unsigned short bf16_t;
constexpr int BM = 256, BK = 64, HALF = 128, HTB = HALF * BK * 2, STAGE_BYTES = 8 * HTB, NXCD = 8, WGM = 8;
__host__ __device__ __forceinline__ int lds_byte(int r, int c) { const int st = (r >> 4) * 2 + (c >> 5), rr = r & 15, cc = c & 31, ob = rr * 64 + cc * 2; return st * 1024 + (ob ^ (((ob >> 9) & 1) << 5)); }
__host__ __device__ __forceinline__ void stage_rc(int b, int& R, int& C) { const int st = b / 1024, sb = b % 1024, swz = sb ^ (((sb >> 9) & 1) << 5); R = (st >> 1) * 16 + swz / 64; C = (st & 1) * 32 + (swz % 64) / 2; }
__host__ __device__ __forceinline__ int perm32(int rho) { const int n = rho >> 4, i = rho & 15; return 8 * (i >> 2) + 4 * n + (i & 3); }
struct Unit { int pm, pn; };
struct Gemm { const bf16_t* A; const bf16_t* Bt; int M, N, K; };
struct StaticOrder {
    int nM, nN, nwg, G, c;
    __host__ __device__ void init(int M, int N, int G_, int c_) { nM = M / BM; nN = N / BM; nwg = nM * nN; G = G_; c = c_; }
    __host__ __device__ bool next(int i, Unit& u) const {
        const long L = (long)i * G + c; if (L >= nwg) return false;
        int wgid = (int)L; { const int q = nwg / NXCD, r = nwg % NXCD, xcd = wgid % NXCD, off = wgid / NXCD; wgid = (xcd < r ? xcd * (q + 1) : r * (q + 1) + (xcd - r) * q) + off; }
        const int nig = WGM * nN, gid = wgid / nig, fm = gid * WGM, gsz = (nM - fm) < WGM ? (nM - fm) : WGM;
        u.pm = fm + ((wgid % nig) % gsz); u.pn = (wgid % nig) / gsz; return true;
    }
    __device__ __forceinline__ void a_ready(const Unit&) const {}
    __device__ __forceinline__ void done(const Unit&) const {}
};

template <class Epi, class Sched, bool SP2>
__device__ __forceinline__ void gemm_phase(PG8_LAS unsigned char* lds, const Gemm g, const Sched& S, const Epi& E, const int tid) {
    const int wid = __builtin_amdgcn_readfirstlane(tid >> 6), lane = tid & 63, wr = wid >> 2, wc = wid & 3, fr = lane & 15, fq = lane >> 4;
    const int K = g.K, nt = K / BK;
    unsigned voffA[2], voffB[2];
#pragma unroll
    for (int i = 0; i < 2; ++i) { int R, C; stage_rc(tid * 16 + i * 8192, R, C); const int Rb = Epi::PERM ? ((R & ~31) + perm32(R & 31)) : R;
        voffA[i] = (unsigned)(R * K + C) * 2u; voffB[i] = (unsigned)(Rb * K + C) * 2u; }
    const size_t kstep = (size_t)(BK * 2);
    const size_t hstep = (size_t)HALF * K * 2;
    const size_t tstep = 2 * hstep;
    const unsigned ldsw = (unsigned)wid * 1024u;
    const int aoff = lds_byte(wr * 64 + fr, fq * 8), boff = lds_byte(wc * 32 + fr, fq * 8);
#define PG8_SA(b, h) (((b) * 2 + (h)) * HTB)
#define PG8_SB(b, h) ((4 + (b) * 2 + (h)) * HTB)
#define PG8_STAGE(bufoff, gbase, voff) do { _Pragma("unroll") for (int _i = 0; _i < 2; ++_i) \
        __builtin_amdgcn_global_load_lds((const unsigned*)((const char*)(gbase) + (voff)[_i]), (PG8_LAS unsigned*)(lds + (bufoff) + ldsw + _i * 8192), 16, 0, 0); } while (0)
#define PG8_LDA(dst, b, h) do { _Pragma("unroll") for (int m = 0; m < 4; ++m) _Pragma("unroll") for (int k = 0; k < 2; ++k) dst[m][k] = *(const PG8_LAS bf16x8*)(lds + PG8_SA(b, h) + aoff + m * 2048 + k * 1024); } while (0)
#define PG8_LDB(dst, b, h) do { _Pragma("unroll") for (int n = 0; n < 2; ++n) _Pragma("unroll") for (int k = 0; k < 2; ++k) dst[n][k] = *(const PG8_LAS bf16x8*)(lds + PG8_SB(b, h) + boff + n * 2048 + k * 1024); } while (0)
#define PG8_MMA(ai, bj, At, Bt) do { __builtin_amdgcn_s_setprio(1); _Pragma("unroll") for (int m = 0; m < 4; ++m) _Pragma("unroll") for (int n = 0; n < 2; ++n) _Pragma("unroll") for (int k = 0; k < 2; ++k) \
        acc[ai][bj][m][n] = __builtin_amdgcn_mfma_f32_16x16x32_bf16(Bt[n][k], At[m][k], acc[ai][bj][m][n], 0, 0, 0); __builtin_amdgcn_s_setprio(0); } while (0)
#define PG8_WAIT_V(n) asm volatile("s_waitcnt vmcnt(" #n ")" ::: "memory")
#define PG8_WAIT_L(n) asm volatile("s_waitcnt lgkmcnt(" #n ")" ::: "memory")
#define PG8_BAR __builtin_amdgcn_s_barrier()
#define PG8_SCHED __builtin_amdgcn_sched_barrier(0)
    Unit cur, nxt; int ui = 0;
    if (!S.next(0, cur)) return;
    f32x4 acc[2][2][4][2];
#pragma unroll
    for (int a = 0; a < 2; ++a)
#pragma unroll
        for (int b = 0; b < 2; ++b)
#pragma unroll
            for (int m = 0; m < 4; ++m)
#pragma unroll
                for (int n = 0; n < 2; ++n) acc[a][b][m][n] = (f32x4){0.f, 0.f, 0.f, 0.f};
    bf16x8 At[4][2], B0[2][2], B1[2][2];
    const char* cA = (const char*)g.A + (size_t)cur.pm * tstep; const char* cB = (const char*)g.Bt + (size_t)cur.pn * tstep;
    S.a_ready(cur);
    if constexpr (SP2) {
    PG8_STAGE(PG8_SB(0, 0), cB, voffB); PG8_STAGE(PG8_SB(0, 1), cB + hstep, voffB); PG8_STAGE(PG8_SA(0, 0), cA, voffA); PG8_STAGE(PG8_SA(0, 1), cA + hstep, voffA);
    if (wr == 1) PG8_BAR;
    PG8_WAIT_V(2); PG8_BAR;
    PG8_STAGE(PG8_SB(1, 0), cB + kstep, voffB); PG8_STAGE(PG8_SA(1, 0), cA + kstep, voffA); PG8_STAGE(PG8_SB(1, 1), cB + hstep + kstep, voffB);
    PG8_WAIT_V(6); PG8_BAR;
    } else {
    PG8_STAGE(PG8_SB(0, 0), cB, voffB); PG8_STAGE(PG8_SA(0, 0), cA, voffA); PG8_STAGE(PG8_SB(0, 1), cB + hstep, voffB); PG8_STAGE(PG8_SA(0, 1), cA + hstep, voffA);
    if (wr == 1) PG8_BAR;
    PG8_WAIT_V(4); PG8_BAR;
    PG8_STAGE(PG8_SB(1, 0), cB + kstep, voffB); PG8_STAGE(PG8_SA(1, 0), cA + kstep, voffA); PG8_STAGE(PG8_SB(1, 1), cB + hstep + kstep, voffB);
    PG8_WAIT_V(6); PG8_BAR;
    }
    for (;;) {
        const bool has_next = S.next(ui + 1, nxt);
        const char* nA = has_next ? (const char*)g.A + (size_t)nxt.pm * tstep : cA; const char* nB = has_next ? (const char*)g.Bt + (size_t)nxt.pn * tstep : cB;
        for (int t = 0; t < nt; t += 2) {
            const bool last = (t == nt - 2);
            const char* a1 = cA + (size_t)(t + 1) * kstep;
            const char* a2 = last ? nA : cA + (size_t)(t + 2) * kstep; const char* b2 = last ? nB : cB + (size_t)(t + 2) * kstep;
            const char* a3 = a2 + kstep; const char* b3 = b2 + kstep;
            if (last && has_next) S.a_ready(nxt);
            if constexpr (SP2) {
            PG8_LDB(B0, 0, 0); PG8_LDB(B1, 0, 1); PG8_SCHED; PG8_LDA(At, 0, 0); PG8_STAGE(PG8_SA(1, 1), a1 + hstep, voffA);
            PG8_WAIT_V(8); PG8_WAIT_L(0); PG8_BAR; PG8_MMA(0, 0, At, B0); PG8_MMA(0, 1, At, B1); PG8_BAR; PG8_SCHED;
            PG8_LDA(At, 0, 1); PG8_STAGE(PG8_SB(0, 0), b2, voffB); PG8_STAGE(PG8_SB(0, 1), b2 + hstep, voffB); PG8_STAGE(PG8_SA(0, 0), a2, voffA);
            PG8_WAIT_V(8); PG8_WAIT_L(0); PG8_BAR; PG8_MMA(1, 0, At, B0); PG8_MMA(1, 1, At, B1); PG8_BAR; PG8_SCHED;
            PG8_LDB(B0, 1, 0); PG8_LDB(B1, 1, 1); PG8_SCHED; PG8_LDA(At, 1, 0); PG8_STAGE(PG8_SA(0, 1), a2 + hstep, voffA);
            PG8_WAIT_V(8); PG8_WAIT_L(0); PG8_BAR; PG8_MMA(0, 0, At, B0); PG8_MMA(0, 1, At, B1); PG8_BAR; PG8_SCHED;
            PG8_LDA(At, 1, 1); PG8_STAGE(PG8_SB(1, 0), b3, voffB); PG8_STAGE(PG8_SB(1, 1), b3 + hstep, voffB); PG8_STAGE(PG8_SA(1, 0), a3, voffA);
            PG8_WAIT_V(8); PG8_WAIT_L(0); PG8_BAR; PG8_MMA(1, 0, At, B0); PG8_MMA(1, 1, At, B1); PG8_BAR; PG8_SCHED;
            } else {
            PG8_LDB(B0, 0, 0); PG8_SCHED; PG8_LDA(At, 0, 0); PG8_STAGE(PG8_SA(1, 1), a1 + hstep, voffA);
            PG8_WAIT_L(8); PG8_BAR; PG8_WAIT_L(0); PG8_MMA(0, 0, At, B0); PG8_BAR; PG8_SCHED;
            PG8_LDB(B1, 0, 1); PG8_STAGE(PG8_SB(0, 0), b2, voffB);
            PG8_BAR; PG8_WAIT_L(0); PG8_MMA(0, 1, At, B1); PG8_BAR;
            PG8_LDA(At, 0, 1); PG8_STAGE(PG8_SA(0, 0), a2, voffA);
            PG8_BAR; PG8_WAIT_L(0); PG8_MMA(1, 0, At, B0); PG8_BAR; PG8_SCHED;
            PG8_STAGE(PG8_SB(0, 1), b2 + hstep, voffB);
            PG8_WAIT_V(6); PG8_BAR; PG8_MMA(1, 1, At, B1); PG8_BAR;
            PG8_LDB(B0, 1, 0); PG8_SCHED; PG8_LDA(At, 1, 0); PG8_STAGE(PG8_SA(0, 1), a2 + hstep, voffA);
            PG8_WAIT_L(8); PG8_BAR; PG8_WAIT_L(0); PG8_MMA(0, 0, At, B0); PG8_BAR; PG8_SCHED;
            PG8_LDB(B1, 1, 1); PG8_STAGE(PG8_SB(1, 0), b3, voffB);
            PG8_BAR; PG8_WAIT_L(0); PG8_MMA(0, 1, At, B1); PG8_BAR;
            PG8_LDA(At, 1, 1); PG8_STAGE(PG8_SA(1, 0), a3, voffA);
            PG8_BAR; PG8_WAIT_L(0); PG8_MMA(1, 0, At, B0); PG8_BAR; PG8_SCHED;
            PG8_STAGE(PG8_SB(1, 1), b3 + hstep, voffB);
            PG8_WAIT_V(6); PG8_BAR; PG8_MMA(1, 1, At, B1); PG8_BAR;
            }
        }
        if (wr == 0) PG8_BAR;
        E(acc, cur, wr, wc, fr, fq); S.done(cur);
        if (!has_next) break;
#pragma unroll
        for (int a = 0; a < 2; ++a)
#pragma unroll
            for (int b = 0; b < 2; ++b)
#pragma unroll
                for (int m = 0; m < 4; ++m)
#pragma unroll
                    for (int n = 0; n < 2; ++n) acc[a][b][m][n] = (f32x4){0.f, 0.f, 0.f, 0.f};
        cur = nxt; cA = nA; cB = nB; ++ui;
        if (wr == 1) PG8_BAR;
    }
    PG8_WAIT_V(0);
    PG8_BAR;
#undef PG8_SA
#undef PG8_SB
#undef PG8_STAGE
#undef PG8_LDA
#undef PG8_LDB
#undef PG8_MMA
#undef PG8_WAIT_V
#undef PG8_WAIT_L
#undef PG8_BAR
#undef PG8_SCHED
}
}

struct EpiF32 {
    static constexpr bool PERM = false;
    float* C; int ldc; int ncols;
    __device__ __forceinline__ void operator()(const f32x4 (&acc)[2][2][4][2], const pg8::Unit& u, int wr, int wc, int fr, int fq) const {
        const int row0 = u.pm * 256 + wr * 64 + fr, col0 = u.pn * 256 + wc * 32 + 4 * fq;
#pragma unroll
        for (int ai = 0; ai < 2; ++ai)
#pragma unroll
            for (int m = 0; m < 4; ++m) { float* rowp = C + (size_t)(row0 + ai * 128 + m * 16) * ldc + col0;
#pragma unroll
                for (int bj = 0; bj < 2; ++bj)
#pragma unroll
                    for (int n = 0; n < 2; ++n) if (col0 + bj * 128 + n * 16 < ncols) *(f32x4*)(rowp + bj * 128 + n * 16) = acc[ai][bj][m][n]; }
    }
};
template <int ACT> struct EpiB16 {
    static constexpr bool PERM = true;
    bf16* O; int ldc; int ncols;
    __device__ __forceinline__ void operator()(const f32x4 (&acc)[2][2][4][2], const pg8::Unit& u, int wr, int wc, int, int) const {
        const int ln = fresh_lane(), fr = ln & 15, fq = ln >> 4;
        const int row0 = u.pm * 256 + wr * 64 + fr, col0 = u.pn * 256 + wc * 32 + 8 * fq;
#pragma unroll
        for (int ai = 0; ai < 2; ++ai)
#pragma unroll
            for (int m = 0; m < 4; ++m) { bf16* rowp = O + (size_t)(row0 + ai * 128 + m * 16) * ldc + col0;
#pragma unroll
                for (int bj = 0; bj < 2; ++bj) { f32x4 v0 = acc[ai][bj][m][0], v1 = acc[ai][bj][m][1];
                    if (col0 + bj * 128 >= ncols) continue;
                    if (ACT) {
#pragma unroll
                    for (int j = 0; j < 4; ++j) { const float a = fmaxf(v0[j], 0.f), b = fmaxf(v1[j], 0.f); v0[j] = a * a; v1[j] = b * b; } }
                    u32x4 w; w.x = cvt_pk_bf16(v0[0], v0[1]); w.y = cvt_pk_bf16(v0[2], v0[3]); w.z = cvt_pk_bf16(v1[0], v1[1]); w.w = cvt_pk_bf16(v1[2], v1[3]);
                    *(u32x4*)(rowp + bj * 128) = w; } }
    }
};
struct EpiQ {
    static constexpr bool PERM = false;
    bf16* Q; const float* ropec; const float* ropes;
    __device__ __forceinline__ void operator()(const f32x4 (&acc)[2][2][4][2], const pg8::Unit& u, int wr, int wc, int, int) const {
        const int ln = fresh_lane(), fr = ln & 15, fq = ln >> 4;
        const int row0 = u.pm * 256 + wr * 64 + fr; const bool sample = u.pm >= 32;
#pragma unroll
        for (int bj = 0; bj < 2; ++bj) {
            const int g0 = u.pn * 256 + bj * 128 + wc * 32, within0 = g0 % 192; const bool isrope = within0 >= 128; const int a = (within0 - 128) >> 5;
#pragma unroll
            for (int ai = 0; ai < 2; ++ai)
#pragma unroll
                for (int m = 0; m < 4; ++m) { const int row = row0 + ai * 128 + m * 16;
                    f32x4 x1 = acc[ai][bj][m][0], x2 = acc[ai][bj][m][1];
                    if (sample && isrope) { const int ntok = (row - NTOK_P) & 1023;
                        const f32x4 cs = *(const f32x4*)(ropec + ntok * 32 + a * 16 + 4 * fq), sn = *(const f32x4*)(ropes + ntok * 32 + a * 16 + 4 * fq);
                        const f32x4 o1 = x1 * cs - x2 * sn, o2 = x1 * sn + x2 * cs; x1 = o1; x2 = o2; }
                    x1 = x1 * QSCALE; x2 = x2 * QSCALE;
                    bf16* p = Q + (size_t)row * 768 + g0 + 4 * fq;
                    *(u32x2*)p = pk4(x1); *(u32x2*)(p + 16) = pk4(x2); asm volatile("" ::: "memory"); }
        }
    }
};
struct EpiKV {
    static constexpr bool PERM = false;
    bf16* KN; bf16* VTP; bf16* VTS;
    __device__ __forceinline__ void operator()(const f32x4 (&acc)[2][2][4][2], const pg8::Unit& u, int wr, int wc, int, int) const {
        const int ln = fresh_lane(), fr = ln & 15, fq = ln >> 4;
        const int h = u.pn, pm = u.pm;
        bf16* vt; int keys, keybase;
        if (pm < 32) { vt = VTP + (size_t)((pm * 4 + h) * 128) * 256; keys = 256; keybase = 0; }
        else if (pm < 48) { const int b = (pm - 32) >> 2; vt = VTS + (size_t)((b * 4 + h) * 128) * 1536; keys = 1536; keybase = 512 + ((pm - 32) & 3) * 256; }
        else { const int b = (pm - 48) >> 1; vt = VTS + (size_t)((b * 4 + h) * 128) * 1536; keys = 1536; keybase = ((pm - 48) & 1) * 256; }
#pragma unroll
        for (int ai = 0; ai < 2; ++ai)
#pragma unroll
            for (int m = 0; m < 4; ++m) { const int rloc = wr * 64 + fr + ai * 128 + m * 16;
                bf16* kp = KN + (size_t)(pm * 256 + rloc) * 512 + h * 128 + wc * 32 + 4 * fq;
#pragma unroll
                for (int n = 0; n < 2; ++n) *(u32x2*)(kp + 16 * n) = pk4(acc[ai][0][m][n]);
#pragma unroll
                for (int n = 0; n < 2; ++n) { const f32x4 v = acc[ai][1][m][n]; const u32x2 w = pk4(v);
                    bf16* vp = vt + (size_t)(wc * 32 + 16 * n + 4 * fq) * keys + keybase + rloc;
                    vp[0] = (bf16)(w.x & 0xffffu); vp[keys] = (bf16)(w.x >> 16); vp[2 * keys] = (bf16)(w.y & 0xffffu); vp[3 * keys] = (bf16)(w.y >> 16); }
                asm volatile("" ::: "memory");
            }
    }
};

struct Args {
    const float *x_prompt, *x_sample, *cache_ckv, *cache_krope, *c, *c_ctx, *w_ada, *b_ada, *g_pre_mix, *w_in, *g_q, *w_uq, *g_kv, *w_ukv,
                *g_v, *w_s, *b_s, *w_conv, *w_out, *g_post_mix, *g_pre_ffn, *w_ff1, *w_ff2, *g_post_ffn;
    float* out; unsigned char* ws; int ph_lo, ph_hi;
};

__device__ __forceinline__ void p0_transpose_item(const float* W, int K, int N, bf16* WT, LAS float* scr, int item, int lane, float scale = 1.0f) {
    const int nblk = N / 32, kb = item / nblk, nb = item % nblk, k0 = 64 * kb, n0 = 32 * nb;
#pragma unroll 8
    for (int i = 0; i < 32; ++i) { const int kk = 2 * i + (lane >> 5); scr[kk * 33 + (lane & 31)] = W[(size_t)(k0 + kk) * N + n0 + (lane & 31)]; }
    asm volatile("s_waitcnt lgkmcnt(0)" ::: "memory");
    const int c = lane & 7;
#pragma unroll
    for (int j = 0; j < 4; ++j) { const int n = (lane >> 3) + 8 * j; const LAS float* s = scr + (8 * c) * 33 + n;
        u32x4 o; o.x = cvt_pk_bf16(s[0 * 33] * scale, s[1 * 33] * scale); o.y = cvt_pk_bf16(s[2 * 33] * scale, s[3 * 33] * scale); o.z = cvt_pk_bf16(s[4 * 33] * scale, s[5 * 33] * scale); o.w = cvt_pk_bf16(s[6 * 33] * scale, s[7 * 33] * scale);
        *(u32x4*)(WT + (size_t)(n0 + n) * K + k0 + 8 * c) = o; }
    asm volatile("s_waitcnt lgkmcnt(0)" ::: "memory");
}

__device__ __forceinline__ void convert_layer(const Args& A, LAS unsigned char* lds, int l, int gwi, int nw, int wave, int lane) {
    unsigned char* ws = A.ws;
    LAS float* scr = (LAS float*)(lds + wave * 16384);
    constexpr int I_IN = 16 * 62, I_UQ = 6 * 24, I_UKV = 4 * 32, I_OUT = 16 * 32, I_F1 = 16 * 128, I_F2 = 64 * 32, I_L = I_IN + I_UQ + I_UKV + I_OUT + I_F1 + I_F2;
    for (int it = gwi; it < I_L; it += nw) {
        int r = it;
        if (r < I_IN) { p0_transpose_item(A.w_in + (size_t)l * 1024 * INC, 1024, INC, (bf16*)(ws + WS_WIN) + (size_t)l * 2048 * 1024, scr, r, lane); continue; } r -= I_IN;
        if (r < I_UQ) { p0_transpose_item(A.w_uq + (size_t)l * 384 * 768, 384, 768, (bf16*)(ws + WS_WUQ) + (size_t)l * 768 * 384, scr, r, lane, QSCALE); continue; } r -= I_UQ;
        if (r < I_UKV) { p0_transpose_item(A.w_ukv + (size_t)l * 256 * 1024, 256, 1024, (bf16*)(ws + WS_WUKV) + (size_t)l * 1024 * 256, scr, r, lane); continue; } r -= I_UKV;
        if (r < I_OUT) { p0_transpose_item(A.w_out + (size_t)l * 1024 * 1024, 1024, 1024, (bf16*)(ws + WS_WOUT) + (size_t)l * 1024 * 1024, scr, r, lane); continue; } r -= I_OUT;
        if (r < I_F1) { p0_transpose_item(A.w_ff1 + (size_t)l * 1024 * 4096, 1024, 4096, (bf16*)(ws + WS_WFF1) + (size_t)l * 4096 * 1024, scr, r, lane); continue; } r -= I_F1;
        p0_transpose_item(A.w_ff2 + (size_t)l * 4096 * 1024, 4096, 1024, (bf16*)(ws + WS_WFF2) + (size_t)l * 1024 * 4096, scr, r, lane);
    }
}

__device__ __forceinline__ void phase_prologue(const Args& A, LAS unsigned char* lds, int wave) {
    const int lane = fresh_lane(), tid = wave * 64 + lane;
    unsigned char* ws = A.ws;
    const int bid = blockIdx.x, G = gridDim.x;
    { const int gt = bid * 512 + tid;
      if (gt < 32768) { const int n = gt >> 5, a = (gt >> 4) & 1, f = gt & 15; const int pos = a == 0 ? (n >> 6) : (n & 63);
          double inv = 1.0; for (int i = 0; i < f; ++i) inv *= 0.5623413251903491;
          double rev = (double)pos * inv * 0.15915494309189535; rev -= floor(rev);
          const float rf = (float)rev;
          ((float*)(ws + WS_ROPE))[gt] = __builtin_amdgcn_cosf(rf); ((float*)(ws + WS_ROPE))[32768 + gt] = __builtin_amdgcn_sinf(rf); } }
    for (int it = bid; it < 192; it += G) {
        const int l = it / 48, cgp = it % 48;
        LAS float* sl = (LAS float*)lds;
        for (int i = tid; i < 5120; i += 512) { const int ci = i >> 10, k = i & 1023; const float v = ci == 0 ? A.c_ctx[k] : A.c[(ci - 1) * 1024 + k]; sl[i] = v / (1.0f + __expf(-v)); }
        __syncthreads();
        float a0[5], a1[5];
#pragma unroll
        for (int ci = 0; ci < 5; ++ci) { a0[ci] = 0.f; a1[ci] = 0.f; }
        const float* wp = A.w_ada + ((size_t)l * 1024 + wave * 128) * 6144 + cgp * 128 + 2 * lane;
#pragma unroll 8
        for (int kk = 0; kk < 128; ++kk) { const f32x2 wv = *(const f32x2*)(wp + (size_t)kk * 6144); const int k = wave * 128 + kk;
#pragma unroll
            for (int ci = 0; ci < 5; ++ci) { const float s = sl[ci * 1024 + k]; a0[ci] += s * wv.x; a1[ci] += s * wv.y; } }
        LAS float* part = (LAS float*)(lds + 32768);
#pragma unroll
        for (int ci = 0; ci < 5; ++ci) { part[(wave * 5 + ci) * 128 + 2 * lane] = a0[ci]; part[(wave * 5 + ci) * 128 + 2 * lane + 1] = a1[ci]; }
        __syncthreads();
        for (int i = tid; i < 640; i += 512) { const int ci = i >> 7, col = i & 127; float s = 0.f;
#pragma unroll
            for (int w = 0; w < 8; ++w) s += part[(w * 5 + ci) * 128 + col];
            const int gcol = cgp * 128 + col; ((float*)(ws + WS_MOD))[(l * 5 + ci) * 6144 + gcol] = s + A.b_ada[l * 6144 + gcol]; }
        __syncthreads();
    }
    convert_layer(A, lds, 0, bid * 8 + wave, G * 8, wave, lane);
}

__device__ __forceinline__ int cond_of_row(int r) { return r < NTOK_P ? 0 : 1 + ((r - NTOK_P) >> 10); }

__device__ __forceinline__ void norm_mod_store(const f32x4 (&v)[4], const LAS float* g, const LAS float* sc, const LAS float* sh, bf16* hrow, int lane) {
    float ss = 0.f;
#pragma unroll
    for (int j = 0; j < 4; ++j) ss += sumsq4(v[j]);
    const float rstd = 1.0f / sqrtf(wave_sum(ss, lane) * (1.0f / 1024.0f) + EPS);
#pragma unroll
    for (int j = 0; j < 4; ++j) { const int idx = 4 * lane + 256 * j;
        const f32x4 gg = *(const LAS f32x4*)(g + idx), s1 = *(const LAS f32x4*)(sc + idx), s0 = *(const LAS f32x4*)(sh + idx);
        const f32x4 o = v[j] * rstd * gg * (1.0f + s1) + s0;
        *(u32x2*)(hrow + idx) = pk4(o); }
}
__device__ __forceinline__ const float* x_in_row(const Args& A, int r) { return r < NTOK_P ? A.x_prompt + (size_t)r * 1024 : A.x_sample + (size_t)(r - NTOK_P) * 1024; }
__device__ __forceinline__ void fill_vec(LAS float* dst, const float* src, int tid) { if (tid < 256) *(LAS f32x4*)(dst + 4 * tid) = *(const f32x4*)(src + 4 * tid); }

__device__ __forceinline__ void phase_pre(const Args& A, LAS unsigned char* lds, int lane, int wave) {
    const int gw = blockIdx.x * 8 + wave, NGW = gridDim.x * 8;
    const float* mod = (const float*)(A.ws + WS_MOD); bf16* H = (bf16*)(A.ws + WS_H);
    LAS float* P = (LAS float*)lds;
    { const int t2 = (wave & 3) * 64 + lane, hv = wave >> 2;
      for (int v = hv; v < 11; v += 2) { const float* src = v == 0 ? A.g_pre_mix : (v <= 5 ? mod + (size_t)(v - 1) * 6144 + 1024 : mod + (size_t)(v - 6) * 6144);
          const int slot = v == 0 ? 1 : (v <= 5 ? 7 + (v - 1) : 12 + (v - 6));
          *(LAS f32x4*)(P + slot * 1024 + 4 * t2) = *(const f32x4*)(src + 4 * t2); } }
    __syncthreads();
    for (int r0 = gw; r0 < NTOK; r0 += 2 * NGW) {
        f32x4 v[2][4];
#pragma unroll
        for (int u = 0; u < 2; ++u) { const float* xr = x_in_row(A, r0 + u * NGW);
#pragma unroll
            for (int j = 0; j < 4; ++j) v[u][j] = __builtin_nontemporal_load((const f32x4*)(xr + 4 * lane + 256 * j)); }
#pragma unroll
        for (int u = 0; u < 2; ++u) { const int r = r0 + u * NGW, ci = cond_of_row(r);
            norm_mod_store(v[u], P + 1024, P + (7 + ci) * 1024, P + (12 + ci) * 1024, H + (size_t)r * 1024, lane); }
    }
    __syncthreads();
}

__device__ __forceinline__ void phase_post(const Args& A, int l, int which, LAS unsigned char* lds, int lane, int wave) {
    const int gw = blockIdx.x * 8 + wave, NGW = gridDim.x * 8;
    const float* mod = (const float*)(A.ws + WS_MOD); bf16* H = (bf16*)(A.ws + WS_H); const bf16* MIX = (const bf16*)(A.ws + WS_MIX);
    const bool first = (l == 0 && which == 0), has_h = (which == 0) || (l < DEPTH - 1), last = (l == DEPTH - 1 && which == 1);
    bf16* XB = (bf16*)(A.ws + WS_XB);
    LAS float* P = (LAS float*)lds;
    f32x4 rxf[2][4]; u32x2 rxb[2][4], rt[2][4];
#define POST_LOAD(r0_) do { _Pragma("unroll") for (int u = 0; u < 2; ++u) { const int r_ = (r0_) + u * NGW; \
        if (first) { const float* xr_ = x_in_row(A, r_); _Pragma("unroll") for (int j = 0; j < 4; ++j) rxf[u][j] = __builtin_nontemporal_load((const f32x4*)(xr_ + 4 * lane + 256 * j)); } \
        else { const bf16* xr_ = XB + (size_t)r_ * 1024; _Pragma("unroll") for (int j = 0; j < 4; ++j) rxb[u][j] = __builtin_nontemporal_load((const u32x2*)(xr_ + 4 * lane + 256 * j)); } \
        const bf16* tr_ = MIX + (size_t)r_ * 1024; _Pragma("unroll") for (int j = 0; j < 4; ++j) rt[u][j] = __builtin_nontemporal_load((const u32x2*)(tr_ + 4 * lane + 256 * j)); } } while (0)
#pragma unroll
    for (int u = 0; u < 2; ++u)
#pragma unroll
        for (int j = 0; j < 4; ++j) { rxf[u][j] = (f32x4){0.f, 0.f, 0.f, 0.f}; rxb[u][j] = (u32x2){0u, 0u}; }
    POST_LOAD(gw);
    { const int t2 = (wave & 3) * 64 + lane, hv = wave >> 2;
      const int l2 = which == 0 ? l : l + 1;
      const int l2c = l2 < DEPTH ? l2 : l, gofs = which == 0 ? 2048 : 5120, sofs = which == 0 ? 4096 : 1024, hofs = which == 0 ? 3072 : 0;
      const float* g01 = hv == 0 ? (which == 0 ? A.g_post_mix : A.g_post_ffn) + l * 1024 : (which == 0 ? A.g_pre_ffn + l * 1024 : A.g_pre_mix + l2c * 1024);
      f32x4 tmp[9];
      tmp[0] = *(const f32x4*)(g01 + 4 * t2);
#pragma unroll
      for (int vv = 1; vv < 9; ++vv) { const int v0 = hv + 2 * vv, v = v0 < 17 ? v0 : 16;
          const int off = v < 7 ? (l * 5 + (v - 2)) * 6144 + gofs : (v < 12 ? (l2c * 5 + (v - 7)) * 6144 + sofs : (l2c * 5 + (v - 12)) * 6144 + hofs);
          tmp[vv] = *(const f32x4*)(mod + off + 4 * t2); }
      __builtin_amdgcn_sched_barrier(0);
#pragma unroll
      for (int vv = 0; vv < 9; ++vv) { const int v = hv + 2 * vv; if (v < 17) *(LAS f32x4*)(P + v * 1024 + 4 * t2) = tmp[vv]; } }
    __syncthreads();
    for (int r0 = gw; r0 < NTOK; r0 += 2 * NGW) {
        f32x4 v[2][4], t[2][4];
#pragma unroll
        for (int u = 0; u < 2; ++u)
#pragma unroll
            for (int j = 0; j < 4; ++j) { v[u][j] = first ? rxf[u][j] : bf4(rxb[u][j]); t[u][j] = bf4(rt[u][j]); }
        if (r0 + 2 * NGW < NTOK) POST_LOAD(r0 + 2 * NGW);
#pragma unroll
        for (int u = 0; u < 2; ++u) { const int r = r0 + u * NGW; const LAS float* ga = P + (2 + cond_of_row(r)) * 1024;
            float ss = 0.f;
#pragma unroll
            for (int j = 0; j < 4; ++j) ss += sumsq4(t[u][j]);
            const float rstd = 1.0f / sqrtf(wave_sum(ss, lane) * (1.0f / 1024.0f) + EPS);
#pragma unroll
            for (int j = 0; j < 4; ++j) { const int idx = 4 * lane + 256 * j;
                const f32x4 gg = *(const LAS f32x4*)(P + idx), gv = *(const LAS f32x4*)(ga + idx);
                v[u][j] = v[u][j] + gv * (t[u][j] * rstd * gg);
                if (last) __builtin_nontemporal_store(v[u][j], (f32x4*)(A.out + (size_t)r * 1024 + idx));
                else __builtin_nontemporal_store(pk4(v[u][j]), (u32x2*)(XB + (size_t)r * 1024 + idx)); } }
        if (has_h) {
#pragma unroll
            for (int u = 0; u < 2; ++u) { const int r = r0 + u * NGW, ci = cond_of_row(r);
                norm_mod_store(v[u], P + 1024, P + (7 + ci) * 1024, P + (12 + ci) * 1024, H + (size_t)r * 1024, lane); } }
    }
    __syncthreads();
}

#undef POST_LOAD
__device__ __forceinline__ void phase_split(const Args& A, int l, int lane, int wave) {
    const int gw = blockIdx.x * 8 + wave, NGW = gridDim.x * 8;
    unsigned char* ws = A.ws;
    const bf16* Z = (const bf16*)(ws + WS_Z);
    bf16* QN = (bf16*)(ws + WS_QN); bf16* CKVN = (bf16*)(ws + WS_CKVN); bf16* KRB = (bf16*)(ws + WS_KRB); bf16* UG = (bf16*)(ws + WS_UG); bf16* VN = (bf16*)(ws + WS_VN);
    bf16* CC = (bf16*)(ws + WS_CONCAT);
    const float* ropec = (const float*)(ws + WS_ROPE); const float* ropes = ropec + 32768;
    float* out_ckv = A.out + (size_t)NTOK * 1024; float* out_kr = out_ckv + (size_t)32 * 4 * 256 * 256;
    for (int idx = gw; idx < 2048; idx += NGW) { const int r = NTOK + idx, b = idx >> 9, j = idx & 511;
        const f32x4 cv = *(const f32x4*)(A.cache_ckv + ((size_t)(b * 4 + l) * 512 + j) * 256 + 4 * lane);
        const float kv = A.cache_krope[((size_t)(b * 4 + l) * 512 + j) * 64 + lane];
        *(u32x2*)(CKVN + (size_t)r * 256 + 4 * lane) = pk4(cv);
        KRB[(size_t)r * 64 + lane] = (bf16)(cvt_pk_bf16(kv, 0.f) & 0xffffu); }
    const f32x4 gkv = *(const f32x4*)(A.g_kv + l * 256 + 4 * lane), gvv = *(const f32x4*)(A.g_v + l * 256 + 4 * lane);
    const float* wcp = A.w_conv + (size_t)l * 3 * 256 + 4 * lane;
    const f32x4 wc0 = *(const f32x4*)(wcp), wc1 = *(const f32x4*)(wcp + 256), wc2 = *(const f32x4*)(wcp + 512);
    f32x2 gq[3];
#pragma unroll
    for (int j = 0; j < 3; ++j) gq[j] = *(const f32x2*)(A.g_q + l * 384 + 2 * lane + 128 * j);
    for (int r0 = gw; r0 < NTOK; r0 += 2 * NGW) {
        f32x2 q[2][3]; f32x4 cv[2], uu[2], vv[2], bg[2], zc[2], zm[2], zp[2]; float kr[2], cs[2], sn[2];
#pragma unroll
        for (int u = 0; u < 2; ++u) { const int r = r0 + u * NGW; const bf16* z = Z + (size_t)r * INC;
            const bool prompt = r < NTOK_P; const int n = prompt ? (r & 255) : ((r - NTOK_P) & 1023), len = prompt ? 256 : 1024;
#pragma unroll
            for (int j = 0; j < 3; ++j) q[u][j] = ld2bf(z + ZQ + 2 * lane + 128 * j);
            cv[u] = ld4bf(z + ZCKV + 4 * lane); kr[u] = ld1bf(z + ZKR + lane);
            uu[u] = ld4bf(z + ZU + 4 * lane); vv[u] = ld4bf(z + ZV + 4 * lane); bg[u] = ld4bf(z + ZBG + 4 * lane);
            zc[u] = ld4bf(z + ZCG + 4 * lane) * ld4bf(z + ZHH + 4 * lane);
            zm[u] = (f32x4){0.f, 0.f, 0.f, 0.f}; zp[u] = zm[u];
            if (n > 0) zm[u] = ld4bf(z - INC + ZCG + 4 * lane) * ld4bf(z - INC + ZHH + 4 * lane);
            if (n < len - 1) zp[u] = ld4bf(z + INC + ZCG + 4 * lane) * ld4bf(z + INC + ZHH + 4 * lane);
            cs[u] = 1.f; sn[u] = 0.f;
            if (!prompt) { const int a = lane >> 5, f = lane & 15; cs[u] = ropec[n * 32 + a * 16 + f]; sn[u] = ropes[n * 32 + a * 16 + f]; } }
#pragma unroll
        for (int u = 0; u < 2; ++u) { const int r = r0 + u * NGW; const bool prompt = r < NTOK_P; const int n = prompt ? (r & 255) : ((r - NTOK_P) & 1023);
            { float ss = 0.f;
#pragma unroll
              for (int j = 0; j < 3; ++j) ss += q[u][j].x * q[u][j].x + q[u][j].y * q[u][j].y;
              const float rstd = 1.0f / sqrtf(wave_sum(ss, lane) * (1.0f / 384.0f) + EPS);
#pragma unroll
              for (int j = 0; j < 3; ++j) *(unsigned*)(QN + (size_t)r * 384 + 2 * lane + 128 * j) = cvt_pk_bf16(q[u][j].x * rstd * gq[j].x, q[u][j].y * rstd * gq[j].y); }
            { const float rstd = 1.0f / sqrtf(wave_sum(sumsq4(cv[u]), lane) * (1.0f / 256.0f) + EPS);
              const f32x4 c2 = cv[u] * rstd * gkv;
              if (prompt) __builtin_nontemporal_store(c2, (f32x4*)(out_ckv + ((size_t)((r >> 8) * 4 + l) * 256 + n) * 256 + 4 * lane));
              *(u32x2*)(CKVN + (size_t)r * 256 + 4 * lane) = pk4(c2); }
            { float k2 = kr[u];
              if (prompt) __builtin_nontemporal_store(k2, out_kr + ((size_t)((r >> 8) * 4 + l) * 256 + n) * 64 + lane);
              else { const float partner = shx(k2, 16, lane); const int p = (lane >> 4) & 1;
                  k2 = p == 0 ? k2 * cs[u] - partner * sn[u] : partner * sn[u] + k2 * cs[u]; }
              KRB[(size_t)r * 64 + lane] = (bf16)(cvt_pk_bf16(k2, 0.f) & 0xffffu); }
            *(u32x2*)(UG + (size_t)r * 256 + 4 * lane) = pk4(gelu4(uu[u]));
            { f32x4 v = gelu4(vv[u]);
              const float rstd = 1.0f / sqrtf(wave_sum(sumsq4(v), lane) * (1.0f / 256.0f) + EPS);
              *(u32x2*)(VN + (size_t)r * 256 + 4 * lane) = pk4(v * rstd * gvv); }
            { const f32x4 y = zm[u] * wc0 + zc[u] * wc1 + zp[u] * wc2;
              *(u32x2*)(CC + (size_t)r * 1024 + 768 + 4 * lane) = pk4(bg[u] * y); }
        }
    }
}

#define MFMA32(a, b, c) __builtin_amdgcn_mfma_f32_32x32x16_bf16((a), (b), (c), 0, 0, 0)
constexpr int AT_KROW = 400, AT_VROW = 144, AT_KBYTES = 64 * AT_KROW, AT_STAGE = AT_KBYTES + 128 * AT_VROW;
__device__ __forceinline__ void attn_store_tile(const f32x16& ot, float inv, bf16* crow  , int t, int hh) {
#pragma unroll
    for (int g = 0; g < 4; ++g) { u32x2 w; w.x = cvt_pk_bf16(ot[4 * g] * inv, ot[4 * g + 1] * inv); w.y = cvt_pk_bf16(ot[4 * g + 2] * inv, ot[4 * g + 3] * inv);
        *(u32x2*)(crow + 32 * t + 8 * g + 4 * hh) = w; }
}

__device__ __forceinline__ void phase_mixer(const Args& A, int l, LAS unsigned char* lds, int lane_in, int wave) {
    unsigned char* ws = A.ws;
    const bf16* Q = (const bf16*)(ws + WS_Q); const bf16* KN = (const bf16*)(ws + WS_KNOPE); const bf16* KRB = (const bf16*)(ws + WS_KRB);
    const bf16* VTP = (const bf16*)(ws + WS_VTP); const bf16* VTS = (const bf16*)(ws + WS_VTS);
    const bf16* UG = (const bf16*)(ws + WS_UG); const bf16* VN = (const bf16*)(ws + WS_VN);
    bf16* CC = (bf16*)(ws + WS_CONCAT);
    for (int slot = 0; ; ++slot) {
        int it;
        if (gridDim.x == 256) {
            if (slot == 0) it = blockIdx.x; else if (slot == 1 && blockIdx.x >= 128 && blockIdx.x < 224) it = 256 + (int)blockIdx.x - 128; else break;
        } else { it = (int)blockIdx.x + slot * (int)gridDim.x; if (it >= 352) break; }
        int lane = lane_in; asm volatile("" : "+v"(lane));
        const int rho = lane & 31, hh = lane >> 5, tid = wave * 64 + lane;
        if (it < 256) {
            int h, q0, keys, nkeys, split, rowA, rowB; const bf16* vt;
            const bool heavy = it < 128;
            if (heavy) {
                const int xj = it >> 3, pr = 2 * (it & 7) + (xj >> 3), b = pr >> 2, qt = xj & 7; h = pr & 3;
                q0 = NTOK_P + b * 1024 + qt * 128 + (wave & 3) * 32; keys = 1536; nkeys = 1536; split = 512; rowA = NTOK + b * 512; rowB = NTOK_P + b * 1024;
                vt = VTS + (size_t)((b * 4 + h) * 128) * 1536; }
            else { const int i2 = it - 128, b = i2 >> 2; h = i2 & 3; q0 = b * 256 + wave * 32; keys = 256; nkeys = 256; split = 0; rowA = 0; rowB = b * 256;
                vt = VTP + (size_t)((b * 4 + h) * 128) * 256; }
            bf16x8 qf[12];
            { const bf16* qp = Q + (size_t)(q0 + rho) * 768 + h * 192 + 8 * hh;
#pragma unroll
              for (int ks = 0; ks < 12; ++ks) qf[ks] = *(const bf16x8*)(qp + 16 * ks); }
            if (heavy) {
                const float* ropec = (const float*)(ws + WS_ROPE); const int ntok = (q0 + rho - NTOK_P) & 1023;
#pragma unroll
                for (int a = 0; a < 2; ++a) { const float* cp = ropec + ntok * 32 + a * 16 + 8 * hh;
                    const f32x4 c0 = *(const f32x4*)cp, c1 = *(const f32x4*)(cp + 4), s0 = *(const f32x4*)(cp + 32768), s1 = *(const f32x4*)(cp + 32768 + 4);
                    const u32x4 w1 = __builtin_bit_cast(u32x4, qf[8 + 2 * a]), w2 = __builtin_bit_cast(u32x4, qf[9 + 2 * a]); u32x4 r1, r2;
#pragma unroll
                    for (int j = 0; j < 4; ++j) { const float x1l = __uint_as_float(w1[j] << 16), x1h = __uint_as_float(w1[j] & 0xffff0000u), x2l = __uint_as_float(w2[j] << 16), x2h = __uint_as_float(w2[j] & 0xffff0000u);
                        const float cl = j < 2 ? c0[2 * j] : c1[2 * j - 4], ch = j < 2 ? c0[2 * j + 1] : c1[2 * j - 3], sl = j < 2 ? s0[2 * j] : s1[2 * j - 4], sh = j < 2 ? s0[2 * j + 1] : s1[2 * j - 3];
                        r1[j] = cvt_pk_bf16(x1l * cl - x2l * sl, x1h * ch - x2h * sh); r2[j] = cvt_pk_bf16(x1l * sl + x2l * cl, x1h * sh + x2h * ch); }
                    qf[8 + 2 * a] = __builtin_bit_cast(bf16x8, r1); qf[9 + 2 * a] = __builtin_bit_cast(bf16x8, r2); }
            }
            f32x16 o[4];
#pragma unroll
            for (int t = 0; t < 4; ++t)
#pragma unroll
                for (int i = 0; i < 16; ++i) o[t][i] = 0.f;
            float m = 0.f, lsum = 0.f; bool fresh = true;
            int kslot[2], kcol[2], vd[2], vc[2];
#pragma unroll
            for (int j = 0; j < 2; ++j) { const int c = tid + 512 * j, kap = c >> 4; kcol[j] = c & 15;
                kslot[j] = (kap & 32) + (kap & 3) + 4 * ((kap >> 4) & 1) + 8 * ((kap >> 2) & 3);
                vd[j] = c >> 3; vc[j] = c & 7; }
            const int rkap = tid >> 3, rc8 = tid & 7, rslot = (rkap & 32) + (rkap & 3) + 4 * ((rkap >> 4) & 1) + 8 * ((rkap >> 2) & 3);
            u32x4 sk[2], sr, sv[2];
#define AT_GLOAD(k0) do { const int rb_ = (k0) < split ? rowA + (k0) : rowB + ((k0) - split); \
                _Pragma("unroll") for (int j = 0; j < 2; ++j) sk[j] = *(const u32x4*)(KN + (size_t)(rb_ + ((tid + 512 * j) >> 4)) * 512 + h * 128 + kcol[j] * 8); \
                sr = *(const u32x4*)(KRB + (size_t)(rb_ + rkap) * 64 + rc8 * 8); \
                _Pragma("unroll") for (int j = 0; j < 2; ++j) sv[j] = *(const u32x4*)(vt + (size_t)vd[j] * keys + (k0) + vc[j] * 8); } while (0)
#define AT_SWRITE(buf) do { LAS unsigned char* sb_ = lds + (buf) * AT_STAGE; \
                _Pragma("unroll") for (int j = 0; j < 2; ++j) *(LAS u32x4*)(sb_ + kslot[j] * AT_KROW + kcol[j] * 16) = sk[j]; \
                *(LAS u32x4*)(sb_ + rslot * AT_KROW + 256 + rc8 * 16) = sr; \
                _Pragma("unroll") for (int j = 0; j < 2; ++j) *(LAS u32x4*)(sb_ + AT_KBYTES + vd[j] * AT_VROW + vc[j] * 16) = sv[j]; } while (0)
            const int ntile = nkeys >> 6;
            const int blk_lo = heavy ? (wave >> 2) : 0, blk_hi = heavy ? blk_lo + 1 : 2;
            AT_GLOAD(0); AT_SWRITE(0);
            __syncthreads();
            for (int tI = 0; tI < ntile; ++tI) {
                if (tI + 1 < ntile) AT_GLOAD((tI + 1) * 64);
                { const LAS unsigned char* sb = lds + (tI & 1) * AT_STAGE;
                for (int blk = blk_lo; blk < blk_hi; ++blk) {
                    const LAS unsigned char* kp = sb + (32 * blk + rho) * AT_KROW + hh * 16;
                    f32x16 sc;
#pragma unroll
                    for (int i = 0; i < 16; ++i) sc[i] = -m;
                    bf16x8 kf[12];
#pragma unroll
                    for (int ks = 0; ks < 12; ++ks) kf[ks] = *(const LAS bf16x8*)(kp + ks * 32);
                    __builtin_amdgcn_sched_barrier(0);
#pragma unroll
                    for (int ks = 0; ks < 12; ++ks) sc = MFMA32(kf[ks], qf[ks], sc);
                    const LAS unsigned char* vp = sb + AT_KBYTES + rho * AT_VROW + (32 * blk + 16 * hh) * 2;
                    bf16x8 vf[8];
#pragma unroll
                    for (int t = 0; t < 4; ++t)
#pragma unroll
                        for (int s2 = 0; s2 < 2; ++s2) vf[t * 2 + s2] = *(const LAS bf16x8*)(vp + 32 * t * AT_VROW + 16 * s2);
                    __builtin_amdgcn_sched_barrier(0);
                    float mx = sc[0];
#pragma unroll
                    for (int i = 1; i < 16; ++i) mx = fmaxf(mx, sc[i]);
                    { const auto rr = __builtin_amdgcn_permlane32_swap(__float_as_uint(mx), __float_as_uint(mx), false, false); mx = fmaxf(__uint_as_float(rr[0]), __uint_as_float(rr[1])); }
                    if (fresh || __builtin_amdgcn_ballot_w64(mx > 8.0f) != 0ull) { const float delta = fresh ? mx : fmaxf(mx, 0.f), alpha = fresh ? 0.f : __builtin_amdgcn_exp2f(-delta); m += delta; lsum *= alpha; fresh = false;
#pragma unroll
                        for (int i = 0; i < 16; ++i) sc[i] -= delta;
#pragma unroll
                        for (int t = 0; t < 4; ++t) o[t] = o[t] * alpha; }
                    float ps = 0.f;
#pragma unroll
                    for (int i = 0; i < 16; ++i) { sc[i] = __builtin_amdgcn_exp2f(sc[i]); ps += sc[i]; }
                    lsum += ps;
                    bf16x8 pb[2];
#pragma unroll
                    for (int s2 = 0; s2 < 2; ++s2) { u32x4 w; w.x = cvt_pk_bf16(sc[8 * s2 + 0], sc[8 * s2 + 1]); w.y = cvt_pk_bf16(sc[8 * s2 + 2], sc[8 * s2 + 3]); w.z = cvt_pk_bf16(sc[8 * s2 + 4], sc[8 * s2 + 5]); w.w = cvt_pk_bf16(sc[8 * s2 + 6], sc[8 * s2 + 7]);
                        pb[s2] = __builtin_bit_cast(bf16x8, w); }
#pragma unroll
                    for (int s2 = 0; s2 < 2; ++s2)
#pragma unroll
                        for (int t = 0; t < 4; ++t) o[t] = MFMA32(vf[t * 2 + s2], pb[s2], o[t]);
                }
                }
                if (tI + 1 < ntile) AT_SWRITE((tI + 1) & 1);
                __syncthreads();
            }
#undef AT_GLOAD
#undef AT_SWRITE
            lsum += shx(lsum, 32, lane);
            bf16* crow = CC + (size_t)(q0 + rho) * 1024 + h * 128;
            if (!heavy) { const float inv = 1.0f / lsum;
#pragma unroll
                for (int t = 0; t < 4; ++t) attn_store_tile(o[t], inv, crow, t, hh);
            } else {
                const int half = wave >> 2;
                LAS float* mine = (LAS float*)(lds + wave * 8704);
                LAS const float* theirs = (LAS const float*)(lds + (wave ^ 4) * 8704);
#pragma unroll
                for (int t2 = 0; t2 < 2; ++t2)
#pragma unroll
                    for (int i = 0; i < 16; ++i) mine[(t2 * 16 + i) * 64 + lane] = half == 0 ? o[2 + t2][i] : o[t2][i];
                if (hh == 0) { mine[2048 + rho] = m; mine[2080 + rho] = lsum; }
                __syncthreads();
                const float mp = theirs[2048 + rho], lp = theirs[2080 + rho];
                const float mg = fmaxf(m, mp), wo = __builtin_amdgcn_exp2f(m - mg), wp = __builtin_amdgcn_exp2f(mp - mg);
                const float inv = 1.0f / (wo * lsum + wp * lp);
#pragma unroll
                for (int t2 = 0; t2 < 2; ++t2) { f32x16 acc;
#pragma unroll
                    for (int i = 0; i < 16; ++i) acc[i] = wo * (half == 0 ? o[t2][i] : o[2 + t2][i]) + wp * theirs[(t2 * 16 + i) * 64 + lane];
                    attn_store_tile(acc, inv, crow, half * 2 + t2, hh); }
                __syncthreads();
            }
        } else {
            const int c = it - 256;
            const int hd = wave & 3, ph = wave >> 2;
            const float* wbase = A.w_s + ((size_t)(l * 4 + hd) * 128 + 64 * ph + rho) * 128 + 8 * hh;
            f32x4 wva[16], wvb[16];
#pragma unroll
            for (int ks = 0; ks < 8; ++ks) { wva[2 * ks] = *(const f32x4*)(wbase + 16 * ks); wva[2 * ks + 1] = *(const f32x4*)(wbase + 16 * ks + 4); }
            LAS bf16* vnT = (LAS bf16*)lds;
            { bf16x8 vv[8];
#pragma unroll
              for (int pass = 0; pass < 8; ++pass) { const int u = wave + 8 * pass, qq = (u & 1) * 64 + lane, c8 = (u >> 1) * 8; vv[pass] = *(const bf16x8*)(VN + (size_t)(c * 128 + qq) * 256 + c8); }
#pragma unroll
              for (int pass = 0; pass < 8; ++pass) { const int u = wave + 8 * pass, qq = (u & 1) * 64 + lane, c8 = (u >> 1) * 8;
#pragma unroll
                for (int j = 0; j < 8; ++j) vnT[(c8 + j) * 136 + qq] = (bf16)vv[pass][j]; } }
            __syncthreads();
#pragma unroll
            for (int pp = 0; pp < 2; ++pp) { const int pt = 2 * ph + pp;
                bf16x8 af[8];
#pragma unroll
                for (int ks = 0; ks < 8; ++ks) { const f32x4 w0 = pp == 0 ? wva[2 * ks] : wvb[2 * ks], w1 = pp == 0 ? wva[2 * ks + 1] : wvb[2 * ks + 1];
                    u32x4 w; w.x = cvt_pk_bf16(w0.x, w0.y); w.y = cvt_pk_bf16(w0.z, w0.w); w.z = cvt_pk_bf16(w1.x, w1.y); w.w = cvt_pk_bf16(w1.z, w1.w); af[ks] = __builtin_bit_cast(bf16x8, w); }
                if (pp == 0) {
#pragma unroll
                    for (int ks = 0; ks < 8; ++ks) { wvb[2 * ks] = *(const f32x4*)(wbase + 32 * 128 + 16 * ks); wvb[2 * ks + 1] = *(const f32x4*)(wbase + 32 * 128 + 16 * ks + 4); } }
                float bs[16]; bf16 ugv[2][16];
#pragma unroll
                for (int i = 0; i < 16; ++i) { const int p = 32 * pt + (i & 3) + 8 * (i >> 2) + 4 * hh; bs[i] = A.b_s[(l * 4 + hd) * 128 + p];
#pragma unroll
                    for (int d = 0; d < 2; ++d) ugv[d][i] = UG[((size_t)c * 128 + p) * 256 + hd * 64 + 32 * d + rho]; }
                f32x16 acc[2];
#pragma unroll
                for (int d = 0; d < 2; ++d)
#pragma unroll
                    for (int i = 0; i < 16; ++i) acc[d][i] = 0.f;
#pragma unroll
                for (int ks = 0; ks < 8; ++ks)
#pragma unroll
                    for (int d = 0; d < 2; ++d) { const bf16x8 bfr = *(const LAS bf16x8*)(vnT + (hd * 64 + 32 * d + rho) * 136 + 16 * ks + 8 * hh); acc[d] = MFMA32(af[ks], bfr, acc[d]); }
#pragma unroll
                for (int d = 0; d < 2; ++d) { const int col = hd * 64 + 32 * d + rho;
#pragma unroll
                    for (int i = 0; i < 16; ++i) { const int p = 32 * pt + (i & 3) + 8 * (i >> 2) + 4 * hh; const size_t row = (size_t)c * 128 + p;
                        const float mixed = acc[d][i] + bs[i];
                        const float ug = __uint_as_float((unsigned)ugv[d][i] << 16);
                        CC[row * 1024 + 512 + col] = (bf16)(cvt_pk_bf16(ug * mixed, 0.f) & 0xffffu); } }
            }
            __syncthreads();
        }
    }
}

__global__ void __launch_bounds__(512, 2) fwd_megakernel(Args A) {
    extern __shared__ __attribute__((aligned(16))) unsigned char smem[];
    LAS unsigned char* lds = (LAS unsigned char*)smem;
    const int wave0 = __builtin_amdgcn_readfirstlane((int)threadIdx.x >> 6);
    unsigned* const bar = (unsigned*)(A.ws + WS_BAR);
    volatile LAS unsigned* const barst = (volatile LAS unsigned*)(lds + LDS_BARST);
    const unsigned xcc = xb_xcc_id();
    if (wave0 == 0) { const int l0 = fresh_lane(); if (l0 < 2) barst[l0] = 0u; if (l0 == 0 && A.ph_hi - A.ph_lo > 1) (void)xb_add(&bar[XB_XCNT(xcc)], 1u); }
    __syncthreads();
    if (A.ph_lo < 0) cg::this_grid().sync();
    bool dup_done = false; (void)dup_done;
    for (int ph = A.ph_lo; ph < A.ph_hi; ++ph) {
        const int wave = wave0;
#define LANE fresh_lane()
#define TID (wave * 64 + fresh_lane())
        unsigned char* ws = A.ws; asm volatile("" : "+s"(ws));
        if (ph == 0) phase_prologue(A, lds, wave);
        else if (ph == 1) phase_pre(A, lds, LANE, wave);
        else {
            const int l = (ph - 2) / 9, k = (ph - 2) % 9;
            const int G = gridDim.x, bid = blockIdx.x;
            if (k == 0) {
                pg8::Gemm g{(const bf16*)(ws + WS_H), (const bf16*)(ws + WS_WIN) + (size_t)l * 2048 * 1024, NTOK, 2048, 1024}; pg8::StaticOrder S; S.init(NTOK, 2048, G, bid);
                EpiB16<0> E{(bf16*)(ws + WS_Z), INC, INC}; pg8::gemm_phase<EpiB16<0>, pg8::StaticOrder, true>(lds, g, S, E, TID);
            } else if (k == 1) phase_split(A, l, LANE, wave);
            else if (k == 2) {
                { pg8::Gemm g{(const bf16*)(ws + WS_QN), (const bf16*)(ws + WS_WUQ) + (size_t)l * 768 * 384, NTOK, 768, 384}; pg8::StaticOrder S; S.init(NTOK, 768, G, bid);
                  EpiB16<0> E{(bf16*)(ws + WS_Q), 768, 768}; pg8::gemm_phase<EpiB16<0>, pg8::StaticOrder, false>(lds, g, S, E, TID); }
                { pg8::Gemm g{(const bf16*)(ws + WS_CKVN), (const bf16*)(ws + WS_WUKV) + (size_t)l * 1024 * 256, NROWKV, 1024, 256}; pg8::StaticOrder S; S.init(NROWKV, 1024, G, (bid + G - 144 % G) % G);
                  EpiKV E{(bf16*)(ws + WS_KNOPE), (bf16*)(ws + WS_VTP), (bf16*)(ws + WS_VTS)}; pg8::gemm_phase<EpiKV, pg8::StaticOrder, false>(lds, g, S, E, TID); }
            } else if (k == 3) phase_mixer(A, l, lds, LANE, wave);
            else if (k == 4 || k == 7) {
                const bool o = (k == 4);
                pg8::Gemm g{(const bf16*)(ws + (o ? WS_CONCAT : WS_ACT)), o ? (const bf16*)(ws + WS_WOUT) + (size_t)l * 1024 * 1024 : (const bf16*)(ws + WS_WFF2) + (size_t)l * 1024 * 4096, NTOK, 1024, o ? 1024 : 4096};
                pg8::StaticOrder S; S.init(NTOK, 1024, G, bid);
                EpiB16<0> E{(bf16*)(ws + WS_MIX), 1024, 1024}; pg8::gemm_phase<EpiB16<0>, pg8::StaticOrder, true>(lds, g, S, E, TID);
                if (!o && l + 1 < DEPTH) { const int first = G > 192 ? 192 : 0;
                    if (bid >= first) convert_layer(A, lds, l + 1, (bid - first) * 8 + wave, (G - first) * 8, wave, LANE); }
            } else if (k == 5) phase_post(A, l, 0, lds, LANE, wave);
            else if (k == 6) {
                pg8::Gemm g{(const bf16*)(ws + WS_H), (const bf16*)(ws + WS_WFF1) + (size_t)l * 4096 * 1024, NTOK, 4096, 1024}; pg8::StaticOrder S; S.init(NTOK, 4096, G, bid);
                EpiB16<1> E{(bf16*)(ws + WS_ACT), 4096, 4096}; pg8::gemm_phase<EpiB16<1>, pg8::StaticOrder, true>(lds, g, S, E, TID);
            } else phase_post(A, l, 1, lds, LANE, wave);
        }
        if (ph + 1 < A.ph_hi) xcd_barrier(bar, xcc, barst, wave == 0 && fresh_lane() == 0);
#if PROBE_DUP >= 0
        {
            bool again = false;
            if (PROBE_DUP == 100) { if (ph + 1 < A.ph_hi) xcd_barrier(bar, xcc, barst, wave == 0 && fresh_lane() == 0); }
            else if (!dup_done) {
                const int kk = ph >= 2 ? (ph - 2) % 9 : -1;
                if (PROBE_DUP == 50) again = (ph == 0);
                else if (PROBE_DUP == 60) again = (kk == 0 || kk == 2 || kk == 4 || kk == 6 || kk == 7);
                else again = (kk == PROBE_DUP);
            }
            if (again) { dup_done = true; --ph; } else dup_done = false;
        }
#endif
    }
}

constexpr int N_PHASES = 2 + 9 * DEPTH;

extern "C" void kernel_launch(void* const* d_in, const int* in_sizes, int n_in, void* d_out, int out_size, void* d_ws, size_t ws_size, hipStream_t stream) {
    static int grid = 0;
    if (grid == 0) {
        if (n_in != 24 || ws_size < WS_END || in_sizes[9] != DEPTH * 1024 * INC) { fprintf(stderr, "kernel_launch: unexpected problem (n_in %d, ws %zu, w_in %d)\n", n_in, ws_size, n_in > 9 ? in_sizes[9] : -1); grid = -1; return; }
        int dev = 0, cus = 0, per_cu = 0;
        hipGetDevice(&dev); hipDeviceGetAttribute(&cus, hipDeviceAttributeMultiprocessorCount, dev);
        if (hipFuncSetAttribute((const void*)fwd_megakernel, hipFuncAttributeMaxDynamicSharedMemorySize, LDS_BYTES) != hipSuccess) { fprintf(stderr, "kernel_launch: hipFuncSetAttribute failed\n"); grid = -1; return; }
        if (hipOccupancyMaxActiveBlocksPerMultiprocessor(&per_cu, (const void*)fwd_megakernel, 512, LDS_BYTES) != hipSuccess || per_cu < 1) { fprintf(stderr, "kernel_launch: occupancy query says %d\n", per_cu); per_cu = 1; }
        (void)hipGetLastError();
        grid = cus * 1;
        fprintf(stderr, "kernel_launch: grid %d (cus %d, per_cu %d)\n", grid, cus, per_cu);
    }
    if (grid < 0) return;
    if (hipMemsetAsync((char*)d_ws + WS_BAR, 0, 16384, stream) != hipSuccess) { fprintf(stderr, "kernel_launch: memset failed\n"); return; }
    Args a{};
    const float** ap = (const float**)&a;
    for (int i = 0; i < 24; ++i) ap[i] = (const float*)d_in[i];
    a.out = (float*)d_out; a.ws = (unsigned char*)d_ws;
#if MK_PER_PHASE
    for (int ph = 0; ph < N_PHASES; ++ph) { a.ph_lo = ph; a.ph_hi = ph + 1; hipLaunchKernelGGL(fwd_megakernel, dim3(grid), dim3(512), LDS_BYTES, stream, a); }
#else
    a.ph_lo = 0; a.ph_hi = N_PHASES;
    void* args[] = {&a};
    hipError_t e = hipLaunchCooperativeKernel((const void*)fwd_megakernel, dim3(grid), dim3(512), args, LDS_BYTES, stream);
    if (e != hipSuccess) fprintf(stderr, "kernel_launch: cooperative launch failed: %s (grid %d)\n", hipGetErrorString(e), grid);
#endif
}
```

```cpp
#include <hip/hip_runtime.h>
#include <hip/hip_cooperative_groups.h>
#include <cstdio>
namespace cg = cooperative_groups;

#ifndef MK_PER_PHASE
#define MK_PER_PHASE 0
#endif

#ifndef PROBE_DUP
#define PROBE_DUP -1
#endif
#define LAS __attribute__((address_space(3)))
typedef unsigned short bf16;
typedef short bf16x8 __attribute__((ext_vector_type(8)));
typedef float f32x2 __attribute__((ext_vector_type(2)));
typedef float f32x4 __attribute__((ext_vector_type(4)));
typedef float f32x16 __attribute__((ext_vector_type(16)));
typedef unsigned u32x2 __attribute__((ext_vector_type(2)));
typedef unsigned u32x4 __attribute__((ext_vector_type(4)));

constexpr int DM = 1024, NTOK_P = 8192, NTOK_S = 4096, NTOK = 12288, NROWKV = 14336;
constexpr int DEPTH = 4, INC = 1984, DFF = 4096;
constexpr int ZQ = 0, ZCKV = 384, ZKR = 640, ZU = 704, ZV = 960, ZBG = 1216, ZCG = 1472, ZHH = 1728;
constexpr float EPS = 1e-6f;
constexpr float QSCALE = 0.07216878364870322f * 1.4426950408889634f;

constexpr size_t MiB = 1u << 20;
constexpr size_t WS_MOD = 0, WS_BAR = 512 * 1024, WS_ROPE = 1 * MiB, WS_WIN = 2 * MiB, WS_WUQ = 18 * MiB, WS_WUKV = 21 * MiB, WS_WOUT = 23 * MiB,
                 WS_WFF1 = 31 * MiB, WS_WFF2 = 63 * MiB, WS_H = 95 * MiB, WS_MIX = 119 * MiB, WS_XB = 143 * MiB, WS_CONCAT = 167 * MiB, WS_QN = 191 * MiB,
                 WS_CKVN = 200 * MiB, WS_KRB = 207 * MiB, WS_UG = 209 * MiB, WS_VN = 215 * MiB, WS_Q = 221 * MiB, WS_KNOPE = 239 * MiB,
                 WS_VTP = 253 * MiB, WS_VTS = 261 * MiB, WS_Z = 267 * MiB, WS_ACT = 267 * MiB, WS_END = 363 * MiB;
constexpr int LDS_BYTES = 147456, LDS_BARST = LDS_BYTES - 64;

__device__ __forceinline__ unsigned cvt_pk_bf16(float lo, float hi) { unsigned r; asm volatile("v_cvt_pk_bf16_f32 %0, %1, %2" : "=v"(r) : "v"(lo), "v"(hi)); return r; }
__device__ __forceinline__ int fresh_lane() { int l; asm volatile("v_mbcnt_lo_u32_b32 %0, -1, 0\n\tv_mbcnt_hi_u32_b32 %0, -1, %0" : "=v"(l)); return l; }
__device__ __forceinline__ float shx(float v, int mask, int lane) { return __int_as_float(__builtin_amdgcn_ds_bpermute((lane ^ mask) << 2, __float_as_int(v))); }
__device__ __forceinline__ float dpp_add(float v, const int ctrl_is) {
    return v; }
#define DPP_ADD(v, ctrl) ((v) + __int_as_float(__builtin_amdgcn_update_dpp(0, __float_as_int(v), (ctrl), 0xf, 0xf, true)))
__device__ __forceinline__ float wave_sum(float v, int lane) {
    (void)lane;
    v = DPP_ADD(v, 0xB1);
    v = DPP_ADD(v, 0x4E);
    v = DPP_ADD(v, 0x141);
    v = DPP_ADD(v, 0x140);
    const int vi = __float_as_int(v);
    return (__int_as_float(__builtin_amdgcn_readlane(vi, 0)) + __int_as_float(__builtin_amdgcn_readlane(vi, 16))) + (__int_as_float(__builtin_amdgcn_readlane(vi, 32)) + __int_as_float(__builtin_amdgcn_readlane(vi, 48)));
}
__device__ __forceinline__ float gelu_tanh(float x) { const float y = 0.7978845608028654f * (x + 0.044715f * x * x * x); return x / (1.0f + __expf(-2.0f * y)); }
__device__ __forceinline__ f32x4 gelu4(f32x4 v) { return (f32x4){gelu_tanh(v.x), gelu_tanh(v.y), gelu_tanh(v.z), gelu_tanh(v.w)}; }
__device__ __forceinline__ float sumsq4(f32x4 v) { return (v.x * v.x + v.y * v.y) + (v.z * v.z + v.w * v.w); }
__device__ __forceinline__ f32x4 bf4(u32x2 w) { return (f32x4){__uint_as_float(w.x << 16), __uint_as_float(w.x & 0xffff0000u), __uint_as_float(w.y << 16), __uint_as_float(w.y & 0xffff0000u)}; }
__device__ __forceinline__ f32x4 ld4bf_nt(const bf16* p) { const u32x2 w = __builtin_nontemporal_load((const u32x2*)p); return (f32x4){__uint_as_float(w.x << 16), __uint_as_float(w.x & 0xffff0000u), __uint_as_float(w.y << 16), __uint_as_float(w.y & 0xffff0000u)}; }
__device__ __forceinline__ f32x4 ld4bf(const bf16* p) { const u32x2 w = *(const u32x2*)p; return (f32x4){__uint_as_float(w.x << 16), __uint_as_float(w.x & 0xffff0000u), __uint_as_float(w.y << 16), __uint_as_float(w.y & 0xffff0000u)}; }
__device__ __forceinline__ f32x2 ld2bf(const bf16* p) { const unsigned w = *(const unsigned*)p; return (f32x2){__uint_as_float(w << 16), __uint_as_float(w & 0xffff0000u)}; }
__device__ __forceinline__ float ld1bf(const bf16* p) { return __uint_as_float((unsigned)*p << 16); }
__device__ __forceinline__ u32x2 pk4(f32x4 v) { u32x2 w; w.x = cvt_pk_bf16(v.x, v.y); w.y = cvt_pk_bf16(v.z, v.w); return w; }


#define XB_TMO      128
#define XB_XCNT(j)  (256  + 64 * (j))
#define XB_XSUB(j)  (1280 + 64 * (j))
#define XB_XGEN(j)  (2304 + 64 * (j))
#define XB_TOP      3328
#define XB_TOPGEN   3392
#define XCD_BAR_WORDS 3456
#define XB_SPIN_CAP (1u << 18)
__device__ __forceinline__ unsigned xb_ld(unsigned* p)              { return __hip_atomic_load(p, __ATOMIC_RELAXED, __HIP_MEMORY_SCOPE_AGENT); }
__device__ __forceinline__ unsigned xb_add(unsigned* p, unsigned v) { return __hip_atomic_fetch_add(p, v, __ATOMIC_RELAXED, __HIP_MEMORY_SCOPE_AGENT); }
__device__ __forceinline__ unsigned xb_xcc_id() { return (unsigned)__builtin_amdgcn_s_getreg((3 << 11) | 20) & 0xFu; }
#define XB_SPIN(cond, bar) do { unsigned _sp = 0; while (cond) { __builtin_amdgcn_s_sleep(1); \
    if ((++_sp & 255u) == 0u) { if (xb_ld(&(bar)[XB_TMO])) break; if (_sp > XB_SPIN_CAP) { atomicAdd(&(bar)[XB_TMO], 1u); break; } } } } while (0)
__device__ __forceinline__ void xcd_barrier_complete(unsigned* bar, unsigned x, unsigned& nloc, unsigned& nx) {
    const unsigned G = gridDim.x * gridDim.y * gridDim.z;
    unsigned sum, cnt, mine, sp = 0u;
    for (;;) {
        sum = 0u; cnt = 0u; mine = 0u;
#pragma unroll
        for (unsigned j = 0; j < 16; ++j) { const unsigned c = xb_ld(&bar[XB_XCNT(j)]); sum += c; cnt += (c > 0u) ? 1u : 0u; mine = (j == x) ? c : mine; }
        if (sum == G) break;
        __builtin_amdgcn_s_sleep(1);
        if ((++sp & 255u) == 0u) { if (xb_ld(&bar[XB_TMO])) break; if (sp > XB_SPIN_CAP) { atomicAdd(&bar[XB_TMO], 1u); break; } }
    }
    nloc = mine > 0u ? mine : 1u; nx = cnt > 0u ? cnt : 1u;
}
__device__ __forceinline__ void xcd_barrier(unsigned* bar, unsigned x, volatile LAS unsigned* st, bool leader) {
    asm volatile("s_waitcnt vmcnt(0)" ::: "memory");
    __syncthreads();
    if (leader) {
        __builtin_amdgcn_s_waitcnt(0);
        unsigned nloc = st[0], nx = st[1];
        if (nloc == 0u) { xcd_barrier_complete(bar, x, nloc, nx); st[0] = nloc; st[1] = nx; }
        const unsigned old = xb_add(&bar[XB_XSUB(x)], 1u);
        const unsigned gen = old / nloc;
        if (old + 1u == (gen + 1u) * nloc) {
            __builtin_amdgcn_fence(__ATOMIC_RELEASE, "agent");
            asm volatile("s_waitcnt vmcnt(0)" ::: "memory");
            const unsigned og = xb_add(&bar[XB_TOP], 1u);
            const unsigned tg = og / nx;
            if (og + 1u == (tg + 1u) * nx) xb_add(&bar[XB_TOPGEN], 1u);
            else XB_SPIN(xb_ld(&bar[XB_TOPGEN]) == tg, bar);
            __builtin_amdgcn_fence(__ATOMIC_ACQUIRE, "agent");
            xb_add(&bar[XB_XGEN(x)], 1u);
            asm volatile("s_waitcnt vmcnt(0)" ::: "memory");
        } else {
            XB_SPIN(xb_ld(&bar[XB_XGEN(x)]) == gen, bar);
            __builtin_amdgcn_fence(__ATOMIC_ACQUIRE, "agent");
            asm volatile("s_waitcnt vmcnt(0)" ::: "memory");
        }
    }
    __syncthreads();
}

namespace pg8 {
#define PG8_LAS __attribute__((address_space(3)))
typedef unsigned short bf16_t;
constexpr int BM = 256, BK = 64, HALF = 128, HTB = HALF * BK * 2, STAGE_BYTES = 8 * HTB, NXCD = 8, WGM = 8;
__host__ __device__ __forceinline__ int lds_byte(int r, int c) { const int st = (r >> 4) * 2 + (c >> 5), rr = r & 15, cc = c & 31, ob = rr * 64 + cc * 2; return st * 1024 + (ob ^ (((ob >> 9) & 1) << 5)); }
__host__ __device__ __forceinline__ void stage_rc(int b, int& R, int& C) { const int st = b / 1024, sb = b % 1024, swz = sb ^ (((sb >> 9) & 1) << 5); R = (st >> 1) * 16 + swz / 64; C = (st & 1) * 32 + (swz % 64) / 2; }
__host__ __device__ __forceinline__ int perm32(int rho) { const int n = rho >> 4, i = rho & 15; return 8 * (i >> 2) + 4 * n + (i & 3); }
struct Unit { int pm, pn; };
struct Gemm { const bf16_t* A; const bf16_t* Bt; int M, N, K; };
struct StaticOrder {
    int nM, nN, nwg, G, c;
    __host__ __device__ void init(int M, int N, int G_, int c_) { nM = M / BM; nN = N / BM; nwg = nM * nN; G = G_; c = c_; }
    __host__ __device__ bool next(int i, Unit& u) const {
        const long L = (long)i * G + c; if (L >= nwg) return false;
        int wgid = (int)L; { const int q = nwg / NXCD, r = nwg % NXCD, xcd = wgid % NXCD, off = wgid / NXCD; wgid = (xcd < r ? xcd * (q + 1) : r * (q + 1) + (xcd - r) * q) + off; }
        const int nig = WGM * nN, gid = wgid / nig, fm = gid * WGM, gsz = (nM - fm) < WGM ? (nM - fm) : WGM;
        u.pm = fm + ((wgid % nig) % gsz); u.pn = (wgid % nig) / gsz; return true;
    }
    __device__ __forceinline__ void a_ready(const Unit&) const {}
    __device__ __forceinline__ void done(const Unit&) const {}
};

template <class Epi, class Sched, bool SP2>
__device__ __forceinline__ void gemm_phase(PG8_LAS unsigned char* lds, const Gemm g, const Sched& S, const Epi& E, const int tid) {
    const int wid = __builtin_amdgcn_readfirstlane(tid >> 6), lane = tid & 63, wr = wid >> 2, wc = wid & 3, fr = lane & 15, fq = lane >> 4;
    const int K = g.K, nt = K / BK;
    unsigned voffA[2], voffB[2];
#pragma unroll
    for (int i = 0; i < 2; ++i) { int R, C; stage_rc(tid * 16 + i * 8192, R, C); const int Rb = Epi::PERM ? ((R & ~31) + perm32(R & 31)) : R;
        voffA[i] = (unsigned)(R * K + C) * 2u; voffB[i] = (unsigned)(Rb * K + C) * 2u; }
    const size_t kstep = (size_t)(BK * 2);
    const size_t hstep = (size_t)HALF * K * 2;
    const size_t tstep = 2 * hstep;
    const unsigned ldsw = (unsigned)wid * 1024u;
    const int aoff = lds_byte(wr * 64 + fr, fq * 8), boff = lds_byte(wc * 32 + fr, fq * 8);
#define PG8_SA(b, h) (((b) * 2 + (h)) * HTB)
#define PG8_SB(b, h) ((4 + (b) * 2 + (h)) * HTB)
#define PG8_STAGE(bufoff, gbase, voff) do { _Pragma("unroll") for (int _i = 0; _i < 2; ++_i) \
        __builtin_amdgcn_global_load_lds((const unsigned*)((const char*)(gbase) + (voff)[_i]), (PG8_LAS unsigned*)(lds + (bufoff) + ldsw + _i * 8192), 16, 0, 0); } while (0)
#define PG8_LDA(dst, b, h) do { _Pragma("unroll") for (int m = 0; m < 4; ++m) _Pragma("unroll") for (int k = 0; k < 2; ++k) dst[m][k] = *(const PG8_LAS bf16x8*)(lds + PG8_SA(b, h) + aoff + m * 2048 + k * 1024); } while (0)
#define PG8_LDB(dst, b, h) do { _Pragma("unroll") for (int n = 0; n < 2; ++n) _Pragma("unroll") for (int k = 0; k < 2; ++k) dst[n][k] = *(const PG8_LAS bf16x8*)(lds + PG8_SB(b, h) + boff + n * 2048 + k * 1024); } while (0)
#define PG8_MMA(ai, bj, At, Bt) do { __builtin_amdgcn_s_setprio(1); _Pragma("unroll") for (int m = 0; m < 4; ++m) _Pragma("unroll") for (int n = 0; n < 2; ++n) _Pragma("unroll") for (int k = 0; k < 2; ++k) \
        acc[ai][bj][m][n] = __builtin_amdgcn_mfma_f32_16x16x32_bf16(Bt[n][k], At[m][k], acc[ai][bj][m][n], 0, 0, 0); __builtin_amdgcn_s_setprio(0); } while (0)
#define PG8_WAIT_V(n) asm volatile("s_waitcnt vmcnt(" #n ")" ::: "memory")
#define PG8_WAIT_L(n) asm volatile("s_waitcnt lgkmcnt(" #n ")" ::: "memory")
#define PG8_BAR __builtin_amdgcn_s_barrier()
#define PG8_SCHED __builtin_amdgcn_sched_barrier(0)
    Unit cur, nxt; int ui = 0;
    if (!S.next(0, cur)) return;
    f32x4 acc[2][2][4][2];
#pragma unroll
    for (int a = 0; a < 2; ++a)
#pragma unroll
        for (int b = 0; b < 2; ++b)
#pragma unroll
            for (int m = 0; m < 4; ++m)
#pragma unroll
                for (int n = 0; n < 2; ++n) acc[a][b][m][n] = (f32x4){0.f, 0.f, 0.f, 0.f};
    bf16x8 At[4][2], B0[2][2], B1[2][2];
    const char* cA = (const char*)g.A + (size_t)cur.pm * tstep; const char* cB = (const char*)g.Bt + (size_t)cur.pn * tstep;
    S.a_ready(cur);
    if constexpr (SP2) {
    PG8_STAGE(PG8_SB(0, 0), cB, voffB); PG8_STAGE(PG8_SB(0, 1), cB + hstep, voffB); PG8_STAGE(PG8_SA(0, 0), cA, voffA); PG8_STAGE(PG8_SA(0, 1), cA + hstep, voffA);
    if (wr == 1) PG8_BAR;
    PG8_WAIT_V(2); PG8_BAR;
    PG8_STAGE(PG8_SB(1, 0), cB + kstep, voffB); PG8_STAGE(PG8_SA(1, 0), cA + kstep, voffA); PG8_STAGE(PG8_SB(1, 1), cB + hstep + kstep, voffB);
    PG8_WAIT_V(6); PG8_BAR;
    } else {
    PG8_STAGE(PG8_SB(0, 0), cB, voffB); PG8_STAGE(PG8_SA(0, 0), cA, voffA); PG8_STAGE(PG8_SB(0, 1), cB + hstep, voffB); PG8_STAGE(PG8_SA(0, 1), cA + hstep, voffA);
    if (wr == 1) PG8_BAR;
    PG8_WAIT_V(4); PG8_BAR;
    PG8_STAGE(PG8_SB(1, 0), cB + kstep, voffB); PG8_STAGE(PG8_SA(1, 0), cA + kstep, voffA); PG8_STAGE(PG8_SB(1, 1), cB + hstep + kstep, voffB);
    PG8_WAIT_V(6); PG8_BAR;
    }
    for (;;) {
        const bool has_next = S.next(ui + 1, nxt);
        const char* nA = has_next ? (const char*)g.A + (size_t)nxt.pm * tstep : cA; const char* nB = has_next ? (const char*)g.Bt + (size_t)nxt.pn * tstep : cB;
        for (int t = 0; t < nt; t += 2) {
            asm volatile(".p2align 6");
            const bool last = (t == nt - 2);
            const char* a1 = cA + (size_t)(t + 1) * kstep;
            const char* a2 = last ? nA : cA + (size_t)(t + 2) * kstep; const char* b2 = last ? nB : cB + (size_t)(t + 2) * kstep;
            const char* a3 = a2 + kstep; const char* b3 = b2 + kstep;
            if (last && has_next) S.a_ready(nxt);
            if constexpr (SP2) {
            PG8_LDB(B0, 0, 0); PG8_LDB(B1, 0, 1); PG8_SCHED; PG8_LDA(At, 0, 0); PG8_STAGE(PG8_SA(1, 1), a1 + hstep, voffA);
            PG8_WAIT_V(8); PG8_WAIT_L(0); PG8_BAR; PG8_MMA(0, 0, At, B0); PG8_MMA(0, 1, At, B1); PG8_BAR; PG8_SCHED;
            PG8_LDA(At, 0, 1); PG8_STAGE(PG8_SB(0, 0), b2, voffB); PG8_STAGE(PG8_SB(0, 1), b2 + hstep, voffB); PG8_STAGE(PG8_SA(0, 0), a2, voffA);
            PG8_WAIT_V(8); PG8_WAIT_L(0); PG8_BAR; PG8_MMA(1, 0, At, B0); PG8_MMA(1, 1, At, B1); PG8_BAR; PG8_SCHED;
            PG8_LDB(B0, 1, 0); PG8_LDB(B1, 1, 1); PG8_SCHED; PG8_LDA(At, 1, 0); PG8_STAGE(PG8_SA(0, 1), a2 + hstep, voffA);
            PG8_WAIT_V(8); PG8_WAIT_L(0); PG8_BAR; PG8_MMA(0, 0, At, B0); PG8_MMA(0, 1, At, B1); PG8_BAR; PG8_SCHED;
            PG8_LDA(At, 1, 1); PG8_STAGE(PG8_SB(1, 0), b3, voffB); PG8_STAGE(PG8_SB(1, 1), b3 + hstep, voffB); PG8_STAGE(PG8_SA(1, 0), a3, voffA);
            PG8_WAIT_V(8); PG8_WAIT_L(0); PG8_BAR; PG8_MMA(1, 0, At, B0); PG8_MMA(1, 1, At, B1); PG8_BAR; PG8_SCHED;
            } else {
            PG8_LDB(B0, 0, 0); PG8_SCHED; PG8_LDA(At, 0, 0); PG8_STAGE(PG8_SA(1, 1), a1 + hstep, voffA);
            PG8_WAIT_L(8); PG8_BAR; PG8_WAIT_L(0); PG8_MMA(0, 0, At, B0); PG8_BAR; PG8_SCHED;
            PG8_LDB(B1, 0, 1); PG8_STAGE(PG8_SB(0, 0), b2, voffB);
            PG8_BAR; PG8_WAIT_L(0); PG8_MMA(0, 1, At, B1); PG8_BAR;
            PG8_LDA(At, 0, 1); PG8_STAGE(PG8_SA(0, 0), a2, voffA);
            PG8_BAR; PG8_WAIT_L(0); PG8_MMA(1, 0, At, B0); PG8_BAR; PG8_SCHED;
            PG8_STAGE(PG8_SB(0, 1), b2 + hstep, voffB);
            PG8_WAIT_V(6); PG8_BAR; PG8_MMA(1, 1, At, B1); PG8_BAR;
            PG8_LDB(B0, 1, 0); PG8_SCHED; PG8_LDA(At, 1, 0); PG8_STAGE(PG8_SA(0, 1), a2 + hstep, voffA);
            PG8_WAIT_L(8); PG8_BAR; PG8_WAIT_L(0); PG8_MMA(0, 0, At, B0); PG8_BAR; PG8_SCHED;
            PG8_LDB(B1, 1, 1); PG8_STAGE(PG8_SB(1, 0), b3, voffB);
            PG8_BAR; PG8_WAIT_L(0); PG8_MMA(0, 1, At, B1); PG8_BAR;
            PG8_LDA(At, 1, 1); PG8_STAGE(PG8_SA(1, 0), a3, voffA);
            PG8_BAR; PG8_WAIT_L(0); PG8_MMA(1, 0, At, B0); PG8_BAR; PG8_SCHED;
            PG8_STAGE(PG8_SB(1, 1), b3 + hstep, voffB);
            PG8_WAIT_V(6); PG8_BAR; PG8_MMA(1, 1, At, B1); PG8_BAR;
            }
        }
        if (wr == 0) PG8_BAR;
        E(acc, cur, wr, wc, fr, fq); S.done(cur);
        if (!has_next) break;
#pragma unroll
        for (int a = 0; a < 2; ++a)
#pragma unroll
            for (int b = 0; b < 2; ++b)
#pragma unroll
                for (int m = 0; m < 4; ++m)
#pragma unroll
                    for (int n = 0; n < 2; ++n) acc[a][b][m][n] = (f32x4){0.f, 0.f, 0.f, 0.f};
        cur = nxt; cA = nA; cB = nB; ++ui;
        if (wr == 1) PG8_BAR;
    }
    PG8_WAIT_V(0);
    PG8_BAR;
#undef PG8_SA
#undef PG8_SB
#undef PG8_STAGE
#undef PG8_LDA
#undef PG8_LDB
#undef PG8_MMA
#undef PG8_WAIT_V
#undef PG8_WAIT_L
#undef PG8_BAR
#undef PG8_SCHED
}
}

struct EpiF32 {
    static constexpr bool PERM = false;
    float* C; int ldc; int ncols;
    __device__ __forceinline__ void operator()(const f32x4 (&acc)[2][2][4][2], const pg8::Unit& u, int wr, int wc, int fr, int fq) const {
        const int row0 = u.pm * 256 + wr * 64 + fr, col0 = u.pn * 256 + wc * 32 + 4 * fq;
#pragma unroll
        for (int ai = 0; ai < 2; ++ai)
#pragma unroll
            for (int m = 0; m < 4; ++m) { float* rowp = C + (size_t)(row0 + ai * 128 + m * 16) * ldc + col0;
#pragma unroll
                for (int bj = 0; bj < 2; ++bj)
#pragma unroll
                    for (int n = 0; n < 2; ++n) if (col0 + bj * 128 + n * 16 < ncols) *(f32x4*)(rowp + bj * 128 + n * 16) = acc[ai][bj][m][n]; }
    }
};
template <int ACT> struct EpiB16 {
    static constexpr bool PERM = true;
    bf16* O; int ldc; int ncols;
    __device__ __forceinline__ void operator()(const f32x4 (&acc)[2][2][4][2], const pg8::Unit& u, int wr, int wc, int, int) const {
        const int ln = fresh_lane(), fr = ln & 15, fq = ln >> 4;
        const int row0 = u.pm * 256 + wr * 64 + fr, col0 = u.pn * 256 + wc * 32 + 8 * fq;
#pragma unroll
        for (int ai = 0; ai < 2; ++ai)
#pragma unroll
            for (int m = 0; m < 4; ++m) { bf16* rowp = O + (size_t)(row0 + ai * 128 + m * 16) * ldc + col0;
#pragma unroll
                for (int bj = 0; bj < 2; ++bj) { f32x4 v0 = acc[ai][bj][m][0], v1 = acc[ai][bj][m][1];
                    if (col0 + bj * 128 >= ncols) continue;
                    if (ACT) {
#pragma unroll
                    for (int j = 0; j < 4; ++j) { const float a = fmaxf(v0[j], 0.f), b = fmaxf(v1[j], 0.f); v0[j] = a * a; v1[j] = b * b; } }
                    u32x4 w; w.x = cvt_pk_bf16(v0[0], v0[1]); w.y = cvt_pk_bf16(v0[2], v0[3]); w.z = cvt_pk_bf16(v1[0], v1[1]); w.w = cvt_pk_bf16(v1[2], v1[3]);
                    *(u32x4*)(rowp + bj * 128) = w; } }
    }
};
struct EpiQ {
    static constexpr bool PERM = false;
    bf16* Q; const float* ropec; const float* ropes;
    __device__ __forceinline__ void operator()(const f32x4 (&acc)[2][2][4][2], const pg8::Unit& u, int wr, int wc, int, int) const {
        const int ln = fresh_lane(), fr = ln & 15, fq = ln >> 4;
        const int row0 = u.pm * 256 + wr * 64 + fr; const bool sample = u.pm >= 32;
#pragma unroll
        for (int bj = 0; bj < 2; ++bj) {
            const int g0 = u.pn * 256 + bj * 128 + wc * 32, within0 = g0 % 192; const bool isrope = within0 >= 128; const int a = (within0 - 128) >> 5;
#pragma unroll
            for (int ai = 0; ai < 2; ++ai)
#pragma unroll
                for (int m = 0; m < 4; ++m) { const int row = row0 + ai * 128 + m * 16;
                    f32x4 x1 = acc[ai][bj][m][0], x2 = acc[ai][bj][m][1];
                    if (sample && isrope) { const int ntok = (row - NTOK_P) & 1023;
                        const f32x4 cs = *(const f32x4*)(ropec + ntok * 32 + a * 16 + 4 * fq), sn = *(const f32x4*)(ropes + ntok * 32 + a * 16 + 4 * fq);
                        const f32x4 o1 = x1 * cs - x2 * sn, o2 = x1 * sn + x2 * cs; x1 = o1; x2 = o2; }
                    x1 = x1 * QSCALE; x2 = x2 * QSCALE;
                    bf16* p = Q + (size_t)row * 768 + g0 + 4 * fq;
                    *(u32x2*)p = pk4(x1); *(u32x2*)(p + 16) = pk4(x2); asm volatile("" ::: "memory"); }
        }
    }
};
struct EpiKV {
    static constexpr bool PERM = false;
    bf16* KN; bf16* VTP; bf16* VTS;
    __device__ __forceinline__ void operator()(const f32x4 (&acc)[2][2][4][2], const pg8::Unit& u, int wr, int wc, int, int) const {
        const int ln = fresh_lane(), fr = ln & 15, fq = ln >> 4;
        const int h = u.pn, pm = u.pm;
        bf16* vt; int keys, keybase;
        if (pm < 32) { vt = VTP + (size_t)((pm * 4 + h) * 128) * 256; keys = 256; keybase = 0; }
        else if (pm < 48) { const int b = (pm - 32) >> 2; vt = VTS + (size_t)((b * 4 + h) * 128) * 1536; keys = 1536; keybase = 512 + ((pm - 32) & 3) * 256; }
        else { const int b = (pm - 48) >> 1; vt = VTS + (size_t)((b * 4 + h) * 128) * 1536; keys = 1536; keybase = ((pm - 48) & 1) * 256; }
#pragma unroll
        for (int ai = 0; ai < 2; ++ai)
#pragma unroll
            for (int m = 0; m < 4; ++m) { const int rloc = wr * 64 + fr + ai * 128 + m * 16;
                bf16* kp = KN + (size_t)(pm * 256 + rloc) * 512 + h * 128 + wc * 32 + 4 * fq;
#pragma unroll
                for (int n = 0; n < 2; ++n) *(u32x2*)(kp + 16 * n) = pk4(acc[ai][0][m][n]);
#pragma unroll
                for (int n = 0; n < 2; ++n) { const f32x4 v = acc[ai][1][m][n]; const u32x2 w = pk4(v);
                    bf16* vp = vt + (size_t)(wc * 32 + 16 * n + 4 * fq) * keys + keybase + rloc;
                    vp[0] = (bf16)(w.x & 0xffffu); vp[keys] = (bf16)(w.x >> 16); vp[2 * keys] = (bf16)(w.y & 0xffffu); vp[3 * keys] = (bf16)(w.y >> 16); }
                asm volatile("" ::: "memory");
            }
    }
};

struct Args {
    const float *x_prompt, *x_sample, *cache_ckv, *cache_krope, *c, *c_ctx, *w_ada, *b_ada, *g_pre_mix, *w_in, *g_q, *w_uq, *g_kv, *w_ukv,
                *g_v, *w_s, *b_s, *w_conv, *w_out, *g_post_mix, *g_pre_ffn, *w_ff1, *w_ff2, *g_post_ffn;
    float* out; unsigned char* ws; int ph_lo, ph_hi;
};

__device__ __forceinline__ void p0_transpose_item(const float* W, int K, int N, bf16* WT, LAS float* scr, int item, int lane, float scale = 1.0f) {
    const int nblk = N / 32, kb = item / nblk, nb = item % nblk, k0 = 64 * kb, n0 = 32 * nb;
#pragma unroll 8
    for (int i = 0; i < 32; ++i) { const int kk = 2 * i + (lane >> 5); scr[kk * 33 + (lane & 31)] = W[(size_t)(k0 + kk) * N + n0 + (lane & 31)]; }
    asm volatile("s_waitcnt lgkmcnt(0)" ::: "memory");
    const int c = lane & 7;
#pragma unroll
    for (int j = 0; j < 4; ++j) { const int n = (lane >> 3) + 8 * j; const LAS float* s = scr + (8 * c) * 33 + n;
        u32x4 o; o.x = cvt_pk_bf16(s[0 * 33] * scale, s[1 * 33] * scale); o.y = cvt_pk_bf16(s[2 * 33] * scale, s[3 * 33] * scale); o.z = cvt_pk_bf16(s[4 * 33] * scale, s[5 * 33] * scale); o.w = cvt_pk_bf16(s[6 * 33] * scale, s[7 * 33] * scale);
        *(u32x4*)(WT + (size_t)(n0 + n) * K + k0 + 8 * c) = o; }
    asm volatile("s_waitcnt lgkmcnt(0)" ::: "memory");
}

__device__ __forceinline__ void convert_layer(const Args& A, LAS unsigned char* lds, int l, int gwi, int nw, int wave, int lane) {
    unsigned char* ws = A.ws;
    LAS float* scr = (LAS float*)(lds + wave * 16384);
    constexpr int I_IN = 16 * 62, I_UQ = 6 * 24, I_UKV = 4 * 32, I_OUT = 16 * 32, I_F1 = 16 * 128, I_F2 = 64 * 32, I_L = I_IN + I_UQ + I_UKV + I_OUT + I_F1 + I_F2;
    for (int it = gwi; it < I_L; it += nw) {
        int r = it;
        if (r < I_IN) { p0_transpose_item(A.w_in + (size_t)l * 1024 * INC, 1024, INC, (bf16*)(ws + WS_WIN) + (size_t)l * 2048 * 1024, scr, r, lane); continue; } r -= I_IN;
        if (r < I_UQ) { p0_transpose_item(A.w_uq + (size_t)l * 384 * 768, 384, 768, (bf16*)(ws + WS_WUQ) + (size_t)l * 768 * 384, scr, r, lane, QSCALE); continue; } r -= I_UQ;
        if (r < I_UKV) { p0_transpose_item(A.w_ukv + (size_t)l * 256 * 1024, 256, 1024, (bf16*)(ws + WS_WUKV) + (size_t)l * 1024 * 256, scr, r, lane); continue; } r -= I_UKV;
        if (r < I_OUT) { p0_transpose_item(A.w_out + (size_t)l * 1024 * 1024, 1024, 1024, (bf16*)(ws + WS_WOUT) + (size_t)l * 1024 * 1024, scr, r, lane); continue; } r -= I_OUT;
        if (r < I_F1) { p0_transpose_item(A.w_ff1 + (size_t)l * 1024 * 4096, 1024, 4096, (bf16*)(ws + WS_WFF1) + (size_t)l * 4096 * 1024, scr, r, lane); continue; } r -= I_F1;
        p0_transpose_item(A.w_ff2 + (size_t)l * 4096 * 1024, 4096, 1024, (bf16*)(ws + WS_WFF2) + (size_t)l * 1024 * 4096, scr, r, lane);
    }
}

__device__ __forceinline__ void phase_prologue(const Args& A, LAS unsigned char* lds, int wave) {
    const int lane = fresh_lane(), tid = wave * 64 + lane;
    unsigned char* ws = A.ws;
    const int bid = blockIdx.x, G = gridDim.x;
    { const int gt = bid * 512 + tid;
      if (gt < 32768) { const int n = gt >> 5, a = (gt >> 4) & 1, f = gt & 15; const int pos = a == 0 ? (n >> 6) : (n & 63);
          double inv = 1.0; for (int i = 0; i < f; ++i) inv *= 0.5623413251903491;
          double rev = (double)pos * inv * 0.15915494309189535; rev -= floor(rev);
          const float rf = (float)rev;
          ((float*)(ws + WS_ROPE))[gt] = __builtin_amdgcn_cosf(rf); ((float*)(ws + WS_ROPE))[32768 + gt] = __builtin_amdgcn_sinf(rf); } }
    for (int it = bid; it < 192; it += G) {
        const int l = it / 48, cgp = it % 48;
        LAS float* sl = (LAS float*)lds;
        for (int i = tid; i < 5120; i += 512) { const int ci = i >> 10, k = i & 1023; const float v = ci == 0 ? A.c_ctx[k] : A.c[(ci - 1) * 1024 + k]; sl[i] = v / (1.0f + __expf(-v)); }
        __syncthreads();
        float a0[5], a1[5];
#pragma unroll
        for (int ci = 0; ci < 5; ++ci) { a0[ci] = 0.f; a1[ci] = 0.f; }
        const float* wp = A.w_ada + ((size_t)l * 1024 + wave * 128) * 6144 + cgp * 128 + 2 * lane;
#pragma unroll 8
        for (int kk = 0; kk < 128; ++kk) { const f32x2 wv = *(const f32x2*)(wp + (size_t)kk * 6144); const int k = wave * 128 + kk;
#pragma unroll
            for (int ci = 0; ci < 5; ++ci) { const float s = sl[ci * 1024 + k]; a0[ci] += s * wv.x; a1[ci] += s * wv.y; } }
        LAS float* part = (LAS float*)(lds + 32768);
#pragma unroll
        for (int ci = 0; ci < 5; ++ci) { part[(wave * 5 + ci) * 128 + 2 * lane] = a0[ci]; part[(wave * 5 + ci) * 128 + 2 * lane + 1] = a1[ci]; }
        __syncthreads();
        for (int i = tid; i < 640; i += 512) { const int ci = i >> 7, col = i & 127; float s = 0.f;
#pragma unroll
            for (int w = 0; w < 8; ++w) s += part[(w * 5 + ci) * 128 + col];
            const int gcol = cgp * 128 + col; ((float*)(ws + WS_MOD))[(l * 5 + ci) * 6144 + gcol] = s + A.b_ada[l * 6144 + gcol]; }
        __syncthreads();
    }
    convert_layer(A, lds, 0, bid * 8 + wave, G * 8, wave, lane);
}

__device__ __forceinline__ int cond_of_row(int r) { return r < NTOK_P ? 0 : 1 + ((r - NTOK_P) >> 10); }

__device__ __forceinline__ void norm_mod_store(const f32x4 (&v)[4], const LAS float* g, const LAS float* sc, const LAS float* sh, bf16* hrow, int lane) {
    float ss = 0.f;
#pragma unroll
    for (int j = 0; j < 4; ++j) ss += sumsq4(v[j]);
    const float rstd = 1.0f / sqrtf(wave_sum(ss, lane) * (1.0f / 1024.0f) + EPS);
#pragma unroll
    for (int j = 0; j < 4; ++j) { const int idx = 4 * lane + 256 * j;
        const f32x4 gg = *(const LAS f32x4*)(g + idx), s1 = *(const LAS f32x4*)(sc + idx), s0 = *(const LAS f32x4*)(sh + idx);
        const f32x4 o = v[j] * rstd * gg * (1.0f + s1) + s0;
        *(u32x2*)(hrow + idx) = pk4(o); }
}
__device__ __forceinline__ const float* x_in_row(const Args& A, int r) { return r < NTOK_P ? A.x_prompt + (size_t)r * 1024 : A.x_sample + (size_t)(r - NTOK_P) * 1024; }
__device__ __forceinline__ void fill_vec(LAS float* dst, const float* src, int tid) { if (tid < 256) *(LAS f32x4*)(dst + 4 * tid) = *(const f32x4*)(src + 4 * tid); }

__device__ __forceinline__ void phase_pre(const Args& A, LAS unsigned char* lds, int lane, int wave) {
    const int gw = blockIdx.x * 8 + wave, NGW = gridDim.x * 8;
    const float* mod = (const float*)(A.ws + WS_MOD); bf16* H = (bf16*)(A.ws + WS_H);
    LAS float* P = (LAS float*)lds;
    { const int t2 = (wave & 3) * 64 + lane, hv = wave >> 2;
      for (int v = hv; v < 11; v += 2) { const float* src = v == 0 ? A.g_pre_mix : (v <= 5 ? mod + (size_t)(v - 1) * 6144 + 1024 : mod + (size_t)(v - 6) * 6144);
          const int slot = v == 0 ? 1 : (v <= 5 ? 7 + (v - 1) : 12 + (v - 6));
          *(LAS f32x4*)(P + slot * 1024 + 4 * t2) = *(const f32x4*)(src + 4 * t2); } }
    __syncthreads();
    for (int r0 = gw; r0 < NTOK; r0 += 2 * NGW) {
        f32x4 v[2][4];
#pragma unroll
        for (int u = 0; u < 2; ++u) { const float* xr = x_in_row(A, r0 + u * NGW);
#pragma unroll
            for (int j = 0; j < 4; ++j) v[u][j] = __builtin_nontemporal_load((const f32x4*)(xr + 4 * lane + 256 * j)); }
#pragma unroll
        for (int u = 0; u < 2; ++u) { const int r = r0 + u * NGW, ci = cond_of_row(r);
            norm_mod_store(v[u], P + 1024, P + (7 + ci) * 1024, P + (12 + ci) * 1024, H + (size_t)r * 1024, lane); }
    }
    __syncthreads();
}

__device__ __forceinline__ void phase_post(const Args& A, int l, int which, LAS unsigned char* lds, int lane, int wave) {
    const int gw = blockIdx.x * 8 + wave, NGW = gridDim.x * 8;
    const float* mod = (const float*)(A.ws + WS_MOD); bf16* H = (bf16*)(A.ws + WS_H); const bf16* MIX = (const bf16*)(A.ws + WS_MIX);
    const bool first = (l == 0 && which == 0), has_h = (which == 0) || (l < DEPTH - 1), last = (l == DEPTH - 1 && which == 1);
    bf16* XB = (bf16*)(A.ws + WS_XB);
    LAS float* P = (LAS float*)lds;
    f32x4 rxf[2][4]; u32x2 rxb[2][4], rt[2][4];
#define POST_LOAD(r0_) do { _Pragma("unroll") for (int u = 0; u < 2; ++u) { const int r_ = (r0_) + u * NGW; \
        if (first) { const float* xr_ = x_in_row(A, r_); _Pragma("unroll") for (int j = 0; j < 4; ++j) rxf[u][j] = __builtin_nontemporal_load((const f32x4*)(xr_ + 4 * lane + 256 * j)); } \
        else { const bf16* xr_ = XB + (size_t)r_ * 1024; _Pragma("unroll") for (int j = 0; j < 4; ++j) rxb[u][j] = __builtin_nontemporal_load((const u32x2*)(xr_ + 4 * lane + 256 * j)); } \
        const bf16* tr_ = MIX + (size_t)r_ * 1024; _Pragma("unroll") for (int j = 0; j < 4; ++j) rt[u][j] = __builtin_nontemporal_load((const u32x2*)(tr_ + 4 * lane + 256 * j)); } } while (0)
#pragma unroll
    for (int u = 0; u < 2; ++u)
#pragma unroll
        for (int j = 0; j < 4; ++j) { rxf[u][j] = (f32x4){0.f, 0.f, 0.f, 0.f}; rxb[u][j] = (u32x2){0u, 0u}; }
    POST_LOAD(gw);
    { const int t2 = (wave & 3) * 64 + lane, hv = wave >> 2;
      const int l2 = which == 0 ? l : l + 1;
      const int l2c = l2 < DEPTH ? l2 : l, gofs = which == 0 ? 2048 : 5120, sofs = which == 0 ? 4096 : 1024, hofs = which == 0 ? 3072 : 0;
      const float* g01 = hv == 0 ? (which == 0 ? A.g_post_mix : A.g_post_ffn) + l * 1024 : (which == 0 ? A.g_pre_ffn + l * 1024 : A.g_pre_mix + l2c * 1024);
      f32x4 tmp[9];
      tmp[0] = *(const f32x4*)(g01 + 4 * t2);
#pragma unroll
      for (int vv = 1; vv < 9; ++vv) { const int v0 = hv + 2 * vv, v = v0 < 17 ? v0 : 16;
          const int off = v < 7 ? (l * 5 + (v - 2)) * 6144 + gofs : (v < 12 ? (l2c * 5 + (v - 7)) * 6144 + sofs : (l2c * 5 + (v - 12)) * 6144 + hofs);
          tmp[vv] = *(const f32x4*)(mod + off + 4 * t2); }
      __builtin_amdgcn_sched_barrier(0);
#pragma unroll
      for (int vv = 0; vv < 9; ++vv) { const int v = hv + 2 * vv; if (v < 17) *(LAS f32x4*)(P + v * 1024 + 4 * t2) = tmp[vv]; } }
    __syncthreads();
    for (int r0 = gw; r0 < NTOK; r0 += 2 * NGW) {
        f32x4 v[2][4], t[2][4];
#pragma unroll
        for (int u = 0; u < 2; ++u)
#pragma unroll
            for (int j = 0; j < 4; ++j) { v[u][j] = first ? rxf[u][j] : bf4(rxb[u][j]); t[u][j] = bf4(rt[u][j]); }
        if (r0 + 2 * NGW < NTOK) POST_LOAD(r0 + 2 * NGW);
#pragma unroll
        for (int u = 0; u < 2; ++u) { const int r = r0 + u * NGW; const LAS float* ga = P + (2 + cond_of_row(r)) * 1024;
            float ss = 0.f;
#pragma unroll
            for (int j = 0; j < 4; ++j) ss += sumsq4(t[u][j]);
            const float rstd = 1.0f / sqrtf(wave_sum(ss, lane) * (1.0f / 1024.0f) + EPS);
#pragma unroll
            for (int j = 0; j < 4; ++j) { const int idx = 4 * lane + 256 * j;
                const f32x4 gg = *(const LAS f32x4*)(P + idx), gv = *(const LAS f32x4*)(ga + idx);
                v[u][j] = v[u][j] + gv * (t[u][j] * rstd * gg);
                if (last) __builtin_nontemporal_store(v[u][j], (f32x4*)(A.out + (size_t)r * 1024 + idx));
                else __builtin_nontemporal_store(pk4(v[u][j]), (u32x2*)(XB + (size_t)r * 1024 + idx)); } }
        if (has_h) {
#pragma unroll
            for (int u = 0; u < 2; ++u) { const int r = r0 + u * NGW, ci = cond_of_row(r);
                norm_mod_store(v[u], P + 1024, P + (7 + ci) * 1024, P + (12 + ci) * 1024, H + (size_t)r * 1024, lane); } }
    }
    __syncthreads();
}

#undef POST_LOAD
__device__ __forceinline__ void phase_split(const Args& A, int l, int lane, int wave) {
    const int gw = blockIdx.x * 8 + wave, NGW = gridDim.x * 8;
    unsigned char* ws = A.ws;
    const bf16* Z = (const bf16*)(ws + WS_Z);
    bf16* QN = (bf16*)(ws + WS_QN); bf16* CKVN = (bf16*)(ws + WS_CKVN); bf16* KRB = (bf16*)(ws + WS_KRB); bf16* UG = (bf16*)(ws + WS_UG); bf16* VN = (bf16*)(ws + WS_VN);
    bf16* CC = (bf16*)(ws + WS_CONCAT);
    const float* ropec = (const float*)(ws + WS_ROPE); const float* ropes = ropec + 32768;
    float* out_ckv = A.out + (size_t)NTOK * 1024; float* out_kr = out_ckv + (size_t)32 * 4 * 256 * 256;
    for (int idx = gw; idx < 2048; idx += NGW) { const int r = NTOK + idx, b = idx >> 9, j = idx & 511;
        const f32x4 cv = *(const f32x4*)(A.cache_ckv + ((size_t)(b * 4 + l) * 512 + j) * 256 + 4 * lane);
        const float kv = A.cache_krope[((size_t)(b * 4 + l) * 512 + j) * 64 + lane];
        *(u32x2*)(CKVN + (size_t)r * 256 + 4 * lane) = pk4(cv);
        KRB[(size_t)r * 64 + lane] = (bf16)(cvt_pk_bf16(kv, 0.f) & 0xffffu); }
    const f32x4 gkv = *(const f32x4*)(A.g_kv + l * 256 + 4 * lane), gvv = *(const f32x4*)(A.g_v + l * 256 + 4 * lane);
    const float* wcp = A.w_conv + (size_t)l * 3 * 256 + 4 * lane;
    const f32x4 wc0 = *(const f32x4*)(wcp), wc1 = *(const f32x4*)(wcp + 256), wc2 = *(const f32x4*)(wcp + 512);
    f32x2 gq[3];
#pragma unroll
    for (int j = 0; j < 3; ++j) gq[j] = *(const f32x2*)(A.g_q + l * 384 + 2 * lane + 128 * j);
    for (int r0 = gw; r0 < NTOK; r0 += 2 * NGW) {
        f32x2 q[2][3]; f32x4 cv[2], uu[2], vv[2], bg[2], zc[2], zm[2], zp[2]; float kr[2], cs[2], sn[2];
#pragma unroll
        for (int u = 0; u < 2; ++u) { const int r = r0 + u * NGW; const bf16* z = Z + (size_t)r * INC;
            const bool prompt = r < NTOK_P; const int n = prompt ? (r & 255) : ((r - NTOK_P) & 1023), len = prompt ? 256 : 1024;
#pragma unroll
            for (int j = 0; j < 3; ++j) q[u][j] = ld2bf(z + ZQ + 2 * lane + 128 * j);
            cv[u] = ld4bf(z + ZCKV + 4 * lane); kr[u] = ld1bf(z + ZKR + lane);
            uu[u] = ld4bf(z + ZU + 4 * lane); vv[u] = ld4bf(z + ZV + 4 * lane); bg[u] = ld4bf(z + ZBG + 4 * lane);
            zc[u] = ld4bf(z + ZCG + 4 * lane) * ld4bf(z + ZHH + 4 * lane);
            zm[u] = (f32x4){0.f, 0.f, 0.f, 0.f}; zp[u] = zm[u];
            if (n > 0) zm[u] = ld4bf(z - INC + ZCG + 4 * lane) * ld4bf(z - INC + ZHH + 4 * lane);
            if (n < len - 1) zp[u] = ld4bf(z + INC + ZCG + 4 * lane) * ld4bf(z + INC + ZHH + 4 * lane);
            cs[u] = 1.f; sn[u] = 0.f;
            if (!prompt) { const int a = lane >> 5, f = lane & 15; cs[u] = ropec[n * 32 + a * 16 + f]; sn[u] = ropes[n * 32 + a * 16 + f]; } }
#pragma unroll
        for (int u = 0; u < 2; ++u) { const int r = r0 + u * NGW; const bool prompt = r < NTOK_P; const int n = prompt ? (r & 255) : ((r - NTOK_P) & 1023);
            { float ss = 0.f;
#pragma unroll
              for (int j = 0; j < 3; ++j) ss += q[u][j].x * q[u][j].x + q[u][j].y * q[u][j].y;
              const float rstd = 1.0f / sqrtf(wave_sum(ss, lane) * (1.0f / 384.0f) + EPS);
#pragma unroll
              for (int j = 0; j < 3; ++j) *(unsigned*)(QN + (size_t)r * 384 + 2 * lane + 128 * j) = cvt_pk_bf16(q[u][j].x * rstd * gq[j].x, q[u][j].y * rstd * gq[j].y); }
            { const float rstd = 1.0f / sqrtf(wave_sum(sumsq4(cv[u]), lane) * (1.0f / 256.0f) + EPS);
              const f32x4 c2 = cv[u] * rstd * gkv;
              if (prompt) __builtin_nontemporal_store(c2, (f32x4*)(out_ckv + ((size_t)((r >> 8) * 4 + l) * 256 + n) * 256 + 4 * lane));
              *(u32x2*)(CKVN + (size_t)r * 256 + 4 * lane) = pk4(c2); }
            { float k2 = kr[u];
              if (prompt) __builtin_nontemporal_store(k2, out_kr + ((size_t)((r >> 8) * 4 + l) * 256 + n) * 64 + lane);
              else { const float partner = shx(k2, 16, lane); const int p = (lane >> 4) & 1;
                  k2 = p == 0 ? k2 * cs[u] - partner * sn[u] : partner * sn[u] + k2 * cs[u]; }
              KRB[(size_t)r * 64 + lane] = (bf16)(cvt_pk_bf16(k2, 0.f) & 0xffffu); }
            *(u32x2*)(UG + (size_t)r * 256 + 4 * lane) = pk4(gelu4(uu[u]));
            { f32x4 v = gelu4(vv[u]);
              const float rstd = 1.0f / sqrtf(wave_sum(sumsq4(v), lane) * (1.0f / 256.0f) + EPS);
              *(u32x2*)(VN + (size_t)r * 256 + 4 * lane) = pk4(v * rstd * gvv); }
            { const f32x4 y = zm[u] * wc0 + zc[u] * wc1 + zp[u] * wc2;
              *(u32x2*)(CC + (size_t)r * 1024 + 768 + 4 * lane) = pk4(bg[u] * y); }
        }
    }
}

#define MFMA32(a, b, c) __builtin_amdgcn_mfma_f32_32x32x16_bf16((a), (b), (c), 0, 0, 0)
constexpr int AT_KROW = 400, AT_VROW = 144, AT_KBYTES = 64 * AT_KROW, AT_STAGE = AT_KBYTES + 128 * AT_VROW;
__device__ __forceinline__ void attn_store_tile(const f32x16& ot, float inv, bf16* crow  , int t, int hh) {
#pragma unroll
    for (int g = 0; g < 4; ++g) { u32x2 w; w.x = cvt_pk_bf16(ot[4 * g] * inv, ot[4 * g + 1] * inv); w.y = cvt_pk_bf16(ot[4 * g + 2] * inv, ot[4 * g + 3] * inv);
        *(u32x2*)(crow + 32 * t + 8 * g + 4 * hh) = w; }
}

__device__ __forceinline__ void phase_mixer(const Args& A, int l, LAS unsigned char* lds, int lane_in, int wave) {
    unsigned char* ws = A.ws;
    const bf16* Q = (const bf16*)(ws + WS_Q); const bf16* KN = (const bf16*)(ws + WS_KNOPE); const bf16* KRB = (const bf16*)(ws + WS_KRB);
    const bf16* VTP = (const bf16*)(ws + WS_VTP); const bf16* VTS = (const bf16*)(ws + WS_VTS);
    const bf16* UG = (const bf16*)(ws + WS_UG); const bf16* VN = (const bf16*)(ws + WS_VN);
    bf16* CC = (bf16*)(ws + WS_CONCAT);
    for (int slot = 0; ; ++slot) {
        int it;
        if (gridDim.x == 256) {
            if (slot == 0) it = blockIdx.x; else if (slot == 1 && blockIdx.x >= 128 && blockIdx.x < 224) it = 256 + (int)blockIdx.x - 128; else break;
        } else { it = (int)blockIdx.x + slot * (int)gridDim.x; if (it >= 352) break; }
        int lane = lane_in; asm volatile("" : "+v"(lane));
        const int rho = lane & 31, hh = lane >> 5, tid = wave * 64 + lane;
        if (it < 256) {
            int h, q0, keys, nkeys, split, rowA, rowB; const bf16* vt;
            const bool heavy = it < 128;
            if (heavy) {
                const int xj = it >> 3, pr = 2 * (it & 7) + (xj >> 3), b = pr >> 2, qt = xj & 7; h = pr & 3;
                q0 = NTOK_P + b * 1024 + qt * 128 + (wave & 3) * 32; keys = 1536; nkeys = 1536; split = 512; rowA = NTOK + b * 512; rowB = NTOK_P + b * 1024;
                vt = VTS + (size_t)((b * 4 + h) * 128) * 1536; }
            else { const int i2 = it - 128, b = i2 >> 2; h = i2 & 3; q0 = b * 256 + wave * 32; keys = 256; nkeys = 256; split = 0; rowA = 0; rowB = b * 256;
                vt = VTP + (size_t)((b * 4 + h) * 128) * 256; }
            bf16x8 qf[12];
            { const bf16* qp = Q + (size_t)(q0 + rho) * 768 + h * 192 + 8 * hh;
#pragma unroll
              for (int ks = 0; ks < 12; ++ks) qf[ks] = *(const bf16x8*)(qp + 16 * ks); }
            if (heavy) {
                const float* ropec = (const float*)(ws + WS_ROPE); const int ntok = (q0 + rho - NTOK_P) & 1023;
#pragma unroll
                for (int a = 0; a < 2; ++a) { const float* cp = ropec + ntok * 32 + a * 16 + 8 * hh;
                    const f32x4 c0 = *(const f32x4*)cp, c1 = *(const f32x4*)(cp + 4), s0 = *(const f32x4*)(cp + 32768), s1 = *(const f32x4*)(cp + 32768 + 4);
                    const u32x4 w1 = __builtin_bit_cast(u32x4, qf[8 + 2 * a]), w2 = __builtin_bit_cast(u32x4, qf[9 + 2 * a]); u32x4 r1, r2;
#pragma unroll
                    for (int j = 0; j < 4; ++j) { const float x1l = __uint_as_float(w1[j] << 16), x1h = __uint_as_float(w1[j] & 0xffff0000u), x2l = __uint_as_float(w2[j] << 16), x2h = __uint_as_float(w2[j] & 0xffff0000u);
                        const float cl = j < 2 ? c0[2 * j] : c1[2 * j - 4], ch = j < 2 ? c0[2 * j + 1] : c1[2 * j - 3], sl = j < 2 ? s0[2 * j] : s1[2 * j - 4], sh = j < 2 ? s0[2 * j + 1] : s1[2 * j - 3];
                        r1[j] = cvt_pk_bf16(x1l * cl - x2l * sl, x1h * ch - x2h * sh); r2[j] = cvt_pk_bf16(x1l * sl + x2l * cl, x1h * sh + x2h * ch); }
                    qf[8 + 2 * a] = __builtin_bit_cast(bf16x8, r1); qf[9 + 2 * a] = __builtin_bit_cast(bf16x8, r2); }
            }
            f32x16 o[4];
#pragma unroll
            for (int t = 0; t < 4; ++t)
#pragma unroll
                for (int i = 0; i < 16; ++i) o[t][i] = 0.f;
            float m = 0.f, lsum = 0.f; bool fresh = true;
            int kslot[2], kcol[2], vd[2], vc[2];
#pragma unroll
            for (int j = 0; j < 2; ++j) { const int c = tid + 512 * j, kap = c >> 4; kcol[j] = c & 15;
                kslot[j] = (kap & 32) + (kap & 3) + 4 * ((kap >> 4) & 1) + 8 * ((kap >> 2) & 3);
                vd[j] = c >> 3; vc[j] = c & 7; }
            const int rkap = tid >> 3, rc8 = tid & 7, rslot = (rkap & 32) + (rkap & 3) + 4 * ((rkap >> 4) & 1) + 8 * ((rkap >> 2) & 3);
            u32x4 sk[2], sr, sv[2];
#define AT_GLOAD(k0) do { const int rb_ = (k0) < split ? rowA + (k0) : rowB + ((k0) - split); \
                _Pragma("unroll") for (int j = 0; j < 2; ++j) sk[j] = *(const u32x4*)(KN + (size_t)(rb_ + ((tid + 512 * j) >> 4)) * 512 + h * 128 + kcol[j] * 8); \
                sr = *(const u32x4*)(KRB + (size_t)(rb_ + rkap) * 64 + rc8 * 8); \
                _Pragma("unroll") for (int j = 0; j < 2; ++j) sv[j] = *(const u32x4*)(vt + (size_t)vd[j] * keys + (k0) + vc[j] * 8); } while (0)
#define AT_SWRITE(buf) do { LAS unsigned char* sb_ = lds + (buf) * AT_STAGE; \
                _Pragma("unroll") for (int j = 0; j < 2; ++j) *(LAS u32x4*)(sb_ + kslot[j] * AT_KROW + kcol[j] * 16) = sk[j]; \
                *(LAS u32x4*)(sb_ + rslot * AT_KROW + 256 + rc8 * 16) = sr; \
                _Pragma("unroll") for (int j = 0; j < 2; ++j) *(LAS u32x4*)(sb_ + AT_KBYTES + vd[j] * AT_VROW + vc[j] * 16) = sv[j]; } while (0)
            const int ntile = nkeys >> 6;
            const int blk_lo = heavy ? (wave >> 2) : 0, blk_hi = heavy ? blk_lo + 1 : 2;
            AT_GLOAD(0); AT_SWRITE(0);
            __syncthreads();
            for (int tI = 0; tI < ntile; ++tI) {
                if (tI + 1 < ntile) AT_GLOAD((tI + 1) * 64);
                { const LAS unsigned char* sb = lds + (tI & 1) * AT_STAGE;
                for (int blk = blk_lo; blk < blk_hi; ++blk) {
                    const LAS unsigned char* kp = sb + (32 * blk + rho) * AT_KROW + hh * 16;
                    f32x16 sc;
#pragma unroll
                    for (int i = 0; i < 16; ++i) sc[i] = -m;
                    bf16x8 kf[12];
#pragma unroll
                    for (int ks = 0; ks < 12; ++ks) kf[ks] = *(const LAS bf16x8*)(kp + ks * 32);
                    __builtin_amdgcn_sched_barrier(0);
#pragma unroll
                    for (int ks = 0; ks < 12; ++ks) sc = MFMA32(kf[ks], qf[ks], sc);
                    const LAS unsigned char* vp = sb + AT_KBYTES + rho * AT_VROW + (32 * blk + 16 * hh) * 2;
                    bf16x8 vf[8];
#pragma unroll
                    for (int t = 0; t < 4; ++t)
#pragma unroll
                        for (int s2 = 0; s2 < 2; ++s2) vf[t * 2 + s2] = *(const LAS bf16x8*)(vp + 32 * t * AT_VROW + 16 * s2);
                    __builtin_amdgcn_sched_barrier(0);
                    float mx = sc[0];
#pragma unroll
                    for (int i = 1; i < 16; ++i) mx = fmaxf(mx, sc[i]);
                    { const auto rr = __builtin_amdgcn_permlane32_swap(__float_as_uint(mx), __float_as_uint(mx), false, false); mx = fmaxf(__uint_as_float(rr[0]), __uint_as_float(rr[1])); }
                    if (fresh || __builtin_amdgcn_ballot_w64(mx > 8.0f) != 0ull) { const float delta = fresh ? mx : fmaxf(mx, 0.f), alpha = fresh ? 0.f : __builtin_amdgcn_exp2f(-delta); m += delta; lsum *= alpha; fresh = false;
#pragma unroll
                        for (int i = 0; i < 16; ++i) sc[i] -= delta;
#pragma unroll
                        for (int t = 0; t < 4; ++t) o[t] = o[t] * alpha; }
                    float ps = 0.f;
#pragma unroll
                    for (int i = 0; i < 16; ++i) { sc[i] = __builtin_amdgcn_exp2f(sc[i]); ps += sc[i]; }
                    lsum += ps;
                    bf16x8 pb[2];
#pragma unroll
                    for (int s2 = 0; s2 < 2; ++s2) { u32x4 w; w.x = cvt_pk_bf16(sc[8 * s2 + 0], sc[8 * s2 + 1]); w.y = cvt_pk_bf16(sc[8 * s2 + 2], sc[8 * s2 + 3]); w.z = cvt_pk_bf16(sc[8 * s2 + 4], sc[8 * s2 + 5]); w.w = cvt_pk_bf16(sc[8 * s2 + 6], sc[8 * s2 + 7]);
                        pb[s2] = __builtin_bit_cast(bf16x8, w); }
#pragma unroll
                    for (int s2 = 0; s2 < 2; ++s2)
#pragma unroll
                        for (int t = 0; t < 4; ++t) o[t] = MFMA32(vf[t * 2 + s2], pb[s2], o[t]);
                }
                }
                if (tI + 1 < ntile) AT_SWRITE((tI + 1) & 1);
                __syncthreads();
            }
#undef AT_GLOAD
#undef AT_SWRITE
            lsum += shx(lsum, 32, lane);
            bf16* crow = CC + (size_t)(q0 + rho) * 1024 + h * 128;
            if (!heavy) { const float inv = 1.0f / lsum;
#pragma unroll
                for (int t = 0; t < 4; ++t) attn_store_tile(o[t], inv, crow, t, hh);
            } else {
                const int half = wave >> 2;
                LAS float* mine = (LAS float*)(lds + wave * 8704);
                LAS const float* theirs = (LAS const float*)(lds + (wave ^ 4) * 8704);
#pragma unroll
                for (int t2 = 0; t2 < 2; ++t2)
#pragma unroll
                    for (int i = 0; i < 16; ++i) mine[(t2 * 16 + i) * 64 + lane] = half == 0 ? o[2 + t2][i] : o[t2][i];
                if (hh == 0) { mine[2048 + rho] = m; mine[2080 + rho] = lsum; }
                __syncthreads();
                const float mp = theirs[2048 + rho], lp = theirs[2080 + rho];
                const float mg = fmaxf(m, mp), wo = __builtin_amdgcn_exp2f(m - mg), wp = __builtin_amdgcn_exp2f(mp - mg);
                const float inv = 1.0f / (wo * lsum + wp * lp);
#pragma unroll
                for (int t2 = 0; t2 < 2; ++t2) { f32x16 acc;
#pragma unroll
                    for (int i = 0; i < 16; ++i) acc[i] = wo * (half == 0 ? o[t2][i] : o[2 + t2][i]) + wp * theirs[(t2 * 16 + i) * 64 + lane];
                    attn_store_tile(acc, inv, crow, half * 2 + t2, hh); }
                __syncthreads();
            }
        } else {
            const int c = it - 256;
            const int hd = wave & 3, ph = wave >> 2;
            const float* wbase = A.w_s + ((size_t)(l * 4 + hd) * 128 + 64 * ph + rho) * 128 + 8 * hh;
            f32x4 wva[16], wvb[16];
#pragma unroll
            for (int ks = 0; ks < 8; ++ks) { wva[2 * ks] = *(const f32x4*)(wbase + 16 * ks); wva[2 * ks + 1] = *(const f32x4*)(wbase + 16 * ks + 4); }
            LAS bf16* vnT = (LAS bf16*)lds;
            { bf16x8 vv[8];
#pragma unroll
              for (int pass = 0; pass < 8; ++pass) { const int u = wave + 8 * pass, qq = (u & 1) * 64 + lane, c8 = (u >> 1) * 8; vv[pass] = *(const bf16x8*)(VN + (size_t)(c * 128 + qq) * 256 + c8); }
#pragma unroll
              for (int pass = 0; pass < 8; ++pass) { const int u = wave + 8 * pass, qq = (u & 1) * 64 + lane, c8 = (u >> 1) * 8;
#pragma unroll
                for (int j = 0; j < 8; ++j) vnT[(c8 + j) * 136 + qq] = (bf16)vv[pass][j]; } }
            __syncthreads();
#pragma unroll
            for (int pp = 0; pp < 2; ++pp) { const int pt = 2 * ph + pp;
                bf16x8 af[8];
#pragma unroll
                for (int ks = 0; ks < 8; ++ks) { const f32x4 w0 = pp == 0 ? wva[2 * ks] : wvb[2 * ks], w1 = pp == 0 ? wva[2 * ks + 1] : wvb[2 * ks + 1];
                    u32x4 w; w.x = cvt_pk_bf16(w0.x, w0.y); w.y = cvt_pk_bf16(w0.z, w0.w); w.z = cvt_pk_bf16(w1.x, w1.y); w.w = cvt_pk_bf16(w1.z, w1.w); af[ks] = __builtin_bit_cast(bf16x8, w); }
                if (pp == 0) {
#pragma unroll
                    for (int ks = 0; ks < 8; ++ks) { wvb[2 * ks] = *(const f32x4*)(wbase + 32 * 128 + 16 * ks); wvb[2 * ks + 1] = *(const f32x4*)(wbase + 32 * 128 + 16 * ks + 4); } }
                float bs[16]; bf16 ugv[2][16];
#pragma unroll
                for (int i = 0; i < 16; ++i) { const int p = 32 * pt + (i & 3) + 8 * (i >> 2) + 4 * hh; bs[i] = A.b_s[(l * 4 + hd) * 128 + p];
#pragma unroll
                    for (int d = 0; d < 2; ++d) ugv[d][i] = UG[((size_t)c * 128 + p) * 256 + hd * 64 + 32 * d + rho]; }
                f32x16 acc[2];
#pragma unroll
                for (int d = 0; d < 2; ++d)
#pragma unroll
                    for (int i = 0; i < 16; ++i) acc[d][i] = 0.f;
#pragma unroll
                for (int ks = 0; ks < 8; ++ks)
#pragma unroll
                    for (int d = 0; d < 2; ++d) { const bf16x8 bfr = *(const LAS bf16x8*)(vnT + (hd * 64 + 32 * d + rho) * 136 + 16 * ks + 8 * hh); acc[d] = MFMA32(af[ks], bfr, acc[d]); }
#pragma unroll
                for (int d = 0; d < 2; ++d) { const int col = hd * 64 + 32 * d + rho;
#pragma unroll
                    for (int i = 0; i < 16; ++i) { const int p = 32 * pt + (i & 3) + 8 * (i >> 2) + 4 * hh; const size_t row = (size_t)c * 128 + p;
                        const float mixed = acc[d][i] + bs[i];
                        const float ug = __uint_as_float((unsigned)ugv[d][i] << 16);
                        CC[row * 1024 + 512 + col] = (bf16)(cvt_pk_bf16(ug * mixed, 0.f) & 0xffffu); } }
            }
            __syncthreads();
        }
    }
}

__global__ void __launch_bounds__(512, 2) fwd_megakernel(Args A) {
    extern __shared__ __attribute__((aligned(16))) unsigned char smem[];
    LAS unsigned char* lds = (LAS unsigned char*)smem;
    const int wave0 = __builtin_amdgcn_readfirstlane((int)threadIdx.x >> 6);
    unsigned* const bar = (unsigned*)(A.ws + WS_BAR);
    volatile LAS unsigned* const barst = (volatile LAS unsigned*)(lds + LDS_BARST);
    const unsigned xcc = xb_xcc_id();
    if (wave0 == 0) { const int l0 = fresh_lane(); if (l0 < 2) barst[l0] = 0u; if (l0 == 0 && A.ph_hi - A.ph_lo > 1) (void)xb_add(&bar[XB_XCNT(xcc)], 1u); }
    __syncthreads();
    if (A.ph_lo < 0) cg::this_grid().sync();
    bool dup_done = false; (void)dup_done;
    for (int ph = A.ph_lo; ph < A.ph_hi; ++ph) {
        const int wave = wave0;
#define LANE fresh_lane()
#define TID (wave * 64 + fresh_lane())
        unsigned char* ws = A.ws; asm volatile("" : "+s"(ws));
        if (ph == 0) phase_prologue(A, lds, wave);
        else if (ph == 1) phase_pre(A, lds, LANE, wave);
        else {
            const int l = (ph - 2) / 9, k = (ph - 2) % 9;
            const int G = gridDim.x, bid = blockIdx.x;
            if (k == 0) {
                pg8::Gemm g{(const bf16*)(ws + WS_H), (const bf16*)(ws + WS_WIN) + (size_t)l * 2048 * 1024, NTOK, 2048, 1024}; pg8::StaticOrder S; S.init(NTOK, 2048, G, bid);
                EpiB16<0> E{(bf16*)(ws + WS_Z), INC, INC}; pg8::gemm_phase<EpiB16<0>, pg8::StaticOrder, true>(lds, g, S, E, TID);
            } else if (k == 1) phase_split(A, l, LANE, wave);
            else if (k == 2) {
                { pg8::Gemm g{(const bf16*)(ws + WS_QN), (const bf16*)(ws + WS_WUQ) + (size_t)l * 768 * 384, NTOK, 768, 384}; pg8::StaticOrder S; S.init(NTOK, 768, G, bid);
                  EpiB16<0> E{(bf16*)(ws + WS_Q), 768, 768}; pg8::gemm_phase<EpiB16<0>, pg8::StaticOrder, false>(lds, g, S, E, TID); }
                { pg8::Gemm g{(const bf16*)(ws + WS_CKVN), (const bf16*)(ws + WS_WUKV) + (size_t)l * 1024 * 256, NROWKV, 1024, 256}; pg8::StaticOrder S; S.init(NROWKV, 1024, G, (bid + G - 144 % G) % G);
                  EpiKV E{(bf16*)(ws + WS_KNOPE), (bf16*)(ws + WS_VTP), (bf16*)(ws + WS_VTS)}; pg8::gemm_phase<EpiKV, pg8::StaticOrder, false>(lds, g, S, E, TID); }
            } else if (k == 3) phase_mixer(A, l, lds, LANE, wave);
            else if (k == 4 || k == 7) {
                const bool o = (k == 4);
                pg8::Gemm g{(const bf16*)(ws + (o ? WS_CONCAT : WS_ACT)), o ? (const bf16*)(ws + WS_WOUT) + (size_t)l * 1024 * 1024 : (const bf16*)(ws + WS_WFF2) + (size_t)l * 1024 * 4096, NTOK, 1024, o ? 1024 : 4096};
                pg8::StaticOrder S; S.init(NTOK, 1024, G, bid);
                EpiB16<0> E{(bf16*)(ws + WS_MIX), 1024, 1024}; pg8::gemm_phase<EpiB16<0>, pg8::StaticOrder, true>(lds, g, S, E, TID);
                if (!o && l + 1 < DEPTH) { const int first = G > 192 ? 192 : 0;
                    if (bid >= first) convert_layer(A, lds, l + 1, (bid - first) * 8 + wave, (G - first) * 8, wave, LANE); }
            } else if (k == 5) phase_post(A, l, 0, lds, LANE, wave);
            else if (k == 6) {
                pg8::Gemm g{(const bf16*)(ws + WS_H), (const bf16*)(ws + WS_WFF1) + (size_t)l * 4096 * 1024, NTOK, 4096, 1024}; pg8::StaticOrder S; S.init(NTOK, 4096, G, bid);
                EpiB16<1> E{(bf16*)(ws + WS_ACT), 4096, 4096}; pg8::gemm_phase<EpiB16<1>, pg8::StaticOrder, true>(lds, g, S, E, TID);
            } else phase_post(A, l, 1, lds, LANE, wave);
        }
        if (ph + 1 < A.ph_hi) xcd_barrier(bar, xcc, barst, wave == 0 && fresh_lane() == 0);
#if PROBE_DUP >= 0
        {
            bool again = false;
            if (PROBE_DUP == 100) { if (ph + 1 < A.ph_hi) xcd_barrier(bar, xcc, barst, wave == 0 && fresh_lane() == 0); }
            else if (!dup_done) {
                const int kk = ph >= 2 ? (ph - 2) % 9 : -1;
                if (PROBE_DUP == 50) again = (ph == 0);
                else if (PROBE_DUP == 60) again = (kk == 0 || kk == 2 || kk == 4 || kk == 6 || kk == 7);
                else again = (kk == PROBE_DUP);
            }
            if (again) { dup_done = true; --ph; } else dup_done = false;
        }
#endif
    }
}

constexpr int N_PHASES = 2 + 9 * DEPTH;

extern "C" void kernel_launch(void* const* d_in, const int* in_sizes, int n_in, void* d_out, int out_size, void* d_ws, size_t ws_size, hipStream_t stream) {
    static int grid = 0;
    if (grid == 0) {
        if (n_in != 24 || ws_size < WS_END || in_sizes[9] != DEPTH * 1024 * INC) { fprintf(stderr, "kernel_launch: unexpected problem (n_in %d, ws %zu, w_in %d)\n", n_in, ws_size, n_in > 9 ? in_sizes[9] : -1); grid = -1; return; }
        int dev = 0, cus = 0, per_cu = 0;
        hipGetDevice(&dev); hipDeviceGetAttribute(&cus, hipDeviceAttributeMultiprocessorCount, dev);
        if (hipFuncSetAttribute((const void*)fwd_megakernel, hipFuncAttributeMaxDynamicSharedMemorySize, LDS_BYTES) != hipSuccess) { fprintf(stderr, "kernel_launch: hipFuncSetAttribute failed\n"); grid = -1; return; }
        if (hipOccupancyMaxActiveBlocksPerMultiprocessor(&per_cu, (const void*)fwd_megakernel, 512, LDS_BYTES) != hipSuccess || per_cu < 1) { fprintf(stderr, "kernel_launch: occupancy query says %d\n", per_cu); per_cu = 1; }
        (void)hipGetLastError();
        grid = cus * 1;
        fprintf(stderr, "kernel_launch: grid %d (cus %d, per_cu %d)\n", grid, cus, per_cu);
    }
    if (grid < 0) return;
    if (hipMemsetAsync((char*)d_ws + WS_BAR, 0, 16384, stream) != hipSuccess) { fprintf(stderr, "kernel_launch: memset failed\n"); return; }
    Args a{};
    const float** ap = (const float**)&a;
    for (int i = 0; i < 24; ++i) ap[i] = (const float*)d_in[i];
    a.out = (float*)d_out; a.ws = (unsigned char*)d_ws;
#if MK_PER_PHASE
    for (int ph = 0; ph < N_PHASES; ++ph) { a.ph_lo = ph; a.ph_hi = ph + 1; hipLaunchKernelGGL(fwd_megakernel, dim3(grid), dim3(512), LDS_BYTES, stream, a); }
#else
    a.ph_lo = 0; a.ph_hi = N_PHASES;
    void* args[] = {&a};
    hipError_t e = hipLaunchCooperativeKernel((const void*)fwd_megakernel, dim3(grid), dim3(512), args, LDS_BYTES, stream);
    if (e != hipSuccess) fprintf(stderr, "kernel_launch: cooperative launch failed: %s (grid %d)\n", hipGetErrorString(e), grid);
#endif
}
```
